# Optimizing an MI355X kernel written in HIP

```python
import math
import jax, jax.numpy as jnp
from jax import lax
import numpy as np

D_MODEL = 1024
BATCH = 16
SEQ = 2048
DEPTH = 4

CHUNK = 64
MIX_WIDTH = D_MODEL
A_WIDTH = MIX_WIDTH // 2
B_WIDTH = MIX_WIDTH - A_WIDTH
A_HEADS = 4
A_HEAD_DIM = A_WIDTH // A_HEADS
SPATIAL_CHUNK = 128
DIFF_HEADS = 4
DIFF_HEAD_DIM = B_WIDTH // (2 * DIFF_HEADS)
Q_BLOCK = 128
D_FF = 2816
CONV_WIDTH = 3
EPS = 1e-6
IN_WIDTH = 2 * A_WIDTH + 3 * B_WIDTH

kernel_name = "hybrid_gmlp_diffattn_convffn_trunk"


def rms_norm(x, w):
    xf = x.astype(jnp.float32)
    y = xf * lax.rsqrt(jnp.mean(xf * xf, axis=-1, keepdims=True) + EPS)
    return (y * w.astype(jnp.float32)).astype(x.dtype)


def chunk_causal_mask(q_pos, k_pos):
    return (k_pos[None, :] // CHUNK) <= (q_pos[:, None] // CHUNK)


def spatial_gating_unit(u, v, v_norm_w, w_s, b_s):
    bsz, seq, heads, dh = v.shape
    v = rms_norm(v, v_norm_w)
    n_chunks = seq // SPATIAL_CHUNK
    pos = jnp.arange(SPATIAL_CHUNK)
    mask = chunk_causal_mask(pos, pos)
    w = jnp.where(mask[None], w_s, jnp.zeros_like(w_s)).astype(v.dtype)
    vc = v.reshape(bsz, n_chunks, SPATIAL_CHUNK, heads, dh)
    mixed = jnp.einsum('hij,bnjhd->bnihd', w, vc) + b_s.T.astype(v.dtype)[None, None, :, :, None]
    return u * mixed.reshape(bsz, seq, heads, dh)


def diff_attention(q, k, v, lam):
    seq = q.shape[1]
    scale = DIFF_HEAD_DIM ** -0.5
    outs = []
    for qb in range(seq // Q_BLOCK):
        start, end = qb * Q_BLOCK, (qb + 1) * Q_BLOCK
        q_blk = q[:, start:end].astype(jnp.float32)
        k_blk = k[:, :end].astype(jnp.float32)
        s = jnp.einsum('bihcd,bjhcd->bhcij', q_blk, k_blk) * scale
        mask = chunk_causal_mask(jnp.arange(start, end), jnp.arange(end))
        s = jnp.where(mask, s, -jnp.inf)
        p = jax.nn.softmax(s, axis=-1)
        a = p[:, :, 0] - lam * p[:, :, 1]
        outs.append(jnp.einsum('bhij,bjhe->bihe', a, v[:, :end].astype(jnp.float32)))
    return jnp.concatenate(outs, axis=1).astype(v.dtype)


def causal_depthwise_conv(g, w, b):
    seq = g.shape[1]
    gp = jnp.pad(g, ((0, 0), (CONV_WIDTH - 1, 0), (0, 0)))
    out = b.astype(g.dtype)
    for tap in range(CONV_WIDTH):
        out = out + w[tap].astype(g.dtype) * gp[:, tap:tap + seq]
    return out


def hybrid_layer(x, layer_idx, norm_attn_w, w_in, gmlp_v_norm_w, spatial_w, spatial_b,
                 gmlp_out_norm_w, q_norm_w, k_norm_w, lambda_q1, lambda_k1, lambda_q2,
                 lambda_k2, diff_out_norm_w, w_out, norm_ffn_w, w_gate, w_up, conv_w,
                 conv_b, w_down):
    bsz, seq, _ = x.shape
    h = rms_norm(x, norm_attn_w)
    proj = h @ w_in
    splits = [A_WIDTH, 2 * A_WIDTH, 2 * A_WIDTH + B_WIDTH, 2 * A_WIDTH + 2 * B_WIDTH]
    a_u, a_v, b_q, b_k, b_v = jnp.split(proj, splits, axis=-1)

    a_u = jax.nn.gelu(a_u, approximate=False).reshape(bsz, seq, A_HEADS, A_HEAD_DIM)
    a_v = jax.nn.gelu(a_v, approximate=False).reshape(bsz, seq, A_HEADS, A_HEAD_DIM)
    a_out = spatial_gating_unit(a_u, a_v, gmlp_v_norm_w, spatial_w, spatial_b)
    a_out = rms_norm(a_out, gmlp_out_norm_w).reshape(bsz, seq, A_WIDTH)

    q = rms_norm(b_q.reshape(bsz, seq, DIFF_HEADS, 2, DIFF_HEAD_DIM), q_norm_w)
    k = rms_norm(b_k.reshape(bsz, seq, DIFF_HEADS, 2, DIFF_HEAD_DIM), k_norm_w)
    v = b_v.reshape(bsz, seq, DIFF_HEADS, 2 * DIFF_HEAD_DIM)
    lambda_init = 0.8 - 0.6 * math.exp(-0.3 * (layer_idx + 1))
    lam = (jnp.exp(jnp.sum(lambda_q1.astype(jnp.float32) * lambda_k1.astype(jnp.float32)))
           - jnp.exp(jnp.sum(lambda_q2.astype(jnp.float32) * lambda_k2.astype(jnp.float32)))
           + lambda_init)
    o = diff_attention(q, k, v, lam)
    b_out = (rms_norm(o, diff_out_norm_w) * (1.0 - lambda_init)).reshape(bsz, seq, B_WIDTH)

    x = x + jnp.concatenate([a_out, b_out], axis=-1) @ w_out

    h = rms_norm(x, norm_ffn_w)
    g = causal_depthwise_conv(h @ w_gate, conv_w, conv_b)
    f = jax.nn.silu(g) * (h @ w_up)
    return x + f @ w_down


def setup_inputs(seed: int = 0) -> dict:
    key = jax.random.key(seed)
    ks = jax.random.split(key, 20)
    f32 = jnp.float32
    L = DEPTH
    res_scale = (2 * DEPTH) ** -0.5

    def nrm(k, shape, scale):
        return jax.random.normal(k, shape, f32) * scale

    return {
        "x": nrm(ks[0], (BATCH, SEQ, D_MODEL), 1.0),
        "norm_attn_w": 1.0 + nrm(ks[1], (L, D_MODEL), 0.02),
        "w_in": nrm(ks[2], (L, D_MODEL, IN_WIDTH), D_MODEL ** -0.5),
        "gmlp_v_norm_w": 1.0 + nrm(ks[3], (L, A_HEADS, A_HEAD_DIM), 0.02),
        "spatial_w": nrm(ks[4], (L, A_HEADS, SPATIAL_CHUNK, SPATIAL_CHUNK), SPATIAL_CHUNK ** -0.5),
        "spatial_b": 1.0 + nrm(ks[5], (L, A_HEADS, SPATIAL_CHUNK), 0.02),
        "gmlp_out_norm_w": 1.0 + nrm(ks[6], (L, A_HEADS, A_HEAD_DIM), 0.02),
        "q_norm_w": 1.0 + nrm(ks[7], (L, DIFF_HEAD_DIM), 0.02),
        "k_norm_w": 1.0 + nrm(ks[8], (L, DIFF_HEAD_DIM), 0.02),
        "lambda_q1": nrm(ks[9], (L, DIFF_HEAD_DIM), 0.1),
        "lambda_k1": nrm(ks[10], (L, DIFF_HEAD_DIM), 0.1),
        "lambda_q2": nrm(ks[11], (L, DIFF_HEAD_DIM), 0.1),
        "lambda_k2": nrm(ks[12], (L, DIFF_HEAD_DIM), 0.1),
        "diff_out_norm_w": 1.0 + nrm(ks[13], (L, 2 * DIFF_HEAD_DIM), 0.02),
        "w_out": nrm(ks[14], (L, MIX_WIDTH, D_MODEL), MIX_WIDTH ** -0.5 * res_scale),
        "norm_ffn_w": 1.0 + nrm(ks[15], (L, D_MODEL), 0.02),
        "w_gate": nrm(ks[16], (L, D_MODEL, D_FF), D_MODEL ** -0.5),
        "w_up": nrm(ks[17], (L, D_MODEL, D_FF), D_MODEL ** -0.5),
        "conv_w": nrm(ks[18], (L, CONV_WIDTH, D_FF), CONV_WIDTH ** -0.5),
        "conv_b": nrm(jax.random.fold_in(ks[18], 1), (L, D_FF), 0.02),
        "w_down": nrm(ks[19], (L, D_FF, D_MODEL), D_FF ** -0.5 * res_scale),
    }


def reference(x, norm_attn_w, w_in, gmlp_v_norm_w, spatial_w, spatial_b, gmlp_out_norm_w,
              q_norm_w, k_norm_w, lambda_q1, lambda_k1, lambda_q2, lambda_k2,
              diff_out_norm_w, w_out, norm_ffn_w, w_gate, w_up, conv_w, conv_b, w_down):
    for layer in range(DEPTH):
        x = hybrid_layer(
            x, layer, norm_attn_w[layer], w_in[layer], gmlp_v_norm_w[layer], spatial_w[layer],
            spatial_b[layer], gmlp_out_norm_w[layer], q_norm_w[layer], k_norm_w[layer],
            lambda_q1[layer], lambda_k1[layer], lambda_q2[layer], lambda_k2[layer],
            diff_out_norm_w[layer], w_out[layer], norm_ffn_w[layer], w_gate[layer], w_up[layer],
            conv_w[layer], conv_b[layer], w_down[layer])
    return x
```

```cpp
#include <hip/hip_runtime.h>
#include <hip/hip_cooperative_groups.h>
#include <cstdio>
#include <cmath>
#include <cstring>

typedef unsigned short bf16_t;
#define DI __device__ __forceinline__

constexpr int T_TOK = 32768, DM = 1024, SEQ = 2048, DFF = 2816, INW = 2560, NLAYER = 4;
constexpr float EPS = 1e-6f;
constexpr float QSCALE = 0.125f * 1.4426950408889634f;

constexpr size_t MiB = 1024ull * 1024ull;
constexpr size_t OFF_XB = 0;
constexpr size_t OFF_R = 64 * MiB;
constexpr size_t OFF_U = OFF_R, OFF_Q = OFF_R + 32 * MiB, OFF_KB = OFF_R + 64 * MiB, OFF_GVT = OFF_R + 96 * MiB, OFF_VT = OFF_R + 128 * MiB, OFF_MIX = OFF_R + 160 * MiB;
constexpr size_t OFF_F = OFF_R, OFF_GB = OFF_R + 176 * MiB, OFF_PB = OFF_R + 188 * MiB, OFF_UB = OFF_R + 200 * MiB;
constexpr size_t OFF_W = 288 * MiB, W_STRIDE = 24 * MiB;
constexpr size_t WO_IN = 0, WO_OUT = 5 * MiB, WO_GU = 7 * MiB, WO_DN = 18 * MiB, WO_SP = 23 * MiB + 512 * 1024;
constexpr size_t OFF_SS1 = 384 * MiB, OFF_SS2 = OFF_SS1 + 128 * 1024, OFF_SSV = OFF_SS2 + 128 * 1024;
constexpr size_t OFF_TMP1 = 386 * MiB, OFF_TMP2 = 418 * MiB;

DI int tid_opaque() { int t = threadIdx.x; asm volatile("" : "+v"(t)); return t; }
DI float bf2f(bf16_t b) { return __uint_as_float(((unsigned)b) << 16); }
DI bf16_t f2bf(float f) { unsigned u = __float_as_uint(f); u += 0x7FFFu + ((u >> 16) & 1u); return (bf16_t)(u >> 16); }
DI float gelu_exact(float x) { return 0.5f * x * (1.0f + erff(x * 0.70710678118654752f)); }
DI int permpos16(int k) { return (k & 3) + 4 * (k >> 3) + 8 * ((k >> 2) & 1); }
DI float wave_sum(float v) { for (int o = 32; o >= 1; o >>= 1) v += __shfl_xor(v, o); return v; }

struct LayerP {
  const float *norm_attn_w, *w_in, *v_norm_w, *sp_w, *sp_b, *out_norm_w, *q_norm_w, *k_norm_w, *lq1, *lk1, *lq2, *lk2, *diff_norm_w, *w_out, *norm_ffn_w, *w_gate, *w_up, *conv_w, *conv_b, *w_down;
  float lambda_init, pad0;
};
struct Params {
  const float* x; float* out; unsigned char* ws;
  LayerP L[NLAYER];
};

DI float compute_lam(const LayerP& lp) {
  const int lane = threadIdx.x & 63;
  float a = lp.lq1[lane] * lp.lk1[lane], b = lp.lq2[lane] * lp.lk2[lane];
  a = wave_sum(a); b = wave_sum(b);
  return expf(a) - expf(b) + lp.lambda_init;
}

__global__ __launch_bounds__(256) void n_prep_x(const float* x, bf16_t* XB, float* SS) {
  const int row = blockIdx.x * 4 + (threadIdx.x >> 6), lane = threadIdx.x & 63;
  const float* xp = x + (size_t)row * DM; float s = 0.f;
  for (int c = lane; c < DM; c += 64) { float v = xp[c]; s += v * v; XB[(size_t)row * DM + c] = f2bf(v); }
  s = wave_sum(s); if (lane == 0) SS[row] = s;
}
__global__ __launch_bounds__(256) void n_rowss(const float* x, float* SS) {
  const int row = blockIdx.x * 4 + (threadIdx.x >> 6), lane = threadIdx.x & 63;
  const float* xp = x + (size_t)row * DM; float s = 0.f;
  for (int c = lane; c < DM; c += 64) { float v = xp[c]; s += v * v; }
  s = wave_sum(s); if (lane == 0) SS[row] = s;
}
__global__ __launch_bounds__(256) void n_gemm(const bf16_t* A, int lda, const float* W, int ldw, int col0, int K, const float* kscale, const float* rowss, float* C, int ldc) {
  __shared__ float sA[16][65]; __shared__ float sB[16][64];
  const int tid = threadIdx.x, tx = tid & 15, ty = tid >> 4, m0 = blockIdx.y * 64, n0 = blockIdx.x * 64;
  float acc[4][4];
#pragma unroll
  for (int i = 0; i < 4; ++i)
#pragma unroll
    for (int j = 0; j < 4; ++j) acc[i][j] = 0.f;
  for (int k0 = 0; k0 < K; k0 += 16) {
    { const int r = tid >> 2, kk = (tid & 3) * 4; const bf16_t* ap = A + (size_t)(m0 + r) * lda + k0 + kk;
#pragma unroll
      for (int i = 0; i < 4; ++i) sA[kk + i][r] = bf2f(ap[i]) * (kscale ? kscale[k0 + kk + i] : 1.f); }
    { const int kk = tid >> 4, n = (tid & 15) * 4; const float* wp = W + (size_t)(k0 + kk) * ldw + col0 + n0 + n;
#pragma unroll
      for (int i = 0; i < 4; ++i) sB[kk][n + i] = wp[i]; }
    __syncthreads();
#pragma unroll
    for (int kk = 0; kk < 16; ++kk) {
      float a[4], b[4];
#pragma unroll
      for (int i = 0; i < 4; ++i) { a[i] = sA[kk][ty * 4 + i]; b[i] = sB[kk][tx * 4 + i]; }
#pragma unroll
      for (int i = 0; i < 4; ++i)
#pragma unroll
        for (int j = 0; j < 4; ++j) acc[i][j] += a[i] * b[j];
    }
    __syncthreads();
  }
#pragma unroll
  for (int i = 0; i < 4; ++i) { const int row = m0 + ty * 4 + i; const float rs = rowss ? rsqrtf(rowss[row] * (1.0f / DM) + EPS) : 1.f;
#pragma unroll
    for (int j = 0; j < 4; ++j) C[(size_t)row * ldc + n0 + tx * 4 + j] = acc[i][j] * rs; }
}
__global__ __launch_bounds__(256) void n_postA(const float* TMP, int slice, bf16_t* U, bf16_t* Q, bf16_t* KB, bf16_t* GVT, bf16_t* VT, const float* qw, const float* kw) {
  const int gid = blockIdx.x * 256 + threadIdx.x, t = gid >> 2, g = gid & 3;
  const float* tp = TMP + (size_t)t * 256 + g * 64; const int cb = slice * 256 + g * 64;
  if (cb < 512) { for (int d = 0; d < 64; ++d) U[(size_t)t * 512 + cb + d] = f2bf(gelu_exact(tp[d])); }
  else if (cb < 1024) { for (int d = 0; d < 64; ++d) GVT[(size_t)(cb - 512 + d) * T_TOK + t] = f2bf(gelu_exact(tp[d])); }
  else if (cb < 2048) { const bool isq = cb < 1536; float ss = 0.f; for (int d = 0; d < 64; ++d) ss += tp[d] * tp[d];
    const float rs = rsqrtf(ss * (1.0f / 64.0f) + EPS) * (isq ? QSCALE : 1.0f); const float* w = isq ? qw : kw; bf16_t* o = isq ? Q + (size_t)t * 512 + (cb - 1024) : KB + (size_t)t * 512 + (cb - 1536);
    for (int d = 0; d < 64; ++d) o[d] = f2bf(tp[d] * rs * w[d]); }
  else { const int tp16 = (t & ~15) + permpos16(t & 15); for (int d = 0; d < 64; ++d) VT[(size_t)(cb - 2048 + d) * T_TOK + tp16] = f2bf(tp[d]); }
}
__global__ __launch_bounds__(256) void n_ssv(const bf16_t* GVT, float* SSV) {
  const int gid = blockIdx.x * 256 + threadIdx.x, t = gid & (T_TOK - 1), h = gid >> 15; float s = 0.f;
  for (int d = 0; d < 128; ++d) { const float v = bf2f(GVT[(size_t)(h * 128 + d) * T_TOK + t]); s += v * v; }
  SSV[t * 4 + h] = s;
}
__global__ __launch_bounds__(128) void n_spatial(const bf16_t* U, const bf16_t* GVT, const float* SSV, const float* spw, const float* spb, const float* vnw, const float* onw, bf16_t* MIX) {
  const int t = blockIdx.x, h = blockIdx.y, d = threadIdx.x, t0 = t & ~127, i = t & 127, jmax = (i < 64) ? 64 : 128;
  __shared__ float red[2];
  float acc = 0.f; const float* wr = spw + ((size_t)h * 128 + i) * 128; const bf16_t* gp = GVT + (size_t)(h * 128 + d) * T_TOK + t0;
  for (int j = 0; j < jmax; ++j) acc += wr[j] * bf2f(gp[j]) * rsqrtf(SSV[(t0 + j) * 4 + h] * (1.0f / 128.0f) + EPS);
  const float mixed = acc * vnw[h * 128 + d] + spb[h * 128 + i];
  const float o = bf2f(U[(size_t)t * 512 + h * 128 + d]) * mixed;
  float ss = wave_sum(o * o); if ((d & 63) == 0) red[d >> 6] = ss; __syncthreads(); ss = red[0] + red[1];
  MIX[(size_t)t * 1024 + h * 128 + d] = f2bf(o * rsqrtf(ss * (1.0f / 128.0f) + EPS) * onw[h * 128 + d]);
}
__global__ __launch_bounds__(128) void n_attn(const bf16_t* Q, const bf16_t* KB, const bf16_t* VT, bf16_t* MIX, LayerP lp) {
  const int t = blockIdx.x, h = blockIdx.y, tid = threadIdx.x, b = t >> 11, s = t & 2047, nk = ((s >> 6) + 1) * 64;
  __shared__ float sq[128]; __shared__ float p1[2048]; __shared__ float p2[2048]; __shared__ float red[4];
  const float lam = compute_lam(lp);
  sq[tid] = bf2f(Q[(size_t)t * 512 + h * 128 + tid]); __syncthreads();
  float l1 = 0.f, l2 = 0.f;
  for (int key = tid; key < nk; key += 128) { const bf16_t* kp = KB + (size_t)(b * 2048 + key) * 512 + h * 128; float s1 = 0.f, s2 = 0.f;
    for (int d = 0; d < 64; ++d) { s1 += sq[d] * bf2f(kp[d]); s2 += sq[64 + d] * bf2f(kp[64 + d]); }
    const float e1 = exp2f(s1), e2 = exp2f(s2); p1[key] = e1; p2[key] = e2; l1 += e1; l2 += e2; }
  l1 = wave_sum(l1); l2 = wave_sum(l2); if ((tid & 63) == 0) { red[(tid >> 6) * 2] = l1; red[(tid >> 6) * 2 + 1] = l2; } __syncthreads();
  l1 = red[0] + red[2]; l2 = red[1] + red[3]; __syncthreads();
  const bf16_t* vp = VT + (size_t)(h * 128 + tid) * T_TOK + b * 2048; float o1 = 0.f, o2 = 0.f;
  for (int key = 0; key < nk; ++key) { const float v = bf2f(vp[(key & ~15) + permpos16(key & 15)]); o1 += p1[key] * v; o2 += p2[key] * v; }
  const float o = o1 / l1 - lam * o2 / l2;
  float ss = wave_sum(o * o); if ((tid & 63) == 0) red[tid >> 6] = ss; __syncthreads(); ss = red[0] + red[1];
  MIX[(size_t)t * 1024 + 512 + h * 128 + tid] = f2bf(o * rsqrtf(ss * (1.0f / 128.0f) + EPS) * lp.diff_norm_w[tid] * (1.0f - lp.lambda_init));
}
__global__ __launch_bounds__(256) void n_resid(const float* TMP, int col0, const float* base, float* X, bf16_t* XB) {
  const size_t gid = (size_t)blockIdx.x * 256 + threadIdx.x; const int t = (int)(gid >> 8), c = (int)(gid & 255);
  const size_t o = (size_t)t * DM + col0 + c; const float v = base[o] + TMP[gid]; X[o] = v; XB[o] = f2bf(v);
}
__global__ __launch_bounds__(256) void n_postD(const float* G, const float* Up, int col0, const float* cw, const float* cb, bf16_t* F) {
  const size_t gid = (size_t)blockIdx.x * 256 + threadIdx.x; const int t = (int)(gid >> 8), c = (int)(gid & 255), s = t & 2047, cc = col0 + c;
  float g = cw[2 * DFF + cc] * G[gid] + cb[cc];
  if (s >= 1) g += cw[DFF + cc] * G[gid - 256];
  if (s >= 2) g += cw[cc] * G[gid - 512];
  const float f = g / (1.0f + expf(-g)) * Up[gid];
  F[(size_t)t * DFF + cc] = f2bf(f);
}


namespace pg8 {
#define PG8_LAS __attribute__((address_space(3)))
typedef unsigned short bf16_t;
typedef short bf16x8 __attribute__((ext_vector_type(8)));
typedef float f32x4 __attribute__((ext_vector_type(4)));
typedef unsigned u32x4 __attribute__((ext_vector_type(4)));
constexpr int BM = 256, BK = 64, HALF = 128, HTB = HALF * BK * 2  , STAGE_BYTES = 8 * HTB, NXCD = 8, WGM = 8;

__host__ __device__ __forceinline__ int lds_byte(int r, int c) { const int st = (r >> 4) * 2 + (c >> 5), rr = r & 15, cc = c & 31, ob = rr * 64 + cc * 2; return st * 1024 + (ob ^ (((ob >> 9) & 1) << 5)); }
__host__ __device__ __forceinline__ void stage_rc(int b, int& R, int& C) { const int st = b / 1024, sb = b % 1024, swz = sb ^ (((sb >> 9) & 1) << 5); R = (st >> 1) * 16 + swz / 64; C = (st & 1) * 32 + (swz % 64) / 2; }
__host__ __device__ __forceinline__ int perm32(int rho) { const int n = rho >> 4, i = rho & 15; return 8 * (i >> 2) + 4 * n + (i & 3); }

struct Unit { int pm, pn; };
struct Gemm { const bf16_t* A; const bf16_t* Bt; int M, N, K; };

struct StaticOrder {
    int nM, nN, nwg, G, c;
    __host__ __device__ void init(int M, int N, int G_, int c_) { nM = M / BM; nN = N / BM; nwg = nM * nN; G = G_; c = c_; }
    __host__ __device__ bool next(int i, Unit& u) const {
        const long L = (long)i * G + c; if (L >= nwg) return false;
        int wgid = (int)L; { const int q = nwg / NXCD, r = nwg % NXCD, xcd = wgid % NXCD, off = wgid / NXCD; wgid = (xcd < r ? xcd * (q + 1) : r * (q + 1) + (xcd - r) * q) + off; }
        const int nig = WGM * nN, gid = wgid / nig, fm = gid * WGM, gsz = (nM - fm) < WGM ? (nM - fm) : WGM;
        u.pm = fm + ((wgid % nig) % gsz); u.pn = (wgid % nig) / gsz; return true;
    }
    __device__ __forceinline__ void a_ready(const Unit&) const {}
    __device__ __forceinline__ void done(const Unit&) const {}
};
template <class Epi, class Sched>
__device__ __forceinline__ void gemm_phase(PG8_LAS unsigned char* lds, const Gemm g, const Sched& S, const Epi& E) {
    const int tid = tid_opaque(), wid = __builtin_amdgcn_readfirstlane(tid >> 6), lane = tid & 63, wr = wid >> 2, wc = wid & 3, fr = lane & 15, fq = lane >> 4;
    const int K = g.K, nt = K / BK;
    unsigned voffA[2], voffB[2];
#pragma unroll
    for (int i = 0; i < 2; ++i) { int R, C; stage_rc(tid * 16 + i * 8192, R, C); const int Rb = Epi::PERM ? ((R & ~31) + perm32(R & 31)) : R;
        voffA[i] = (unsigned)(R * K + C) * 2u; voffB[i] = (unsigned)(Rb * K + C) * 2u; }
    const size_t kstep = (size_t)(BK * 2);
    const size_t hstep = (size_t)HALF * K * 2;
    const size_t tstep = 2 * hstep;
    const unsigned ldsw = (unsigned)wid * 1024u;
    const int aoff = lds_byte(wr * 64 + fr, fq * 8), boff = lds_byte(wc * 32 + fr, fq * 8);
#define PG8_SA(b, h) (((b) * 2 + (h)) * HTB)
#define PG8_SB(b, h) ((4 + (b) * 2 + (h)) * HTB)
#define PG8_STAGE(bufoff, gbase, voff) do { _Pragma("unroll") for (int _i = 0; _i < 2; ++_i) \
        __builtin_amdgcn_global_load_lds((const unsigned*)((const char*)(gbase) + (voff)[_i]), (PG8_LAS unsigned*)(lds + (bufoff) + ldsw + _i * 8192), 16, 0, 0); } while (0)
#define PG8_LDA(dst, b, h) do { _Pragma("unroll") for (int m = 0; m < 4; ++m) _Pragma("unroll") for (int k = 0; k < 2; ++k) dst[m][k] = *(const PG8_LAS bf16x8*)(lds + PG8_SA(b, h) + aoff + m * 2048 + k * 1024); } while (0)
#define PG8_LDB(dst, b, h) do { _Pragma("unroll") for (int n = 0; n < 2; ++n) _Pragma("unroll") for (int k = 0; k < 2; ++k) dst[n][k] = *(const PG8_LAS bf16x8*)(lds + PG8_SB(b, h) + boff + n * 2048 + k * 1024); } while (0)
#define PG8_MMA(ai, bj, At, Bt) do { __builtin_amdgcn_s_setprio(1); _Pragma("unroll") for (int m = 0; m < 4; ++m) _Pragma("unroll") for (int n = 0; n < 2; ++n) _Pragma("unroll") for (int k = 0; k < 2; ++k) \
        acc[ai][bj][m][n] = __builtin_amdgcn_mfma_f32_16x16x32_bf16(Bt[n][k], At[m][k], acc[ai][bj][m][n], 0, 0, 0); __builtin_amdgcn_s_setprio(0); } while (0)
#define PG8_WAIT_V(n) asm volatile("s_waitcnt vmcnt(" #n ")" ::: "memory")
#define PG8_WAIT_L(n) asm volatile("s_waitcnt lgkmcnt(" #n ")" ::: "memory")
#define PG8_BAR __builtin_amdgcn_s_barrier()
#define PG8_SCHED __builtin_amdgcn_sched_barrier(0)
    Unit cur, nxt; int ui = 0;
    if (!S.next(0, cur)) return;
    f32x4 acc[2][2][4][2];
#pragma unroll
    for (int a = 0; a < 2; ++a)
#pragma unroll
        for (int b = 0; b < 2; ++b)
#pragma unroll
            for (int m = 0; m < 4; ++m)
#pragma unroll
                for (int n = 0; n < 2; ++n) acc[a][b][m][n] = (f32x4){0.f, 0.f, 0.f, 0.f};
    bf16x8 At[4][2], B0[2][2], B1[2][2];
    const char* cA = (const char*)g.A + (size_t)cur.pm * tstep; const char* cB = (const char*)g.Bt + (size_t)cur.pn * tstep;
    S.a_ready(cur);
    PG8_STAGE(PG8_SB(0, 0), cB, voffB); PG8_STAGE(PG8_SA(0, 0), cA, voffA); PG8_STAGE(PG8_SB(0, 1), cB + hstep, voffB); PG8_STAGE(PG8_SA(0, 1), cA + hstep, voffA);
    if (wr == 1) PG8_BAR;
    PG8_WAIT_V(4); PG8_BAR;
    PG8_STAGE(PG8_SB(1, 0), cB + kstep, voffB); PG8_STAGE(PG8_SA(1, 0), cA + kstep, voffA); PG8_STAGE(PG8_SB(1, 1), cB + hstep + kstep, voffB);
    PG8_WAIT_V(6); PG8_BAR;
    for (;;) {
        const bool has_next = S.next(ui + 1, nxt);
        const char* nA = has_next ? (const char*)g.A + (size_t)nxt.pm * tstep : cA; const char* nB = has_next ? (const char*)g.Bt + (size_t)nxt.pn * tstep : cB;
        for (int t = 0; t < nt; t += 2) {
            const bool last = (t == nt - 2);
            const char* a1 = cA + (size_t)(t + 1) * kstep;
            const char* a2 = last ? nA : cA + (size_t)(t + 2) * kstep; const char* b2 = last ? nB : cB + (size_t)(t + 2) * kstep;
            const char* a3 = a2 + kstep; const char* b3 = b2 + kstep;
            if (last && has_next) S.a_ready(nxt);
            PG8_LDB(B0, 0, 0); PG8_SCHED; PG8_LDA(At, 0, 0); PG8_STAGE(PG8_SA(1, 1), a1 + hstep, voffA);
            PG8_WAIT_L(8); PG8_BAR; PG8_WAIT_L(0); PG8_MMA(0, 0, At, B0); PG8_BAR; PG8_SCHED;
            PG8_LDB(B1, 0, 1); PG8_STAGE(PG8_SB(0, 0), b2, voffB);
            PG8_BAR; PG8_WAIT_L(0); PG8_MMA(0, 1, At, B1); PG8_BAR;
            PG8_LDA(At, 0, 1); PG8_STAGE(PG8_SA(0, 0), a2, voffA);
            PG8_BAR; PG8_WAIT_L(0); PG8_MMA(1, 0, At, B0); PG8_BAR; PG8_SCHED;
            PG8_STAGE(PG8_SB(0, 1), b2 + hstep, voffB);
            PG8_WAIT_V(6); PG8_BAR; PG8_MMA(1, 1, At, B1); PG8_BAR;
            PG8_LDB(B0, 1, 0); PG8_SCHED; PG8_LDA(At, 1, 0); PG8_STAGE(PG8_SA(0, 1), a2 + hstep, voffA);
            PG8_WAIT_L(8); PG8_BAR; PG8_WAIT_L(0); PG8_MMA(0, 0, At, B0); PG8_BAR; PG8_SCHED;
            PG8_LDB(B1, 1, 1); PG8_STAGE(PG8_SB(1, 0), b3, voffB);
            PG8_BAR; PG8_WAIT_L(0); PG8_MMA(0, 1, At, B1); PG8_BAR;
            PG8_LDA(At, 1, 1); PG8_STAGE(PG8_SA(1, 0), a3, voffA);
            PG8_BAR; PG8_WAIT_L(0); PG8_MMA(1, 0, At, B0); PG8_BAR; PG8_SCHED;
            PG8_STAGE(PG8_SB(1, 1), b3 + hstep, voffB);
            PG8_WAIT_V(6); PG8_BAR; PG8_MMA(1, 1, At, B1); PG8_BAR;
        }
        if constexpr (!Epi::AFTER_DRAIN) { E(acc, cur, wr, wc, fr, fq); S.done(cur); }
        if (!has_next) break;
#pragma unroll
        for (int a = 0; a < 2; ++a)
#pragma unroll
            for (int b = 0; b < 2; ++b)
#pragma unroll
                for (int m = 0; m < 4; ++m)
#pragma unroll
                    for (int n = 0; n < 2; ++n) acc[a][b][m][n] = (f32x4){0.f, 0.f, 0.f, 0.f};
        cur = nxt; cA = nA; cB = nB; ++ui;
    }
    PG8_WAIT_V(0);
    if (wr == 0) PG8_BAR;
    PG8_BAR;
    if constexpr (Epi::AFTER_DRAIN) { E.fused(acc, cur, wr, wc, fr, fq, lds, wid, lane); S.done(cur); }
#undef PG8_SA
#undef PG8_SB
#undef PG8_STAGE
#undef PG8_LDA
#undef PG8_LDB
#undef PG8_MMA
#undef PG8_WAIT_V
#undef PG8_WAIT_L
#undef PG8_BAR
#undef PG8_SCHED
}
}

namespace cg = cooperative_groups;
using pg8::f32x4; using pg8::bf16x8; using pg8::Unit;
typedef unsigned u32x2_t __attribute__((ext_vector_type(2)));
typedef unsigned u32x4_t __attribute__((ext_vector_type(4)));
typedef float f32x16 __attribute__((ext_vector_type(16)));
typedef float f32x2_t __attribute__((ext_vector_type(2)));
#define LAS PG8_LAS
constexpr int LDS_BYTES = 131072;
#ifndef EN_MASK
#define EN_MASK 0x7f
#endif

DI unsigned pk2(float lo, float hi) { unsigned r; asm volatile("v_cvt_pk_bf16_f32 %0, %1, %2" : "=v"(r) : "v"(lo), "v"(hi)); return r; }
DI float bflo(unsigned w) { return __uint_as_float(w << 16); }
DI float bfhi(unsigned w) { return __uint_as_float(w & 0xffff0000u); }
DI float gelu1(float v) {
  const float av = fabsf(v), t = __builtin_amdgcn_rcpf(av * 0.2316418882f + 1.0f);
  float q = t * 0.5307027145f + (-0.7265760135f); q = q * t + 0.7107068705f; q = q * t + (-0.142248368f); q = q * t + 0.127414796f; q = q * t;
  const float e = __builtin_amdgcn_exp2f((v * v) * (-0.72134752044f));
  const float m = v * (q * e);
  return v < 0.f ? m : v - m;
}
DI float rs1024(float ss) { return rsqrtf(ss * (1.0f / 1024.0f) + EPS); }

struct MParams { const float* in[21]; float* out; unsigned char* ws; int ph_lo, ph_hi; };
struct LP {
  const float *norm_attn_w, *w_in, *v_norm_w, *sp_w, *sp_b, *out_norm_w, *q_norm_w, *k_norm_w, *lq1, *lk1, *lq2, *lk2, *diff_norm_w, *w_out, *norm_ffn_w, *w_gate, *w_up, *conv_w, *conv_b, *w_down;
  float lambda_init;
  const bf16_t *WinT, *WoutT, *WguT, *WdT, *Wsp;
};
DI LP make_lp(const MParams& p, int l) {
  LP L;
  L.norm_attn_w = p.in[1] + (size_t)l * DM; L.w_in = p.in[2] + (size_t)l * DM * INW; L.v_norm_w = p.in[3] + (size_t)l * 512; L.sp_w = p.in[4] + (size_t)l * 65536; L.sp_b = p.in[5] + (size_t)l * 512;
  L.out_norm_w = p.in[6] + (size_t)l * 512; L.q_norm_w = p.in[7] + (size_t)l * 64; L.k_norm_w = p.in[8] + (size_t)l * 64; L.lq1 = p.in[9] + (size_t)l * 64; L.lk1 = p.in[10] + (size_t)l * 64;
  L.lq2 = p.in[11] + (size_t)l * 64; L.lk2 = p.in[12] + (size_t)l * 64; L.diff_norm_w = p.in[13] + (size_t)l * 128; L.w_out = p.in[14] + (size_t)l * DM * DM; L.norm_ffn_w = p.in[15] + (size_t)l * DM;
  L.w_gate = p.in[16] + (size_t)l * DM * DFF; L.w_up = p.in[17] + (size_t)l * DM * DFF; L.conv_w = p.in[18] + (size_t)l * 3 * DFF; L.conv_b = p.in[19] + (size_t)l * DFF; L.w_down = p.in[20] + (size_t)l * DFF * DM;
  L.lambda_init = 0.8f - 0.6f * expf(-0.3f * (float)(l + 1));
  const unsigned char* wb = p.ws + OFF_W + (size_t)l * W_STRIDE;
  L.WinT = (const bf16_t*)(wb + WO_IN); L.WoutT = (const bf16_t*)(wb + WO_OUT); L.WguT = (const bf16_t*)(wb + WO_GU); L.WdT = (const bf16_t*)(wb + WO_DN); L.Wsp = (const bf16_t*)(wb + WO_SP);
  return L;
}
DI float lam_of(const LP& lp) {
  const int lane = threadIdx.x & 63;
  float a = lp.lq1[lane] * lp.lk1[lane], b = lp.lq2[lane] * lp.lk2[lane];
  a = wave_sum(a); b = wave_sum(b);
  return expf(a) - expf(b) + lp.lambda_init;
}

DI void conv_item(bf16_t* dst, int K, int row, int kg, const float* src, int ld, int col, const float* ks) {
  float v[32];
#pragma unroll
  for (int i = 0; i < 32; ++i) v[i] = src[(size_t)(kg * 32 + i) * ld + col];
  if (ks) {
#pragma unroll
    for (int i = 0; i < 32; i += 4) { const f32x4 s = *(const f32x4*)(ks + kg * 32 + i); v[i] *= s[0]; v[i + 1] *= s[1]; v[i + 2] *= s[2]; v[i + 3] *= s[3]; }
  }
  u32x4_t* d = (u32x4_t*)(dst + (size_t)row * K + kg * 32);
#pragma unroll
  for (int i = 0; i < 4; ++i) { u32x4_t w; w.x = pk2(v[8 * i], v[8 * i + 1]); w.y = pk2(v[8 * i + 2], v[8 * i + 3]); w.z = pk2(v[8 * i + 4], v[8 * i + 5]); w.w = pk2(v[8 * i + 6], v[8 * i + 7]); d[i] = w; }
}
DI int perm_logical(int p) {
  const int bj = p >> 7, wc = (p >> 5) & 3, n = (p >> 4) & 1, fq = (p >> 2) & 3, e = p & 3;
  return 64 * wc + 32 * bj + 8 * fq + 4 * n + e;
}
DI void prologue(const MParams& p) {
  const int tidp = tid_opaque(); const int gtid = blockIdx.x * 512 + tidp, gsz = gridDim.x * 512;
  unsigned char* ws = p.ws;
  { const int gw = gtid >> 6, nw = gsz >> 6, lane = threadIdx.x & 63; bf16_t* XB = (bf16_t*)(ws + OFF_XB); float* SS1 = (float*)(ws + OFF_SS1);
    for (int row = gw; row < T_TOK; row += nw) { const float* xp = p.in[0] + (size_t)row * DM; float s = 0.f;
#pragma unroll
      for (int i = 0; i < 4; ++i) { const f32x4 v = *(const f32x4*)(xp + i * 256 + lane * 4); s += v[0] * v[0] + v[1] * v[1] + v[2] * v[2] + v[3] * v[3];
        u32x2_t w; w.x = pk2(v[0], v[1]); w.y = pk2(v[2], v[3]); *(u32x2_t*)(XB + (size_t)row * DM + i * 256 + lane * 4) = w; }
      s = wave_sum(s); if (lane == 0) SS1[row] = s; } }
  { float* SSV = (float*)(ws + OFF_SSV); for (int i = gtid; i < T_TOK * 4; i += gsz) SSV[i] = 0.f; }
  for (int l = 0; l < NLAYER; ++l) {
    const LP lp = make_lp(p, l);
    for (int w = gtid; w < 2560 * 32; w += gsz) { const int row = w % 2560, kg = w / 2560; int col;
      if (row < 1536) { const int L = (row & ~255) + perm_logical(row & 255); col = L < 512 ? L : L + 512; }
      else { const int r = row - 1536; col = r < 512 ? 512 + r : 1536 + r; }
      conv_item((bf16_t*)lp.WinT, 1024, row, kg, lp.w_in, INW, col, lp.norm_attn_w); }
    for (int w = gtid; w < 1024 * 32; w += gsz) { const int row = w % 1024, kg = w / 1024; conv_item((bf16_t*)lp.WoutT, 1024, row, kg, lp.w_out, DM, row, nullptr); }
    for (int w = gtid; w < 5632 * 32; w += gsz) { const int row = w % 5632, kg = w / 5632; const int pn = row >> 8, pp = row & 255, bj = pp >> 7;
      const int q = pp & 127, wc = (q >> 5) & 3, n = (q >> 4) & 1, fq = (q >> 2) & 3, e = q & 3; const int cc = 128 * pn + 32 * wc + 8 * fq + 4 * n + e;
      conv_item((bf16_t*)lp.WguT, 1024, row, kg, bj ? lp.w_up : lp.w_gate, DFF, cc, lp.norm_ffn_w); }
    for (int w = gtid; w < 1024 * 88; w += gsz) { const int row = w % 1024, kg = w / 1024; conv_item((bf16_t*)lp.WdT, DFF, row, kg, lp.w_down, DM, row, nullptr); }
    for (int i = gtid; i < 65536; i += gsz) { const int jj = i & 127, ii = (i >> 7) & 127; ((bf16_t*)lp.Wsp)[i] = ((jj >> 6) <= (ii >> 6)) ? f2bf(lp.sp_w[i]) : (bf16_t)0; }
  }
}

struct EpiResid {
  static constexpr bool PERM = false, AFTER_DRAIN = false;
  const float* base; float* X; bf16_t* XB; float* SS;
  DI void operator()(const f32x4 (&acc)[2][2][4][2], const Unit& u, int wr, int wc, int fr, int fq) const {
    const int row0 = u.pm * 256 + wr * 64 + fr, col0 = u.pn * 256 + wc * 32 + 4 * fq;
#pragma unroll
    for (int ai = 0; ai < 2; ++ai)
#pragma unroll
      for (int m = 0; m < 4; ++m) { const int row = row0 + ai * 128 + m * 16; const size_t ro = (size_t)row * DM + col0; float ss = 0.f;
#pragma unroll
        for (int bj = 0; bj < 2; ++bj)
#pragma unroll
          for (int n = 0; n < 2; ++n) { const size_t o = ro + bj * 128 + n * 16; const f32x4 v = acc[ai][bj][m][n] + *(const f32x4*)(base + o); *(f32x4*)(X + o) = v;
            u32x2_t w; w.x = pk2(v[0], v[1]); w.y = pk2(v[2], v[3]); *(u32x2_t*)(XB + o) = w; ss += (v[0] * v[0] + v[1] * v[1]) + (v[2] * v[2] + v[3] * v[3]); }
        ss += __shfl_xor(ss, 16); ss += __shfl_xor(ss, 32); if (fq == 0) unsafeAtomicAdd(SS + row, ss);
        asm volatile("" ::: "memory"); }
  }
};
struct EpiA1 {
  static constexpr bool PERM = false, AFTER_DRAIN = false;
  const float* SS1; bf16_t *U, *Q, *KB; const float *qw, *kw;
  DI void operator()(const f32x4 (&acc)[2][2][4][2], const Unit& u, int wr, int wc, int fr, int fq) const {
    const int row0 = u.pm * 256 + wr * 64 + fr, lc0 = wc * 64 + 8 * fq, region = u.pn >> 1;
    if (region == 0) {
#pragma unroll
      for (int ai = 0; ai < 2; ++ai)
#pragma unroll
        for (int m = 0; m < 4; ++m) { const int row = row0 + ai * 128 + m * 16; const float rs = rs1024(SS1[row]);
#pragma unroll
          for (int bj = 0; bj < 2; ++bj) { const f32x4 a = acc[ai][bj][m][0] * rs, b = acc[ai][bj][m][1] * rs; u32x4_t w;
            w.x = pk2(gelu1(a[0]), gelu1(a[1])); w.y = pk2(gelu1(a[2]), gelu1(a[3])); w.z = pk2(gelu1(b[0]), gelu1(b[1])); w.w = pk2(gelu1(b[2]), gelu1(b[3]));
            *(u32x4_t*)(U + (size_t)row * 512 + u.pn * 256 + lc0 + 32 * bj) = w; asm volatile("" ::: "memory"); } }
    } else {
      const bool isq = region == 1; const float* wp = (isq ? qw : kw) + 8 * fq; bf16_t* dst = (isq ? Q : KB) + (u.pn & 1) * 256 + lc0; const float sc = isq ? QSCALE : 1.0f;
      f32x4 wv[2][2];
#pragma unroll
      for (int bj = 0; bj < 2; ++bj)
#pragma unroll
        for (int n = 0; n < 2; ++n) wv[bj][n] = *(const f32x4*)(wp + 32 * bj + 4 * n);
#pragma unroll
      for (int ai = 0; ai < 2; ++ai)
#pragma unroll
        for (int m = 0; m < 4; ++m) { const int row = row0 + ai * 128 + m * 16; const float rs = rs1024(SS1[row]); float ss = 0.f; f32x4 v[2][2];
#pragma unroll
          for (int bj = 0; bj < 2; ++bj)
#pragma unroll
            for (int n = 0; n < 2; ++n) { v[bj][n] = acc[ai][bj][m][n] * rs; const f32x4 t = v[bj][n]; ss += (t[0] * t[0] + t[1] * t[1]) + (t[2] * t[2] + t[3] * t[3]); }
          ss += __shfl_xor(ss, 16); ss += __shfl_xor(ss, 32);
          const float r2 = rsqrtf(ss * (1.0f / 64.0f) + EPS) * sc;
#pragma unroll
          for (int bj = 0; bj < 2; ++bj) { const f32x4 a = v[bj][0] * r2 * wv[bj][0], b = v[bj][1] * r2 * wv[bj][1]; u32x4_t w;
            w.x = pk2(a[0], a[1]); w.y = pk2(a[2], a[3]); w.z = pk2(b[0], b[1]); w.w = pk2(b[2], b[3]);
            *(u32x4_t*)(dst + (size_t)row * 512 + 32 * bj) = w; }
          asm volatile("" ::: "memory"); }
    }
  }
};
struct EpiA2 {
  static constexpr bool PERM = false, AFTER_DRAIN = false;
  const float* SS1; bf16_t *GVT, *VT; float* SSV;
  DI void operator()(const f32x4 (&acc)[2][2][4][2], const Unit& u, int wr, int wc, int fr, int fq) const {
    const int colbase = u.pn * 256 + wc * 32;
    f32x4 rs[2][2];
#pragma unroll
    for (int bj = 0; bj < 2; ++bj)
#pragma unroll
      for (int n = 0; n < 2; ++n) { const f32x4 s = *(const f32x4*)(SS1 + colbase + bj * 128 + n * 16 + 4 * fq); rs[bj][n] = (f32x4){rs1024(s[0]), rs1024(s[1]), rs1024(s[2]), rs1024(s[3])}; }
    if (u.pm < 2) {
#pragma unroll
      for (int ai = 0; ai < 2; ++ai) { const int head = 2 * u.pm + ai;
#pragma unroll
        for (int bj = 0; bj < 2; ++bj)
#pragma unroll
          for (int n = 0; n < 2; ++n) { f32x4 sq = (f32x4){0.f, 0.f, 0.f, 0.f}; const int tok = colbase + bj * 128 + n * 16 + 4 * fq;
#pragma unroll
            for (int m = 0; m < 4; ++m) { const int row = u.pm * 256 + ai * 128 + wr * 64 + m * 16 + fr;
              const f32x4 a = acc[ai][bj][m][n] * rs[bj][n]; f32x4 g; g[0] = gelu1(a[0]); g[1] = gelu1(a[1]); g[2] = gelu1(a[2]); g[3] = gelu1(a[3]);
              u32x2_t w; w.x = pk2(g[0], g[1]); w.y = pk2(g[2], g[3]); *(u32x2_t*)(GVT + (size_t)row * T_TOK + tok) = w; sq += g * g; }
#pragma unroll
            for (int e = 0; e < 4; ++e) { float s = sq[e]; s += __shfl_xor(s, 1); s += __shfl_xor(s, 2); s += __shfl_xor(s, 4); s += __shfl_xor(s, 8); sq[e] = s; }
            if (fr == 0) {
#pragma unroll
              for (int e = 0; e < 4; ++e) unsafeAtomicAdd(SSV + (size_t)(tok + e) * 4 + head, sq[e]); }
            asm volatile("" ::: "memory"); } }
    } else {
#pragma unroll
      for (int ai = 0; ai < 2; ++ai)
#pragma unroll
        for (int m = 0; m < 4; ++m) { const int row = (u.pm - 2) * 256 + ai * 128 + wr * 64 + m * 16 + fr;
#pragma unroll
          for (int bj = 0; bj < 2; ++bj)
#pragma unroll
            for (int n = 0; n < 2; ++n) { const f32x4 a = acc[ai][bj][m][n] * rs[bj][n]; u32x2_t w; w.x = pk2(a[0], a[1]); w.y = pk2(a[2], a[3]);
              *(u32x2_t*)(VT + (size_t)row * T_TOK + colbase + bj * 128 + n * 16 + 8 * (fq & 1) + 4 * (fq >> 1)) = w; } }
    }
  }
};
struct EpiD {
  static constexpr bool PERM = false, AFTER_DRAIN = false;
  const float* SS2; const float *cw, *cb; bf16_t* F; float *GB, *PB, *UB;
  DI void operator()(const f32x4 (&acc)[2][2][4][2], const Unit& u, int wr, int wc, int fr, int fq) const {
    const int cbase = u.pn * 128 + wc * 32 + 8 * fq;
    const int src1 = fq * 16 + ((fr + 15) & 15), src2 = fq * 16 + ((fr + 14) & 15);
#pragma unroll
    for (int ai = 0; ai < 2; ++ai) {
      const int rb = u.pm * 256 + ai * 128 + wr * 64, bd = rb >> 6;
      float rs[4];
#pragma unroll
      for (int m = 0; m < 4; ++m) rs[m] = rs1024(SS2[rb + 16 * m + fr]);
#pragma unroll
      for (int n = 0; n < 2; ++n) {
        const int cn = cbase + 4 * n;
        const f32x4 w0 = *(const f32x4*)(cw + cn), w1 = *(const f32x4*)(cw + DFF + cn), w2 = *(const f32x4*)(cw + 2 * DFF + cn), bb = *(const f32x4*)(cb + cn);
        float fo[4][4]; f32x4 pg, ug, gg;
#pragma unroll
        for (int e = 0; e < 4; ++e) {
          float G[4], r1[4], r2[4];
#pragma unroll
          for (int m = 0; m < 4; ++m) { G[m] = acc[ai][0][m][n][e] * rs[m]; r1[m] = __shfl(G[m], src1); r2[m] = __shfl(G[m], src2); }
#pragma unroll
          for (int m = 0; m < 4; ++m) {
            const float p1 = (fr >= 1) ? r1[m] : (m > 0 ? r1[m > 0 ? m - 1 : 0] : 0.f);
            const float p2 = (fr >= 2) ? r2[m] : (m > 0 ? r2[m > 0 ? m - 1 : 0] : 0.f);
            const float g = w2[e] * G[m] + w1[e] * p1 + w0[e] * p2 + bb[e];
            const float uv = acc[ai][1][m][n][e] * rs[m];
            if (m == 0) { pg[e] = g; ug[e] = uv; }
            if (m == 3) gg[e] = G[3];
            fo[m][e] = g * __builtin_amdgcn_rcpf(1.0f + __expf(-g)) * uv;
          }
        }
#pragma unroll
        for (int m = 0; m < 4; ++m) {
          if (!(m == 0 && fr < 2)) { u32x2_t w; w.x = pk2(fo[m][0], fo[m][1]); w.y = pk2(fo[m][2], fo[m][3]); *(u32x2_t*)(F + (size_t)(rb + 16 * m + fr) * DFF + cn) = w; }
        }
        if (fr < 2) { *(f32x4*)(PB + (size_t)(bd * 2 + fr) * DFF + cn) = pg; *(f32x4*)(UB + (size_t)(bd * 2 + fr) * DFF + cn) = ug; }
        if (fr >= 14) { *(f32x4*)(GB + (size_t)(bd * 2 + fr - 14) * DFF + cn) = gg; }
        asm volatile("" ::: "memory");
      }
    }
  }
};
DI void fixup_phase(const LP& lp, unsigned char* ws) {
  const float *GB = (const float*)(ws + OFF_GB), *PB = (const float*)(ws + OFF_PB), *UB = (const float*)(ws + OFF_UB); bf16_t* F = (bf16_t*)(ws + OFF_F);
  const int gtid = blockIdx.x * 512 + tid_opaque(), gsz = gridDim.x * 512;
  for (int w = gtid; w < 512 * 2 * 704; w += gsz) {
    const int c = (w % 704) * 4, j = (w / 704) & 1, bd = w / 1408;
    f32x4 g = *(const f32x4*)(PB + (size_t)(bd * 2 + j) * DFF + c);
    if (bd & 31) { const f32x4 gm1 = *(const f32x4*)(GB + (size_t)((bd - 1) * 2 + 1) * DFF + c); const f32x4 w0 = *(const f32x4*)(lp.conv_w + c);
      if (j == 0) { const f32x4 gm2 = *(const f32x4*)(GB + (size_t)((bd - 1) * 2) * DFF + c); const f32x4 w1 = *(const f32x4*)(lp.conv_w + DFF + c); g += w1 * gm1 + w0 * gm2; }
      else g += w0 * gm1; }
    const f32x4 uv = *(const f32x4*)(UB + (size_t)(bd * 2 + j) * DFF + c); float f[4];
#pragma unroll
    for (int e = 0; e < 4; ++e) f[e] = g[e] * __builtin_amdgcn_rcpf(1.0f + __expf(-g[e])) * uv[e];
    u32x2_t o; o.x = pk2(f[0], f[1]); o.y = pk2(f[2], f[3]);
    *(u32x2_t*)(F + (size_t)(bd * 64 + j) * DFF + c) = o;
  }
}

DI void spatial_phase(const LP& lp, unsigned char* ws, LAS unsigned char* lds) {
  const bf16_t *U = (const bf16_t*)(ws + OFF_U), *GVT = (const bf16_t*)(ws + OFF_GVT); const float* SSV = (const float*)(ws + OFF_SSV); bf16_t* MIX = (bf16_t*)(ws + OFF_MIX);
  LAS float* sr = (LAS float*)lds;
  const int tid = tid_opaque(), lane = tid & 63, w = __builtin_amdgcn_readfirstlane(tid >> 6), l15 = lane & 15, kq = lane >> 4;
  for (int it = blockIdx.x; it < 1024; it += gridDim.x) {
    const int h = it & 3, tok0 = (it >> 2) * 128;
    if (tid < 128) sr[tid] = rsqrtf(SSV[(size_t)(tok0 + tid) * 4 + h] * (1.0f / 128.0f) + EPS);
    __syncthreads();
    const int i0 = 16 * w, nks = (w < 4) ? 2 : 4, irow = tok0 + i0 + l15;
    bf16x8 yf[4];
#pragma unroll
    for (int ks = 0; ks < 4; ++ks) {
      u32x4_t o = (u32x4_t){0u, 0u, 0u, 0u};
      if (ks < nks) { const u32x4_t raw = *(const u32x4_t*)(lp.Wsp + (size_t)(h * 128 + i0 + l15) * 128 + ks * 32 + kq * 8);
        const LAS float* s = sr + ks * 32 + kq * 8;
        o.x = pk2(bflo(raw.x) * s[0], bfhi(raw.x) * s[1]); o.y = pk2(bflo(raw.y) * s[2], bfhi(raw.y) * s[3]); o.z = pk2(bflo(raw.z) * s[4], bfhi(raw.z) * s[5]); o.w = pk2(bflo(raw.w) * s[6], bfhi(raw.w) * s[7]); }
      yf[ks] = __builtin_bit_cast(bf16x8, o);
    }
    const float bias = lp.sp_b[h * 128 + i0 + l15];
    float o[8][4]; float ss = 0.f;
#pragma unroll
    for (int dt = 0; dt < 8; ++dt) {
      f32x4 acc = (f32x4){0.f, 0.f, 0.f, 0.f};
#pragma unroll
      for (int ks = 0; ks < 4; ++ks) if (ks < nks) {
        const bf16x8 xf = *(const bf16x8*)(GVT + (size_t)(h * 128 + 16 * dt + l15) * T_TOK + tok0 + ks * 32 + kq * 8);
        acc = __builtin_amdgcn_mfma_f32_16x16x32_bf16(xf, yf[ks], acc, 0, 0, 0); }
      const int d0 = 16 * dt + 4 * kq; const f32x4 wv = *(const f32x4*)(lp.v_norm_w + h * 128 + d0);
      const u32x2_t ur = *(const u32x2_t*)(U + (size_t)irow * 512 + h * 128 + d0);
      o[dt][0] = bflo(ur.x) * (acc[0] * wv[0] + bias); o[dt][1] = bfhi(ur.x) * (acc[1] * wv[1] + bias); o[dt][2] = bflo(ur.y) * (acc[2] * wv[2] + bias); o[dt][3] = bfhi(ur.y) * (acc[3] * wv[3] + bias);
      ss += (o[dt][0] * o[dt][0] + o[dt][1] * o[dt][1]) + (o[dt][2] * o[dt][2] + o[dt][3] * o[dt][3]);
    }
    ss += __shfl_xor(ss, 16); ss += __shfl_xor(ss, 32);
    const float rs = rsqrtf(ss * (1.0f / 128.0f) + EPS);
#pragma unroll
    for (int dt = 0; dt < 8; ++dt) { const int d0 = 16 * dt + 4 * kq; const f32x4 wo = *(const f32x4*)(lp.out_norm_w + h * 128 + d0);
      u32x2_t q; q.x = pk2(o[dt][0] * rs * wo[0], o[dt][1] * rs * wo[1]); q.y = pk2(o[dt][2] * rs * wo[2], o[dt][3] * rs * wo[3]);
      *(u32x2_t*)(MIX + (size_t)irow * 1024 + h * 128 + d0) = q; }
    __syncthreads();
  }
}

DI void attn_phase(const MParams& p, int l, LAS unsigned char* lds) {
  unsigned char* ws = p.ws;
  const bf16_t *Q = (const bf16_t*)(ws + OFF_Q), *KB = (const bf16_t*)(ws + OFF_KB), *VT = (const bf16_t*)(ws + OFF_VT); bf16_t* MIX = (bf16_t*)(ws + OFF_MIX);
  constexpr int KBUF = 16384, VBUF = 16384, STG = KBUF + VBUF, QOFF = 2 * STG;
  static_assert(QOFF + 65536 <= LDS_BYTES, "attention LDS");
  const float lambda_init = 0.8f - 0.6f * expf(-0.3f * (float)(l + 1));
  const float* dnw = p.in[13] + l * 128;
#pragma unroll 1
  for (int pi = blockIdx.x; pi < 256; pi += gridDim.x) {
    const int b = pi >> 4, h = (pi >> 2) & 3, j = pi & 3;
#pragma unroll 1
    for (int it = 0; it < 2; ++it) {
      const int tid = tid_opaque(), lane = tid & 63, w = __builtin_amdgcn_readfirstlane(tid >> 6), l31 = lane & 31, hh = lane >> 5;
      const int qb = it ? j : 7 - j, t0 = b * 2048 + 256 * qb, ntl = 4 * qb + 4, ntw = 4 * qb + (w >> 1) + 1;
#pragma unroll
      for (int i = 0; i < 8; ++i) { const int P = (w * 8 + i) * 64 + lane, row = P >> 4, pos = P & 15, pc = pos ^ (row & 15);
        __builtin_amdgcn_global_load_lds((const unsigned*)(Q + (size_t)(t0 + row) * 512 + h * 128 + pc * 8), (LAS unsigned*)(lds + QOFF + (w * 8 + i) * 1024), 16, 0, 0); }
      const bf16_t* kbase = KB + (size_t)(b * 2048) * 512 + h * 128; const bf16_t* vbase = VT + (size_t)(h * 128) * T_TOK + b * 2048;
      int koff[2], voff[2];
#pragma unroll
      for (int i = 0; i < 2; ++i) { const int P = (w * 2 + i) * 64 + lane; { const int row = P >> 4, pos = P & 15, pc = pos ^ (row & 15); koff[i] = row * 512 + pc * 8; }
        { const int row = P >> 3, pos = P & 7, pc = pos ^ ((row >> 1) & 7); voff[i] = row * T_TOK + pc * 8; } }
#define ATT_STAGE(kt, buf) do { _Pragma("unroll") for (int i = 0; i < 2; ++i) { \
        __builtin_amdgcn_global_load_lds((const unsigned*)(kbase + (size_t)(kt) * (64 * 512) + koff[i]), (LAS unsigned*)(lds + (buf) * STG + (w * 2 + i) * 1024), 16, 0, 0); \
        __builtin_amdgcn_global_load_lds((const unsigned*)(vbase + (kt) * 64 + voff[i]), (LAS unsigned*)(lds + (buf) * STG + KBUF + (w * 2 + i) * 1024), 16, 0, 0); } } while (0)
      ATT_STAGE(0, 0);
      asm volatile("s_waitcnt vmcnt(0)" ::: "memory");
      __syncthreads();
      f32x16 O[2][4];
#pragma unroll
      for (int c = 0; c < 2; ++c)
#pragma unroll
        for (int bk = 0; bk < 4; ++bk)
#pragma unroll
          for (int i = 0; i < 16; ++i) O[c][bk][i] = 0.f;
      float lsum[2] = {0.f, 0.f};
      const int qr = 32 * w + l31;
      int k_lane = l31 * 256 + ((hh ^ (l31 & 15)) << 4), q_lane = QOFF + qr * 256 + ((hh ^ (qr & 15)) << 4), v_lane = KBUF + l31 * 128 + ((hh ^ ((l31 >> 1) & 7)) << 4);
#pragma unroll 1
      for (int kt = 0; kt < ntl; ++kt) {
        if (kt + 1 < ntl) ATT_STAGE(kt + 1, (kt + 1) & 1);
        if (kt < ntw) {
          asm volatile("" : "+v"(k_lane), "+v"(q_lane), "+v"(v_lane));
          const LAS unsigned char* tb = lds + (kt & 1) * STG;
#pragma unroll
          for (int kb = 0; kb < 2; ++kb) {
            bf16x8 pf[2][2];
#pragma unroll
            for (int c = 0; c < 2; ++c) {
              f32x16 S;
#pragma unroll
              for (int i = 0; i < 16; ++i) S[i] = 0.f;
#pragma unroll
              for (int ks = 0; ks < 4; ++ks) {
                const int xo = (c * 8 + ks * 2) << 4;
                const bf16x8 qf = *(const LAS bf16x8*)(lds + (q_lane ^ xo));
                const bf16x8 kf = *(const LAS bf16x8*)(tb + (k_lane ^ xo) + kb * 8192);
                S = __builtin_amdgcn_mfma_f32_32x32x16_bf16(kf, qf, S, 0, 0, 0);
              }
              float ls = 0.f;
#pragma unroll
              for (int hs = 0; hs < 2; ++hs) { u32x4_t pw;
#pragma unroll
                for (int t = 0; t < 4; ++t) { const float a = __builtin_amdgcn_exp2f(S[8 * hs + 2 * t]), bq = __builtin_amdgcn_exp2f(S[8 * hs + 2 * t + 1]); ls += a + bq; pw[t] = pk2(a, bq); }
                pf[c][hs] = __builtin_bit_cast(bf16x8, pw); }
              lsum[c] += ls;
              __builtin_amdgcn_sched_barrier(0);
            }
#pragma unroll
            for (int bk = 0; bk < 4; ++bk) {
              const bf16x8 v0 = *(const LAS bf16x8*)(tb + (v_lane ^ ((2 * kb) << 5)) + bk * 4096);
              const bf16x8 v1 = *(const LAS bf16x8*)(tb + (v_lane ^ ((2 * kb + 1) << 5)) + bk * 4096);
              O[0][bk] = __builtin_amdgcn_mfma_f32_32x32x16_bf16(v0, pf[0][0], O[0][bk], 0, 0, 0);
              O[1][bk] = __builtin_amdgcn_mfma_f32_32x32x16_bf16(v0, pf[1][0], O[1][bk], 0, 0, 0);
              O[0][bk] = __builtin_amdgcn_mfma_f32_32x32x16_bf16(v1, pf[0][1], O[0][bk], 0, 0, 0);
              O[1][bk] = __builtin_amdgcn_mfma_f32_32x32x16_bf16(v1, pf[1][1], O[1][bk], 0, 0, 0);
              __builtin_amdgcn_sched_barrier(0);
            }
          }
        }
        asm volatile("s_waitcnt vmcnt(0)" ::: "memory");
        __syncthreads();
      }
#undef ATT_STAGE
      const int tid2 = tid_opaque(), lane2 = tid2 & 63, w2 = __builtin_amdgcn_readfirstlane(tid2 >> 6), hh2 = lane2 >> 5, qr2 = 32 * w2 + (lane2 & 31);
      float lam;
      { const float* q1 = p.in[9] + l * 64; const float* k1 = p.in[10] + l * 64; const float* q2 = p.in[11] + l * 64; const float* k2 = p.in[12] + l * 64;
        float a = q1[lane2] * k1[lane2], bq = q2[lane2] * k2[lane2]; a = wave_sum(a); bq = wave_sum(bq); lam = expf(a) - expf(bq) + lambda_init; }
      float l1 = lsum[0], l2 = lsum[1]; l1 += __shfl_xor(l1, 32); l2 += __shfl_xor(l2, 32);
      const float inv1 = 1.0f / l1, inv2 = lam / l2; float ss = 0.f;
#pragma unroll
      for (int bk = 0; bk < 4; ++bk)
#pragma unroll
        for (int i = 0; i < 16; ++i) { const float o = O[0][bk][i] * inv1 - O[1][bk][i] * inv2; O[0][bk][i] = o; ss += o * o; }
      ss += __shfl_xor(ss, 32);
      const float rs = rsqrtf(ss * (1.0f / 128.0f) + EPS) * (1.0f - lambda_init);
      bf16_t* orow = MIX + (size_t)(t0 + qr2) * 1024 + 512 + h * 128;
#pragma unroll
      for (int bk = 0; bk < 4; ++bk)
#pragma unroll
        for (int g = 0; g < 4; ++g) { const int dv0 = 32 * bk + 8 * g + 4 * hh2; const f32x4 wv = *(const f32x4*)(dnw + dv0);
          u32x2_t q; q.x = pk2(O[0][bk][4 * g] * rs * wv[0], O[0][bk][4 * g + 1] * rs * wv[1]); q.y = pk2(O[0][bk][4 * g + 2] * rs * wv[2], O[0][bk][4 * g + 3] * rs * wv[3]);
          *(u32x2_t*)(orow + dv0) = q; }
    }
  }
}

DI void zero_f32(float* p, int n) { for (int i = blockIdx.x * 512 + tid_opaque(); i < n; i += gridDim.x * 512) p[i] = 0.f; }

DI void phaseA(const MParams& p, int l, LAS unsigned char* lds) {
  unsigned char* ws = p.ws; const bf16_t* XB = (const bf16_t*)(ws + OFF_XB); const bf16_t* WinT = (const bf16_t*)(ws + OFF_W + (size_t)l * W_STRIDE + WO_IN); const float* SS1 = (const float*)(ws + OFF_SS1);
  zero_f32((float*)(ws + OFF_SS2), T_TOK);
  { pg8::Gemm g{XB, WinT, T_TOK, 1536, DM}; pg8::StaticOrder S; S.init(T_TOK, 1536, gridDim.x, blockIdx.x);
    EpiA1 E{SS1, (bf16_t*)(ws + OFF_U), (bf16_t*)(ws + OFF_Q), (bf16_t*)(ws + OFF_KB), p.in[7] + l * 64, p.in[8] + l * 64}; pg8::gemm_phase<EpiA1, pg8::StaticOrder>(lds, g, S, E); }
  { pg8::Gemm g{WinT + (size_t)1536 * DM, XB, 1024, T_TOK, DM}; pg8::StaticOrder S; S.init(1024, T_TOK, gridDim.x, blockIdx.x);
    EpiA2 E{SS1, (bf16_t*)(ws + OFF_GVT), (bf16_t*)(ws + OFF_VT), (float*)(ws + OFF_SSV)}; pg8::gemm_phase<EpiA2, pg8::StaticOrder>(lds, g, S, E); }
}
DI void phaseCE(const MParams& p, int l, bool isC, LAS unsigned char* lds) {
  unsigned char* ws = p.ws; const unsigned char* wb = ws + OFF_W + (size_t)l * W_STRIDE;
  if (isC) zero_f32((float*)(ws + OFF_SS1), T_TOK);
  pg8::Gemm g{(const bf16_t*)(ws + (isC ? OFF_MIX : OFF_F)), (const bf16_t*)(wb + (isC ? WO_OUT : WO_DN)), T_TOK, DM, isC ? DM : DFF}; pg8::StaticOrder S; S.init(T_TOK, DM, gridDim.x, blockIdx.x);
  EpiResid E{(isC && l == 0) ? p.in[0] : p.out, p.out, (bf16_t*)(ws + OFF_XB), (float*)(ws + (isC ? OFF_SS2 : OFF_SS1))}; pg8::gemm_phase<EpiResid, pg8::StaticOrder>(lds, g, S, E);
}
DI void phaseD(const MParams& p, int l, LAS unsigned char* lds) {
  unsigned char* ws = p.ws;
  zero_f32((float*)(ws + OFF_SSV), T_TOK * 4);
  pg8::Gemm g{(const bf16_t*)(ws + OFF_XB), (const bf16_t*)(ws + OFF_W + (size_t)l * W_STRIDE + WO_GU), T_TOK, 2 * DFF, DM}; pg8::StaticOrder S; S.init(T_TOK, 2 * DFF, gridDim.x, blockIdx.x);
  EpiD E{(const float*)(ws + OFF_SS2), p.in[18] + (size_t)l * 3 * DFF, p.in[19] + (size_t)l * DFF, (bf16_t*)(ws + OFF_F), (float*)(ws + OFF_GB), (float*)(ws + OFF_PB), (float*)(ws + OFF_UB)};
  pg8::gemm_phase<EpiD, pg8::StaticOrder>(lds, g, S, E);
}

__global__ void __launch_bounds__(512) k_run(MParams p) {
  extern __shared__ __attribute__((aligned(16))) unsigned char lds_raw[];
  LAS unsigned char* lds = (LAS unsigned char*)lds_raw;
  cg::grid_group grid = cg::this_grid();
  for (int ph = p.ph_lo; ph < p.ph_hi; ++ph) {
    if (ph == 0) { if (EN_MASK & 1) prologue(p); }
    else {
      const int l = (ph - 1) / 6, s = (ph - 1) % 6;
      if (s == 0) { if (EN_MASK & 2) phaseA(p, l, lds); }
      else if (s == 1) { if (EN_MASK & 4) attn_phase(p, l, lds); if (EN_MASK & 8) { const LP lp = make_lp(p, l); spatial_phase(lp, p.ws, lds); } }
      else if (s == 2 || s == 5) { if (EN_MASK & 16) phaseCE(p, l, s == 2, lds); }
      else if (s == 3) { if (EN_MASK & 32) phaseD(p, l, lds); }
      else { if (EN_MASK & 64) { const LP lp = make_lp(p, l); fixup_phase(lp, p.ws); } }
    }
    if (ph + 1 < p.ph_hi) grid.sync();
  }
}

#ifndef OPT_MASK
#define OPT_MASK 0x7f
#endif
static void launch_opt(const MParams& base, int ph_lo, int ph_hi, hipStream_t st) {
  MParams a = base; a.ph_lo = ph_lo; a.ph_hi = ph_hi;
  hipLaunchKernelGGL(k_run, dim3(256), dim3(512), LDS_BYTES, st, a);
}
static void run_layer(const Params& p, const MParams& mp, int l, hipStream_t st) {
  const LayerP& lp = p.L[l]; unsigned char* ws = p.ws;
  bf16_t *XB = (bf16_t*)(ws + OFF_XB), *U = (bf16_t*)(ws + OFF_U), *Q = (bf16_t*)(ws + OFF_Q), *KB = (bf16_t*)(ws + OFF_KB), *GVT = (bf16_t*)(ws + OFF_GVT), *VT = (bf16_t*)(ws + OFF_VT), *MIX = (bf16_t*)(ws + OFF_MIX), *F = (bf16_t*)(ws + OFF_F);
  float *SS1 = (float*)(ws + OFF_SS1), *SS2 = (float*)(ws + OFF_SS2), *SSV = (float*)(ws + OFF_SSV), *TMP1 = (float*)(ws + OFF_TMP1), *TMP2 = (float*)(ws + OFF_TMP2);
  const float* base = (l == 0) ? p.x : p.out; const int ph0 = 1 + 6 * l;
  if (OPT_MASK & 1) { hipMemsetAsync(SSV, 0, T_TOK * 16, st); launch_opt(mp, ph0, ph0 + 1, st); }
  else {
    for (int s = 0; s < 10; ++s) {
      n_gemm<<<dim3(4, T_TOK / 64), 256, 0, st>>>(XB, DM, lp.w_in, INW, s * 256, DM, lp.norm_attn_w, SS1, TMP1, 256);
      n_postA<<<T_TOK * 4 / 256, 256, 0, st>>>(TMP1, s, U, Q, KB, GVT, VT, lp.q_norm_w, lp.k_norm_w);
    }
    n_ssv<<<T_TOK * 4 / 256, 256, 0, st>>>(GVT, SSV);
  }
  if (OPT_MASK & 2) launch_opt(mp, ph0 + 1, ph0 + 2, st);
  else {
    n_spatial<<<dim3(T_TOK, 4), 128, 0, st>>>(U, GVT, SSV, lp.sp_w, lp.sp_b, lp.v_norm_w, lp.out_norm_w, MIX);
    n_attn<<<dim3(T_TOK, 4), 128, 0, st>>>(Q, KB, VT, MIX, lp);
  }
  if (OPT_MASK & 4) { hipMemsetAsync(SS2, 0, T_TOK * 4, st); launch_opt(mp, ph0 + 2, ph0 + 3, st); }
  else {
    for (int s = 0; s < 4; ++s) {
      n_gemm<<<dim3(4, T_TOK / 64), 256, 0, st>>>(MIX, DM, lp.w_out, DM, s * 256, DM, nullptr, nullptr, TMP1, 256);
      n_resid<<<T_TOK, 256, 0, st>>>(TMP1, s * 256, base, p.out, XB);
    }
    n_rowss<<<T_TOK / 4, 256, 0, st>>>(p.out, SS2);
  }
  if (OPT_MASK & 8) { launch_opt(mp, ph0 + 3, ph0 + 4, st); launch_opt(mp, ph0 + 4, ph0 + 5, st); }
  else {
    for (int s = 0; s < 11; ++s) {
      n_gemm<<<dim3(4, T_TOK / 64), 256, 0, st>>>(XB, DM, lp.w_gate, DFF, s * 256, DM, lp.norm_ffn_w, SS2, TMP1, 256);
      n_gemm<<<dim3(4, T_TOK / 64), 256, 0, st>>>(XB, DM, lp.w_up, DFF, s * 256, DM, lp.norm_ffn_w, SS2, TMP2, 256);
      n_postD<<<T_TOK, 256, 0, st>>>(TMP1, TMP2, s * 256, lp.conv_w, lp.conv_b, F);
    }
  }
  if (OPT_MASK & 32) { hipMemsetAsync(SS1, 0, T_TOK * 4, st); launch_opt(mp, ph0 + 5, ph0 + 6, st); }
  else {
    for (int s = 0; s < 4; ++s) {
      n_gemm<<<dim3(4, T_TOK / 64), 256, 0, st>>>(F, DFF, lp.w_down, DM, s * 256, DFF, nullptr, nullptr, TMP1, 256);
      n_resid<<<T_TOK, 256, 0, st>>>(TMP1, s * 256, p.out, p.out, XB);
    }
    n_rowss<<<T_TOK / 4, 256, 0, st>>>(p.out, SS1);
  }
}

extern "C" void kernel_launch(void* const* d_in, const int* in_sizes, int n_in, void* d_out, int out_size, void* d_ws, size_t ws_size, hipStream_t stream) {
  static int inited = 0;
  if (!inited) { hipFuncSetAttribute((const void*)k_run, hipFuncAttributeMaxDynamicSharedMemorySize, LDS_BYTES); inited = 1; }
  MParams mp; memset(&mp, 0, sizeof(mp));
  for (int i = 0; i < 21; ++i) mp.in[i] = (const float*)d_in[i];
  mp.out = (float*)d_out; mp.ws = (unsigned char*)d_ws;
  if (OPT_MASK == 0x7f) {
    static int grid_blocks = 0;
    if (!grid_blocks) { int dev = 0, cus = 0, per_cu = 0; hipGetDevice(&dev); hipDeviceGetAttribute(&cus, hipDeviceAttributeMultiprocessorCount, dev);
      hipOccupancyMaxActiveBlocksPerMultiprocessor(&per_cu, (const void*)k_run, 512, LDS_BYTES); if (per_cu < 1) per_cu = 1; grid_blocks = cus * per_cu; if (grid_blocks > 256) grid_blocks = 256; }
    mp.ph_lo = 0; mp.ph_hi = 1 + 6 * NLAYER;
    void* args[] = {&mp};
    hipError_t e = hipLaunchCooperativeKernel((const void*)k_run, dim3(grid_blocks), dim3(512), args, LDS_BYTES, stream);
    if (e != hipSuccess) fprintf(stderr, "cooperative launch failed: %s (grid %d)\n", hipGetErrorString(e), grid_blocks);
    return;
  }
  Params p; memset(&p, 0, sizeof(p));
  p.x = (const float*)d_in[0]; p.out = (float*)d_out; p.ws = (unsigned char*)d_ws;
  for (int l = 0; l < NLAYER; ++l) {
    LayerP& L = p.L[l];
    L.norm_attn_w = (const float*)d_in[1] + (size_t)l * DM; L.w_in = (const float*)d_in[2] + (size_t)l * DM * INW; L.v_norm_w = (const float*)d_in[3] + (size_t)l * 512;
    L.sp_w = (const float*)d_in[4] + (size_t)l * 4 * 128 * 128; L.sp_b = (const float*)d_in[5] + (size_t)l * 512; L.out_norm_w = (const float*)d_in[6] + (size_t)l * 512;
    L.q_norm_w = (const float*)d_in[7] + (size_t)l * 64; L.k_norm_w = (const float*)d_in[8] + (size_t)l * 64;
    L.lq1 = (const float*)d_in[9] + (size_t)l * 64; L.lk1 = (const float*)d_in[10] + (size_t)l * 64; L.lq2 = (const float*)d_in[11] + (size_t)l * 64; L.lk2 = (const float*)d_in[12] + (size_t)l * 64;
    L.diff_norm_w = (const float*)d_in[13] + (size_t)l * 128; L.w_out = (const float*)d_in[14] + (size_t)l * DM * DM; L.norm_ffn_w = (const float*)d_in[15] + (size_t)l * DM;
    L.w_gate = (const float*)d_in[16] + (size_t)l * DM * DFF; L.w_up = (const float*)d_in[17] + (size_t)l * DM * DFF; L.conv_w = (const float*)d_in[18] + (size_t)l * 3 * DFF;
    L.conv_b = (const float*)d_in[19] + (size_t)l * DFF; L.w_down = (const float*)d_in[20] + (size_t)l * DFF * DM;
    L.lambda_init = (float)(0.8 - 0.6 * exp(-0.3 * (double)(l + 1)));
  }
  launch_opt(mp, 0, 1, stream);
  for (int l = 0; l < NLAYER; ++l) run_layer(p, mp, l, stream);
}
```

```cpp
#include <hip/hip_runtime.h>
#include <hip/hip_cooperative_groups.h>
#include <cstdio>
#include <cmath>
#include <cstring>

typedef unsigned short bf16_t;
#define DI __device__ __forceinline__

constexpr int T_TOK = 32768, DM = 1024, SEQ = 2048, DFF = 2816, INW = 2560, NLAYER = 4;
constexpr float EPS = 1e-6f;
constexpr float QSCALE = 0.125f * 1.4426950408889634f;

constexpr size_t MiB = 1024ull * 1024ull;
constexpr size_t OFF_XB = 0;
constexpr size_t OFF_R = 64 * MiB;
constexpr size_t OFF_U = OFF_R, OFF_Q = OFF_R + 32 * MiB, OFF_KB = OFF_R + 64 * MiB, OFF_GVT = OFF_R + 96 * MiB, OFF_VT = OFF_R + 128 * MiB, OFF_MIX = OFF_R + 160 * MiB;
constexpr size_t OFF_F = OFF_R, OFF_GB = OFF_R + 176 * MiB, OFF_PB = OFF_R + 188 * MiB, OFF_UB = OFF_R + 200 * MiB;
constexpr size_t OFF_W = 288 * MiB, W_STRIDE = 24 * MiB;
constexpr size_t WO_IN = 0, WO_OUT = 5 * MiB, WO_GU = 7 * MiB, WO_DN = 18 * MiB, WO_SP = 23 * MiB + 512 * 1024;
constexpr size_t OFF_SS1 = 384 * MiB, OFF_SS2 = OFF_SS1 + 128 * 1024, OFF_SSV = OFF_SS2 + 128 * 1024;
constexpr size_t OFF_BAR = 385 * MiB;
constexpr size_t OFF_TMP1 = 386 * MiB, OFF_TMP2 = 418 * MiB;

DI int tid_opaque() { int t = threadIdx.x; asm volatile("" : "+v"(t)); return t; }
DI float bf2f(bf16_t b) { return __uint_as_float(((unsigned)b) << 16); }
DI bf16_t f2bf(float f) { unsigned u = __float_as_uint(f); u += 0x7FFFu + ((u >> 16) & 1u); return (bf16_t)(u >> 16); }
DI float gelu_exact(float x) { return 0.5f * x * (1.0f + erff(x * 0.70710678118654752f)); }
DI int permpos16(int k) { return (k & 3) + 4 * (k >> 3) + 8 * ((k >> 2) & 1); }
DI float wave_sum(float v) { for (int o = 32; o >= 1; o >>= 1) v += __shfl_xor(v, o); return v; }

struct LayerP {
  const float *norm_attn_w, *w_in, *v_norm_w, *sp_w, *sp_b, *out_norm_w, *q_norm_w, *k_norm_w, *lq1, *lk1, *lq2, *lk2, *diff_norm_w, *w_out, *norm_ffn_w, *w_gate, *w_up, *conv_w, *conv_b, *w_down;
  float lambda_init, pad0;
};
struct Params {
  const float* x; float* out; unsigned char* ws;
  LayerP L[NLAYER];
};

DI float compute_lam(const LayerP& lp) {
  const int lane = threadIdx.x & 63;
  float a = lp.lq1[lane] * lp.lk1[lane], b = lp.lq2[lane] * lp.lk2[lane];
  a = wave_sum(a); b = wave_sum(b);
  return expf(a) - expf(b) + lp.lambda_init;
}

__global__ __launch_bounds__(256) void n_prep_x(const float* x, bf16_t* XB, float* SS) {
  const int row = blockIdx.x * 4 + (threadIdx.x >> 6), lane = threadIdx.x & 63;
  const float* xp = x + (size_t)row * DM; float s = 0.f;
  for (int c = lane; c < DM; c += 64) { float v = xp[c]; s += v * v; XB[(size_t)row * DM + c] = f2bf(v); }
  s = wave_sum(s); if (lane == 0) SS[row] = s;
}
__global__ __launch_bounds__(256) void n_rowss(const float* x, float* SS) {
  const int row = blockIdx.x * 4 + (threadIdx.x >> 6), lane = threadIdx.x & 63;
  const float* xp = x + (size_t)row * DM; float s = 0.f;
  for (int c = lane; c < DM; c += 64) { float v = xp[c]; s += v * v; }
  s = wave_sum(s); if (lane == 0) SS[row] = s;
}
__global__ __launch_bounds__(256) void n_gemm(const bf16_t* A, int lda, const float* W, int ldw, int col0, int K, const float* kscale, const float* rowss, float* C, int ldc) {
  __shared__ float sA[16][65]; __shared__ float sB[16][64];
  const int tid = threadIdx.x, tx = tid & 15, ty = tid >> 4, m0 = blockIdx.y * 64, n0 = blockIdx.x * 64;
  float acc[4][4];
#pragma unroll
  for (int i = 0; i < 4; ++i)
#pragma unroll
    for (int j = 0; j < 4; ++j) acc[i][j] = 0.f;
  for (int k0 = 0; k0 < K; k0 += 16) {
    { const int r = tid >> 2, kk = (tid & 3) * 4; const bf16_t* ap = A + (size_t)(m0 + r) * lda + k0 + kk;
#pragma unroll
      for (int i = 0; i < 4; ++i) sA[kk + i][r] = bf2f(ap[i]) * (kscale ? kscale[k0 + kk + i] : 1.f); }
    { const int kk = tid >> 4, n = (tid & 15) * 4; const float* wp = W + (size_t)(k0 + kk) * ldw + col0 + n0 + n;
#pragma unroll
      for (int i = 0; i < 4; ++i) sB[kk][n + i] = wp[i]; }
    __syncthreads();
#pragma unroll
    for (int kk = 0; kk < 16; ++kk) {
      float a[4], b[4];
#pragma unroll
      for (int i = 0; i < 4; ++i) { a[i] = sA[kk][ty * 4 + i]; b[i] = sB[kk][tx * 4 + i]; }
#pragma unroll
      for (int i = 0; i < 4; ++i)
#pragma unroll
        for (int j = 0; j < 4; ++j) acc[i][j] += a[i] * b[j];
    }
    __syncthreads();
  }
#pragma unroll
  for (int i = 0; i < 4; ++i) { const int row = m0 + ty * 4 + i; const float rs = rowss ? rsqrtf(rowss[row] * (1.0f / DM) + EPS) : 1.f;
#pragma unroll
    for (int j = 0; j < 4; ++j) C[(size_t)row * ldc + n0 + tx * 4 + j] = acc[i][j] * rs; }
}
__global__ __launch_bounds__(256) void n_postA(const float* TMP, int slice, bf16_t* U, bf16_t* Q, bf16_t* KB, bf16_t* GVT, bf16_t* VT, const float* qw, const float* kw) {
  const int gid = blockIdx.x * 256 + threadIdx.x, t = gid >> 2, g = gid & 3;
  const float* tp = TMP + (size_t)t * 256 + g * 64; const int cb = slice * 256 + g * 64;
  if (cb < 512) { for (int d = 0; d < 64; ++d) U[(size_t)t * 512 + cb + d] = f2bf(gelu_exact(tp[d])); }
  else if (cb < 1024) { for (int d = 0; d < 64; ++d) GVT[(size_t)(cb - 512 + d) * T_TOK + t] = f2bf(gelu_exact(tp[d])); }
  else if (cb < 2048) { const bool isq = cb < 1536; float ss = 0.f; for (int d = 0; d < 64; ++d) ss += tp[d] * tp[d];
    const float rs = rsqrtf(ss * (1.0f / 64.0f) + EPS) * (isq ? QSCALE : 1.0f); const float* w = isq ? qw : kw; bf16_t* o = isq ? Q + (size_t)t * 512 + (cb - 1024) : KB + (size_t)t * 512 + (cb - 1536);
    for (int d = 0; d < 64; ++d) o[d] = f2bf(tp[d] * rs * w[d]); }
  else { const int tp16 = (t & ~15) + permpos16(t & 15); for (int d = 0; d < 64; ++d) VT[(size_t)(cb - 2048 + d) * T_TOK + tp16] = f2bf(tp[d]); }
}
__global__ __launch_bounds__(256) void n_ssv(const bf16_t* GVT, float* SSV) {
  const int gid = blockIdx.x * 256 + threadIdx.x, t = gid & (T_TOK - 1), h = gid >> 15; float s = 0.f;
  for (int d = 0; d < 128; ++d) { const float v = bf2f(GVT[(size_t)(h * 128 + d) * T_TOK + t]); s += v * v; }
  SSV[t * 4 + h] = s;
}
__global__ __launch_bounds__(128) void n_spatial(const bf16_t* U, const bf16_t* GVT, const float* SSV, const float* spw, const float* spb, const float* vnw, const float* onw, bf16_t* MIX) {
  const int t = blockIdx.x, h = blockIdx.y, d = threadIdx.x, t0 = t & ~127, i = t & 127, jmax = (i < 64) ? 64 : 128;
  __shared__ float red[2];
  float acc = 0.f; const float* wr = spw + ((size_t)h * 128 + i) * 128; const bf16_t* gp = GVT + (size_t)(h * 128 + d) * T_TOK + t0;
  for (int j = 0; j < jmax; ++j) acc += wr[j] * bf2f(gp[j]) * rsqrtf(SSV[(t0 + j) * 4 + h] * (1.0f / 128.0f) + EPS);
  const float mixed = acc * vnw[h * 128 + d] + spb[h * 128 + i];
  const float o = bf2f(U[(size_t)t * 512 + h * 128 + d]) * mixed;
  float ss = wave_sum(o * o); if ((d & 63) == 0) red[d >> 6] = ss; __syncthreads(); ss = red[0] + red[1];
  MIX[(size_t)t * 1024 + h * 128 + d] = f2bf(o * rsqrtf(ss * (1.0f / 128.0f) + EPS) * onw[h * 128 + d]);
}
__global__ __launch_bounds__(128) void n_attn(const bf16_t* Q, const bf16_t* KB, const bf16_t* VT, bf16_t* MIX, LayerP lp) {
  const int t = blockIdx.x, h = blockIdx.y, tid = threadIdx.x, b = t >> 11, s = t & 2047, nk = ((s >> 6) + 1) * 64;
  __shared__ float sq[128]; __shared__ float p1[2048]; __shared__ float p2[2048]; __shared__ float red[4];
  const float lam = compute_lam(lp);
  sq[tid] = bf2f(Q[(size_t)t * 512 + h * 128 + tid]); __syncthreads();
  float l1 = 0.f, l2 = 0.f;
  for (int key = tid; key < nk; key += 128) { const bf16_t* kp = KB + (size_t)(b * 2048 + key) * 512 + h * 128; float s1 = 0.f, s2 = 0.f;
    for (int d = 0; d < 64; ++d) { s1 += sq[d] * bf2f(kp[d]); s2 += sq[64 + d] * bf2f(kp[64 + d]); }
    const float e1 = exp2f(s1), e2 = exp2f(s2); p1[key] = e1; p2[key] = e2; l1 += e1; l2 += e2; }
  l1 = wave_sum(l1); l2 = wave_sum(l2); if ((tid & 63) == 0) { red[(tid >> 6) * 2] = l1; red[(tid >> 6) * 2 + 1] = l2; } __syncthreads();
  l1 = red[0] + red[2]; l2 = red[1] + red[3]; __syncthreads();
  const bf16_t* vp = VT + (size_t)(h * 128 + tid) * T_TOK + b * 2048; float o1 = 0.f, o2 = 0.f;
  for (int key = 0; key < nk; ++key) { const float v = bf2f(vp[(key & ~15) + permpos16(key & 15)]); o1 += p1[key] * v; o2 += p2[key] * v; }
  const float o = o1 / l1 - lam * o2 / l2;
  float ss = wave_sum(o * o); if ((tid & 63) == 0) red[tid >> 6] = ss; __syncthreads(); ss = red[0] + red[1];
  MIX[(size_t)t * 1024 + 512 + h * 128 + tid] = f2bf(o * rsqrtf(ss * (1.0f / 128.0f) + EPS) * lp.diff_norm_w[tid] * (1.0f - lp.lambda_init));
}
__global__ __launch_bounds__(256) void n_resid(const float* TMP, int col0, const float* base, float* X, bf16_t* XB) {
  const size_t gid = (size_t)blockIdx.x * 256 + threadIdx.x; const int t = (int)(gid >> 8), c = (int)(gid & 255);
  const size_t o = (size_t)t * DM + col0 + c; const float v = base[o] + TMP[gid]; X[o] = v; XB[o] = f2bf(v);
}
__global__ __launch_bounds__(256) void n_postD(const float* G, const float* Up, int col0, const float* cw, const float* cb, bf16_t* F) {
  const size_t gid = (size_t)blockIdx.x * 256 + threadIdx.x; const int t = (int)(gid >> 8), c = (int)(gid & 255), s = t & 2047, cc = col0 + c;
  float g = cw[2 * DFF + cc] * G[gid] + cb[cc];
  if (s >= 1) g += cw[DFF + cc] * G[gid - 256];
  if (s >= 2) g += cw[cc] * G[gid - 512];
  const float f = g / (1.0f + expf(-g)) * Up[gid];
  F[(size_t)t * DFF + cc] = f2bf(f);
}


namespace pg8 {
#define PG8_LAS __attribute__((address_space(3)))
typedef unsigned short bf16_t;
typedef short bf16x8 __attribute__((ext_vector_type(8)));
typedef float f32x4 __attribute__((ext_vector_type(4)));
typedef unsigned u32x4 __attribute__((ext_vector_type(4)));
constexpr int BM = 256, BK = 64, HALF = 128, HTB = HALF * BK * 2  , STAGE_BYTES = 8 * HTB, NXCD = 8, WGM = 8;

__host__ __device__ __forceinline__ int lds_byte(int r, int c) { const int st = (r >> 4) * 2 + (c >> 5), rr = r & 15, cc = c & 31, ob = rr * 64 + cc * 2; return st * 1024 + (ob ^ (((ob >> 9) & 1) << 5)); }
__host__ __device__ __forceinline__ void stage_rc(int b, int& R, int& C) { const int st = b / 1024, sb = b % 1024, swz = sb ^ (((sb >> 9) & 1) << 5); R = (st >> 1) * 16 + swz / 64; C = (st & 1) * 32 + (swz % 64) / 2; }
__host__ __device__ __forceinline__ int perm32(int rho) { const int n = rho >> 4, i = rho & 15; return 8 * (i >> 2) + 4 * n + (i & 3); }

struct Unit { int pm, pn; };
struct Gemm { const bf16_t* A; const bf16_t* Bt; int M, N, K; };

struct StaticOrder {
    int nM, nN, nwg, G, c;
    __host__ __device__ void init(int M, int N, int G_, int c_) { nM = M / BM; nN = N / BM; nwg = nM * nN; G = G_; c = c_; }
    __host__ __device__ bool next(int i, Unit& u) const {
        const long L = (long)i * G + c; if (L >= nwg) return false;
        int wgid = (int)L; { const int q = nwg / NXCD, r = nwg % NXCD, xcd = wgid % NXCD, off = wgid / NXCD; wgid = (xcd < r ? xcd * (q + 1) : r * (q + 1) + (xcd - r) * q) + off; }
        const int nig = WGM * nN, gid = wgid / nig, fm = gid * WGM, gsz = (nM - fm) < WGM ? (nM - fm) : WGM;
        u.pm = fm + ((wgid % nig) % gsz); u.pn = (wgid % nig) / gsz; return true;
    }
    __device__ __forceinline__ void a_ready(const Unit&) const {}
    __device__ __forceinline__ void done(const Unit&) const {}
};
template <class Epi, class Sched>
__device__ __forceinline__ void gemm_phase(PG8_LAS unsigned char* lds, const Gemm g, const Sched& S, const Epi& E) {
    const int tid = tid_opaque(), wid = __builtin_amdgcn_readfirstlane(tid >> 6), lane = tid & 63, wr = wid >> 2, wc = wid & 3, fr = lane & 15, fq = lane >> 4;
    const int K = g.K, nt = K / BK;
    unsigned voffA[2], voffB[2];
#pragma unroll
    for (int i = 0; i < 2; ++i) { int R, C; stage_rc(tid * 16 + i * 8192, R, C); const int Rb = Epi::PERM ? ((R & ~31) + perm32(R & 31)) : R;
        voffA[i] = (unsigned)(R * K + C) * 2u; voffB[i] = (unsigned)(Rb * K + C) * 2u; }
    const size_t kstep = (size_t)(BK * 2);
    const size_t hstep = (size_t)HALF * K * 2;
    const size_t tstep = 2 * hstep;
    const unsigned ldsw = (unsigned)wid * 1024u;
    const int aoff = lds_byte(wr * 64 + fr, fq * 8), boff = lds_byte(wc * 32 + fr, fq * 8);
#define PG8_SA(b, h) (((b) * 2 + (h)) * HTB)
#define PG8_SB(b, h) ((4 + (b) * 2 + (h)) * HTB)
#define PG8_STAGE(bufoff, gbase, voff) do { _Pragma("unroll") for (int _i = 0; _i < 2; ++_i) \
        __builtin_amdgcn_global_load_lds((const unsigned*)((const char*)(gbase) + (voff)[_i]), (PG8_LAS unsigned*)(lds + (bufoff) + ldsw + _i * 8192), 16, 0, 0); } while (0)
#define PG8_LDA(dst, b, h) do { _Pragma("unroll") for (int m = 0; m < 4; ++m) _Pragma("unroll") for (int k = 0; k < 2; ++k) dst[m][k] = *(const PG8_LAS bf16x8*)(lds + PG8_SA(b, h) + aoff + m * 2048 + k * 1024); } while (0)
#define PG8_LDB(dst, b, h) do { _Pragma("unroll") for (int n = 0; n < 2; ++n) _Pragma("unroll") for (int k = 0; k < 2; ++k) dst[n][k] = *(const PG8_LAS bf16x8*)(lds + PG8_SB(b, h) + boff + n * 2048 + k * 1024); } while (0)
#define PG8_MMA(ai, bj, At, Bt) do { __builtin_amdgcn_s_setprio(1); _Pragma("unroll") for (int m = 0; m < 4; ++m) _Pragma("unroll") for (int n = 0; n < 2; ++n) _Pragma("unroll") for (int k = 0; k < 2; ++k) \
        acc[ai][bj][m][n] = __builtin_amdgcn_mfma_f32_16x16x32_bf16(Bt[n][k], At[m][k], acc[ai][bj][m][n], 0, 0, 0); __builtin_amdgcn_s_setprio(0); } while (0)
#define PG8_WAIT_V(n) asm volatile("s_waitcnt vmcnt(" #n ")" ::: "memory")
#define PG8_WAIT_L(n) asm volatile("s_waitcnt lgkmcnt(" #n ")" ::: "memory")
#define PG8_BAR __builtin_amdgcn_s_barrier()
#define PG8_SCHED __builtin_amdgcn_sched_barrier(0)
    Unit cur, nxt; int ui = 0;
    if (!S.next(0, cur)) return;
    f32x4 acc[2][2][4][2];
#pragma unroll
    for (int a = 0; a < 2; ++a)
#pragma unroll
        for (int b = 0; b < 2; ++b)
#pragma unroll
            for (int m = 0; m < 4; ++m)
#pragma unroll
                for (int n = 0; n < 2; ++n) acc[a][b][m][n] = (f32x4){0.f, 0.f, 0.f, 0.f};
    bf16x8 At[4][2], B0[2][2], B1[2][2];
    const char* cA = (const char*)g.A + (size_t)cur.pm * tstep; const char* cB = (const char*)g.Bt + (size_t)cur.pn * tstep;
    S.a_ready(cur);
    PG8_STAGE(PG8_SB(0, 0), cB, voffB); PG8_STAGE(PG8_SA(0, 0), cA, voffA); PG8_STAGE(PG8_SB(0, 1), cB + hstep, voffB); PG8_STAGE(PG8_SA(0, 1), cA + hstep, voffA);
    if (wr == 1) PG8_BAR;
    PG8_WAIT_V(4); PG8_BAR;
    PG8_STAGE(PG8_SB(1, 0), cB + kstep, voffB); PG8_STAGE(PG8_SA(1, 0), cA + kstep, voffA); PG8_STAGE(PG8_SB(1, 1), cB + hstep + kstep, voffB);
    PG8_WAIT_V(6); PG8_BAR;
    for (;;) {
        const bool has_next = S.next(ui + 1, nxt);
        const char* nA = has_next ? (const char*)g.A + (size_t)nxt.pm * tstep : cA; const char* nB = has_next ? (const char*)g.Bt + (size_t)nxt.pn * tstep : cB;
        for (int t = 0; t < nt; t += 2) {
            const bool last = (t == nt - 2);
            const char* a1 = cA + (size_t)(t + 1) * kstep;
            const char* a2 = last ? nA : cA + (size_t)(t + 2) * kstep; const char* b2 = last ? nB : cB + (size_t)(t + 2) * kstep;
            const char* a3 = a2 + kstep; const char* b3 = b2 + kstep;
            if (last && has_next) S.a_ready(nxt);
            PG8_LDB(B0, 0, 0); PG8_SCHED; PG8_LDA(At, 0, 0); PG8_STAGE(PG8_SA(1, 1), a1 + hstep, voffA);
            PG8_WAIT_L(8); PG8_BAR; PG8_WAIT_L(0); PG8_MMA(0, 0, At, B0); PG8_BAR; PG8_SCHED;
            PG8_LDB(B1, 0, 1); PG8_STAGE(PG8_SB(0, 0), b2, voffB);
            PG8_BAR; PG8_WAIT_L(0); PG8_MMA(0, 1, At, B1); PG8_BAR;
            PG8_LDA(At, 0, 1); PG8_STAGE(PG8_SA(0, 0), a2, voffA);
            PG8_BAR; PG8_WAIT_L(0); PG8_MMA(1, 0, At, B0); PG8_BAR; PG8_SCHED;
            PG8_STAGE(PG8_SB(0, 1), b2 + hstep, voffB);
            PG8_WAIT_V(6); PG8_BAR; PG8_MMA(1, 1, At, B1); PG8_BAR;
            PG8_LDB(B0, 1, 0); PG8_SCHED; PG8_LDA(At, 1, 0); PG8_STAGE(PG8_SA(0, 1), a2 + hstep, voffA);
            PG8_WAIT_L(8); PG8_BAR; PG8_WAIT_L(0); PG8_MMA(0, 0, At, B0); PG8_BAR; PG8_SCHED;
            PG8_LDB(B1, 1, 1); PG8_STAGE(PG8_SB(1, 0), b3, voffB);
            PG8_BAR; PG8_WAIT_L(0); PG8_MMA(0, 1, At, B1); PG8_BAR;
            PG8_LDA(At, 1, 1); PG8_STAGE(PG8_SA(1, 0), a3, voffA);
            PG8_BAR; PG8_WAIT_L(0); PG8_MMA(1, 0, At, B0); PG8_BAR; PG8_SCHED;
            PG8_STAGE(PG8_SB(1, 1), b3 + hstep, voffB);
            PG8_WAIT_V(6); PG8_BAR; PG8_MMA(1, 1, At, B1); PG8_BAR;
        }
        if constexpr (!Epi::AFTER_DRAIN) { E(acc, cur, wr, wc, fr, fq); if constexpr (Epi::TWICE) { asm volatile("" ::: "memory"); E(acc, cur, wr, wc, fr, fq); } S.done(cur); }
        if (!has_next) break;
#pragma unroll
        for (int a = 0; a < 2; ++a)
#pragma unroll
            for (int b = 0; b < 2; ++b)
#pragma unroll
                for (int m = 0; m < 4; ++m)
#pragma unroll
                    for (int n = 0; n < 2; ++n) acc[a][b][m][n] = (f32x4){0.f, 0.f, 0.f, 0.f};
        cur = nxt; cA = nA; cB = nB; ++ui;
    }
    PG8_WAIT_V(0);
    if (wr == 0) PG8_BAR;
    PG8_BAR;
    if constexpr (Epi::AFTER_DRAIN) { E.fused(acc, cur, wr, wc, fr, fq, lds, wid, lane); S.done(cur); }
#undef PG8_SA
#undef PG8_SB
#undef PG8_STAGE
#undef PG8_LDA
#undef PG8_LDB
#undef PG8_MMA
#undef PG8_WAIT_V
#undef PG8_WAIT_L
#undef PG8_BAR
#undef PG8_SCHED
}
}

namespace cg = cooperative_groups;
using pg8::f32x4; using pg8::bf16x8; using pg8::Unit;
typedef unsigned u32x2_t __attribute__((ext_vector_type(2)));
typedef unsigned u32x4_t __attribute__((ext_vector_type(4)));
typedef float f32x16 __attribute__((ext_vector_type(16)));
typedef float f32x2_t __attribute__((ext_vector_type(2)));
#define LAS PG8_LAS
constexpr int LDS_BYTES = 131072 + 16;
#ifndef EN_MASK
#define EN_MASK 0x7f
#endif
#ifndef PROBE_EPI_D
#define PROBE_EPI_D 0
#endif
#ifndef PROBE_SYNC
#define PROBE_SYNC 0
#endif
#ifndef PROBE_MASK
#define PROBE_MASK 0x00
#endif

DI unsigned pk2(float lo, float hi) { unsigned r; asm volatile("v_cvt_pk_bf16_f32 %0, %1, %2" : "=v"(r) : "v"(lo), "v"(hi)); return r; }
DI float bflo(unsigned w) { return __uint_as_float(w << 16); }
DI float bfhi(unsigned w) { return __uint_as_float(w & 0xffff0000u); }
DI float gelu1(float v) {
  const float av = fabsf(v), t = __builtin_amdgcn_rcpf(av * 0.2316418882f + 1.0f);
  float q = t * 0.5307027145f + (-0.7265760135f); q = q * t + 0.7107068705f; q = q * t + (-0.142248368f); q = q * t + 0.127414796f; q = q * t;
  const float e = __builtin_amdgcn_exp2f((v * v) * (-0.72134752044f));
  const float m = v * (q * e);
  return v < 0.f ? m : v - m;
}
DI float rs1024(float ss) { return rsqrtf(ss * (1.0f / 1024.0f) + EPS); }

struct MParams { const float* in[21]; float* out; unsigned char* ws; int ph_lo, ph_hi; };
struct LP {
  const float *norm_attn_w, *w_in, *v_norm_w, *sp_w, *sp_b, *out_norm_w, *q_norm_w, *k_norm_w, *lq1, *lk1, *lq2, *lk2, *diff_norm_w, *w_out, *norm_ffn_w, *w_gate, *w_up, *conv_w, *conv_b, *w_down;
  float lambda_init;
  const bf16_t *WinT, *WoutT, *WguT, *WdT, *Wsp;
};
DI LP make_lp(const MParams& p, int l) {
  LP L;
  L.norm_attn_w = p.in[1] + (size_t)l * DM; L.w_in = p.in[2] + (size_t)l * DM * INW; L.v_norm_w = p.in[3] + (size_t)l * 512; L.sp_w = p.in[4] + (size_t)l * 65536; L.sp_b = p.in[5] + (size_t)l * 512;
  L.out_norm_w = p.in[6] + (size_t)l * 512; L.q_norm_w = p.in[7] + (size_t)l * 64; L.k_norm_w = p.in[8] + (size_t)l * 64; L.lq1 = p.in[9] + (size_t)l * 64; L.lk1 = p.in[10] + (size_t)l * 64;
  L.lq2 = p.in[11] + (size_t)l * 64; L.lk2 = p.in[12] + (size_t)l * 64; L.diff_norm_w = p.in[13] + (size_t)l * 128; L.w_out = p.in[14] + (size_t)l * DM * DM; L.norm_ffn_w = p.in[15] + (size_t)l * DM;
  L.w_gate = p.in[16] + (size_t)l * DM * DFF; L.w_up = p.in[17] + (size_t)l * DM * DFF; L.conv_w = p.in[18] + (size_t)l * 3 * DFF; L.conv_b = p.in[19] + (size_t)l * DFF; L.w_down = p.in[20] + (size_t)l * DFF * DM;
  L.lambda_init = 0.8f - 0.6f * expf(-0.3f * (float)(l + 1));
  const unsigned char* wb = p.ws + OFF_W + (size_t)l * W_STRIDE;
  L.WinT = (const bf16_t*)(wb + WO_IN); L.WoutT = (const bf16_t*)(wb + WO_OUT); L.WguT = (const bf16_t*)(wb + WO_GU); L.WdT = (const bf16_t*)(wb + WO_DN); L.Wsp = (const bf16_t*)(wb + WO_SP);
  return L;
}
DI float lam_of(const LP& lp) {
  const int lane = threadIdx.x & 63;
  float a = lp.lq1[lane] * lp.lk1[lane], b = lp.lq2[lane] * lp.lk2[lane];
  a = wave_sum(a); b = wave_sum(b);
  return expf(a) - expf(b) + lp.lambda_init;
}

DI void conv_item(bf16_t* dst, int K, int row, int kg, const float* src, int ld, int col, const float* ks) {
  float v[32];
#pragma unroll
  for (int i = 0; i < 32; ++i) v[i] = src[(size_t)(kg * 32 + i) * ld + col];
  if (ks) {
#pragma unroll
    for (int i = 0; i < 32; i += 4) { const f32x4 s = *(const f32x4*)(ks + kg * 32 + i); v[i] *= s[0]; v[i + 1] *= s[1]; v[i + 2] *= s[2]; v[i + 3] *= s[3]; }
  }
  u32x4_t* d = (u32x4_t*)(dst + (size_t)row * K + kg * 32);
#pragma unroll
  for (int i = 0; i < 4; ++i) { u32x4_t w; w.x = pk2(v[8 * i], v[8 * i + 1]); w.y = pk2(v[8 * i + 2], v[8 * i + 3]); w.z = pk2(v[8 * i + 4], v[8 * i + 5]); w.w = pk2(v[8 * i + 6], v[8 * i + 7]); d[i] = w; }
}
DI int perm_logical(int p) {
  const int bj = p >> 7, wc = (p >> 5) & 3, n = (p >> 4) & 1, fq = (p >> 2) & 3, e = p & 3;
  return 64 * wc + 32 * bj + 8 * fq + 4 * n + e;
}
DI void prologue(const MParams& p) {
  const int tidp = tid_opaque(); const int gtid = blockIdx.x * 512 + tidp, gsz = gridDim.x * 512;
  unsigned char* ws = p.ws;
  { const int gw = gtid >> 6, nw = gsz >> 6, lane = threadIdx.x & 63; bf16_t* XB = (bf16_t*)(ws + OFF_XB); float* SS1 = (float*)(ws + OFF_SS1);
    for (int row = gw; row < T_TOK; row += nw) { const float* xp = p.in[0] + (size_t)row * DM; float s = 0.f;
#pragma unroll
      for (int i = 0; i < 4; ++i) { const f32x4 v = *(const f32x4*)(xp + i * 256 + lane * 4); s += v[0] * v[0] + v[1] * v[1] + v[2] * v[2] + v[3] * v[3];
        u32x2_t w; w.x = pk2(v[0], v[1]); w.y = pk2(v[2], v[3]); *(u32x2_t*)(XB + (size_t)row * DM + i * 256 + lane * 4) = w; }
      s = wave_sum(s); if (lane == 0) SS1[row] = s; } }
  { float* SSV = (float*)(ws + OFF_SSV); for (int i = gtid; i < T_TOK * 4; i += gsz) SSV[i] = 0.f; }
  { unsigned* bw = (unsigned*)(ws + OFF_BAR); for (int i = gtid; i < 3456; i += gsz) bw[i] = 0u; }
  for (int l = 0; l < NLAYER; ++l) {
    const LP lp = make_lp(p, l);
    for (int w = gtid; w < 2560 * 32; w += gsz) { const int row = w % 2560, kg = w / 2560; int col;
      if (row < 1536) { const int L = (row & ~255) + perm_logical(row & 255); col = L < 512 ? L : L + 512; }
      else { const int r = row - 1536; col = r < 512 ? 512 + r : 1536 + r; }
      conv_item((bf16_t*)lp.WinT, 1024, row, kg, lp.w_in, INW, col, lp.norm_attn_w); }
    for (int w = gtid; w < 1024 * 32; w += gsz) { const int row = w % 1024, kg = w / 1024; conv_item((bf16_t*)lp.WoutT, 1024, row, kg, lp.w_out, DM, row, nullptr); }
    for (int w = gtid; w < 5632 * 32; w += gsz) { const int row = w % 5632, kg = w / 5632; const int pn = row >> 8, pp = row & 255, bj = pp >> 7;
      const int q = pp & 127, wc = (q >> 5) & 3, n = (q >> 4) & 1, fq = (q >> 2) & 3, e = q & 3; const int cc = 128 * pn + 32 * wc + 8 * fq + 4 * n + e;
      conv_item((bf16_t*)lp.WguT, 1024, row, kg, bj ? lp.w_up : lp.w_gate, DFF, cc, lp.norm_ffn_w); }
    for (int w = gtid; w < 1024 * 88; w += gsz) { const int row = w % 1024, kg = w / 1024; conv_item((bf16_t*)lp.WdT, DFF, row, kg, lp.w_down, DM, row, nullptr); }
    for (int i = gtid; i < 65536; i += gsz) { const int jj = i & 127, ii = (i >> 7) & 127; ((bf16_t*)lp.Wsp)[i] = ((jj >> 6) <= (ii >> 6)) ? f2bf(lp.sp_w[i]) : (bf16_t)0; }
  }
}

struct EpiResid {
  static constexpr bool PERM = false, AFTER_DRAIN = false, TWICE = false;
  const float* base; float* X; bf16_t* XB; float* SS;
  DI void operator()(const f32x4 (&acc)[2][2][4][2], const Unit& u, int wr, int wc, int fr, int fq) const {
    const int row0 = u.pm * 256 + wr * 64 + fr, col0 = u.pn * 256 + wc * 32 + 4 * fq;
    f32x4 nb[2][2];
#pragma unroll
    for (int bj = 0; bj < 2; ++bj)
#pragma unroll
      for (int n = 0; n < 2; ++n) nb[bj][n] = *(const f32x4*)(base + (size_t)row0 * DM + col0 + bj * 128 + n * 16);
#pragma unroll
    for (int g = 0; g < 8; ++g) { const int ai = g >> 2, m = g & 3; const int row = row0 + ai * 128 + m * 16; const size_t ro = (size_t)row * DM + col0; float ss = 0.f;
      f32x4 cbv[2][2];
#pragma unroll
      for (int bj = 0; bj < 2; ++bj)
#pragma unroll
        for (int n = 0; n < 2; ++n) cbv[bj][n] = nb[bj][n];
      if (g < 7) { const int r2 = row0 + ((g + 1) >> 2) * 128 + ((g + 1) & 3) * 16;
#pragma unroll
        for (int bj = 0; bj < 2; ++bj)
#pragma unroll
          for (int n = 0; n < 2; ++n) nb[bj][n] = *(const f32x4*)(base + (size_t)r2 * DM + col0 + bj * 128 + n * 16); }
#pragma unroll
      for (int bj = 0; bj < 2; ++bj)
#pragma unroll
        for (int n = 0; n < 2; ++n) { const size_t o = ro + bj * 128 + n * 16; const f32x4 v = acc[ai][bj][m][n] + cbv[bj][n]; *(f32x4*)(X + o) = v;
          u32x2_t w; w.x = pk2(v[0], v[1]); w.y = pk2(v[2], v[3]); *(u32x2_t*)(XB + o) = w; ss += (v[0] * v[0] + v[1] * v[1]) + (v[2] * v[2] + v[3] * v[3]); }
      ss += __shfl_xor(ss, 16); ss += __shfl_xor(ss, 32); if (fq == 0) unsafeAtomicAdd(SS + row, ss);
      asm volatile("" ::: "memory"); }
  }
};
struct EpiA1 {
  static constexpr bool PERM = false, AFTER_DRAIN = false, TWICE = false;
  const float* SS1; bf16_t *U, *Q, *KB; const float *qw, *kw;
  DI void operator()(const f32x4 (&acc)[2][2][4][2], const Unit& u, int wr, int wc, int fr, int fq) const {
    const int row0 = u.pm * 256 + wr * 64 + fr, lc0 = wc * 64 + 8 * fq, region = u.pn >> 1;
    float rsv[8];
#pragma unroll
    for (int g = 0; g < 8; ++g) rsv[g] = SS1[row0 + (g >> 2) * 128 + (g & 3) * 16];
    if (region == 0) {
#pragma unroll
      for (int g = 0; g < 8; ++g) { const int ai = g >> 2, m = g & 3; const int row = row0 + ai * 128 + m * 16; const float rs = rs1024(rsv[g]);
#pragma unroll
        for (int bj = 0; bj < 2; ++bj) { const f32x4 a = acc[ai][bj][m][0] * rs, b = acc[ai][bj][m][1] * rs; u32x4_t w;
          w.x = pk2(gelu1(a[0]), gelu1(a[1])); w.y = pk2(gelu1(a[2]), gelu1(a[3])); w.z = pk2(gelu1(b[0]), gelu1(b[1])); w.w = pk2(gelu1(b[2]), gelu1(b[3]));
          *(u32x4_t*)(U + (size_t)row * 512 + u.pn * 256 + lc0 + 32 * bj) = w; } }
    } else {
      const bool isq = region == 1; const float* wp = (isq ? qw : kw) + 8 * fq; bf16_t* dst = (isq ? Q : KB) + (u.pn & 1) * 256 + lc0; const float sc = isq ? QSCALE : 1.0f;
      f32x4 wv[2][2];
#pragma unroll
      for (int bj = 0; bj < 2; ++bj)
#pragma unroll
        for (int n = 0; n < 2; ++n) wv[bj][n] = *(const f32x4*)(wp + 32 * bj + 4 * n);
#pragma unroll
      for (int g = 0; g < 8; ++g) { const int ai = g >> 2, m = g & 3; const int row = row0 + ai * 128 + m * 16; const float rs = rs1024(rsv[g]); float ss = 0.f; f32x4 v[2][2];
#pragma unroll
        for (int bj = 0; bj < 2; ++bj)
#pragma unroll
          for (int n = 0; n < 2; ++n) { v[bj][n] = acc[ai][bj][m][n] * rs; const f32x4 t = v[bj][n]; ss += (t[0] * t[0] + t[1] * t[1]) + (t[2] * t[2] + t[3] * t[3]); }
        ss += __shfl_xor(ss, 16); ss += __shfl_xor(ss, 32);
        const float r2 = rsqrtf(ss * (1.0f / 64.0f) + EPS) * sc;
#pragma unroll
        for (int bj = 0; bj < 2; ++bj) { const f32x4 a = v[bj][0] * r2 * wv[bj][0], b = v[bj][1] * r2 * wv[bj][1]; u32x4_t w;
          w.x = pk2(a[0], a[1]); w.y = pk2(a[2], a[3]); w.z = pk2(b[0], b[1]); w.w = pk2(b[2], b[3]);
          *(u32x4_t*)(dst + (size_t)row * 512 + 32 * bj) = w; } }
    }
  }
};
struct EpiA2 {
  static constexpr bool PERM = false, AFTER_DRAIN = false, TWICE = false;
  const float* SS1; bf16_t *GVT, *VT; float* SSV;
  DI void operator()(const f32x4 (&acc)[2][2][4][2], const Unit& u, int wr, int wc, int fr, int fq) const {
    const int colbase = u.pn * 256 + wc * 32;
    f32x4 rs[2][2];
#pragma unroll
    for (int bj = 0; bj < 2; ++bj)
#pragma unroll
      for (int n = 0; n < 2; ++n) { const f32x4 s = *(const f32x4*)(SS1 + colbase + bj * 128 + n * 16 + 4 * fq); rs[bj][n] = (f32x4){rs1024(s[0]), rs1024(s[1]), rs1024(s[2]), rs1024(s[3])}; }
    if (u.pm < 2) {
#pragma unroll
      for (int ai = 0; ai < 2; ++ai) { const int head = 2 * u.pm + ai;
#pragma unroll
        for (int bj = 0; bj < 2; ++bj)
#pragma unroll
          for (int n = 0; n < 2; ++n) { f32x4 sq = (f32x4){0.f, 0.f, 0.f, 0.f}; const int tok = colbase + bj * 128 + n * 16 + 4 * fq;
#pragma unroll
            for (int m = 0; m < 4; ++m) { const int row = u.pm * 256 + ai * 128 + wr * 64 + m * 16 + fr;
              const f32x4 a = acc[ai][bj][m][n] * rs[bj][n]; f32x4 g; g[0] = gelu1(a[0]); g[1] = gelu1(a[1]); g[2] = gelu1(a[2]); g[3] = gelu1(a[3]);
              u32x2_t w; w.x = pk2(g[0], g[1]); w.y = pk2(g[2], g[3]); *(u32x2_t*)(GVT + (size_t)row * T_TOK + tok) = w; sq += g * g; }
#pragma unroll
            for (int e = 0; e < 4; ++e) { float s = sq[e]; s += __shfl_xor(s, 1); s += __shfl_xor(s, 2); s += __shfl_xor(s, 4); s += __shfl_xor(s, 8); sq[e] = s; }
            if (fr == 0) {
#pragma unroll
              for (int e = 0; e < 4; ++e) unsafeAtomicAdd(SSV + (size_t)(tok + e) * 4 + head, sq[e]); }
            asm volatile("" ::: "memory"); } }
    } else {
#pragma unroll
      for (int ai = 0; ai < 2; ++ai)
#pragma unroll
        for (int m = 0; m < 4; ++m) { const int row = (u.pm - 2) * 256 + ai * 128 + wr * 64 + m * 16 + fr;
#pragma unroll
          for (int bj = 0; bj < 2; ++bj)
#pragma unroll
            for (int n = 0; n < 2; ++n) { const f32x4 a = acc[ai][bj][m][n] * rs[bj][n]; u32x2_t w; w.x = pk2(a[0], a[1]); w.y = pk2(a[2], a[3]);
              *(u32x2_t*)(VT + (size_t)row * T_TOK + colbase + bj * 128 + n * 16 + 8 * (fq & 1) + 4 * (fq >> 1)) = w; } }
    }
  }
};
struct EpiD {
  static constexpr bool PERM = false, AFTER_DRAIN = false, TWICE = (PROBE_EPI_D != 0);
  const float* SS2; const float *cw, *cb; bf16_t* F; float *GB, *PB, *UB;
  DI void operator()(const f32x4 (&acc)[2][2][4][2], const Unit& u, int wr, int wc, int fr, int fq) const {
    const int cbase = u.pn * 128 + wc * 32 + 8 * fq;
    const int src1 = fq * 16 + ((fr + 15) & 15), src2 = fq * 16 + ((fr + 14) & 15);
    const int rb0 = u.pm * 256 + wr * 64;
    float rsv[8]; f32x4 w0[2], w1[2], w2[2], bb[2];
#pragma unroll
    for (int g = 0; g < 8; ++g) rsv[g] = SS2[rb0 + (g >> 2) * 128 + (g & 3) * 16 + fr];
#pragma unroll
    for (int n = 0; n < 2; ++n) { w0[n] = *(const f32x4*)(cw + cbase + 4 * n); w1[n] = *(const f32x4*)(cw + DFF + cbase + 4 * n); w2[n] = *(const f32x4*)(cw + 2 * DFF + cbase + 4 * n); bb[n] = *(const f32x4*)(cb + cbase + 4 * n); }
#pragma unroll
    for (int ai = 0; ai < 2; ++ai) {
      const int rb = rb0 + ai * 128, bd = rb >> 6;
      float rs[4];
#pragma unroll
      for (int m = 0; m < 4; ++m) rs[m] = rs1024(rsv[ai * 4 + m]);
      unsigned fo[4][4];
#pragma unroll
      for (int n = 0; n < 2; ++n) {
        const int cn = cbase + 4 * n;
        f32x4 pg, ug, gg; float fv[4][4];
#pragma unroll
        for (int e = 0; e < 4; ++e) {
          float G[4], r1[4], r2[4];
#pragma unroll
          for (int m = 0; m < 4; ++m) { G[m] = acc[ai][0][m][n][e] * rs[m]; r1[m] = __shfl(G[m], src1); r2[m] = __shfl(G[m], src2); }
#pragma unroll
          for (int m = 0; m < 4; ++m) {
            const float p1 = (fr >= 1) ? r1[m] : (m > 0 ? r1[m > 0 ? m - 1 : 0] : 0.f);
            const float p2 = (fr >= 2) ? r2[m] : (m > 0 ? r2[m > 0 ? m - 1 : 0] : 0.f);
            const float g = w2[n][e] * G[m] + w1[n][e] * p1 + w0[n][e] * p2 + bb[n][e];
            const float uv = acc[ai][1][m][n][e] * rs[m];
            if (m == 0) { pg[e] = g; ug[e] = uv; }
            if (m == 3) gg[e] = G[3];
            fv[m][e] = g * __builtin_amdgcn_rcpf(1.0f + __expf(-g)) * uv;
          }
        }
#pragma unroll
        for (int m = 0; m < 4; ++m) { fo[m][2 * n] = pk2(fv[m][0], fv[m][1]); fo[m][2 * n + 1] = pk2(fv[m][2], fv[m][3]); }
        if (fr < 2) { *(f32x4*)(PB + (size_t)(bd * 2 + fr) * DFF + cn) = pg; *(f32x4*)(UB + (size_t)(bd * 2 + fr) * DFF + cn) = ug; }
        if (fr >= 14) { *(f32x4*)(GB + (size_t)(bd * 2 + fr - 14) * DFF + cn) = gg; }
      }
#pragma unroll
      for (int m = 0; m < 4; ++m) {
        if (!(m == 0 && fr < 2)) { u32x4_t w; w.x = fo[m][0]; w.y = fo[m][1]; w.z = fo[m][2]; w.w = fo[m][3]; *(u32x4_t*)(F + (size_t)(rb + 16 * m + fr) * DFF + cbase) = w; }
      }
    }
  }
};
DI void fixup_phase(const LP& lp, unsigned char* ws) {
  const float *GB = (const float*)(ws + OFF_GB), *PB = (const float*)(ws + OFF_PB), *UB = (const float*)(ws + OFF_UB); bf16_t* F = (bf16_t*)(ws + OFF_F);
  const int gtid = blockIdx.x * 512 + tid_opaque(), gsz = gridDim.x * 512;
  for (int w = gtid; w < 512 * 2 * 704; w += gsz) {
    const int c = (w % 704) * 4, j = (w / 704) & 1, bd = w / 1408;
    f32x4 g = *(const f32x4*)(PB + (size_t)(bd * 2 + j) * DFF + c);
    if (bd & 31) { const f32x4 gm1 = *(const f32x4*)(GB + (size_t)((bd - 1) * 2 + 1) * DFF + c); const f32x4 w0 = *(const f32x4*)(lp.conv_w + c);
      if (j == 0) { const f32x4 gm2 = *(const f32x4*)(GB + (size_t)((bd - 1) * 2) * DFF + c); const f32x4 w1 = *(const f32x4*)(lp.conv_w + DFF + c); g += w1 * gm1 + w0 * gm2; }
      else g += w0 * gm1; }
    const f32x4 uv = *(const f32x4*)(UB + (size_t)(bd * 2 + j) * DFF + c); float f[4];
#pragma unroll
    for (int e = 0; e < 4; ++e) f[e] = g[e] * __builtin_amdgcn_rcpf(1.0f + __expf(-g[e])) * uv[e];
    u32x2_t o; o.x = pk2(f[0], f[1]); o.y = pk2(f[2], f[3]);
    *(u32x2_t*)(F + (size_t)(bd * 64 + j) * DFF + c) = o;
  }
}

DI void spatial_phase(const LP& lp, unsigned char* ws, LAS unsigned char* lds) {
  const bf16_t *U = (const bf16_t*)(ws + OFF_U), *GVT = (const bf16_t*)(ws + OFF_GVT); const float* SSV = (const float*)(ws + OFF_SSV); bf16_t* MIX = (bf16_t*)(ws + OFF_MIX);
  LAS float* sr = (LAS float*)lds;
  const int tid = tid_opaque(), lane = tid & 63, w = __builtin_amdgcn_readfirstlane(tid >> 6), l15 = lane & 15, kq = lane >> 4;
  for (int it = blockIdx.x; it < 1024; it += gridDim.x) {
    const int h = it & 3, tok0 = (it >> 2) * 128;
    if (tid < 128) sr[tid] = rsqrtf(SSV[(size_t)(tok0 + tid) * 4 + h] * (1.0f / 128.0f) + EPS);
    __syncthreads();
    const int i0 = 16 * w, nks = (w < 4) ? 2 : 4, irow = tok0 + i0 + l15;
    bf16x8 yf[4];
#pragma unroll
    for (int ks = 0; ks < 4; ++ks) {
      u32x4_t o = (u32x4_t){0u, 0u, 0u, 0u};
      if (ks < nks) { const u32x4_t raw = *(const u32x4_t*)(lp.Wsp + (size_t)(h * 128 + i0 + l15) * 128 + ks * 32 + kq * 8);
        const LAS float* s = sr + ks * 32 + kq * 8;
        o.x = pk2(bflo(raw.x) * s[0], bfhi(raw.x) * s[1]); o.y = pk2(bflo(raw.y) * s[2], bfhi(raw.y) * s[3]); o.z = pk2(bflo(raw.z) * s[4], bfhi(raw.z) * s[5]); o.w = pk2(bflo(raw.w) * s[6], bfhi(raw.w) * s[7]); }
      yf[ks] = __builtin_bit_cast(bf16x8, o);
    }
    const float bias = lp.sp_b[h * 128 + i0 + l15];
    float o[8][4]; float ss = 0.f;
#pragma unroll
    for (int dt = 0; dt < 8; ++dt) {
      f32x4 acc = (f32x4){0.f, 0.f, 0.f, 0.f};
#pragma unroll
      for (int ks = 0; ks < 4; ++ks) if (ks < nks) {
        const bf16x8 xf = *(const bf16x8*)(GVT + (size_t)(h * 128 + 16 * dt + l15) * T_TOK + tok0 + ks * 32 + kq * 8);
        acc = __builtin_amdgcn_mfma_f32_16x16x32_bf16(xf, yf[ks], acc, 0, 0, 0); }
      const int d0 = 16 * dt + 4 * kq; const f32x4 wv = *(const f32x4*)(lp.v_norm_w + h * 128 + d0);
      const u32x2_t ur = *(const u32x2_t*)(U + (size_t)irow * 512 + h * 128 + d0);
      o[dt][0] = bflo(ur.x) * (acc[0] * wv[0] + bias); o[dt][1] = bfhi(ur.x) * (acc[1] * wv[1] + bias); o[dt][2] = bflo(ur.y) * (acc[2] * wv[2] + bias); o[dt][3] = bfhi(ur.y) * (acc[3] * wv[3] + bias);
      ss += (o[dt][0] * o[dt][0] + o[dt][1] * o[dt][1]) + (o[dt][2] * o[dt][2] + o[dt][3] * o[dt][3]);
    }
    ss += __shfl_xor(ss, 16); ss += __shfl_xor(ss, 32);
    const float rs = rsqrtf(ss * (1.0f / 128.0f) + EPS);
#pragma unroll
    for (int dt = 0; dt < 8; ++dt) { const int d0 = 16 * dt + 4 * kq; const f32x4 wo = *(const f32x4*)(lp.out_norm_w + h * 128 + d0);
      u32x2_t q; q.x = pk2(o[dt][0] * rs * wo[0], o[dt][1] * rs * wo[1]); q.y = pk2(o[dt][2] * rs * wo[2], o[dt][3] * rs * wo[3]);
      *(u32x2_t*)(MIX + (size_t)irow * 1024 + h * 128 + d0) = q; }
    __syncthreads();
  }
}

DI void attn_phase(const MParams& p, int l, LAS unsigned char* lds) {
  unsigned char* ws = p.ws;
  const bf16_t *Q = (const bf16_t*)(ws + OFF_Q), *KB = (const bf16_t*)(ws + OFF_KB), *VT = (const bf16_t*)(ws + OFF_VT); bf16_t* MIX = (bf16_t*)(ws + OFF_MIX);
  constexpr int KBUF = 16384, VBUF = 16384, STG = KBUF + VBUF, QOFF = 2 * STG;
  static_assert(QOFF + 65536 <= LDS_BYTES, "attention LDS");
  const float lambda_init = 0.8f - 0.6f * expf(-0.3f * (float)(l + 1));
  const float* dnw = p.in[13] + l * 128;
#pragma unroll 1
  for (int pi = blockIdx.x; pi < 256; pi += gridDim.x) {
    const int b = pi >> 4, h = (pi >> 2) & 3, j = pi & 3;
#pragma unroll 1
    for (int it = 0; it < 2; ++it) {
      const int tid = tid_opaque(), lane = tid & 63, w = __builtin_amdgcn_readfirstlane(tid >> 6), l31 = lane & 31, hh = lane >> 5;
      const int qb = it ? j : 7 - j, t0 = b * 2048 + 256 * qb, ntl = 4 * qb + 4, ntw = 4 * qb + (w >> 1) + 1;
#pragma unroll
      for (int i = 0; i < 8; ++i) { const int P = (w * 8 + i) * 64 + lane, row = P >> 4, pos = P & 15, pc = pos ^ (row & 15);
        __builtin_amdgcn_global_load_lds((const unsigned*)(Q + (size_t)(t0 + row) * 512 + h * 128 + pc * 8), (LAS unsigned*)(lds + QOFF + (w * 8 + i) * 1024), 16, 0, 0); }
      const bf16_t* kbase = KB + (size_t)(b * 2048) * 512 + h * 128; const bf16_t* vbase = VT + (size_t)(h * 128) * T_TOK + b * 2048;
      int koff[2], voff[2];
#pragma unroll
      for (int i = 0; i < 2; ++i) { const int P = (w * 2 + i) * 64 + lane; { const int row = P >> 4, pos = P & 15, pc = pos ^ (row & 15); koff[i] = row * 512 + pc * 8; }
        { const int row = P >> 3, pos = P & 7, pc = pos ^ ((row >> 1) & 7); voff[i] = row * T_TOK + pc * 8; } }
#define ATT_STAGE(kt, buf) do { _Pragma("unroll") for (int i = 0; i < 2; ++i) { \
        __builtin_amdgcn_global_load_lds((const unsigned*)(kbase + (size_t)(kt) * (64 * 512) + koff[i]), (LAS unsigned*)(lds + (buf) * STG + (w * 2 + i) * 1024), 16, 0, 0); \
        __builtin_amdgcn_global_load_lds((const unsigned*)(vbase + (kt) * 64 + voff[i]), (LAS unsigned*)(lds + (buf) * STG + KBUF + (w * 2 + i) * 1024), 16, 0, 0); } } while (0)
      ATT_STAGE(0, 0);
      asm volatile("s_waitcnt vmcnt(0)" ::: "memory");
      __syncthreads();
      f32x16 O[2][4];
#pragma unroll
      for (int c = 0; c < 2; ++c)
#pragma unroll
        for (int bk = 0; bk < 4; ++bk)
#pragma unroll
          for (int i = 0; i < 16; ++i) O[c][bk][i] = 0.f;
      float lsum[2] = {0.f, 0.f};
      const int qr = 32 * w + l31;
      int k_lane = l31 * 256 + ((hh ^ (l31 & 15)) << 4), q_lane = QOFF + qr * 256 + ((hh ^ (qr & 15)) << 4), v_lane = KBUF + l31 * 128 + ((hh ^ ((l31 >> 1) & 7)) << 4);
#pragma unroll 1
      for (int kt = 0; kt < ntl; ++kt) {
        if (kt + 1 < ntl) ATT_STAGE(kt + 1, (kt + 1) & 1);
        if (kt < ntw) {
          asm volatile("" : "+v"(k_lane), "+v"(q_lane), "+v"(v_lane));
          const LAS unsigned char* tb = lds + (kt & 1) * STG;
#pragma unroll
          for (int kb = 0; kb < 2; ++kb) {
            bf16x8 pf[2][2];
#pragma unroll
            for (int c = 0; c < 2; ++c) {
              f32x16 S;
#pragma unroll
              for (int i = 0; i < 16; ++i) S[i] = 0.f;
#pragma unroll
              for (int ks = 0; ks < 4; ++ks) {
                const int xo = (c * 8 + ks * 2) << 4;
                const bf16x8 qf = *(const LAS bf16x8*)(lds + (q_lane ^ xo));
                const bf16x8 kf = *(const LAS bf16x8*)(tb + (k_lane ^ xo) + kb * 8192);
                S = __builtin_amdgcn_mfma_f32_32x32x16_bf16(kf, qf, S, 0, 0, 0);
              }
              float ls = 0.f;
#pragma unroll
              for (int hs = 0; hs < 2; ++hs) { u32x4_t pw;
#pragma unroll
                for (int t = 0; t < 4; ++t) { const float a = __builtin_amdgcn_exp2f(S[8 * hs + 2 * t]), bq = __builtin_amdgcn_exp2f(S[8 * hs + 2 * t + 1]); ls += a + bq; pw[t] = pk2(a, bq); }
                pf[c][hs] = __builtin_bit_cast(bf16x8, pw); }
              lsum[c] += ls;
              __builtin_amdgcn_sched_barrier(0);
            }
#pragma unroll
            for (int bk = 0; bk < 4; ++bk) {
              const bf16x8 v0 = *(const LAS bf16x8*)(tb + (v_lane ^ ((2 * kb) << 5)) + bk * 4096);
              const bf16x8 v1 = *(const LAS bf16x8*)(tb + (v_lane ^ ((2 * kb + 1) << 5)) + bk * 4096);
              O[0][bk] = __builtin_amdgcn_mfma_f32_32x32x16_bf16(v0, pf[0][0], O[0][bk], 0, 0, 0);
              O[1][bk] = __builtin_amdgcn_mfma_f32_32x32x16_bf16(v0, pf[1][0], O[1][bk], 0, 0, 0);
              O[0][bk] = __builtin_amdgcn_mfma_f32_32x32x16_bf16(v1, pf[0][1], O[0][bk], 0, 0, 0);
              O[1][bk] = __builtin_amdgcn_mfma_f32_32x32x16_bf16(v1, pf[1][1], O[1][bk], 0, 0, 0);
              __builtin_amdgcn_sched_barrier(0);
            }
          }
        }
        asm volatile("s_waitcnt vmcnt(0)" ::: "memory");
        __syncthreads();
      }
#undef ATT_STAGE
      const int tid2 = tid_opaque(), lane2 = tid2 & 63, w2 = __builtin_amdgcn_readfirstlane(tid2 >> 6), hh2 = lane2 >> 5, qr2 = 32 * w2 + (lane2 & 31);
      float lam;
      { const float* q1 = p.in[9] + l * 64; const float* k1 = p.in[10] + l * 64; const float* q2 = p.in[11] + l * 64; const float* k2 = p.in[12] + l * 64;
        float a = q1[lane2] * k1[lane2], bq = q2[lane2] * k2[lane2]; a = wave_sum(a); bq = wave_sum(bq); lam = expf(a) - expf(bq) + lambda_init; }
      float l1 = lsum[0], l2 = lsum[1]; l1 += __shfl_xor(l1, 32); l2 += __shfl_xor(l2, 32);
      const float inv1 = 1.0f / l1, inv2 = lam / l2; float ss = 0.f;
#pragma unroll
      for (int bk = 0; bk < 4; ++bk)
#pragma unroll
        for (int i = 0; i < 16; ++i) { const float o = O[0][bk][i] * inv1 - O[1][bk][i] * inv2; O[0][bk][i] = o; ss += o * o; }
      ss += __shfl_xor(ss, 32);
      const float rs = rsqrtf(ss * (1.0f / 128.0f) + EPS) * (1.0f - lambda_init);
      bf16_t* orow = MIX + (size_t)(t0 + qr2) * 1024 + 512 + h * 128;
#pragma unroll
      for (int bk = 0; bk < 4; ++bk)
#pragma unroll
        for (int g = 0; g < 4; ++g) { const int dv0 = 32 * bk + 8 * g + 4 * hh2; const f32x4 wv = *(const f32x4*)(dnw + dv0);
          u32x2_t q; q.x = pk2(O[0][bk][4 * g] * rs * wv[0], O[0][bk][4 * g + 1] * rs * wv[1]); q.y = pk2(O[0][bk][4 * g + 2] * rs * wv[2], O[0][bk][4 * g + 3] * rs * wv[3]);
          *(u32x2_t*)(orow + dv0) = q; }
    }
  }
}


#define XB_TMO      128
#define XB_XCNT(j)  (256  + 64 * (j))
#define XB_XSUB(j)  (1280 + 64 * (j))
#define XB_XGEN(j)  (2304 + 64 * (j))
#define XB_TOP      3328
#define XB_TOPGEN   3392
#define XCD_BAR_WORDS 3456
#define XB_SPIN_CAP (1u << 18)

__device__ __forceinline__ unsigned xb_ld(unsigned* p)              { return __hip_atomic_load(p, __ATOMIC_RELAXED, __HIP_MEMORY_SCOPE_AGENT); }
__device__ __forceinline__ unsigned xb_add(unsigned* p, unsigned v) { return __hip_atomic_fetch_add(p, v, __ATOMIC_RELAXED, __HIP_MEMORY_SCOPE_AGENT); }
__device__ __forceinline__ unsigned xb_xcc_id() { return (unsigned)__builtin_amdgcn_s_getreg((3 << 11) | 20) & 0xFu; }
#define XB_SPIN(cond, bar) do { unsigned _sp = 0; while (cond) { __builtin_amdgcn_s_sleep(1); \
    if ((++_sp & 255u) == 0u) { if (xb_ld(&(bar)[XB_TMO])) break; if (_sp > XB_SPIN_CAP) { atomicAdd(&(bar)[XB_TMO], 1u); break; } } } } while (0)

struct XcdBarrier {
    unsigned* bar; unsigned x;
    volatile LAS unsigned* st;
};

__device__ __forceinline__ XcdBarrier xcd_barrier_post(unsigned* bar, volatile LAS unsigned* st) {
    XcdBarrier b; b.bar = bar; b.x = xb_xcc_id(); b.st = st;
    if (threadIdx.x == 0) (void)xb_add(&bar[XB_XCNT(b.x)], 1u);
    return b;
}
__device__ __forceinline__ void xcd_barrier_complete(unsigned* bar, unsigned x, unsigned& nloc, unsigned& nx) {
    const unsigned G = gridDim.x * gridDim.y * gridDim.z;
    unsigned sum, cnt, mine, sp = 0u;
    for (;;) {
        sum = 0u; cnt = 0u; mine = 0u;
#pragma unroll
        for (unsigned j = 0; j < 16; ++j) { const unsigned c = xb_ld(&bar[XB_XCNT(j)]); sum += c; cnt += (c > 0u) ? 1u : 0u; mine = (j == x) ? c : mine; }
        if (sum == G) break;
        __builtin_amdgcn_s_sleep(1);
        if ((++sp & 255u) == 0u) { if (xb_ld(&bar[XB_TMO])) break; if (sp > XB_SPIN_CAP) { atomicAdd(&bar[XB_TMO], 1u); break; } }
    }
    nloc = mine > 0u ? mine : 1u; nx = cnt > 0u ? cnt : 1u;
}

__device__ __forceinline__ void xcd_barrier(const XcdBarrier& b) {
    asm volatile("s_waitcnt vmcnt(0)" ::: "memory");
    __syncthreads();
    if (threadIdx.x == 0) {
        unsigned* bar = b.bar;
        __builtin_amdgcn_s_waitcnt(0);
        unsigned nloc = b.st[0], nx = b.st[1];
        if (nloc == 0u) { xcd_barrier_complete(bar, b.x, nloc, nx); b.st[0] = nloc; b.st[1] = nx; }
        const unsigned old = xb_add(&bar[XB_XSUB(b.x)], 1u);
        const unsigned gen = old / nloc;
        if (old + 1u == (gen + 1u) * nloc) {
            __builtin_amdgcn_fence(__ATOMIC_RELEASE, "agent");
            asm volatile("s_waitcnt vmcnt(0)" ::: "memory");
            const unsigned og = xb_add(&bar[XB_TOP], 1u);
            const unsigned tg = og / nx;
            if (og + 1u == (tg + 1u) * nx) xb_add(&bar[XB_TOPGEN], 1u);
            else XB_SPIN(xb_ld(&bar[XB_TOPGEN]) == tg, bar);
            __builtin_amdgcn_fence(__ATOMIC_ACQUIRE, "agent");
            xb_add(&bar[XB_XGEN(b.x)], 1u);
            asm volatile("s_waitcnt vmcnt(0)" ::: "memory");
        } else {
            XB_SPIN(xb_ld(&bar[XB_XGEN(b.x)]) == gen, bar);
            __builtin_amdgcn_fence(__ATOMIC_ACQUIRE, "agent");
            asm volatile("s_waitcnt vmcnt(0)" ::: "memory");
        }
    }
    __syncthreads();
}

DI void zero_f32(float* p, int n) { for (int i = blockIdx.x * 512 + tid_opaque(); i < n; i += gridDim.x * 512) p[i] = 0.f; }

DI void phaseA(const MParams& p, int l, LAS unsigned char* lds) {
  unsigned char* ws = p.ws; const bf16_t* XB = (const bf16_t*)(ws + OFF_XB); const bf16_t* WinT = (const bf16_t*)(ws + OFF_W + (size_t)l * W_STRIDE + WO_IN); const float* SS1 = (const float*)(ws + OFF_SS1);
  zero_f32((float*)(ws + OFF_SS2), T_TOK);
  { pg8::Gemm g{XB, WinT, T_TOK, 1536, DM}; pg8::StaticOrder S; S.init(T_TOK, 1536, gridDim.x, blockIdx.x);
    EpiA1 E{SS1, (bf16_t*)(ws + OFF_U), (bf16_t*)(ws + OFF_Q), (bf16_t*)(ws + OFF_KB), p.in[7] + l * 64, p.in[8] + l * 64}; pg8::gemm_phase<EpiA1, pg8::StaticOrder>(lds, g, S, E); }
  { pg8::Gemm g{WinT + (size_t)1536 * DM, XB, 1024, T_TOK, DM}; pg8::StaticOrder S; S.init(1024, T_TOK, gridDim.x, blockIdx.x);
    EpiA2 E{SS1, (bf16_t*)(ws + OFF_GVT), (bf16_t*)(ws + OFF_VT), (float*)(ws + OFF_SSV)}; pg8::gemm_phase<EpiA2, pg8::StaticOrder>(lds, g, S, E); }
}
DI void phaseCE(const MParams& p, int l, bool isC, LAS unsigned char* lds) {
  unsigned char* ws = p.ws; const unsigned char* wb = ws + OFF_W + (size_t)l * W_STRIDE;
  if (isC) zero_f32((float*)(ws + OFF_SS1), T_TOK);
  pg8::Gemm g{(const bf16_t*)(ws + (isC ? OFF_MIX : OFF_F)), (const bf16_t*)(wb + (isC ? WO_OUT : WO_DN)), T_TOK, DM, isC ? DM : DFF}; pg8::StaticOrder S; S.init(T_TOK, DM, gridDim.x, blockIdx.x);
  EpiResid E{(isC && l == 0) ? p.in[0] : p.out, p.out, (bf16_t*)(ws + OFF_XB), (float*)(ws + (isC ? OFF_SS2 : OFF_SS1))}; pg8::gemm_phase<EpiResid, pg8::StaticOrder>(lds, g, S, E);
}
DI void phaseD(const MParams& p, int l, LAS unsigned char* lds) {
  unsigned char* ws = p.ws;
  zero_f32((float*)(ws + OFF_SSV), T_TOK * 4);
  pg8::Gemm g{(const bf16_t*)(ws + OFF_XB), (const bf16_t*)(ws + OFF_W + (size_t)l * W_STRIDE + WO_GU), T_TOK, 2 * DFF, DM}; pg8::StaticOrder S; S.init(T_TOK, 2 * DFF, gridDim.x, blockIdx.x);
  EpiD E{(const float*)(ws + OFF_SS2), p.in[18] + (size_t)l * 3 * DFF, p.in[19] + (size_t)l * DFF, (bf16_t*)(ws + OFF_F), (float*)(ws + OFF_GB), (float*)(ws + OFF_PB), (float*)(ws + OFF_UB)};
  pg8::gemm_phase<EpiD, pg8::StaticOrder>(lds, g, S, E);
}

__global__ void __launch_bounds__(512) k_run(MParams p) {
  extern __shared__ __attribute__((aligned(16))) unsigned char lds_raw[];
  LAS unsigned char* lds = (LAS unsigned char*)lds_raw;
  cg::grid_group grid = cg::this_grid();
  if (threadIdx.x < 4) ((LAS unsigned*)(lds + 131072))[threadIdx.x] = 0u;
  __syncthreads();
  XcdBarrier xbar; xbar.bar = (unsigned*)(p.ws + OFF_BAR); xbar.x = 0; xbar.st = (volatile LAS unsigned*)(lds + 131072);
  for (int ph = p.ph_lo; ph < p.ph_hi; ++ph) {
    for (int rep = 0; rep < 1 + ((PROBE_MASK >> (ph == 0 ? 6 : (ph - 1) % 6)) & 1); ++rep) {
    if (ph == 0) { if (EN_MASK & 1) prologue(p); }
    else {
      const int l = (ph - 1) / 6, s = (ph - 1) % 6;
      if (s == 0) { if (EN_MASK & 2) phaseA(p, l, lds); }
      else if (s == 1) { if (EN_MASK & 4) attn_phase(p, l, lds); if (EN_MASK & 8) { const LP lp = make_lp(p, l); spatial_phase(lp, p.ws, lds); } }
      else if (s == 2 || s == 5) { if (EN_MASK & 16) phaseCE(p, l, s == 2, lds); }
      else if (s == 3) { if (EN_MASK & 32) phaseD(p, l, lds); }
      else { if (EN_MASK & 64) { const LP lp = make_lp(p, l); fixup_phase(lp, p.ws); } }
    }
    }
    if (ph + 1 < p.ph_hi) {
      if (ph == 0 || p.ph_lo != 0) {
        grid.sync();
        if (p.ph_lo == 0) xbar = xcd_barrier_post((unsigned*)(p.ws + OFF_BAR), (volatile LAS unsigned*)(lds + 131072));
      } else xcd_barrier(xbar);
    }
  }
}

#ifndef OPT_MASK
#define OPT_MASK 0x7f
#endif
static void launch_opt(const MParams& base, int ph_lo, int ph_hi, hipStream_t st) {
  MParams a = base; a.ph_lo = ph_lo; a.ph_hi = ph_hi;
  hipLaunchKernelGGL(k_run, dim3(256), dim3(512), LDS_BYTES, st, a);
}
static void run_layer(const Params& p, const MParams& mp, int l, hipStream_t st) {
  const LayerP& lp = p.L[l]; unsigned char* ws = p.ws;
  bf16_t *XB = (bf16_t*)(ws + OFF_XB), *U = (bf16_t*)(ws + OFF_U), *Q = (bf16_t*)(ws + OFF_Q), *KB = (bf16_t*)(ws + OFF_KB), *GVT = (bf16_t*)(ws + OFF_GVT), *VT = (bf16_t*)(ws + OFF_VT), *MIX = (bf16_t*)(ws + OFF_MIX), *F = (bf16_t*)(ws + OFF_F);
  float *SS1 = (float*)(ws + OFF_SS1), *SS2 = (float*)(ws + OFF_SS2), *SSV = (float*)(ws + OFF_SSV), *TMP1 = (float*)(ws + OFF_TMP1), *TMP2 = (float*)(ws + OFF_TMP2);
  const float* base = (l == 0) ? p.x : p.out; const int ph0 = 1 + 6 * l;
  if (OPT_MASK & 1) { hipMemsetAsync(SSV, 0, T_TOK * 16, st); launch_opt(mp, ph0, ph0 + 1, st); }
  else {
    for (int s = 0; s < 10; ++s) {
      n_gemm<<<dim3(4, T_TOK / 64), 256, 0, st>>>(XB, DM, lp.w_in, INW, s * 256, DM, lp.norm_attn_w, SS1, TMP1, 256);
      n_postA<<<T_TOK * 4 / 256, 256, 0, st>>>(TMP1, s, U, Q, KB, GVT, VT, lp.q_norm_w, lp.k_norm_w);
    }
    n_ssv<<<T_TOK * 4 / 256, 256, 0, st>>>(GVT, SSV);
  }
  if (OPT_MASK & 2) launch_opt(mp, ph0 + 1, ph0 + 2, st);
  else {
    n_spatial<<<dim3(T_TOK, 4), 128, 0, st>>>(U, GVT, SSV, lp.sp_w, lp.sp_b, lp.v_norm_w, lp.out_norm_w, MIX);
    n_attn<<<dim3(T_TOK, 4), 128, 0, st>>>(Q, KB, VT, MIX, lp);
  }
  if (OPT_MASK & 4) { hipMemsetAsync(SS2, 0, T_TOK * 4, st); launch_opt(mp, ph0 + 2, ph0 + 3, st); }
  else {
    for (int s = 0; s < 4; ++s) {
      n_gemm<<<dim3(4, T_TOK / 64), 256, 0, st>>>(MIX, DM, lp.w_out, DM, s * 256, DM, nullptr, nullptr, TMP1, 256);
      n_resid<<<T_TOK, 256, 0, st>>>(TMP1, s * 256, base, p.out, XB);
    }
    n_rowss<<<T_TOK / 4, 256, 0, st>>>(p.out, SS2);
  }
  if (OPT_MASK & 8) { launch_opt(mp, ph0 + 3, ph0 + 4, st); launch_opt(mp, ph0 + 4, ph0 + 5, st); }
  else {
    for (int s = 0; s < 11; ++s) {
      n_gemm<<<dim3(4, T_TOK / 64), 256, 0, st>>>(XB, DM, lp.w_gate, DFF, s * 256, DM, lp.norm_ffn_w, SS2, TMP1, 256);
      n_gemm<<<dim3(4, T_TOK / 64), 256, 0, st>>>(XB, DM, lp.w_up, DFF, s * 256, DM, lp.norm_ffn_w, SS2, TMP2, 256);
      n_postD<<<T_TOK, 256, 0, st>>>(TMP1, TMP2, s * 256, lp.conv_w, lp.conv_b, F);
    }
  }
  if (OPT_MASK & 32) { hipMemsetAsync(SS1, 0, T_TOK * 4, st); launch_opt(mp, ph0 + 5, ph0 + 6, st); }
  else {
    for (int s = 0; s < 4; ++s) {
      n_gemm<<<dim3(4, T_TOK / 64), 256, 0, st>>>(F, DFF, lp.w_down, DM, s * 256, DFF, nullptr, nullptr, TMP1, 256);
      n_resid<<<T_TOK, 256, 0, st>>>(TMP1, s * 256, p.out, p.out, XB);
    }
    n_rowss<<<T_TOK / 4, 256, 0, st>>>(p.out, SS1);
  }
}

extern "C" void kernel_launch(void* const* d_in, const int* in_sizes, int n_in, void* d_out, int out_size, void* d_ws, size_t ws_size, hipStream_t stream) {
  static int inited = 0;
  if (!inited) { hipFuncSetAttribute((const void*)k_run, hipFuncAttributeMaxDynamicSharedMemorySize, LDS_BYTES); inited = 1; }
  MParams mp; memset(&mp, 0, sizeof(mp));
  for (int i = 0; i < 21; ++i) mp.in[i] = (const float*)d_in[i];
  mp.out = (float*)d_out; mp.ws = (unsigned char*)d_ws;
  if (OPT_MASK == 0x7f) {
    static int grid_blocks = 0;
    if (!grid_blocks) { int dev = 0, cus = 0, per_cu = 0; hipGetDevice(&dev); hipDeviceGetAttribute(&cus, hipDeviceAttributeMultiprocessorCount, dev);
      hipOccupancyMaxActiveBlocksPerMultiprocessor(&per_cu, (const void*)k_run, 512, LDS_BYTES); if (per_cu < 1) per_cu = 1; grid_blocks = cus * per_cu; if (grid_blocks > 256) grid_blocks = 256; }
    mp.ph_lo = 0; mp.ph_hi = 1 + 6 * NLAYER;
    void* args[] = {&mp};
    hipError_t e = hipLaunchCooperativeKernel((const void*)k_run, dim3(grid_blocks), dim3(512), args, LDS_BYTES, stream);
    if (e != hipSuccess) fprintf(stderr, "cooperative launch failed: %s (grid %d)\n", hipGetErrorString(e), grid_blocks);
    return;
  }
  Params p; memset(&p, 0, sizeof(p));
  p.x = (const float*)d_in[0]; p.out = (float*)d_out; p.ws = (unsigned char*)d_ws;
  for (int l = 0; l < NLAYER; ++l) {
    LayerP& L = p.L[l];
    L.norm_attn_w = (const float*)d_in[1] + (size_t)l * DM; L.w_in = (const float*)d_in[2] + (size_t)l * DM * INW; L.v_norm_w = (const float*)d_in[3] + (size_t)l * 512;
    L.sp_w = (const float*)d_in[4] + (size_t)l * 4 * 128 * 128; L.sp_b = (const float*)d_in[5] + (size_t)l * 512; L.out_norm_w = (const float*)d_in[6] + (size_t)l * 512;
    L.q_norm_w = (const float*)d_in[7] + (size_t)l * 64; L.k_norm_w = (const float*)d_in[8] + (size_t)l * 64;
    L.lq1 = (const float*)d_in[9] + (size_t)l * 64; L.lk1 = (const float*)d_in[10] + (size_t)l * 64; L.lq2 = (const float*)d_in[11] + (size_t)l * 64; L.lk2 = (const float*)d_in[12] + (size_t)l * 64;
    L.diff_norm_w = (const float*)d_in[13] + (size_t)l * 128; L.w_out = (const float*)d_in[14] + (size_t)l * DM * DM; L.norm_ffn_w = (const float*)d_in[15] + (size_t)l * DM;
    L.w_gate = (const float*)d_in[16] + (size_t)l * DM * DFF; L.w_up = (const float*)d_in[17] + (size_t)l * DM * DFF; L.conv_w = (const float*)d_in[18] + (size_t)l * 3 * DFF;
    L.conv_b = (const float*)d_in[19] + (size_t)l * DFF; L.w_down = (const float*)d_in[20] + (size_t)l * DFF * DM;
    L.lambda_init = (float)(0.8 - 0.6 * exp(-0.3 * (double)(l + 1)));
  }
  launch_opt(mp, 0, 1, stream);
  for (int l = 0; l < NLAYER; ++l) run_layer(p, mp, l, stream);
}
```

```cpp
#include <hip/hip_runtime.h>
#include <hip/hip_cooperative_groups.h>
#include <cstdio>
#include <cmath>
#include <cstring>

typedef unsigned short bf16_t;
#define DI __device__ __forceinline__

constexpr int T_TOK = 32768, DM = 1024, SEQ = 2048, DFF = 2816, INW = 2560, NLAYER = 4;
constexpr float EPS = 1e-6f;
constexpr float QSCALE = 0.125f * 1.4426950408889634f;

constexpr size_t MiB = 1024ull * 1024ull;
constexpr size_t OFF_XB = 0;
constexpr size_t OFF_R = 64 * MiB;
constexpr size_t OFF_U = OFF_R, OFF_Q = OFF_R + 32 * MiB, OFF_KB = OFF_R + 64 * MiB, OFF_GVT = OFF_R + 96 * MiB, OFF_VT = OFF_R + 128 * MiB, OFF_MIX = OFF_R + 160 * MiB;
constexpr size_t OFF_F = OFF_R, OFF_GB = OFF_R + 176 * MiB, OFF_PB = OFF_R + 188 * MiB, OFF_UB = OFF_R + 200 * MiB;
constexpr size_t OFF_W = 288 * MiB, W_STRIDE = 24 * MiB;
constexpr size_t WO_IN = 0, WO_OUT = 5 * MiB, WO_GU = 7 * MiB, WO_DN = 18 * MiB, WO_SP = 23 * MiB + 512 * 1024;
constexpr size_t OFF_SS1 = 384 * MiB, OFF_SS2 = OFF_SS1 + 256 * 1024, OFF_SSV = OFF_SS2 + 256 * 1024;
constexpr size_t OFF_BAR = 385 * MiB + 512 * 1024;
constexpr size_t OFF_TMP1 = 386 * MiB, OFF_TMP2 = 418 * MiB;

DI int tid_opaque() { int t = threadIdx.x; asm volatile("" : "+v"(t)); return t; }
DI float bf2f(bf16_t b) { return __uint_as_float(((unsigned)b) << 16); }
DI bf16_t f2bf(float f) { unsigned u = __float_as_uint(f); u += 0x7FFFu + ((u >> 16) & 1u); return (bf16_t)(u >> 16); }
DI float gelu_exact(float x) { return 0.5f * x * (1.0f + erff(x * 0.70710678118654752f)); }
DI int permpos16(int k) { return (k & 3) + 4 * (k >> 3) + 8 * ((k >> 2) & 1); }
DI float wave_sum(float v) { for (int o = 32; o >= 1; o >>= 1) v += __shfl_xor(v, o); return v; }

namespace pg8 {
#define PG8_LAS __attribute__((address_space(3)))
typedef unsigned short bf16_t;
typedef short bf16x8 __attribute__((ext_vector_type(8)));
typedef float f32x4 __attribute__((ext_vector_type(4)));
typedef unsigned u32x4 __attribute__((ext_vector_type(4)));
constexpr int BM = 256, BK = 64, HALF = 128, HTB = HALF * BK * 2  , STAGE_BYTES = 8 * HTB, NXCD = 8, WGM = 8;

__host__ __device__ __forceinline__ int lds_byte(int r, int c) { const int st = (r >> 4) * 2 + (c >> 5), rr = r & 15, cc = c & 31, ob = rr * 64 + cc * 2; return st * 1024 + (ob ^ (((ob >> 9) & 1) << 5)); }
__host__ __device__ __forceinline__ void stage_rc(int b, int& R, int& C) { const int st = b / 1024, sb = b % 1024, swz = sb ^ (((sb >> 9) & 1) << 5); R = (st >> 1) * 16 + swz / 64; C = (st & 1) * 32 + (swz % 64) / 2; }
__host__ __device__ __forceinline__ int perm32(int rho) { const int n = rho >> 4, i = rho & 15; return 8 * (i >> 2) + 4 * n + (i & 3); }

struct Unit { int pm, pn; };
struct Gemm { const bf16_t* A; const bf16_t* Bt; int M, N, K; };

struct StaticOrder {
    int nM, nN, nwg, G, c;
    __host__ __device__ void init(int M, int N, int G_, int c_) { nM = M / BM; nN = N / BM; nwg = nM * nN; G = G_; c = c_; }
    __host__ __device__ bool next(int i, Unit& u) const {
        const long L = (long)i * G + c; if (L >= nwg) return false;
        int wgid = (int)L; { const int q = nwg / NXCD, r = nwg % NXCD, xcd = wgid % NXCD, off = wgid / NXCD; wgid = (xcd < r ? xcd * (q + 1) : r * (q + 1) + (xcd - r) * q) + off; }
        const int nig = WGM * nN, gid = wgid / nig, fm = gid * WGM, gsz = (nM - fm) < WGM ? (nM - fm) : WGM;
        u.pm = fm + ((wgid % nig) % gsz); u.pn = (wgid % nig) / gsz; return true;
    }
    __device__ __forceinline__ void a_ready(const Unit&) const {}
    __device__ __forceinline__ void done(const Unit&) const {}
};
template <class Epi, class Sched>
__device__ __forceinline__ void gemm_phase(PG8_LAS unsigned char* lds, const Gemm g, const Sched& S, const Epi& E) {
    const int tid = tid_opaque(), wid = __builtin_amdgcn_readfirstlane(tid >> 6), lane = tid & 63, wr = wid >> 2, wc = wid & 3, fr = lane & 15, fq = lane >> 4;
    const int K = g.K, nt = K / BK;
    unsigned voffA[2], voffB[2];
#pragma unroll
    for (int i = 0; i < 2; ++i) { int R, C; stage_rc(tid * 16 + i * 8192, R, C); const int Rb = Epi::PERM ? ((R & ~31) + perm32(R & 31)) : R;
        voffA[i] = (unsigned)(R * K + C) * 2u; voffB[i] = (unsigned)(Rb * K + C) * 2u; }
    const size_t kstep = (size_t)(BK * 2);
    const size_t hstep = (size_t)HALF * K * 2;
    const size_t tstep = 2 * hstep;
    const unsigned ldsw = (unsigned)wid * 1024u;
    const int aoff = lds_byte(wr * 64 + fr, fq * 8), boff = lds_byte(wc * 32 + fr, fq * 8);
#define PG8_SA(b, h) (((b) * 2 + (h)) * HTB)
#define PG8_SB(b, h) ((4 + (b) * 2 + (h)) * HTB)
#define PG8_STAGE(bufoff, gbase, voff) do { _Pragma("unroll") for (int _i = 0; _i < 2; ++_i) \
        __builtin_amdgcn_global_load_lds((const unsigned*)((const char*)(gbase) + (voff)[_i]), (PG8_LAS unsigned*)(lds + (bufoff) + ldsw + _i * 8192), 16, 0, 0); } while (0)
#define PG8_LDA(dst, b, h) do { _Pragma("unroll") for (int m = 0; m < 4; ++m) _Pragma("unroll") for (int k = 0; k < 2; ++k) dst[m][k] = *(const PG8_LAS bf16x8*)(lds + PG8_SA(b, h) + aoff + m * 2048 + k * 1024); } while (0)
#define PG8_LDB(dst, b, h) do { _Pragma("unroll") for (int n = 0; n < 2; ++n) _Pragma("unroll") for (int k = 0; k < 2; ++k) dst[n][k] = *(const PG8_LAS bf16x8*)(lds + PG8_SB(b, h) + boff + n * 2048 + k * 1024); } while (0)
#define PG8_MMA(ai, bj, At, Bt) do { __builtin_amdgcn_s_setprio(1); _Pragma("unroll") for (int m = 0; m < 4; ++m) _Pragma("unroll") for (int n = 0; n < 2; ++n) _Pragma("unroll") for (int k = 0; k < 2; ++k) \
        acc[ai][bj][m][n] = __builtin_amdgcn_mfma_f32_16x16x32_bf16(Bt[n][k], At[m][k], acc[ai][bj][m][n], 0, 0, 0); __builtin_amdgcn_s_setprio(0); } while (0)
#define PG8_WAIT_V(n) asm volatile("s_waitcnt vmcnt(" #n ")" ::: "memory")
#define PG8_WAIT_L(n) asm volatile("s_waitcnt lgkmcnt(" #n ")" ::: "memory")
#define PG8_BAR __builtin_amdgcn_s_barrier()
#define PG8_SCHED __builtin_amdgcn_sched_barrier(0)
    Unit cur, nxt; int ui = 0;
    if (!S.next(0, cur)) return;
    f32x4 acc[2][2][4][2];
#pragma unroll
    for (int a = 0; a < 2; ++a)
#pragma unroll
        for (int b = 0; b < 2; ++b)
#pragma unroll
            for (int m = 0; m < 4; ++m)
#pragma unroll
                for (int n = 0; n < 2; ++n) acc[a][b][m][n] = (f32x4){0.f, 0.f, 0.f, 0.f};
    bf16x8 At[4][2], B0[2][2], B1[2][2];
    const char* cA = (const char*)g.A + (size_t)cur.pm * tstep; const char* cB = (const char*)g.Bt + (size_t)cur.pn * tstep;
    S.a_ready(cur);
    PG8_STAGE(PG8_SB(0, 0), cB, voffB); PG8_STAGE(PG8_SA(0, 0), cA, voffA); PG8_STAGE(PG8_SB(0, 1), cB + hstep, voffB); PG8_STAGE(PG8_SA(0, 1), cA + hstep, voffA);
    if (wr == 1) PG8_BAR;
    PG8_WAIT_V(4); PG8_BAR;
    PG8_STAGE(PG8_SB(1, 0), cB + kstep, voffB); PG8_STAGE(PG8_SA(1, 0), cA + kstep, voffA); PG8_STAGE(PG8_SB(1, 1), cB + hstep + kstep, voffB);
    PG8_WAIT_V(6); PG8_BAR;
    for (;;) {
        const bool has_next = S.next(ui + 1, nxt);
        const char* nA = has_next ? (const char*)g.A + (size_t)nxt.pm * tstep : cA; const char* nB = has_next ? (const char*)g.Bt + (size_t)nxt.pn * tstep : cB;
        for (int t = 0; t < nt; t += 2) {
            const bool last = (t == nt - 2);
            const char* a1 = cA + (size_t)(t + 1) * kstep;
            const char* a2 = last ? nA : cA + (size_t)(t + 2) * kstep; const char* b2 = last ? nB : cB + (size_t)(t + 2) * kstep;
            const char* a3 = a2 + kstep; const char* b3 = b2 + kstep;
            if (last && has_next) S.a_ready(nxt);
            PG8_LDB(B0, 0, 0); PG8_SCHED; PG8_LDA(At, 0, 0); PG8_STAGE(PG8_SA(1, 1), a1 + hstep, voffA);
            PG8_WAIT_L(8); PG8_BAR; PG8_WAIT_L(0); PG8_MMA(0, 0, At, B0); PG8_BAR; PG8_SCHED;
            PG8_LDB(B1, 0, 1); PG8_STAGE(PG8_SB(0, 0), b2, voffB);
            PG8_BAR; PG8_WAIT_L(0); PG8_MMA(0, 1, At, B1); PG8_BAR;
            PG8_LDA(At, 0, 1); PG8_STAGE(PG8_SA(0, 0), a2, voffA);
            PG8_BAR; PG8_WAIT_L(0); PG8_MMA(1, 0, At, B0); PG8_BAR; PG8_SCHED;
            PG8_STAGE(PG8_SB(0, 1), b2 + hstep, voffB);
            PG8_WAIT_V(6); PG8_BAR; PG8_MMA(1, 1, At, B1); PG8_BAR;
            PG8_LDB(B0, 1, 0); PG8_SCHED; PG8_LDA(At, 1, 0); PG8_STAGE(PG8_SA(0, 1), a2 + hstep, voffA);
            PG8_WAIT_L(8); PG8_BAR; PG8_WAIT_L(0); PG8_MMA(0, 0, At, B0); PG8_BAR; PG8_SCHED;
            PG8_LDB(B1, 1, 1); PG8_STAGE(PG8_SB(1, 0), b3, voffB);
            PG8_BAR; PG8_WAIT_L(0); PG8_MMA(0, 1, At, B1); PG8_BAR;
            PG8_LDA(At, 1, 1); PG8_STAGE(PG8_SA(1, 0), a3, voffA);
            PG8_BAR; PG8_WAIT_L(0); PG8_MMA(1, 0, At, B0); PG8_BAR; PG8_SCHED;
            PG8_STAGE(PG8_SB(1, 1), b3 + hstep, voffB);
            PG8_WAIT_V(6); PG8_BAR; PG8_MMA(1, 1, At, B1); PG8_BAR;
        }
        if constexpr (!Epi::AFTER_DRAIN) { if (!Epi::TWICE || (ui & 1)) E(acc, cur, wr, wc, fr, fq); S.done(cur); }
        if (!has_next) break;
#pragma unroll
        for (int a = 0; a < 2; ++a)
#pragma unroll
            for (int b = 0; b < 2; ++b)
#pragma unroll
                for (int m = 0; m < 4; ++m)
#pragma unroll
                    for (int n = 0; n < 2; ++n) acc[a][b][m][n] = (f32x4){0.f, 0.f, 0.f, 0.f};
        cur = nxt; cA = nA; cB = nB; ++ui;
    }
    PG8_WAIT_V(0);
    if (wr == 0) PG8_BAR;
    PG8_BAR;
    if constexpr (Epi::AFTER_DRAIN) { E.fused(acc, cur, wr, wc, fr, fq, lds, wid, lane); S.done(cur); }
#undef PG8_SA
#undef PG8_SB
#undef PG8_STAGE
#undef PG8_LDA
#undef PG8_LDB
#undef PG8_MMA
#undef PG8_WAIT_V
#undef PG8_WAIT_L
#undef PG8_BAR
#undef PG8_SCHED
}
}

namespace cg = cooperative_groups;
using pg8::f32x4; using pg8::bf16x8; using pg8::Unit;
typedef unsigned u32x2_t __attribute__((ext_vector_type(2)));
typedef unsigned u32x4_t __attribute__((ext_vector_type(4)));
typedef float f32x16 __attribute__((ext_vector_type(16)));
typedef float f32x2_t __attribute__((ext_vector_type(2)));
#define LAS PG8_LAS
constexpr int LDS_BYTES = 131072 + 16;
#ifndef EN_MASK
#define EN_MASK 0x7f
#endif
#ifndef PROBE_EPI_ACE
#define PROBE_EPI_ACE 0
#endif
#ifndef PROBE_EPI_D
#define PROBE_EPI_D 0
#endif
#ifndef PROBE_SYNC
#define PROBE_SYNC 0
#endif
#ifndef PROBE_MASK
#define PROBE_MASK 0x00
#endif

DI unsigned pk2(float lo, float hi) { unsigned r; asm volatile("v_cvt_pk_bf16_f32 %0, %1, %2" : "=v"(r) : "v"(lo), "v"(hi)); return r; }
DI float bflo(unsigned w) { return __uint_as_float(w << 16); }
DI float bfhi(unsigned w) { return __uint_as_float(w & 0xffff0000u); }
DI float gelu1(float v) {
  const float av = fabsf(v), t = __builtin_amdgcn_rcpf(av * 0.2316418882f + 1.0f);
  float q = t * 0.5307027145f + (-0.7265760135f); q = q * t + 0.7107068705f; q = q * t + (-0.142248368f); q = q * t + 0.127414796f; q = q * t;
  const float e = __builtin_amdgcn_exp2f((v * v) * (-0.72134752044f));
  const float m = v * (q * e);
  return v < 0.f ? m : v - m;
}
typedef unsigned long long u64;
DI float fx2f(u64 v) { return (float)v * (1.0f / 1048576.0f); }
DI u64 f2fx(float v) { return (u64)(v * 1048576.0f + 0.5f); }
DI void fx_add(u64* p, float v) { __hip_atomic_fetch_add(p, f2fx(v), __ATOMIC_RELAXED, __HIP_MEMORY_SCOPE_AGENT); }
DI float rs1024(u64 ss) { return rsqrtf(fx2f(ss) * (1.0f / 1024.0f) + EPS); }

struct MParams { const float* in[21]; float* out; unsigned char* ws; int ph_lo, ph_hi; };
struct LP {
  const float *norm_attn_w, *w_in, *v_norm_w, *sp_w, *sp_b, *out_norm_w, *q_norm_w, *k_norm_w, *lq1, *lk1, *lq2, *lk2, *diff_norm_w, *w_out, *norm_ffn_w, *w_gate, *w_up, *conv_w, *conv_b, *w_down;
  float lambda_init;
  const bf16_t *WinT, *WoutT, *WguT, *WdT, *Wsp;
};
DI LP make_lp(const MParams& p, int l) {
  LP L;
  L.norm_attn_w = p.in[1] + (size_t)l * DM; L.w_in = p.in[2] + (size_t)l * DM * INW; L.v_norm_w = p.in[3] + (size_t)l * 512; L.sp_w = p.in[4] + (size_t)l * 65536; L.sp_b = p.in[5] + (size_t)l * 512;
  L.out_norm_w = p.in[6] + (size_t)l * 512; L.q_norm_w = p.in[7] + (size_t)l * 64; L.k_norm_w = p.in[8] + (size_t)l * 64; L.lq1 = p.in[9] + (size_t)l * 64; L.lk1 = p.in[10] + (size_t)l * 64;
  L.lq2 = p.in[11] + (size_t)l * 64; L.lk2 = p.in[12] + (size_t)l * 64; L.diff_norm_w = p.in[13] + (size_t)l * 128; L.w_out = p.in[14] + (size_t)l * DM * DM; L.norm_ffn_w = p.in[15] + (size_t)l * DM;
  L.w_gate = p.in[16] + (size_t)l * DM * DFF; L.w_up = p.in[17] + (size_t)l * DM * DFF; L.conv_w = p.in[18] + (size_t)l * 3 * DFF; L.conv_b = p.in[19] + (size_t)l * DFF; L.w_down = p.in[20] + (size_t)l * DFF * DM;
  L.lambda_init = 0.8f - 0.6f * expf(-0.3f * (float)(l + 1));
  const unsigned char* wb = p.ws + OFF_W + (size_t)l * W_STRIDE;
  L.WinT = (const bf16_t*)(wb + WO_IN); L.WoutT = (const bf16_t*)(wb + WO_OUT); L.WguT = (const bf16_t*)(wb + WO_GU); L.WdT = (const bf16_t*)(wb + WO_DN); L.Wsp = (const bf16_t*)(wb + WO_SP);
  return L;
}
DI float lam_of(const LP& lp) {
  const int lane = threadIdx.x & 63;
  float a = lp.lq1[lane] * lp.lk1[lane], b = lp.lq2[lane] * lp.lk2[lane];
  a = wave_sum(a); b = wave_sum(b);
  return expf(a) - expf(b) + lp.lambda_init;
}

DI void conv_item(bf16_t* dst, int K, int row, int kg, const float* src, int ld, int col, const float* ks) {
  float v[32];
#pragma unroll
  for (int i = 0; i < 32; ++i) v[i] = src[(size_t)(kg * 32 + i) * ld + col];
  if (ks) {
#pragma unroll
    for (int i = 0; i < 32; i += 4) { const f32x4 s = *(const f32x4*)(ks + kg * 32 + i); v[i] *= s[0]; v[i + 1] *= s[1]; v[i + 2] *= s[2]; v[i + 3] *= s[3]; }
  }
  u32x4_t* d = (u32x4_t*)(dst + (size_t)row * K + kg * 32);
#pragma unroll
  for (int i = 0; i < 4; ++i) { u32x4_t w; w.x = pk2(v[8 * i], v[8 * i + 1]); w.y = pk2(v[8 * i + 2], v[8 * i + 3]); w.z = pk2(v[8 * i + 4], v[8 * i + 5]); w.w = pk2(v[8 * i + 6], v[8 * i + 7]); d[i] = w; }
}
DI int perm_logical(int p) {
  const int bj = p >> 7, wc = (p >> 5) & 3, n = (p >> 4) & 1, fq = (p >> 2) & 3, e = p & 3;
  return 64 * wc + 32 * bj + 8 * fq + 4 * n + e;
}
DI void prologue(const MParams& p) {
  const int tidp = tid_opaque(); const int gtid = blockIdx.x * 512 + tidp, gsz = gridDim.x * 512;
  unsigned char* ws = p.ws;
  { const int gw = gtid >> 6, nw = gsz >> 6, lane = threadIdx.x & 63; bf16_t* XB = (bf16_t*)(ws + OFF_XB); u64* SS1 = (u64*)(ws + OFF_SS1);
    for (int row = gw; row < T_TOK; row += nw) { const float* xp = p.in[0] + (size_t)row * DM; float s = 0.f;
#pragma unroll
      for (int i = 0; i < 4; ++i) { const f32x4 v = *(const f32x4*)(xp + i * 256 + lane * 4); s += v[0] * v[0] + v[1] * v[1] + v[2] * v[2] + v[3] * v[3];
        u32x2_t w; w.x = pk2(v[0], v[1]); w.y = pk2(v[2], v[3]); *(u32x2_t*)(XB + (size_t)row * DM + i * 256 + lane * 4) = w; }
      s = wave_sum(s); if (lane == 0) SS1[row] = f2fx(s); } }
  { u64* SSV = (u64*)(ws + OFF_SSV); for (int i = gtid; i < T_TOK * 4; i += gsz) SSV[i] = 0ull; }
  { unsigned* bw = (unsigned*)(ws + OFF_BAR); for (int i = gtid; i < 3456; i += gsz) bw[i] = 0u; }
  for (int l = 0; l < NLAYER; ++l) {
    const LP lp = make_lp(p, l);
    for (int w = gtid; w < 2560 * 32; w += gsz) { const int row = w % 2560, kg = w / 2560; int col;
      if (row < 1536) { const int L = (row & ~255) + perm_logical(row & 255); col = L < 512 ? L : L + 512; }
      else { const int r = row - 1536; col = r < 512 ? 512 + r : 1536 + r; }
      conv_item((bf16_t*)lp.WinT, 1024, row, kg, lp.w_in, INW, col, lp.norm_attn_w); }
    for (int w = gtid; w < 1024 * 32; w += gsz) { const int row = w % 1024, kg = w / 1024; conv_item((bf16_t*)lp.WoutT, 1024, row, kg, lp.w_out, DM, row, nullptr); }
    for (int w = gtid; w < 5632 * 32; w += gsz) { const int row = w % 5632, kg = w / 5632; const int pn = row >> 8, pp = row & 255, bj = pp >> 7;
      const int q = pp & 127, wc = (q >> 5) & 3, n = (q >> 4) & 1, fq = (q >> 2) & 3, e = q & 3; const int cc = 128 * pn + 32 * wc + 8 * fq + 4 * n + e;
      conv_item((bf16_t*)lp.WguT, 1024, row, kg, bj ? lp.w_up : lp.w_gate, DFF, cc, lp.norm_ffn_w); }
    for (int w = gtid; w < 1024 * 88; w += gsz) { const int row = w % 1024, kg = w / 1024; conv_item((bf16_t*)lp.WdT, DFF, row, kg, lp.w_down, DM, row, nullptr); }
    for (int i = gtid; i < 65536; i += gsz) { const int jj = i & 127, ii = (i >> 7) & 127; ((bf16_t*)lp.Wsp)[i] = ((jj >> 6) <= (ii >> 6)) ? f2bf(lp.sp_w[i]) : (bf16_t)0; }
  }
}

struct DupOrder : pg8::StaticOrder {
  __device__ bool next(int i, Unit& u) const { return pg8::StaticOrder::next(i >> 1, u); }
};
struct EpiResid {
  static constexpr bool PERM = false, AFTER_DRAIN = false, TWICE = (PROBE_EPI_ACE != 0);
  const float* base32; float* out32; bf16_t* XB; u64* SS;
  DI void operator()(const f32x4 (&acc)[2][2][4][2], const Unit& u, int wr, int wc, int fr, int fq) const {
    const int row0 = u.pm * 256 + wr * 64 + fr, col0 = u.pn * 256 + wc * 32 + 4 * fq;
    if (base32) {
      f32x4 nb[2][2];
#pragma unroll
      for (int bj = 0; bj < 2; ++bj)
#pragma unroll
        for (int n = 0; n < 2; ++n) nb[bj][n] = *(const f32x4*)(base32 + (size_t)row0 * DM + col0 + bj * 128 + n * 16);
#pragma unroll
      for (int g = 0; g < 8; ++g) { const int ai = g >> 2, m = g & 3; const int row = row0 + ai * 128 + m * 16; const size_t ro = (size_t)row * DM + col0; float ss = 0.f;
        f32x4 cbv[2][2];
#pragma unroll
        for (int bj = 0; bj < 2; ++bj)
#pragma unroll
          for (int n = 0; n < 2; ++n) cbv[bj][n] = nb[bj][n];
        if (g < 7) { const int r2 = row0 + ((g + 1) >> 2) * 128 + ((g + 1) & 3) * 16;
#pragma unroll
          for (int bj = 0; bj < 2; ++bj)
#pragma unroll
            for (int n = 0; n < 2; ++n) nb[bj][n] = *(const f32x4*)(base32 + (size_t)r2 * DM + col0 + bj * 128 + n * 16); }
#pragma unroll
        for (int bj = 0; bj < 2; ++bj)
#pragma unroll
          for (int n = 0; n < 2; ++n) { const size_t o = ro + bj * 128 + n * 16; const f32x4 v = acc[ai][bj][m][n] + cbv[bj][n];
            u32x2_t w; w.x = pk2(v[0], v[1]); w.y = pk2(v[2], v[3]); *(u32x2_t*)(XB + o) = w; ss += (v[0] * v[0] + v[1] * v[1]) + (v[2] * v[2] + v[3] * v[3]); }
        ss += __shfl_xor(ss, 16); ss += __shfl_xor(ss, 32); if (fq == 0) fx_add(SS + row, ss);
        asm volatile("" ::: "memory"); }
    } else {
      u32x2_t nb[2][2];
#pragma unroll
      for (int bj = 0; bj < 2; ++bj)
#pragma unroll
        for (int n = 0; n < 2; ++n) nb[bj][n] = *(const u32x2_t*)(XB + (size_t)row0 * DM + col0 + bj * 128 + n * 16);
#pragma unroll
      for (int g = 0; g < 8; ++g) { const int ai = g >> 2, m = g & 3; const int row = row0 + ai * 128 + m * 16; const size_t ro = (size_t)row * DM + col0; float ss = 0.f;
        u32x2_t cbv[2][2];
#pragma unroll
        for (int bj = 0; bj < 2; ++bj)
#pragma unroll
          for (int n = 0; n < 2; ++n) cbv[bj][n] = nb[bj][n];
        if (g < 7) { const int r2 = row0 + ((g + 1) >> 2) * 128 + ((g + 1) & 3) * 16;
#pragma unroll
          for (int bj = 0; bj < 2; ++bj)
#pragma unroll
            for (int n = 0; n < 2; ++n) nb[bj][n] = *(const u32x2_t*)(XB + (size_t)r2 * DM + col0 + bj * 128 + n * 16); }
#pragma unroll
        for (int bj = 0; bj < 2; ++bj)
#pragma unroll
          for (int n = 0; n < 2; ++n) { const size_t o = ro + bj * 128 + n * 16; const u32x2_t c = cbv[bj][n];
            const f32x4 v = acc[ai][bj][m][n] + (f32x4){bflo(c.x), bfhi(c.x), bflo(c.y), bfhi(c.y)};
            if (out32) *(f32x4*)(out32 + o) = v;
            else { u32x2_t w; w.x = pk2(v[0], v[1]); w.y = pk2(v[2], v[3]); *(u32x2_t*)(XB + o) = w; ss += (v[0] * v[0] + v[1] * v[1]) + (v[2] * v[2] + v[3] * v[3]); } }
        if (!out32) { ss += __shfl_xor(ss, 16); ss += __shfl_xor(ss, 32); if (fq == 0) fx_add(SS + row, ss); }
        asm volatile("" ::: "memory"); }
    }
  }
};
struct EpiA1 {
  static constexpr bool PERM = false, AFTER_DRAIN = false, TWICE = (PROBE_EPI_ACE != 0);
  const u64* SS1; bf16_t *U, *Q, *KB; const float *qw, *kw;
  DI void operator()(const f32x4 (&acc)[2][2][4][2], const Unit& u, int wr, int wc, int fr, int fq) const {
    const int row0 = u.pm * 256 + wr * 64 + fr, lc0 = wc * 64 + 8 * fq, region = u.pn >> 1;
    u64 rsv[8];
#pragma unroll
    for (int g = 0; g < 8; ++g) rsv[g] = SS1[row0 + (g >> 2) * 128 + (g & 3) * 16];
    if (region == 0) {
#pragma unroll
      for (int g = 0; g < 8; ++g) { const int ai = g >> 2, m = g & 3; const int row = row0 + ai * 128 + m * 16; const float rs = rs1024(rsv[g]);
#pragma unroll
        for (int bj = 0; bj < 2; ++bj) { const f32x4 a = acc[ai][bj][m][0] * rs, b = acc[ai][bj][m][1] * rs; u32x4_t w;
          w.x = pk2(gelu1(a[0]), gelu1(a[1])); w.y = pk2(gelu1(a[2]), gelu1(a[3])); w.z = pk2(gelu1(b[0]), gelu1(b[1])); w.w = pk2(gelu1(b[2]), gelu1(b[3]));
          *(u32x4_t*)(U + (size_t)row * 512 + u.pn * 256 + lc0 + 32 * bj) = w; } }
    } else {
      const bool isq = region == 1; const float* wp = (isq ? qw : kw) + 8 * fq; bf16_t* dst = (isq ? Q : KB) + (u.pn & 1) * 256 + lc0; const float sc = isq ? QSCALE : 1.0f;
      f32x4 wv[2][2];
#pragma unroll
      for (int bj = 0; bj < 2; ++bj)
#pragma unroll
        for (int n = 0; n < 2; ++n) wv[bj][n] = *(const f32x4*)(wp + 32 * bj + 4 * n);
#pragma unroll
      for (int g = 0; g < 8; ++g) { const int ai = g >> 2, m = g & 3; const int row = row0 + ai * 128 + m * 16; const float rs = rs1024(rsv[g]); float ss = 0.f; f32x4 v[2][2];
#pragma unroll
        for (int bj = 0; bj < 2; ++bj)
#pragma unroll
          for (int n = 0; n < 2; ++n) { v[bj][n] = acc[ai][bj][m][n] * rs; const f32x4 t = v[bj][n]; ss += (t[0] * t[0] + t[1] * t[1]) + (t[2] * t[2] + t[3] * t[3]); }
        ss += __shfl_xor(ss, 16); ss += __shfl_xor(ss, 32);
        const float r2 = rsqrtf(ss * (1.0f / 64.0f) + EPS) * sc;
#pragma unroll
        for (int bj = 0; bj < 2; ++bj) { const f32x4 a = v[bj][0] * r2 * wv[bj][0], b = v[bj][1] * r2 * wv[bj][1]; u32x4_t w;
          w.x = pk2(a[0], a[1]); w.y = pk2(a[2], a[3]); w.z = pk2(b[0], b[1]); w.w = pk2(b[2], b[3]);
          *(u32x4_t*)(dst + (size_t)row * 512 + 32 * bj) = w; } }
    }
  }
};
struct EpiA2 {
  static constexpr bool PERM = false, AFTER_DRAIN = false, TWICE = (PROBE_EPI_ACE != 0);
  const u64* SS1; bf16_t *GVT, *VT; u64* SSV;
  DI void operator()(const f32x4 (&acc)[2][2][4][2], const Unit& u, int wr, int wc, int fr, int fq) const {
    const int colbase = u.pn * 256 + wc * 32;
    f32x4 rs[2][2];
#pragma unroll
    for (int bj = 0; bj < 2; ++bj)
#pragma unroll
      for (int n = 0; n < 2; ++n) { const u64* sp = SS1 + colbase + bj * 128 + n * 16 + 4 * fq; rs[bj][n] = (f32x4){rs1024(sp[0]), rs1024(sp[1]), rs1024(sp[2]), rs1024(sp[3])}; }
    if (u.pm < 2) {
#pragma unroll
      for (int ai = 0; ai < 2; ++ai) { const int head = 2 * u.pm + ai;
#pragma unroll
        for (int bj = 0; bj < 2; ++bj)
#pragma unroll
          for (int n = 0; n < 2; ++n) { f32x4 sq = (f32x4){0.f, 0.f, 0.f, 0.f}; const int tok = colbase + bj * 128 + n * 16 + 4 * fq;
#pragma unroll
            for (int m = 0; m < 4; ++m) { const int row = u.pm * 256 + ai * 128 + wr * 64 + m * 16 + fr;
              const f32x4 a = acc[ai][bj][m][n] * rs[bj][n]; f32x4 g; g[0] = gelu1(a[0]); g[1] = gelu1(a[1]); g[2] = gelu1(a[2]); g[3] = gelu1(a[3]);
              u32x2_t w; w.x = pk2(g[0], g[1]); w.y = pk2(g[2], g[3]); *(u32x2_t*)(GVT + (size_t)row * T_TOK + tok) = w; sq += g * g; }
#pragma unroll
            for (int e = 0; e < 4; ++e) { float s = sq[e]; s += __shfl_xor(s, 1); s += __shfl_xor(s, 2); s += __shfl_xor(s, 4); s += __shfl_xor(s, 8); sq[e] = s; }
            if (fr == 0) {
#pragma unroll
              for (int e = 0; e < 4; ++e) fx_add(SSV + (size_t)(tok + e) * 4 + head, sq[e]); }
            asm volatile("" ::: "memory"); } }
    } else {
#pragma unroll
      for (int ai = 0; ai < 2; ++ai)
#pragma unroll
        for (int m = 0; m < 4; ++m) { const int row = (u.pm - 2) * 256 + ai * 128 + wr * 64 + m * 16 + fr;
#pragma unroll
          for (int bj = 0; bj < 2; ++bj)
#pragma unroll
            for (int n = 0; n < 2; ++n) { const f32x4 a = acc[ai][bj][m][n] * rs[bj][n]; u32x2_t w; w.x = pk2(a[0], a[1]); w.y = pk2(a[2], a[3]);
              *(u32x2_t*)(VT + (size_t)row * T_TOK + colbase + bj * 128 + n * 16 + 8 * (fq & 1) + 4 * (fq >> 1)) = w; } }
    }
  }
};
struct EpiD {
  static constexpr bool PERM = false, AFTER_DRAIN = false, TWICE = (PROBE_EPI_D != 0);
  const u64* SS2; const float *cw, *cb; bf16_t* F; float *GB, *PB, *UB;
  DI void operator()(const f32x4 (&acc)[2][2][4][2], const Unit& u, int wr, int wc, int fr, int fq) const {
    const int cbase = u.pn * 128 + wc * 32 + 8 * fq;
    const int src1 = fq * 16 + ((fr + 15) & 15), src2 = fq * 16 + ((fr + 14) & 15);
    const int rb0 = u.pm * 256 + wr * 64;
    u64 rsv[8]; f32x4 w0[2], w1[2], w2[2], bb[2];
#pragma unroll
    for (int g = 0; g < 8; ++g) rsv[g] = SS2[rb0 + (g >> 2) * 128 + (g & 3) * 16 + fr];
#pragma unroll
    for (int n = 0; n < 2; ++n) { w0[n] = *(const f32x4*)(cw + cbase + 4 * n); w1[n] = *(const f32x4*)(cw + DFF + cbase + 4 * n); w2[n] = *(const f32x4*)(cw + 2 * DFF + cbase + 4 * n); bb[n] = *(const f32x4*)(cb + cbase + 4 * n); }
#pragma unroll
    for (int ai = 0; ai < 2; ++ai) {
      const int rb = rb0 + ai * 128, bd = rb >> 6;
      float rs[4];
#pragma unroll
      for (int m = 0; m < 4; ++m) rs[m] = rs1024(rsv[ai * 4 + m]);
      unsigned fo[4][4];
#pragma unroll
      for (int n = 0; n < 2; ++n) {
        const int cn = cbase + 4 * n;
        f32x4 pg, ug, gg; float fv[4][4];
#pragma unroll
        for (int e = 0; e < 4; ++e) {
          float G[4], r1[4], r2[4];
#pragma unroll
          for (int m = 0; m < 4; ++m) { G[m] = acc[ai][0][m][n][e] * rs[m]; r1[m] = __shfl(G[m], src1); r2[m] = __shfl(G[m], src2); }
#pragma unroll
          for (int m = 0; m < 4; ++m) {
            const float p1 = (fr >= 1) ? r1[m] : (m > 0 ? r1[m > 0 ? m - 1 : 0] : 0.f);
            const float p2 = (fr >= 2) ? r2[m] : (m > 0 ? r2[m > 0 ? m - 1 : 0] : 0.f);
            const float g = w2[n][e] * G[m] + w1[n][e] * p1 + w0[n][e] * p2 + bb[n][e];
            const float uv = acc[ai][1][m][n][e] * rs[m];
            if (m == 0) { pg[e] = g; ug[e] = uv; }
            if (m == 3) gg[e] = G[3];
            fv[m][e] = g * __builtin_amdgcn_rcpf(1.0f + __expf(-g)) * uv;
          }
        }
#pragma unroll
        for (int m = 0; m < 4; ++m) { fo[m][2 * n] = pk2(fv[m][0], fv[m][1]); fo[m][2 * n + 1] = pk2(fv[m][2], fv[m][3]); }
        if (fr < 2) { *(f32x4*)(PB + (size_t)(bd * 2 + fr) * DFF + cn) = pg; *(f32x4*)(UB + (size_t)(bd * 2 + fr) * DFF + cn) = ug; }
        if (fr >= 14) { *(f32x4*)(GB + (size_t)(bd * 2 + fr - 14) * DFF + cn) = gg; }
      }
#pragma unroll
      for (int m = 0; m < 4; ++m) {
        if (!(m == 0 && fr < 2)) { u32x4_t w; w.x = fo[m][0]; w.y = fo[m][1]; w.z = fo[m][2]; w.w = fo[m][3]; *(u32x4_t*)(F + (size_t)(rb + 16 * m + fr) * DFF + cbase) = w; }
      }
    }
  }
};
DI void fixup_phase(const LP& lp, unsigned char* ws) {
  const float *GB = (const float*)(ws + OFF_GB), *PB = (const float*)(ws + OFF_PB), *UB = (const float*)(ws + OFF_UB); bf16_t* F = (bf16_t*)(ws + OFF_F);
  const int gtid = blockIdx.x * 512 + tid_opaque(), gsz = gridDim.x * 512;
  for (int w = gtid; w < 512 * 2 * 704; w += gsz) {
    const int c = (w % 704) * 4, j = (w / 704) & 1, bd = w / 1408;
    f32x4 g = *(const f32x4*)(PB + (size_t)(bd * 2 + j) * DFF + c);
    if (bd & 31) { const f32x4 gm1 = *(const f32x4*)(GB + (size_t)((bd - 1) * 2 + 1) * DFF + c); const f32x4 w0 = *(const f32x4*)(lp.conv_w + c);
      if (j == 0) { const f32x4 gm2 = *(const f32x4*)(GB + (size_t)((bd - 1) * 2) * DFF + c); const f32x4 w1 = *(const f32x4*)(lp.conv_w + DFF + c); g += w1 * gm1 + w0 * gm2; }
      else g += w0 * gm1; }
    const f32x4 uv = *(const f32x4*)(UB + (size_t)(bd * 2 + j) * DFF + c); float f[4];
#pragma unroll
    for (int e = 0; e < 4; ++e) f[e] = g[e] * __builtin_amdgcn_rcpf(1.0f + __expf(-g[e])) * uv[e];
    u32x2_t o; o.x = pk2(f[0], f[1]); o.y = pk2(f[2], f[3]);
    *(u32x2_t*)(F + (size_t)(bd * 64 + j) * DFF + c) = o;
  }
}

DI void spatial_phase(const LP& lp, unsigned char* ws, LAS unsigned char* lds) {
  const bf16_t *U = (const bf16_t*)(ws + OFF_U), *GVT = (const bf16_t*)(ws + OFF_GVT); const u64* SSV = (const u64*)(ws + OFF_SSV); bf16_t* MIX = (bf16_t*)(ws + OFF_MIX);
  LAS float* sr = (LAS float*)lds;
  const int tid = tid_opaque(), lane = tid & 63, w = __builtin_amdgcn_readfirstlane(tid >> 6), l15 = lane & 15, kq = lane >> 4;
  for (int it = blockIdx.x; it < 1024; it += gridDim.x) {
    const int h = it & 3, tok0 = (it >> 2) * 128;
    if (tid < 128) sr[tid] = rsqrtf(fx2f(SSV[(size_t)(tok0 + tid) * 4 + h]) * (1.0f / 128.0f) + EPS);
    __syncthreads();
    const int i0 = 16 * w, nks = (w < 4) ? 2 : 4, irow = tok0 + i0 + l15;
    bf16x8 yf[4];
#pragma unroll
    for (int ks = 0; ks < 4; ++ks) {
      u32x4_t o = (u32x4_t){0u, 0u, 0u, 0u};
      if (ks < nks) { const u32x4_t raw = *(const u32x4_t*)(lp.Wsp + (size_t)(h * 128 + i0 + l15) * 128 + ks * 32 + kq * 8);
        const LAS float* s = sr + ks * 32 + kq * 8;
        o.x = pk2(bflo(raw.x) * s[0], bfhi(raw.x) * s[1]); o.y = pk2(bflo(raw.y) * s[2], bfhi(raw.y) * s[3]); o.z = pk2(bflo(raw.z) * s[4], bfhi(raw.z) * s[5]); o.w = pk2(bflo(raw.w) * s[6], bfhi(raw.w) * s[7]); }
      yf[ks] = __builtin_bit_cast(bf16x8, o);
    }
    const float bias = lp.sp_b[h * 128 + i0 + l15];
    float o[8][4]; float ss = 0.f;
#pragma unroll
    for (int dt = 0; dt < 8; ++dt) {
      f32x4 acc = (f32x4){0.f, 0.f, 0.f, 0.f};
#pragma unroll
      for (int ks = 0; ks < 4; ++ks) if (ks < nks) {
        const bf16x8 xf = *(const bf16x8*)(GVT + (size_t)(h * 128 + 16 * dt + l15) * T_TOK + tok0 + ks * 32 + kq * 8);
        acc = __builtin_amdgcn_mfma_f32_16x16x32_bf16(xf, yf[ks], acc, 0, 0, 0); }
      const int d0 = 16 * dt + 4 * kq; const f32x4 wv = *(const f32x4*)(lp.v_norm_w + h * 128 + d0);
      const u32x2_t ur = *(const u32x2_t*)(U + (size_t)irow * 512 + h * 128 + d0);
      o[dt][0] = bflo(ur.x) * (acc[0] * wv[0] + bias); o[dt][1] = bfhi(ur.x) * (acc[1] * wv[1] + bias); o[dt][2] = bflo(ur.y) * (acc[2] * wv[2] + bias); o[dt][3] = bfhi(ur.y) * (acc[3] * wv[3] + bias);
      ss += (o[dt][0] * o[dt][0] + o[dt][1] * o[dt][1]) + (o[dt][2] * o[dt][2] + o[dt][3] * o[dt][3]);
    }
    ss += __shfl_xor(ss, 16); ss += __shfl_xor(ss, 32);
    const float rs = rsqrtf(ss * (1.0f / 128.0f) + EPS);
#pragma unroll
    for (int dt = 0; dt < 8; ++dt) { const int d0 = 16 * dt + 4 * kq; const f32x4 wo = *(const f32x4*)(lp.out_norm_w + h * 128 + d0);
      u32x2_t q; q.x = pk2(o[dt][0] * rs * wo[0], o[dt][1] * rs * wo[1]); q.y = pk2(o[dt][2] * rs * wo[2], o[dt][3] * rs * wo[3]);
      *(u32x2_t*)(MIX + (size_t)irow * 1024 + h * 128 + d0) = q; }
    __syncthreads();
  }
}

DI void attn_phase(const MParams& p, int l, LAS unsigned char* lds) {
  unsigned char* ws = p.ws;
  const bf16_t *Q = (const bf16_t*)(ws + OFF_Q), *KB = (const bf16_t*)(ws + OFF_KB), *VT = (const bf16_t*)(ws + OFF_VT); bf16_t* MIX = (bf16_t*)(ws + OFF_MIX);
  constexpr int KBUF = 16384, VBUF = 16384, STG = KBUF + VBUF, QOFF = 2 * STG;
  static_assert(QOFF + 65536 <= LDS_BYTES, "attention LDS");
  const float lambda_init = 0.8f - 0.6f * expf(-0.3f * (float)(l + 1));
  const float* dnw = p.in[13] + l * 128;
#pragma unroll 1
  for (int pi = blockIdx.x; pi < 256; pi += gridDim.x) {
    const int b = pi >> 4, h = (pi >> 2) & 3, j = pi & 3;
#pragma unroll 1
    for (int it = 0; it < 2; ++it) {
      const int tid = tid_opaque(), lane = tid & 63, w = __builtin_amdgcn_readfirstlane(tid >> 6), l31 = lane & 31, hh = lane >> 5;
      const int qb = it ? j : 7 - j, t0 = b * 2048 + 256 * qb, ntl = 4 * qb + 4, ntw = 4 * qb + (w >> 1) + 1;
#pragma unroll
      for (int i = 0; i < 8; ++i) { const int P = (w * 8 + i) * 64 + lane, row = P >> 4, pos = P & 15, pc = pos ^ (row & 15);
        __builtin_amdgcn_global_load_lds((const unsigned*)(Q + (size_t)(t0 + row) * 512 + h * 128 + pc * 8), (LAS unsigned*)(lds + QOFF + (w * 8 + i) * 1024), 16, 0, 0); }
      const bf16_t* kbase = KB + (size_t)(b * 2048) * 512 + h * 128; const bf16_t* vbase = VT + (size_t)(h * 128) * T_TOK + b * 2048;
      int koff[2], voff[2];
#pragma unroll
      for (int i = 0; i < 2; ++i) { const int P = (w * 2 + i) * 64 + lane; { const int row = P >> 4, pos = P & 15, pc = pos ^ (row & 15); koff[i] = row * 512 + pc * 8; }
        { const int row = P >> 3, pos = P & 7, pc = pos ^ ((row >> 1) & 7); voff[i] = row * T_TOK + pc * 8; } }
#define ATT_STAGE(kt, buf) do { _Pragma("unroll") for (int i = 0; i < 2; ++i) { \
        __builtin_amdgcn_global_load_lds((const unsigned*)(kbase + (size_t)(kt) * (64 * 512) + koff[i]), (LAS unsigned*)(lds + (buf) * STG + (w * 2 + i) * 1024), 16, 0, 0); \
        __builtin_amdgcn_global_load_lds((const unsigned*)(vbase + (kt) * 64 + voff[i]), (LAS unsigned*)(lds + (buf) * STG + KBUF + (w * 2 + i) * 1024), 16, 0, 0); } } while (0)
      ATT_STAGE(0, 0);
      asm volatile("s_waitcnt vmcnt(0)" ::: "memory");
      __syncthreads();
      f32x16 O[2][4];
#pragma unroll
      for (int c = 0; c < 2; ++c)
#pragma unroll
        for (int bk = 0; bk < 4; ++bk)
#pragma unroll
          for (int i = 0; i < 16; ++i) O[c][bk][i] = 0.f;
      float lsum[2] = {0.f, 0.f};
      const int qr = 32 * w + l31;
      int k_lane = l31 * 256 + ((hh ^ (l31 & 15)) << 4), q_lane = QOFF + qr * 256 + ((hh ^ (qr & 15)) << 4), v_lane = KBUF + l31 * 128 + ((hh ^ ((l31 >> 1) & 7)) << 4);
#pragma unroll 1
      for (int kt = 0; kt < ntl; ++kt) {
        if (kt + 1 < ntl) ATT_STAGE(kt + 1, (kt + 1) & 1);
        if (kt < ntw) {
          asm volatile("" : "+v"(k_lane), "+v"(q_lane), "+v"(v_lane));
          const LAS unsigned char* tb = lds + (kt & 1) * STG;
#pragma unroll
          for (int kb = 0; kb < 2; ++kb) {
            bf16x8 pf[2][2];
#pragma unroll
            for (int c = 0; c < 2; ++c) {
              f32x16 S;
#pragma unroll
              for (int i = 0; i < 16; ++i) S[i] = 0.f;
#pragma unroll
              for (int ks = 0; ks < 4; ++ks) {
                const int xo = (c * 8 + ks * 2) << 4;
                const bf16x8 qf = *(const LAS bf16x8*)(lds + (q_lane ^ xo));
                const bf16x8 kf = *(const LAS bf16x8*)(tb + (k_lane ^ xo) + kb * 8192);
                S = __builtin_amdgcn_mfma_f32_32x32x16_bf16(kf, qf, S, 0, 0, 0);
              }
              float ls = 0.f;
#pragma unroll
              for (int hs = 0; hs < 2; ++hs) { u32x4_t pw;
#pragma unroll
                for (int t = 0; t < 4; ++t) { const float a = __builtin_amdgcn_exp2f(S[8 * hs + 2 * t]), bq = __builtin_amdgcn_exp2f(S[8 * hs + 2 * t + 1]); ls += a + bq; pw[t] = pk2(a, bq); }
                pf[c][hs] = __builtin_bit_cast(bf16x8, pw); }
              lsum[c] += ls;
              __builtin_amdgcn_sched_barrier(0);
            }
#pragma unroll
            for (int bk = 0; bk < 4; ++bk) {
              const bf16x8 v0 = *(const LAS bf16x8*)(tb + (v_lane ^ ((2 * kb) << 5)) + bk * 4096);
              const bf16x8 v1 = *(const LAS bf16x8*)(tb + (v_lane ^ ((2 * kb + 1) << 5)) + bk * 4096);
              O[0][bk] = __builtin_amdgcn_mfma_f32_32x32x16_bf16(v0, pf[0][0], O[0][bk], 0, 0, 0);
              O[1][bk] = __builtin_amdgcn_mfma_f32_32x32x16_bf16(v0, pf[1][0], O[1][bk], 0, 0, 0);
              O[0][bk] = __builtin_amdgcn_mfma_f32_32x32x16_bf16(v1, pf[0][1], O[0][bk], 0, 0, 0);
              O[1][bk] = __builtin_amdgcn_mfma_f32_32x32x16_bf16(v1, pf[1][1], O[1][bk], 0, 0, 0);
              __builtin_amdgcn_sched_barrier(0);
            }
          }
        }
        asm volatile("s_waitcnt vmcnt(0)" ::: "memory");
        __syncthreads();
      }
#undef ATT_STAGE
      const int tid2 = tid_opaque(), lane2 = tid2 & 63, w2 = __builtin_amdgcn_readfirstlane(tid2 >> 6), hh2 = lane2 >> 5, qr2 = 32 * w2 + (lane2 & 31);
      float lam;
      { const float* q1 = p.in[9] + l * 64; const float* k1 = p.in[10] + l * 64; const float* q2 = p.in[11] + l * 64; const float* k2 = p.in[12] + l * 64;
        float a = q1[lane2] * k1[lane2], bq = q2[lane2] * k2[lane2]; a = wave_sum(a); bq = wave_sum(bq); lam = expf(a) - expf(bq) + lambda_init; }
      float l1 = lsum[0], l2 = lsum[1]; l1 += __shfl_xor(l1, 32); l2 += __shfl_xor(l2, 32);
      const float inv1 = 1.0f / l1, inv2 = lam / l2; float ss = 0.f;
#pragma unroll
      for (int bk = 0; bk < 4; ++bk)
#pragma unroll
        for (int i = 0; i < 16; ++i) { const float o = O[0][bk][i] * inv1 - O[1][bk][i] * inv2; O[0][bk][i] = o; ss += o * o; }
      ss += __shfl_xor(ss, 32);
      const float rs = rsqrtf(ss * (1.0f / 128.0f) + EPS) * (1.0f - lambda_init);
      bf16_t* orow = MIX + (size_t)(t0 + qr2) * 1024 + 512 + h * 128;
#pragma unroll
      for (int bk = 0; bk < 4; ++bk)
#pragma unroll
        for (int g = 0; g < 4; ++g) { const int dv0 = 32 * bk + 8 * g + 4 * hh2; const f32x4 wv = *(const f32x4*)(dnw + dv0);
          u32x2_t q; q.x = pk2(O[0][bk][4 * g] * rs * wv[0], O[0][bk][4 * g + 1] * rs * wv[1]); q.y = pk2(O[0][bk][4 * g + 2] * rs * wv[2], O[0][bk][4 * g + 3] * rs * wv[3]);
          *(u32x2_t*)(orow + dv0) = q; }
    }
  }
}


#define XB_TMO      128
#define XB_XCNT(j)  (256  + 64 * (j))
#define XB_XSUB(j)  (1280 + 64 * (j))
#define XB_XGEN(j)  (2304 + 64 * (j))
#define XB_TOP      3328
#define XB_TOPGEN   3392
#define XCD_BAR_WORDS 3456
#define XB_SPIN_CAP (1u << 18)

__device__ __forceinline__ unsigned xb_ld(unsigned* p)              { return __hip_atomic_load(p, __ATOMIC_RELAXED, __HIP_MEMORY_SCOPE_AGENT); }
__device__ __forceinline__ unsigned xb_add(unsigned* p, unsigned v) { return __hip_atomic_fetch_add(p, v, __ATOMIC_RELAXED, __HIP_MEMORY_SCOPE_AGENT); }
__device__ __forceinline__ unsigned xb_xcc_id() { return (unsigned)__builtin_amdgcn_s_getreg((3 << 11) | 20) & 0xFu; }
#define XB_SPIN(cond, bar) do { unsigned _sp = 0; while (cond) { __builtin_amdgcn_s_sleep(1); \
    if ((++_sp & 255u) == 0u) { if (xb_ld(&(bar)[XB_TMO])) break; if (_sp > XB_SPIN_CAP) { atomicAdd(&(bar)[XB_TMO], 1u); break; } } } } while (0)

struct XcdBarrier {
    unsigned* bar; unsigned x;
    volatile LAS unsigned* st;
};

__device__ __forceinline__ XcdBarrier xcd_barrier_post(unsigned* bar, volatile LAS unsigned* st) {
    XcdBarrier b; b.bar = bar; b.x = xb_xcc_id(); b.st = st;
    if (threadIdx.x == 0) (void)xb_add(&bar[XB_XCNT(b.x)], 1u);
    return b;
}
__device__ __forceinline__ void xcd_barrier_complete(unsigned* bar, unsigned x, unsigned& nloc, unsigned& nx) {
    const unsigned G = gridDim.x * gridDim.y * gridDim.z;
    unsigned sum, cnt, mine, sp = 0u;
    for (;;) {
        sum = 0u; cnt = 0u; mine = 0u;
#pragma unroll
        for (unsigned j = 0; j < 16; ++j) { const unsigned c = xb_ld(&bar[XB_XCNT(j)]); sum += c; cnt += (c > 0u) ? 1u : 0u; mine = (j == x) ? c : mine; }
        if (sum == G) break;
        __builtin_amdgcn_s_sleep(1);
        if ((++sp & 255u) == 0u) { if (xb_ld(&bar[XB_TMO])) break; if (sp > XB_SPIN_CAP) { atomicAdd(&bar[XB_TMO], 1u); break; } }
    }
    nloc = mine > 0u ? mine : 1u; nx = cnt > 0u ? cnt : 1u;
}

__device__ __forceinline__ void xcd_barrier(const XcdBarrier& b) {
    asm volatile("s_waitcnt vmcnt(0)" ::: "memory");
    __syncthreads();
    if (threadIdx.x == 0) {
        unsigned* bar = b.bar;
        __builtin_amdgcn_s_waitcnt(0);
        unsigned nloc = b.st[0], nx = b.st[1];
        if (nloc == 0u) { xcd_barrier_complete(bar, b.x, nloc, nx); b.st[0] = nloc; b.st[1] = nx; }
        const unsigned old = xb_add(&bar[XB_XSUB(b.x)], 1u);
        const unsigned gen = old / nloc;
        if (old + 1u == (gen + 1u) * nloc) {
            __builtin_amdgcn_fence(__ATOMIC_RELEASE, "agent");
            asm volatile("s_waitcnt vmcnt(0)" ::: "memory");
            const unsigned og = xb_add(&bar[XB_TOP], 1u);
            const unsigned tg = og / nx;
            if (og + 1u == (tg + 1u) * nx) xb_add(&bar[XB_TOPGEN], 1u);
            else XB_SPIN(xb_ld(&bar[XB_TOPGEN]) == tg, bar);
            __builtin_amdgcn_fence(__ATOMIC_ACQUIRE, "agent");
            xb_add(&bar[XB_XGEN(b.x)], 1u);
            asm volatile("s_waitcnt vmcnt(0)" ::: "memory");
        } else {
            XB_SPIN(xb_ld(&bar[XB_XGEN(b.x)]) == gen, bar);
            __builtin_amdgcn_fence(__ATOMIC_ACQUIRE, "agent");
            asm volatile("s_waitcnt vmcnt(0)" ::: "memory");
        }
    }
    __syncthreads();
}

DI void zero_u64(u64* p, int n) { for (int i = blockIdx.x * 512 + tid_opaque(); i < n; i += gridDim.x * 512) p[i] = 0ull; }

#if PROBE_EPI_ACE
typedef DupOrder OrderACE;
#else
typedef pg8::StaticOrder OrderACE;
#endif
DI void phaseA(const MParams& p, int l, LAS unsigned char* lds) {
  unsigned char* ws = p.ws; const bf16_t* XB = (const bf16_t*)(ws + OFF_XB); const bf16_t* WinT = (const bf16_t*)(ws + OFF_W + (size_t)l * W_STRIDE + WO_IN); const u64* SS1 = (const u64*)(ws + OFF_SS1);
  zero_u64((u64*)(ws + OFF_SS2), T_TOK);
  { pg8::Gemm g{XB, WinT, T_TOK, 1536, DM}; OrderACE S; S.init(T_TOK, 1536, gridDim.x, blockIdx.x);
    EpiA1 E{SS1, (bf16_t*)(ws + OFF_U), (bf16_t*)(ws + OFF_Q), (bf16_t*)(ws + OFF_KB), p.in[7] + l * 64, p.in[8] + l * 64}; pg8::gemm_phase<EpiA1, OrderACE>(lds, g, S, E); }
  { pg8::Gemm g{WinT + (size_t)1536 * DM, XB, 1024, T_TOK, DM}; OrderACE S; S.init(1024, T_TOK, gridDim.x, blockIdx.x);
    EpiA2 E{SS1, (bf16_t*)(ws + OFF_GVT), (bf16_t*)(ws + OFF_VT), (u64*)(ws + OFF_SSV)}; pg8::gemm_phase<EpiA2, OrderACE>(lds, g, S, E); }
}
DI void phaseCE(const MParams& p, int l, bool isC, LAS unsigned char* lds) {
  unsigned char* ws = p.ws; const unsigned char* wb = ws + OFF_W + (size_t)l * W_STRIDE;
  if (isC) zero_u64((u64*)(ws + OFF_SS1), T_TOK);
  pg8::Gemm g{(const bf16_t*)(ws + (isC ? OFF_MIX : OFF_F)), (const bf16_t*)(wb + (isC ? WO_OUT : WO_DN)), T_TOK, DM, isC ? DM : DFF}; OrderACE S; S.init(T_TOK, DM, gridDim.x, blockIdx.x);
  EpiResid E{(isC && l == 0) ? p.in[0] : nullptr, (!isC && l == NLAYER - 1) ? p.out : nullptr, (bf16_t*)(ws + OFF_XB), (u64*)(ws + (isC ? OFF_SS2 : OFF_SS1))}; pg8::gemm_phase<EpiResid, OrderACE>(lds, g, S, E);
}
DI void phaseD(const MParams& p, int l, LAS unsigned char* lds) {
  unsigned char* ws = p.ws;
  zero_u64((u64*)(ws + OFF_SSV), T_TOK * 4);
  pg8::Gemm g{(const bf16_t*)(ws + OFF_XB), (const bf16_t*)(ws + OFF_W + (size_t)l * W_STRIDE + WO_GU), T_TOK, 2 * DFF, DM};
#if PROBE_EPI_D
  DupOrder S;
#else
  pg8::StaticOrder S;
#endif
  S.init(T_TOK, 2 * DFF, gridDim.x, blockIdx.x);
  EpiD E{(const u64*)(ws + OFF_SS2), p.in[18] + (size_t)l * 3 * DFF, p.in[19] + (size_t)l * DFF, (bf16_t*)(ws + OFF_F), (float*)(ws + OFF_GB), (float*)(ws + OFF_PB), (float*)(ws + OFF_UB)};
#if PROBE_EPI_D
  pg8::gemm_phase<EpiD, DupOrder>(lds, g, S, E);
#else
  pg8::gemm_phase<EpiD, pg8::StaticOrder>(lds, g, S, E);
#endif
}

__global__ void __launch_bounds__(512) k_run(MParams p) {
  extern __shared__ __attribute__((aligned(16))) unsigned char lds_raw[];
  LAS unsigned char* lds = (LAS unsigned char*)lds_raw;
  cg::grid_group grid = cg::this_grid();
  if (threadIdx.x < 4) ((LAS unsigned*)(lds + 131072))[threadIdx.x] = 0u;
  __syncthreads();
  XcdBarrier xbar; xbar.bar = (unsigned*)(p.ws + OFF_BAR); xbar.x = 0; xbar.st = (volatile LAS unsigned*)(lds + 131072);
  for (int ph = p.ph_lo; ph < p.ph_hi; ++ph) {
    for (int rep = 0; rep < 1 + ((PROBE_MASK >> (ph == 0 ? 6 : (ph - 1) % 6)) & 1); ++rep) {
    if (ph == 0) { if (EN_MASK & 1) prologue(p); }
    else {
      const int l = (ph - 1) / 6, s = (ph - 1) % 6;
      if (s == 0) { if (EN_MASK & 2) phaseA(p, l, lds); }
      else if (s == 1) { if (EN_MASK & 4) attn_phase(p, l, lds); if (EN_MASK & 8) { const LP lp = make_lp(p, l); spatial_phase(lp, p.ws, lds); } }
      else if (s == 2 || s == 5) { if (EN_MASK & 16) phaseCE(p, l, s == 2, lds); }
      else if (s == 3) { if (EN_MASK & 32) phaseD(p, l, lds); }
      else { if (EN_MASK & 64) { const LP lp = make_lp(p, l); fixup_phase(lp, p.ws); } }
    }
    }
    if (ph + 1 < p.ph_hi) {
      if (ph == 0 || p.ph_lo != 0) {
        grid.sync();
        if (p.ph_lo == 0) xbar = xcd_barrier_post((unsigned*)(p.ws + OFF_BAR), (volatile LAS unsigned*)(lds + 131072));
      } else xcd_barrier(xbar);
    }
  }
}

extern "C" void kernel_launch(void* const* d_in, const int* in_sizes, int n_in, void* d_out, int out_size, void* d_ws, size_t ws_size, hipStream_t stream) {
  static int grid_blocks = 0;
  if (!grid_blocks) {
    (void)hipFuncSetAttribute((const void*)k_run, hipFuncAttributeMaxDynamicSharedMemorySize, LDS_BYTES);
    int dev = 0, cus = 0, per_cu = 0; (void)hipGetDevice(&dev); (void)hipDeviceGetAttribute(&cus, hipDeviceAttributeMultiprocessorCount, dev);
    (void)hipOccupancyMaxActiveBlocksPerMultiprocessor(&per_cu, (const void*)k_run, 512, LDS_BYTES); if (per_cu < 1) per_cu = 1;
    grid_blocks = cus * per_cu; if (grid_blocks > 256) grid_blocks = 256;
  }
  MParams mp; memset(&mp, 0, sizeof(mp));
  for (int i = 0; i < 21; ++i) mp.in[i] = (const float*)d_in[i];
  mp.out = (float*)d_out; mp.ws = (unsigned char*)d_ws; mp.ph_lo = 0; mp.ph_hi = 1 + 6 * NLAYER;
  void* args[] = {&mp};
  hipError_t e = hipLaunchCooperativeKernel((const void*)k_run, dim3(grid_blocks), dim3(512), args, LDS_BYTES, stream);
  if (e != hipSuccess) fprintf(stderr, "cooperative launch failed: %s (grid %d)\n", hipGetErrorString(e), grid_blocks);
}
```

```cpp
#include <hip/hip_runtime.h>
#include <hip/hip_cooperative_groups.h>
#include <cstdio>
#include <cmath>
#include <cstring>

typedef unsigned short bf16_t;
#define DI __device__ __forceinline__

constexpr int T_TOK = 32768, DM = 1024, SEQ = 2048, DFF = 2816, INW = 2560, NLAYER = 4;
constexpr float EPS = 1e-6f;
constexpr float QSCALE = 0.125f * 1.4426950408889634f;

constexpr size_t MiB = 1024ull * 1024ull;
constexpr size_t OFF_XB = 0;
constexpr size_t OFF_R = 64 * MiB;
constexpr size_t OFF_U = OFF_R, OFF_Q = OFF_R + 32 * MiB, OFF_KB = OFF_R + 64 * MiB, OFF_GVT = OFF_R + 96 * MiB, OFF_VT = OFF_R + 128 * MiB, OFF_MIX = OFF_R + 160 * MiB;
constexpr size_t OFF_F = OFF_R, OFF_GB = OFF_R + 176 * MiB, OFF_PB = OFF_R + 188 * MiB, OFF_UB = OFF_R + 200 * MiB;
constexpr size_t OFF_W = 288 * MiB, W_STRIDE = 24 * MiB;
constexpr size_t WO_IN = 0, WO_OUT = 5 * MiB, WO_GU = 7 * MiB, WO_DN = 18 * MiB, WO_SP = 23 * MiB + 512 * 1024;
constexpr size_t OFF_SS1 = 384 * MiB, OFF_SS2 = OFF_SS1 + 256 * 1024, OFF_SSV = OFF_SS2 + 256 * 1024;
constexpr size_t OFF_BAR = 385 * MiB + 512 * 1024;
constexpr size_t OFF_TMP1 = 386 * MiB, OFF_TMP2 = 418 * MiB;

DI int tid_opaque() { int t = threadIdx.x; asm volatile("" : "+v"(t)); return t; }
DI float bf2f(bf16_t b) { return __uint_as_float(((unsigned)b) << 16); }
DI bf16_t f2bf(float f) { unsigned u = __float_as_uint(f); u += 0x7FFFu + ((u >> 16) & 1u); return (bf16_t)(u >> 16); }
DI float gelu_exact(float x) { return 0.5f * x * (1.0f + erff(x * 0.70710678118654752f)); }
DI int permpos16(int k) { return (k & 3) + 4 * (k >> 3) + 8 * ((k >> 2) & 1); }
DI float wave_sum(float v) { for (int o = 32; o >= 1; o >>= 1) v += __shfl_xor(v, o); return v; }

namespace pg8 {
#define PG8_LAS __attribute__((address_space(3)))
typedef unsigned short bf16_t;
typedef short bf16x8 __attribute__((ext_vector_type(8)));
typedef float f32x4 __attribute__((ext_vector_type(4)));
typedef unsigned u32x4 __attribute__((ext_vector_type(4)));
constexpr int BM = 256, BK = 64, HALF = 128, HTB = HALF * BK * 2  , STAGE_BYTES = 8 * HTB, NXCD = 8, WGM = 8;

__host__ __device__ __forceinline__ int lds_byte(int r, int c) { const int st = (r >> 4) * 2 + (c >> 5), rr = r & 15, cc = c & 31, ob = rr * 64 + cc * 2; return st * 1024 + (ob ^ (((ob >> 9) & 1) << 5)); }
__host__ __device__ __forceinline__ void stage_rc(int b, int& R, int& C) { const int st = b / 1024, sb = b % 1024, swz = sb ^ (((sb >> 9) & 1) << 5); R = (st >> 1) * 16 + swz / 64; C = (st & 1) * 32 + (swz % 64) / 2; }
__host__ __device__ __forceinline__ int perm32(int rho) { const int n = rho >> 4, i = rho & 15; return 8 * (i >> 2) + 4 * n + (i & 3); }

struct Unit { int pm, pn; };
struct Gemm { const bf16_t* A; const bf16_t* Bt; int M, N, K; };

struct StaticOrder {
    int nM, nN, nwg, G, c;
    __host__ __device__ void init(int M, int N, int G_, int c_) { nM = M / BM; nN = N / BM; nwg = nM * nN; G = G_; c = c_; }
    __host__ __device__ bool next(int i, Unit& u) const {
        const long L = (long)i * G + c; if (L >= nwg) return false;
        int wgid = (int)L; { const int q = nwg / NXCD, r = nwg % NXCD, xcd = wgid % NXCD, off = wgid / NXCD; wgid = (xcd < r ? xcd * (q + 1) : r * (q + 1) + (xcd - r) * q) + off; }
        const int nig = WGM * nN, gid = wgid / nig, fm = gid * WGM, gsz = (nM - fm) < WGM ? (nM - fm) : WGM;
        u.pm = fm + ((wgid % nig) % gsz); u.pn = (wgid % nig) / gsz; return true;
    }
    __device__ __forceinline__ void a_ready(const Unit&) const {}
    __device__ __forceinline__ void done(const Unit&) const {}
};
template <class Epi, class Sched>
__device__ __forceinline__ void gemm_phase(PG8_LAS unsigned char* lds, const Gemm g, const Sched& S, const Epi& E) {
    const int tid = tid_opaque(), wid = __builtin_amdgcn_readfirstlane(tid >> 6), lane = tid & 63, wr = wid >> 2, wc = wid & 3, fr = lane & 15, fq = lane >> 4;
    const int K = g.K, nt = K / BK;
    unsigned voffA[2], voffB[2];
#pragma unroll
    for (int i = 0; i < 2; ++i) { int R, C; stage_rc(tid * 16 + i * 8192, R, C); const int Rb = Epi::PERM ? ((R & ~31) + perm32(R & 31)) : R;
        voffA[i] = (unsigned)(R * K + C) * 2u; voffB[i] = (unsigned)(Rb * K + C) * 2u; }
    const size_t kstep = (size_t)(BK * 2);
    const size_t hstep = (size_t)HALF * K * 2;
    const size_t tstep = 2 * hstep;
    const unsigned ldsw = (unsigned)wid * 1024u;
    const int aoff = lds_byte(wr * 64 + fr, fq * 8), boff = lds_byte(wc * 32 + fr, fq * 8);
#define PG8_SA(b, h) (((b) * 2 + (h)) * HTB)
#define PG8_SB(b, h) ((4 + (b) * 2 + (h)) * HTB)
#define PG8_STAGE(bufoff, gbase, voff) do { _Pragma("unroll") for (int _i = 0; _i < 2; ++_i) \
        __builtin_amdgcn_global_load_lds((const unsigned*)((const char*)(gbase) + (voff)[_i]), (PG8_LAS unsigned*)(lds + (bufoff) + ldsw + _i * 8192), 16, 0, 0); } while (0)
#define PG8_LDA(dst, b, h) do { _Pragma("unroll") for (int m = 0; m < 4; ++m) _Pragma("unroll") for (int k = 0; k < 2; ++k) dst[m][k] = *(const PG8_LAS bf16x8*)(lds + PG8_SA(b, h) + aoff + m * 2048 + k * 1024); } while (0)
#define PG8_LDB(dst, b, h) do { _Pragma("unroll") for (int n = 0; n < 2; ++n) _Pragma("unroll") for (int k = 0; k < 2; ++k) dst[n][k] = *(const PG8_LAS bf16x8*)(lds + PG8_SB(b, h) + boff + n * 2048 + k * 1024); } while (0)
#define PG8_MMA(ai, bj, At, Bt) do { __builtin_amdgcn_s_setprio(1); _Pragma("unroll") for (int m = 0; m < 4; ++m) _Pragma("unroll") for (int n = 0; n < 2; ++n) _Pragma("unroll") for (int k = 0; k < 2; ++k) \
        acc[ai][bj][m][n] = __builtin_amdgcn_mfma_f32_16x16x32_bf16(Bt[n][k], At[m][k], acc[ai][bj][m][n], 0, 0, 0); __builtin_amdgcn_s_setprio(0); } while (0)
#define PG8_WAIT_V(n) asm volatile("s_waitcnt vmcnt(" #n ")" ::: "memory")
#define PG8_WAIT_L(n) asm volatile("s_waitcnt lgkmcnt(" #n ")" ::: "memory")
#define PG8_BAR __builtin_amdgcn_s_barrier()
#define PG8_SCHED __builtin_amdgcn_sched_barrier(0)
    Unit cur, nxt; int ui = 0;
    if (!S.next(0, cur)) return;
    f32x4 acc[2][2][4][2];
#pragma unroll
    for (int a = 0; a < 2; ++a)
#pragma unroll
        for (int b = 0; b < 2; ++b)
#pragma unroll
            for (int m = 0; m < 4; ++m)
#pragma unroll
                for (int n = 0; n < 2; ++n) acc[a][b][m][n] = (f32x4){0.f, 0.f, 0.f, 0.f};
    bf16x8 At[4][2], B0[2][2], B1[2][2];
    const char* cA = (const char*)g.A + (size_t)cur.pm * tstep; const char* cB = (const char*)g.Bt + (size_t)cur.pn * tstep;
    S.a_ready(cur);
    PG8_STAGE(PG8_SB(0, 0), cB, voffB); PG8_STAGE(PG8_SA(0, 0), cA, voffA); PG8_STAGE(PG8_SB(0, 1), cB + hstep, voffB); PG8_STAGE(PG8_SA(0, 1), cA + hstep, voffA);
    if (wr == 1) PG8_BAR;
    PG8_WAIT_V(4); PG8_BAR;
    PG8_STAGE(PG8_SB(1, 0), cB + kstep, voffB); PG8_STAGE(PG8_SA(1, 0), cA + kstep, voffA); PG8_STAGE(PG8_SB(1, 1), cB + hstep + kstep, voffB);
    PG8_WAIT_V(6); PG8_BAR;
    for (;;) {
        const bool has_next = S.next(ui + 1, nxt);
        const char* nA = has_next ? (const char*)g.A + (size_t)nxt.pm * tstep : cA; const char* nB = has_next ? (const char*)g.Bt + (size_t)nxt.pn * tstep : cB;
        for (int t = 0; t < nt; t += 2) {
            const bool last = (t == nt - 2);
            const char* a1 = cA + (size_t)(t + 1) * kstep;
            const char* a2 = last ? nA : cA + (size_t)(t + 2) * kstep; const char* b2 = last ? nB : cB + (size_t)(t + 2) * kstep;
            const char* a3 = a2 + kstep; const char* b3 = b2 + kstep;
            if (last && has_next) S.a_ready(nxt);
            PG8_LDB(B0, 0, 0); PG8_SCHED; PG8_LDA(At, 0, 0); PG8_STAGE(PG8_SA(1, 1), a1 + hstep, voffA);
            PG8_WAIT_L(8); PG8_BAR; PG8_WAIT_L(0); PG8_MMA(0, 0, At, B0); PG8_BAR; PG8_SCHED;
            PG8_LDB(B1, 0, 1); PG8_STAGE(PG8_SB(0, 0), b2, voffB);
            PG8_BAR; PG8_WAIT_L(0); PG8_MMA(0, 1, At, B1); PG8_BAR;
            PG8_LDA(At, 0, 1); PG8_STAGE(PG8_SA(0, 0), a2, voffA);
            PG8_BAR; PG8_WAIT_L(0); PG8_MMA(1, 0, At, B0); PG8_BAR; PG8_SCHED;
            PG8_STAGE(PG8_SB(0, 1), b2 + hstep, voffB);
            PG8_WAIT_V(6); PG8_BAR; PG8_MMA(1, 1, At, B1); PG8_BAR;
            PG8_LDB(B0, 1, 0); PG8_SCHED; PG8_LDA(At, 1, 0); PG8_STAGE(PG8_SA(0, 1), a2 + hstep, voffA);
            PG8_WAIT_L(8); PG8_BAR; PG8_WAIT_L(0); PG8_MMA(0, 0, At, B0); PG8_BAR; PG8_SCHED;
            PG8_LDB(B1, 1, 1); PG8_STAGE(PG8_SB(1, 0), b3, voffB);
            PG8_BAR; PG8_WAIT_L(0); PG8_MMA(0, 1, At, B1); PG8_BAR;
            PG8_LDA(At, 1, 1); PG8_STAGE(PG8_SA(1, 0), a3, voffA);
            PG8_BAR; PG8_WAIT_L(0); PG8_MMA(1, 0, At, B0); PG8_BAR; PG8_SCHED;
            PG8_STAGE(PG8_SB(1, 1), b3 + hstep, voffB);
            PG8_WAIT_V(6); PG8_BAR; PG8_MMA(1, 1, At, B1); PG8_BAR;
        }
        if constexpr (!Epi::AFTER_DRAIN) { if (!Epi::TWICE || (ui & 1)) E(acc, cur, wr, wc, fr, fq); S.done(cur); }
        if (!has_next) break;
#pragma unroll
        for (int a = 0; a < 2; ++a)
#pragma unroll
            for (int b = 0; b < 2; ++b)
#pragma unroll
                for (int m = 0; m < 4; ++m)
#pragma unroll
                    for (int n = 0; n < 2; ++n) acc[a][b][m][n] = (f32x4){0.f, 0.f, 0.f, 0.f};
        cur = nxt; cA = nA; cB = nB; ++ui;
    }
    PG8_WAIT_V(0);
    if (wr == 0) PG8_BAR;
    PG8_BAR;
    if constexpr (Epi::AFTER_DRAIN) { E.fused(acc, cur, wr, wc, fr, fq, lds, wid, lane); S.done(cur); }
#undef PG8_SA
#undef PG8_SB
#undef PG8_STAGE
#undef PG8_LDA
#undef PG8_LDB
#undef PG8_MMA
#undef PG8_WAIT_V
#undef PG8_WAIT_L
#undef PG8_BAR
#undef PG8_SCHED
}
}

namespace cg = cooperative_groups;
using pg8::f32x4; using pg8::bf16x8; using pg8::Unit;
typedef unsigned u32x2_t __attribute__((ext_vector_type(2)));
typedef unsigned u32x4_t __attribute__((ext_vector_type(4)));
typedef float f32x16 __attribute__((ext_vector_type(16)));
typedef float f32x2_t __attribute__((ext_vector_type(2)));
#define LAS PG8_LAS
constexpr int LDS_BYTES = 131072 + 16;
#ifndef EN_MASK
#define EN_MASK 0x7f
#endif
#ifndef PROBE_EPI_ACE
#define PROBE_EPI_ACE 0
#endif
#ifndef PROBE_EPI_D
#define PROBE_EPI_D 0
#endif
#ifndef PROBE_SYNC
#define PROBE_SYNC 0
#endif
#ifndef PROBE_MASK
#define PROBE_MASK 0x00
#endif

DI unsigned pk2(float lo, float hi) { unsigned r; asm volatile("s_nop 0\n\tv_cvt_pk_bf16_f32 %0, %1, %2\n\ts_nop 1" : "=v"(r) : "v"(lo), "v"(hi)); return r; }
DI float bflo(unsigned w) { return __uint_as_float(w << 16); }
DI float bfhi(unsigned w) { return __uint_as_float(w & 0xffff0000u); }
DI float gelu1(float v) {
  const float av = fabsf(v), t = __builtin_amdgcn_rcpf(av * 0.2316418882f + 1.0f);
  float q = t * 0.5307027145f + (-0.7265760135f); q = q * t + 0.7107068705f; q = q * t + (-0.142248368f); q = q * t + 0.127414796f; q = q * t;
  const float e = __builtin_amdgcn_exp2f((v * v) * (-0.72134752044f));
  const float m = v * (q * e);
  return v < 0.f ? m : v - m;
}
DI float dpp_ror1(float v) { return __builtin_bit_cast(float, __builtin_amdgcn_update_dpp(0, __builtin_bit_cast(int, v), 0x121, 0xf, 0xf, false)); }
DI float dpp_ror2(float v) { return __builtin_bit_cast(float, __builtin_amdgcn_update_dpp(0, __builtin_bit_cast(int, v), 0x122, 0xf, 0xf, false)); }
typedef unsigned long long u64;
DI float fx2f(u64 v) { return (float)v * (1.0f / 1048576.0f); }
DI u64 f2fx(float v) { return (u64)(v * 1048576.0f + 0.5f); }
DI void fx_add(u64* p, float v) { __hip_atomic_fetch_add(p, f2fx(v), __ATOMIC_RELAXED, __HIP_MEMORY_SCOPE_AGENT); }
DI float rs1024(u64 ss) { return rsqrtf(fx2f(ss) * (1.0f / 1024.0f) + EPS); }

struct MParams { const float* in[21]; float* out; unsigned char* ws; int ph_lo, ph_hi; };
struct LP {
  const float *norm_attn_w, *w_in, *v_norm_w, *sp_w, *sp_b, *out_norm_w, *q_norm_w, *k_norm_w, *lq1, *lk1, *lq2, *lk2, *diff_norm_w, *w_out, *norm_ffn_w, *w_gate, *w_up, *conv_w, *conv_b, *w_down;
  float lambda_init;
  const bf16_t *WinT, *WoutT, *WguT, *WdT, *Wsp;
};
DI LP make_lp(const MParams& p, int l) {
  LP L;
  L.norm_attn_w = p.in[1] + (size_t)l * DM; L.w_in = p.in[2] + (size_t)l * DM * INW; L.v_norm_w = p.in[3] + (size_t)l * 512; L.sp_w = p.in[4] + (size_t)l * 65536; L.sp_b = p.in[5] + (size_t)l * 512;
  L.out_norm_w = p.in[6] + (size_t)l * 512; L.q_norm_w = p.in[7] + (size_t)l * 64; L.k_norm_w = p.in[8] + (size_t)l * 64; L.lq1 = p.in[9] + (size_t)l * 64; L.lk1 = p.in[10] + (size_t)l * 64;
  L.lq2 = p.in[11] + (size_t)l * 64; L.lk2 = p.in[12] + (size_t)l * 64; L.diff_norm_w = p.in[13] + (size_t)l * 128; L.w_out = p.in[14] + (size_t)l * DM * DM; L.norm_ffn_w = p.in[15] + (size_t)l * DM;
  L.w_gate = p.in[16] + (size_t)l * DM * DFF; L.w_up = p.in[17] + (size_t)l * DM * DFF; L.conv_w = p.in[18] + (size_t)l * 3 * DFF; L.conv_b = p.in[19] + (size_t)l * DFF; L.w_down = p.in[20] + (size_t)l * DFF * DM;
  L.lambda_init = 0.8f - 0.6f * expf(-0.3f * (float)(l + 1));
  const unsigned char* wb = p.ws + OFF_W + (size_t)l * W_STRIDE;
  L.WinT = (const bf16_t*)(wb + WO_IN); L.WoutT = (const bf16_t*)(wb + WO_OUT); L.WguT = (const bf16_t*)(wb + WO_GU); L.WdT = (const bf16_t*)(wb + WO_DN); L.Wsp = (const bf16_t*)(wb + WO_SP);
  return L;
}
DI float lam_of(const LP& lp) {
  const int lane = threadIdx.x & 63;
  float a = lp.lq1[lane] * lp.lk1[lane], b = lp.lq2[lane] * lp.lk2[lane];
  a = wave_sum(a); b = wave_sum(b);
  return expf(a) - expf(b) + lp.lambda_init;
}

DI void conv_item(bf16_t* dst, int K, int row, int kg, const float* src, int ld, int col, const float* ks) {
  float v[32];
#pragma unroll
  for (int i = 0; i < 32; ++i) v[i] = src[(size_t)(kg * 32 + i) * ld + col];
  if (ks) {
#pragma unroll
    for (int i = 0; i < 32; i += 4) { const f32x4 s = *(const f32x4*)(ks + kg * 32 + i); v[i] *= s[0]; v[i + 1] *= s[1]; v[i + 2] *= s[2]; v[i + 3] *= s[3]; }
  }
  u32x4_t* d = (u32x4_t*)(dst + (size_t)row * K + kg * 32);
#pragma unroll
  for (int i = 0; i < 4; ++i) { u32x4_t w; w.x = pk2(v[8 * i], v[8 * i + 1]); w.y = pk2(v[8 * i + 2], v[8 * i + 3]); w.z = pk2(v[8 * i + 4], v[8 * i + 5]); w.w = pk2(v[8 * i + 6], v[8 * i + 7]); d[i] = w; }
}
DI int perm_logical(int p) {
  const int bj = p >> 7, wc = (p >> 5) & 3, n = (p >> 4) & 1, fq = (p >> 2) & 3, e = p & 3;
  return 64 * wc + 32 * bj + 8 * fq + 4 * n + e;
}
DI void prologue(const MParams& p) {
  const int tidp = tid_opaque(); const int gtid = blockIdx.x * 512 + tidp, gsz = gridDim.x * 512;
  unsigned char* ws = p.ws;
  { const int gw = gtid >> 6, nw = gsz >> 6, lane = threadIdx.x & 63; bf16_t* XB = (bf16_t*)(ws + OFF_XB); u64* SS1 = (u64*)(ws + OFF_SS1);
    for (int row = gw; row < T_TOK; row += nw) { const float* xp = p.in[0] + (size_t)row * DM; float s = 0.f;
#pragma unroll
      for (int i = 0; i < 4; ++i) { const f32x4 v = *(const f32x4*)(xp + i * 256 + lane * 4); s += v[0] * v[0] + v[1] * v[1] + v[2] * v[2] + v[3] * v[3];
        u32x2_t w; w.x = pk2(v[0], v[1]); w.y = pk2(v[2], v[3]); *(u32x2_t*)(XB + (size_t)row * DM + i * 256 + lane * 4) = w; }
      s = wave_sum(s); if (lane == 0) SS1[row] = f2fx(s); } }
  { u64* SSV = (u64*)(ws + OFF_SSV); for (int i = gtid; i < T_TOK * 4; i += gsz) SSV[i] = 0ull; }
  { unsigned* bw = (unsigned*)(ws + OFF_BAR); for (int i = gtid; i < 3456; i += gsz) bw[i] = 0u; }
  for (int l = 0; l < NLAYER; ++l) {
    const LP lp = make_lp(p, l);
    for (int w = gtid; w < 2560 * 32; w += gsz) { const int row = w % 2560, kg = w / 2560; int col;
      if (row < 1536) { const int L = (row & ~255) + perm_logical(row & 255); col = L < 512 ? L : L + 512; }
      else { const int r = row - 1536; col = r < 512 ? 512 + r : 1536 + r; }
      conv_item((bf16_t*)lp.WinT, 1024, row, kg, lp.w_in, INW, col, lp.norm_attn_w); }
    for (int w = gtid; w < 1024 * 32; w += gsz) { const int row = w % 1024, kg = w / 1024; conv_item((bf16_t*)lp.WoutT, 1024, row, kg, lp.w_out, DM, row, nullptr); }
    for (int w = gtid; w < 5632 * 32; w += gsz) { const int row = w % 5632, kg = w / 5632; const int pn = row >> 8, pp = row & 255, bj = pp >> 7;
      const int q = pp & 127, wc = (q >> 5) & 3, n = (q >> 4) & 1, fq = (q >> 2) & 3, e = q & 3; const int cc = 128 * pn + 32 * wc + 8 * fq + 4 * n + e;
      conv_item((bf16_t*)lp.WguT, 1024, row, kg, bj ? lp.w_up : lp.w_gate, DFF, cc, lp.norm_ffn_w); }
    for (int w = gtid; w < 1024 * 88; w += gsz) { const int row = w % 1024, kg = w / 1024; conv_item((bf16_t*)lp.WdT, DFF, row, kg, lp.w_down, DM, row, nullptr); }
    for (int i = gtid; i < 65536; i += gsz) { const int jj = i & 127, ii = (i >> 7) & 127; ((bf16_t*)lp.Wsp)[i] = ((jj >> 6) <= (ii >> 6)) ? f2bf(lp.sp_w[i]) : (bf16_t)0; }
  }
}

struct DupOrder : pg8::StaticOrder {
  __device__ bool next(int i, Unit& u) const { return pg8::StaticOrder::next(i >> 1, u); }
};
struct EpiResid {
  static constexpr bool PERM = false, AFTER_DRAIN = false, TWICE = (PROBE_EPI_ACE != 0);
  const float* base32; float* out32; bf16_t* XB; u64* SS;
  DI void operator()(const f32x4 (&acc)[2][2][4][2], const Unit& u, int wr, int wc, int fr, int fq) const {
    const int row0 = u.pm * 256 + wr * 64 + fr, col0 = u.pn * 256 + wc * 32 + 4 * fq;
    if (base32) {
      f32x4 nb[2][2];
#pragma unroll
      for (int bj = 0; bj < 2; ++bj)
#pragma unroll
        for (int n = 0; n < 2; ++n) nb[bj][n] = *(const f32x4*)(base32 + (size_t)row0 * DM + col0 + bj * 128 + n * 16);
#pragma unroll
      for (int g = 0; g < 8; ++g) { const int ai = g >> 2, m = g & 3; const int row = row0 + ai * 128 + m * 16; const size_t ro = (size_t)row * DM + col0; float ss = 0.f;
        f32x4 cbv[2][2];
#pragma unroll
        for (int bj = 0; bj < 2; ++bj)
#pragma unroll
          for (int n = 0; n < 2; ++n) cbv[bj][n] = nb[bj][n];
        if (g < 7) { const int r2 = row0 + ((g + 1) >> 2) * 128 + ((g + 1) & 3) * 16;
#pragma unroll
          for (int bj = 0; bj < 2; ++bj)
#pragma unroll
            for (int n = 0; n < 2; ++n) nb[bj][n] = *(const f32x4*)(base32 + (size_t)r2 * DM + col0 + bj * 128 + n * 16); }
#pragma unroll
        for (int bj = 0; bj < 2; ++bj)
#pragma unroll
          for (int n = 0; n < 2; ++n) { const size_t o = ro + bj * 128 + n * 16; const f32x4 v = acc[ai][bj][m][n] + cbv[bj][n];
            u32x2_t w; w.x = pk2(v[0], v[1]); w.y = pk2(v[2], v[3]); *(u32x2_t*)(XB + o) = w; ss += (v[0] * v[0] + v[1] * v[1]) + (v[2] * v[2] + v[3] * v[3]); }
        ss += __shfl_xor(ss, 16); ss += __shfl_xor(ss, 32); if (fq == 0) fx_add(SS + row, ss);
        asm volatile("" ::: "memory"); }
    } else {
      u32x2_t nb[2][2];
#pragma unroll
      for (int bj = 0; bj < 2; ++bj)
#pragma unroll
        for (int n = 0; n < 2; ++n) nb[bj][n] = *(const u32x2_t*)(XB + (size_t)row0 * DM + col0 + bj * 128 + n * 16);
#pragma unroll
      for (int g = 0; g < 8; ++g) { const int ai = g >> 2, m = g & 3; const int row = row0 + ai * 128 + m * 16; const size_t ro = (size_t)row * DM + col0; float ss = 0.f;
        u32x2_t cbv[2][2];
#pragma unroll
        for (int bj = 0; bj < 2; ++bj)
#pragma unroll
          for (int n = 0; n < 2; ++n) cbv[bj][n] = nb[bj][n];
        if (g < 7) { const int r2 = row0 + ((g + 1) >> 2) * 128 + ((g + 1) & 3) * 16;
#pragma unroll
          for (int bj = 0; bj < 2; ++bj)
#pragma unroll
            for (int n = 0; n < 2; ++n) nb[bj][n] = *(const u32x2_t*)(XB + (size_t)r2 * DM + col0 + bj * 128 + n * 16); }
#pragma unroll
        for (int bj = 0; bj < 2; ++bj)
#pragma unroll
          for (int n = 0; n < 2; ++n) { const size_t o = ro + bj * 128 + n * 16; const u32x2_t c = cbv[bj][n];
            const f32x4 v = acc[ai][bj][m][n] + (f32x4){bflo(c.x), bfhi(c.x), bflo(c.y), bfhi(c.y)};
            if (out32) *(f32x4*)(out32 + o) = v;
            else { u32x2_t w; w.x = pk2(v[0], v[1]); w.y = pk2(v[2], v[3]); *(u32x2_t*)(XB + o) = w; ss += (v[0] * v[0] + v[1] * v[1]) + (v[2] * v[2] + v[3] * v[3]); } }
        if (!out32) { ss += __shfl_xor(ss, 16); ss += __shfl_xor(ss, 32); if (fq == 0) fx_add(SS + row, ss); }
        asm volatile("" ::: "memory"); }
    }
  }
};
struct EpiA1 {
  static constexpr bool PERM = false, AFTER_DRAIN = false, TWICE = (PROBE_EPI_ACE != 0);
  const u64* SS1; bf16_t *U, *Q, *KB; const float *qw, *kw;
  DI void operator()(const f32x4 (&acc)[2][2][4][2], const Unit& u, int wr, int wc, int fr, int fq) const {
    const int row0 = u.pm * 256 + wr * 64 + fr, lc0 = wc * 64 + 8 * fq, region = u.pn >> 1;
    u64 rsv[8];
#pragma unroll
    for (int g = 0; g < 8; ++g) rsv[g] = SS1[row0 + (g >> 2) * 128 + (g & 3) * 16];
    if (region == 0) {
#pragma unroll
      for (int g = 0; g < 8; ++g) { const int ai = g >> 2, m = g & 3; const int row = row0 + ai * 128 + m * 16; const float rs = rs1024(rsv[g]);
#pragma unroll
        for (int bj = 0; bj < 2; ++bj) { const f32x4 a = acc[ai][bj][m][0] * rs, b = acc[ai][bj][m][1] * rs; u32x4_t w;
          w.x = pk2(gelu1(a[0]), gelu1(a[1])); w.y = pk2(gelu1(a[2]), gelu1(a[3])); w.z = pk2(gelu1(b[0]), gelu1(b[1])); w.w = pk2(gelu1(b[2]), gelu1(b[3]));
          *(u32x4_t*)(U + (size_t)row * 512 + u.pn * 256 + lc0 + 32 * bj) = w; } }
    } else {
      const bool isq = region == 1; const float* wp = (isq ? qw : kw) + 8 * fq; bf16_t* dst = (isq ? Q : KB) + (u.pn & 1) * 256 + lc0; const float sc = isq ? QSCALE : 1.0f;
      f32x4 wv[2][2];
#pragma unroll
      for (int bj = 0; bj < 2; ++bj)
#pragma unroll
        for (int n = 0; n < 2; ++n) wv[bj][n] = *(const f32x4*)(wp + 32 * bj + 4 * n);
#pragma unroll
      for (int g = 0; g < 8; ++g) { const int ai = g >> 2, m = g & 3; const int row = row0 + ai * 128 + m * 16; const float rs = rs1024(rsv[g]); float ss = 0.f; f32x4 v[2][2];
#pragma unroll
        for (int bj = 0; bj < 2; ++bj)
#pragma unroll
          for (int n = 0; n < 2; ++n) { v[bj][n] = acc[ai][bj][m][n] * rs; const f32x4 t = v[bj][n]; ss += (t[0] * t[0] + t[1] * t[1]) + (t[2] * t[2] + t[3] * t[3]); }
        ss += __shfl_xor(ss, 16); ss += __shfl_xor(ss, 32);
        const float r2 = rsqrtf(ss * (1.0f / 64.0f) + EPS) * sc;
#pragma unroll
        for (int bj = 0; bj < 2; ++bj) { const f32x4 a = v[bj][0] * r2 * wv[bj][0], b = v[bj][1] * r2 * wv[bj][1]; u32x4_t w;
          w.x = pk2(a[0], a[1]); w.y = pk2(a[2], a[3]); w.z = pk2(b[0], b[1]); w.w = pk2(b[2], b[3]);
          *(u32x4_t*)(dst + (size_t)row * 512 + 32 * bj) = w; } }
    }
  }
};
struct EpiA2 {
  static constexpr bool PERM = false, AFTER_DRAIN = false, TWICE = (PROBE_EPI_ACE != 0);
  const u64* SS1; bf16_t *GVT, *VT; u64* SSV;
  DI void operator()(const f32x4 (&acc)[2][2][4][2], const Unit& u, int wr, int wc, int fr, int fq) const {
    const int colbase = u.pn * 256 + wc * 32;
    f32x4 rs[2][2];
#pragma unroll
    for (int bj = 0; bj < 2; ++bj)
#pragma unroll
      for (int n = 0; n < 2; ++n) { const u64* sp = SS1 + colbase + bj * 128 + n * 16 + 4 * fq; rs[bj][n] = (f32x4){rs1024(sp[0]), rs1024(sp[1]), rs1024(sp[2]), rs1024(sp[3])}; }
    if (u.pm < 2) {
#pragma unroll
      for (int ai = 0; ai < 2; ++ai) { const int head = 2 * u.pm + ai;
#pragma unroll
        for (int bj = 0; bj < 2; ++bj)
#pragma unroll
          for (int n = 0; n < 2; ++n) { f32x4 sq = (f32x4){0.f, 0.f, 0.f, 0.f}; const int tok = colbase + bj * 128 + n * 16 + 4 * fq;
#pragma unroll
            for (int m = 0; m < 4; ++m) { const int row = u.pm * 256 + ai * 128 + wr * 64 + m * 16 + fr;
              const f32x4 a = acc[ai][bj][m][n] * rs[bj][n]; f32x4 g; g[0] = gelu1(a[0]); g[1] = gelu1(a[1]); g[2] = gelu1(a[2]); g[3] = gelu1(a[3]);
              u32x2_t w; w.x = pk2(g[0], g[1]); w.y = pk2(g[2], g[3]); *(u32x2_t*)(GVT + (size_t)row * T_TOK + tok) = w; sq += g * g; }
#pragma unroll
            for (int e = 0; e < 4; ++e) { float s = sq[e]; s += __shfl_xor(s, 1); s += __shfl_xor(s, 2); s += __shfl_xor(s, 4); s += __shfl_xor(s, 8); sq[e] = s; }
            if (fr == 0) {
#pragma unroll
              for (int e = 0; e < 4; ++e) fx_add(SSV + (size_t)(tok + e) * 4 + head, sq[e]); }
            asm volatile("" ::: "memory"); } }
    } else {
#pragma unroll
      for (int ai = 0; ai < 2; ++ai)
#pragma unroll
        for (int m = 0; m < 4; ++m) { const int row = (u.pm - 2) * 256 + ai * 128 + wr * 64 + m * 16 + fr;
#pragma unroll
          for (int bj = 0; bj < 2; ++bj)
#pragma unroll
            for (int n = 0; n < 2; ++n) { const f32x4 a = acc[ai][bj][m][n] * rs[bj][n]; u32x2_t w; w.x = pk2(a[0], a[1]); w.y = pk2(a[2], a[3]);
              *(u32x2_t*)(VT + (size_t)row * T_TOK + colbase + bj * 128 + n * 16 + 8 * (fq & 1) + 4 * (fq >> 1)) = w; } }
    }
  }
};
struct EpiD {
  static constexpr bool PERM = false, AFTER_DRAIN = false, TWICE = (PROBE_EPI_D != 0);
  const u64* SS2; const float *cw, *cb; bf16_t* F; float *GB, *PB, *UB;
  DI void operator()(const f32x4 (&acc)[2][2][4][2], const Unit& u, int wr, int wc, int fr, int fq) const {
    const int cbase = u.pn * 128 + wc * 32 + 8 * fq;
    const int rb0 = u.pm * 256 + wr * 64;
    u64 rsv[8]; f32x4 w0[2], w1[2], w2[2], bb[2];
#pragma unroll
    for (int g = 0; g < 8; ++g) rsv[g] = SS2[rb0 + (g >> 2) * 128 + (g & 3) * 16 + fr];
#pragma unroll
    for (int n = 0; n < 2; ++n) { w0[n] = *(const f32x4*)(cw + cbase + 4 * n); w1[n] = *(const f32x4*)(cw + DFF + cbase + 4 * n); w2[n] = *(const f32x4*)(cw + 2 * DFF + cbase + 4 * n); bb[n] = *(const f32x4*)(cb + cbase + 4 * n); }
#pragma unroll
    for (int ai = 0; ai < 2; ++ai) {
      const int rb = rb0 + ai * 128, bd = rb >> 6;
      float rs[4];
#pragma unroll
      for (int m = 0; m < 4; ++m) rs[m] = rs1024(rsv[ai * 4 + m]);
      unsigned fo[4][4];
#pragma unroll
      for (int n = 0; n < 2; ++n) {
        const int cn = cbase + 4 * n;
        f32x4 pg, ug, gg; float fv[4][4];
#pragma unroll
        for (int e = 0; e < 4; ++e) {
          float G[4], r1[4], r2[4];
#pragma unroll
          for (int m = 0; m < 4; ++m) { G[m] = acc[ai][0][m][n][e] * rs[m]; r1[m] = dpp_ror1(G[m]); r2[m] = dpp_ror2(G[m]); }
#pragma unroll
          for (int m = 0; m < 4; ++m) {
            const float p1 = (fr >= 1) ? r1[m] : (m > 0 ? r1[m > 0 ? m - 1 : 0] : 0.f);
            const float p2 = (fr >= 2) ? r2[m] : (m > 0 ? r2[m > 0 ? m - 1 : 0] : 0.f);
            const float g = w2[n][e] * G[m] + w1[n][e] * p1 + w0[n][e] * p2 + bb[n][e];
            const float uv = acc[ai][1][m][n][e] * rs[m];
            if (m == 0) { pg[e] = g; ug[e] = uv; }
            if (m == 3) gg[e] = G[3];
            fv[m][e] = g * __builtin_amdgcn_rcpf(1.0f + __expf(-g)) * uv;
          }
        }
#pragma unroll
        for (int m = 0; m < 4; ++m) { fo[m][2 * n] = pk2(fv[m][0], fv[m][1]); fo[m][2 * n + 1] = pk2(fv[m][2], fv[m][3]); }
        if (fr < 2) { *(f32x4*)(PB + (size_t)(bd * 2 + fr) * DFF + cn) = pg; *(f32x4*)(UB + (size_t)(bd * 2 + fr) * DFF + cn) = ug; }
        if (fr >= 14) { *(f32x4*)(GB + (size_t)(bd * 2 + fr - 14) * DFF + cn) = gg; }
      }
#pragma unroll
      for (int m = 0; m < 4; ++m) {
        if (!(m == 0 && fr < 2)) { u32x4_t w; w.x = fo[m][0]; w.y = fo[m][1]; w.z = fo[m][2]; w.w = fo[m][3]; *(u32x4_t*)(F + (size_t)(rb + 16 * m + fr) * DFF + cbase) = w; }
      }
    }
  }
};
DI void fixup_phase(const LP& lp, unsigned char* ws) {
  const float *GB = (const float*)(ws + OFF_GB), *PB = (const float*)(ws + OFF_PB), *UB = (const float*)(ws + OFF_UB); bf16_t* F = (bf16_t*)(ws + OFF_F);
  const int gtid = blockIdx.x * 512 + tid_opaque(), gsz = gridDim.x * 512;
  for (int w = gtid; w < 512 * 2 * 704; w += gsz) {
    const int c = (w % 704) * 4, j = (w / 704) & 1, bd = w / 1408;
    f32x4 g = *(const f32x4*)(PB + (size_t)(bd * 2 + j) * DFF + c);
    if (bd & 31) { const f32x4 gm1 = *(const f32x4*)(GB + (size_t)((bd - 1) * 2 + 1) * DFF + c); const f32x4 w0 = *(const f32x4*)(lp.conv_w + c);
      if (j == 0) { const f32x4 gm2 = *(const f32x4*)(GB + (size_t)((bd - 1) * 2) * DFF + c); const f32x4 w1 = *(const f32x4*)(lp.conv_w + DFF + c); g += w1 * gm1 + w0 * gm2; }
      else g += w0 * gm1; }
    const f32x4 uv = *(const f32x4*)(UB + (size_t)(bd * 2 + j) * DFF + c); float f[4];
#pragma unroll
    for (int e = 0; e < 4; ++e) f[e] = g[e] * __builtin_amdgcn_rcpf(1.0f + __expf(-g[e])) * uv[e];
    u32x2_t o; o.x = pk2(f[0], f[1]); o.y = pk2(f[2], f[3]);
    *(u32x2_t*)(F + (size_t)(bd * 64 + j) * DFF + c) = o;
  }
}

DI void spatial_phase(const LP& lp, unsigned char* ws, LAS unsigned char* lds) {
  const bf16_t *U = (const bf16_t*)(ws + OFF_U), *GVT = (const bf16_t*)(ws + OFF_GVT); const u64* SSV = (const u64*)(ws + OFF_SSV); bf16_t* MIX = (bf16_t*)(ws + OFF_MIX);
  LAS float* sr = (LAS float*)lds;
  const int tid = tid_opaque(), lane = tid & 63, w = __builtin_amdgcn_readfirstlane(tid >> 6), l15 = lane & 15, kq = lane >> 4;
  for (int it = blockIdx.x; it < 1024; it += gridDim.x) {
    const int h = it & 3, tok0 = (it >> 2) * 128;
    if (tid < 128) sr[tid] = rsqrtf(fx2f(SSV[(size_t)(tok0 + tid) * 4 + h]) * (1.0f / 128.0f) + EPS);
    __syncthreads();
    const int i0 = 16 * w, nks = (w < 4) ? 2 : 4, irow = tok0 + i0 + l15;
    bf16x8 yf[4];
#pragma unroll
    for (int ks = 0; ks < 4; ++ks) {
      u32x4_t o = (u32x4_t){0u, 0u, 0u, 0u};
      if (ks < nks) { const u32x4_t raw = *(const u32x4_t*)(lp.Wsp + (size_t)(h * 128 + i0 + l15) * 128 + ks * 32 + kq * 8);
        const LAS float* s = sr + ks * 32 + kq * 8;
        o.x = pk2(bflo(raw.x) * s[0], bfhi(raw.x) * s[1]); o.y = pk2(bflo(raw.y) * s[2], bfhi(raw.y) * s[3]); o.z = pk2(bflo(raw.z) * s[4], bfhi(raw.z) * s[5]); o.w = pk2(bflo(raw.w) * s[6], bfhi(raw.w) * s[7]); }
      yf[ks] = __builtin_bit_cast(bf16x8, o);
    }
    const float bias = lp.sp_b[h * 128 + i0 + l15];
    float o[8][4]; float ss = 0.f;
#pragma unroll
    for (int dt = 0; dt < 8; ++dt) {
      f32x4 acc = (f32x4){0.f, 0.f, 0.f, 0.f};
#pragma unroll
      for (int ks = 0; ks < 4; ++ks) if (ks < nks) {
        const bf16x8 xf = *(const bf16x8*)(GVT + (size_t)(h * 128 + 16 * dt + l15) * T_TOK + tok0 + ks * 32 + kq * 8);
        acc = __builtin_amdgcn_mfma_f32_16x16x32_bf16(xf, yf[ks], acc, 0, 0, 0); }
      const int d0 = 16 * dt + 4 * kq; const f32x4 wv = *(const f32x4*)(lp.v_norm_w + h * 128 + d0);
      const u32x2_t ur = *(const u32x2_t*)(U + (size_t)irow * 512 + h * 128 + d0);
      o[dt][0] = bflo(ur.x) * (acc[0] * wv[0] + bias); o[dt][1] = bfhi(ur.x) * (acc[1] * wv[1] + bias); o[dt][2] = bflo(ur.y) * (acc[2] * wv[2] + bias); o[dt][3] = bfhi(ur.y) * (acc[3] * wv[3] + bias);
      ss += (o[dt][0] * o[dt][0] + o[dt][1] * o[dt][1]) + (o[dt][2] * o[dt][2] + o[dt][3] * o[dt][3]);
    }
    ss += __shfl_xor(ss, 16); ss += __shfl_xor(ss, 32);
    const float rs = rsqrtf(ss * (1.0f / 128.0f) + EPS);
#pragma unroll
    for (int dt = 0; dt < 8; ++dt) { const int d0 = 16 * dt + 4 * kq; const f32x4 wo = *(const f32x4*)(lp.out_norm_w + h * 128 + d0);
      u32x2_t q; q.x = pk2(o[dt][0] * rs * wo[0], o[dt][1] * rs * wo[1]); q.y = pk2(o[dt][2] * rs * wo[2], o[dt][3] * rs * wo[3]);
      *(u32x2_t*)(MIX + (size_t)irow * 1024 + h * 128 + d0) = q; }
    __syncthreads();
  }
}

DI void attn_phase(const MParams& p, int l, LAS unsigned char* lds) {
  unsigned char* ws = p.ws;
  const bf16_t *Q = (const bf16_t*)(ws + OFF_Q), *KB = (const bf16_t*)(ws + OFF_KB), *VT = (const bf16_t*)(ws + OFF_VT); bf16_t* MIX = (bf16_t*)(ws + OFF_MIX);
  constexpr int KBUF = 16384, VBUF = 16384, STG = KBUF + VBUF, QOFF = 2 * STG;
  static_assert(QOFF + 65536 <= LDS_BYTES, "attention LDS");
  const float lambda_init = 0.8f - 0.6f * expf(-0.3f * (float)(l + 1));
  const float* dnw = p.in[13] + l * 128;
#pragma unroll 1
  for (int pi = blockIdx.x; pi < 256; pi += gridDim.x) {
    const int b = pi >> 4, h = (pi >> 2) & 3, j = pi & 3;
#pragma unroll 1
    for (int it = 0; it < 2; ++it) {
      const int tid = tid_opaque(), lane = tid & 63, w = __builtin_amdgcn_readfirstlane(tid >> 6), l31 = lane & 31, hh = lane >> 5;
      const int qb = it ? j : 7 - j, t0 = b * 2048 + 256 * qb, ntl = 4 * qb + 4, ntw = 4 * qb + (w >> 1) + 1;
#pragma unroll
      for (int i = 0; i < 8; ++i) { const int P = (w * 8 + i) * 64 + lane, row = P >> 4, pos = P & 15, pc = pos ^ (row & 15);
        __builtin_amdgcn_global_load_lds((const unsigned*)(Q + (size_t)(t0 + row) * 512 + h * 128 + pc * 8), (LAS unsigned*)(lds + QOFF + (w * 8 + i) * 1024), 16, 0, 0); }
      const bf16_t* kbase = KB + (size_t)(b * 2048) * 512 + h * 128; const bf16_t* vbase = VT + (size_t)(h * 128) * T_TOK + b * 2048;
      int koff[2], voff[2];
#pragma unroll
      for (int i = 0; i < 2; ++i) { const int P = (w * 2 + i) * 64 + lane; { const int row = P >> 4, pos = P & 15, pc = pos ^ (row & 15); koff[i] = row * 512 + pc * 8; }
        { const int row = P >> 3, pos = P & 7, pc = pos ^ ((row >> 1) & 7); voff[i] = row * T_TOK + pc * 8; } }
#define ATT_STAGE(kt, buf) do { _Pragma("unroll") for (int i = 0; i < 2; ++i) { \
        __builtin_amdgcn_global_load_lds((const unsigned*)(kbase + (size_t)(kt) * (64 * 512) + koff[i]), (LAS unsigned*)(lds + (buf) * STG + (w * 2 + i) * 1024), 16, 0, 0); \
        __builtin_amdgcn_global_load_lds((const unsigned*)(vbase + (kt) * 64 + voff[i]), (LAS unsigned*)(lds + (buf) * STG + KBUF + (w * 2 + i) * 1024), 16, 0, 0); } } while (0)
      ATT_STAGE(0, 0);
      asm volatile("s_waitcnt vmcnt(0)" ::: "memory");
      __syncthreads();
      f32x16 O[2][4];
#pragma unroll
      for (int c = 0; c < 2; ++c)
#pragma unroll
        for (int bk = 0; bk < 4; ++bk)
#pragma unroll
          for (int i = 0; i < 16; ++i) O[c][bk][i] = 0.f;
      float lsum[2] = {0.f, 0.f};
      const int qr = 32 * w + l31;
      int k_lane = l31 * 256 + ((hh ^ (l31 & 15)) << 4), q_lane = QOFF + qr * 256 + ((hh ^ (qr & 15)) << 4), v_lane = KBUF + l31 * 128 + ((hh ^ ((l31 >> 1) & 7)) << 4);
#pragma unroll 1
      for (int kt = 0; kt < ntl; ++kt) {
        if (kt + 1 < ntl) ATT_STAGE(kt + 1, (kt + 1) & 1);
        if (kt < ntw) {
          asm volatile("" : "+v"(k_lane), "+v"(q_lane), "+v"(v_lane));
          const LAS unsigned char* tb = lds + (kt & 1) * STG;
#pragma unroll
          for (int kb = 0; kb < 2; ++kb) {
            bf16x8 pf[2][2];
#pragma unroll
            for (int c = 0; c < 2; ++c) {
              f32x16 S;
#pragma unroll
              for (int i = 0; i < 16; ++i) S[i] = 0.f;
#pragma unroll
              for (int ks = 0; ks < 4; ++ks) {
                const int xo = (c * 8 + ks * 2) << 4;
                const bf16x8 qf = *(const LAS bf16x8*)(lds + (q_lane ^ xo));
                const bf16x8 kf = *(const LAS bf16x8*)(tb + (k_lane ^ xo) + kb * 8192);
                S = __builtin_amdgcn_mfma_f32_32x32x16_bf16(kf, qf, S, 0, 0, 0);
              }
              float ls = 0.f;
#pragma unroll
              for (int hs = 0; hs < 2; ++hs) { u32x4_t pw;
#pragma unroll
                for (int t = 0; t < 4; ++t) { const float a = __builtin_amdgcn_exp2f(S[8 * hs + 2 * t]), bq = __builtin_amdgcn_exp2f(S[8 * hs + 2 * t + 1]); ls += a + bq; pw[t] = pk2(a, bq); }
                pf[c][hs] = __builtin_bit_cast(bf16x8, pw); }
              lsum[c] += ls;
              __builtin_amdgcn_sched_barrier(0);
            }
#pragma unroll
            for (int bk = 0; bk < 4; ++bk) {
              const bf16x8 v0 = *(const LAS bf16x8*)(tb + (v_lane ^ ((2 * kb) << 5)) + bk * 4096);
              const bf16x8 v1 = *(const LAS bf16x8*)(tb + (v_lane ^ ((2 * kb + 1) << 5)) + bk * 4096);
              O[0][bk] = __builtin_amdgcn_mfma_f32_32x32x16_bf16(v0, pf[0][0], O[0][bk], 0, 0, 0);
              O[1][bk] = __builtin_amdgcn_mfma_f32_32x32x16_bf16(v0, pf[1][0], O[1][bk], 0, 0, 0);
              O[0][bk] = __builtin_amdgcn_mfma_f32_32x32x16_bf16(v1, pf[0][1], O[0][bk], 0, 0, 0);
              O[1][bk] = __builtin_amdgcn_mfma_f32_32x32x16_bf16(v1, pf[1][1], O[1][bk], 0, 0, 0);
              __builtin_amdgcn_sched_barrier(0);
            }
          }
        }
        asm volatile("s_waitcnt vmcnt(0)" ::: "memory");
        __syncthreads();
      }
#undef ATT_STAGE
      const int tid2 = tid_opaque(), lane2 = tid2 & 63, w2 = __builtin_amdgcn_readfirstlane(tid2 >> 6), hh2 = lane2 >> 5, qr2 = 32 * w2 + (lane2 & 31);
      float lam;
      { const float* q1 = p.in[9] + l * 64; const float* k1 = p.in[10] + l * 64; const float* q2 = p.in[11] + l * 64; const float* k2 = p.in[12] + l * 64;
        float a = q1[lane2] * k1[lane2], bq = q2[lane2] * k2[lane2]; a = wave_sum(a); bq = wave_sum(bq); lam = expf(a) - expf(bq) + lambda_init; }
      float l1 = lsum[0], l2 = lsum[1]; l1 += __shfl_xor(l1, 32); l2 += __shfl_xor(l2, 32);
      const float inv1 = 1.0f / l1, inv2 = lam / l2; float ss = 0.f;
#pragma unroll
      for (int bk = 0; bk < 4; ++bk)
#pragma unroll
        for (int i = 0; i < 16; ++i) { const float o = O[0][bk][i] * inv1 - O[1][bk][i] * inv2; O[0][bk][i] = o; ss += o * o; }
      ss += __shfl_xor(ss, 32);
      const float rs = rsqrtf(ss * (1.0f / 128.0f) + EPS) * (1.0f - lambda_init);
      bf16_t* orow = MIX + (size_t)(t0 + qr2) * 1024 + 512 + h * 128;
#pragma unroll
      for (int bk = 0; bk < 4; ++bk)
#pragma unroll
        for (int g = 0; g < 4; ++g) { const int dv0 = 32 * bk + 8 * g + 4 * hh2; const f32x4 wv = *(const f32x4*)(dnw + dv0);
          u32x2_t q; q.x = pk2(O[0][bk][4 * g] * rs * wv[0], O[0][bk][4 * g + 1] * rs * wv[1]); q.y = pk2(O[0][bk][4 * g + 2] * rs * wv[2], O[0][bk][4 * g + 3] * rs * wv[3]);
          *(u32x2_t*)(orow + dv0) = q; }
    }
  }
}


#define XB_TMO      128
#define XB_XCNT(j)  (256  + 64 * (j))
#define XB_XSUB(j)  (1280 + 64 * (j))
#define XB_XGEN(j)  (2304 + 64 * (j))
#define XB_TOP      3328
#define XB_TOPGEN   3392
#define XCD_BAR_WORDS 3456
#define XB_SPIN_CAP (1u << 18)

__device__ __forceinline__ unsigned xb_ld(unsigned* p)              { return __hip_atomic_load(p, __ATOMIC_RELAXED, __HIP_MEMORY_SCOPE_AGENT); }
__device__ __forceinline__ unsigned xb_add(unsigned* p, unsigned v) { return __hip_atomic_fetch_add(p, v, __ATOMIC_RELAXED, __HIP_MEMORY_SCOPE_AGENT); }
__device__ __forceinline__ unsigned xb_xcc_id() { return (unsigned)__builtin_amdgcn_s_getreg((3 << 11) | 20) & 0xFu; }
#define XB_SPIN(cond, bar) do { unsigned _sp = 0; while (cond) { __builtin_amdgcn_s_sleep(1); \
    if ((++_sp & 255u) == 0u) { if (xb_ld(&(bar)[XB_TMO])) break; if (_sp > XB_SPIN_CAP) { atomicAdd(&(bar)[XB_TMO], 1u); break; } } } } while (0)

struct XcdBarrier {
    unsigned* bar; unsigned x;
    volatile LAS unsigned* st;
};

__device__ __forceinline__ XcdBarrier xcd_barrier_post(unsigned* bar, volatile LAS unsigned* st) {
    XcdBarrier b; b.bar = bar; b.x = xb_xcc_id(); b.st = st;
    if (threadIdx.x == 0) (void)xb_add(&bar[XB_XCNT(b.x)], 1u);
    return b;
}
__device__ __forceinline__ void xcd_barrier_complete(unsigned* bar, unsigned x, unsigned& nloc, unsigned& nx) {
    const unsigned G = gridDim.x * gridDim.y * gridDim.z;
    unsigned sum, cnt, mine, sp = 0u;
    for (;;) {
        sum = 0u; cnt = 0u; mine = 0u;
#pragma unroll
        for (unsigned j = 0; j < 16; ++j) { const unsigned c = xb_ld(&bar[XB_XCNT(j)]); sum += c; cnt += (c > 0u) ? 1u : 0u; mine = (j == x) ? c : mine; }
        if (sum == G) break;
        __builtin_amdgcn_s_sleep(1);
        if ((++sp & 255u) == 0u) { if (xb_ld(&bar[XB_TMO])) break; if (sp > XB_SPIN_CAP) { atomicAdd(&bar[XB_TMO], 1u); break; } }
    }
    nloc = mine > 0u ? mine : 1u; nx = cnt > 0u ? cnt : 1u;
}

__device__ __forceinline__ void xcd_barrier(const XcdBarrier& b) {
    asm volatile("s_waitcnt vmcnt(0)" ::: "memory");
    __syncthreads();
    if (threadIdx.x == 0) {
        unsigned* bar = b.bar;
        __builtin_amdgcn_s_waitcnt(0);
        unsigned nloc = b.st[0], nx = b.st[1];
        if (nloc == 0u) { xcd_barrier_complete(bar, b.x, nloc, nx); b.st[0] = nloc; b.st[1] = nx; }
        const unsigned old = xb_add(&bar[XB_XSUB(b.x)], 1u);
        const unsigned gen = old / nloc;
        if (old + 1u == (gen + 1u) * nloc) {
            __builtin_amdgcn_fence(__ATOMIC_RELEASE, "agent");
            asm volatile("s_waitcnt vmcnt(0)" ::: "memory");
            const unsigned og = xb_add(&bar[XB_TOP], 1u);
            const unsigned tg = og / nx;
            if (og + 1u == (tg + 1u) * nx) xb_add(&bar[XB_TOPGEN], 1u);
            else XB_SPIN(xb_ld(&bar[XB_TOPGEN]) == tg, bar);
            __builtin_amdgcn_fence(__ATOMIC_ACQUIRE, "agent");
            xb_add(&bar[XB_XGEN(b.x)], 1u);
            asm volatile("s_waitcnt vmcnt(0)" ::: "memory");
        } else {
            XB_SPIN(xb_ld(&bar[XB_XGEN(b.x)]) == gen, bar);
            __builtin_amdgcn_fence(__ATOMIC_ACQUIRE, "agent");
            asm volatile("s_waitcnt vmcnt(0)" ::: "memory");
        }
    }
    __syncthreads();
}

DI void zero_u64(u64* p, int n) { for (int i = blockIdx.x * 512 + tid_opaque(); i < n; i += gridDim.x * 512) p[i] = 0ull; }

#if PROBE_EPI_ACE
typedef DupOrder OrderACE;
#else
typedef pg8::StaticOrder OrderACE;
#endif
DI void phaseA(const MParams& p, int l, LAS unsigned char* lds) {
  unsigned char* ws = p.ws; const bf16_t* XB = (const bf16_t*)(ws + OFF_XB); const bf16_t* WinT = (const bf16_t*)(ws + OFF_W + (size_t)l * W_STRIDE + WO_IN); const u64* SS1 = (const u64*)(ws + OFF_SS1);
  zero_u64((u64*)(ws + OFF_SS2), T_TOK);
  { pg8::Gemm g{XB, WinT, T_TOK, 1536, DM}; OrderACE S; S.init(T_TOK, 1536, gridDim.x, blockIdx.x);
    EpiA1 E{SS1, (bf16_t*)(ws + OFF_U), (bf16_t*)(ws + OFF_Q), (bf16_t*)(ws + OFF_KB), p.in[7] + l * 64, p.in[8] + l * 64}; pg8::gemm_phase<EpiA1, OrderACE>(lds, g, S, E); }
  { pg8::Gemm g{WinT + (size_t)1536 * DM, XB, 1024, T_TOK, DM}; OrderACE S; S.init(1024, T_TOK, gridDim.x, blockIdx.x);
    EpiA2 E{SS1, (bf16_t*)(ws + OFF_GVT), (bf16_t*)(ws + OFF_VT), (u64*)(ws + OFF_SSV)}; pg8::gemm_phase<EpiA2, OrderACE>(lds, g, S, E); }
}
DI void phaseCE(const MParams& p, int l, bool isC, LAS unsigned char* lds) {
  unsigned char* ws = p.ws; const unsigned char* wb = ws + OFF_W + (size_t)l * W_STRIDE;
  if (isC) zero_u64((u64*)(ws + OFF_SS1), T_TOK);
  pg8::Gemm g{(const bf16_t*)(ws + (isC ? OFF_MIX : OFF_F)), (const bf16_t*)(wb + (isC ? WO_OUT : WO_DN)), T_TOK, DM, isC ? DM : DFF}; OrderACE S; S.init(T_TOK, DM, gridDim.x, blockIdx.x);
  EpiResid E{(isC && l == 0) ? p.in[0] : nullptr, (!isC && l == NLAYER - 1) ? p.out : nullptr, (bf16_t*)(ws + OFF_XB), (u64*)(ws + (isC ? OFF_SS2 : OFF_SS1))}; pg8::gemm_phase<EpiResid, OrderACE>(lds, g, S, E);
}
DI void phaseD(const MParams& p, int l, LAS unsigned char* lds) {
  unsigned char* ws = p.ws;
  zero_u64((u64*)(ws + OFF_SSV), T_TOK * 4);
  pg8::Gemm g{(const bf16_t*)(ws + OFF_XB), (const bf16_t*)(ws + OFF_W + (size_t)l * W_STRIDE + WO_GU), T_TOK, 2 * DFF, DM};
#if PROBE_EPI_D
  DupOrder S;
#else
  pg8::StaticOrder S;
#endif
  S.init(T_TOK, 2 * DFF, gridDim.x, blockIdx.x);
  EpiD E{(const u64*)(ws + OFF_SS2), p.in[18] + (size_t)l * 3 * DFF, p.in[19] + (size_t)l * DFF, (bf16_t*)(ws + OFF_F), (float*)(ws + OFF_GB), (float*)(ws + OFF_PB), (float*)(ws + OFF_UB)};
#if PROBE_EPI_D
  pg8::gemm_phase<EpiD, DupOrder>(lds, g, S, E);
#else
  pg8::gemm_phase<EpiD, pg8::StaticOrder>(lds, g, S, E);
#endif
}

__global__ void __launch_bounds__(512) k_run(MParams p) {
  extern __shared__ __attribute__((aligned(16))) unsigned char lds_raw[];
  LAS unsigned char* lds = (LAS unsigned char*)lds_raw;
  cg::grid_group grid = cg::this_grid();
  if (threadIdx.x < 4) ((LAS unsigned*)(lds + 131072))[threadIdx.x] = 0u;
  __syncthreads();
  XcdBarrier xbar; xbar.bar = (unsigned*)(p.ws + OFF_BAR); xbar.x = 0; xbar.st = (volatile LAS unsigned*)(lds + 131072);
  for (int ph = p.ph_lo; ph < p.ph_hi; ++ph) {
    for (int rep = 0; rep < 1 + ((PROBE_MASK >> (ph == 0 ? 6 : (ph - 1) % 6)) & 1); ++rep) {
    if (ph == 0) { if (EN_MASK & 1) prologue(p); }
    else {
      const int l = (ph - 1) / 6, s = (ph - 1) % 6;
      if (s == 0) { if (EN_MASK & 2) phaseA(p, l, lds); }
      else if (s == 1) { if (EN_MASK & 4) attn_phase(p, l, lds); if (EN_MASK & 8) { const LP lp = make_lp(p, l); spatial_phase(lp, p.ws, lds); } }
      else if (s == 2 || s == 5) { if (EN_MASK & 16) phaseCE(p, l, s == 2, lds); }
      else if (s == 3) { if (EN_MASK & 32) phaseD(p, l, lds); }
      else { if (EN_MASK & 64) { const LP lp = make_lp(p, l); fixup_phase(lp, p.ws); } }
    }
    }
    if (ph + 1 < p.ph_hi) {
      if (ph == 0 || p.ph_lo != 0) {
        grid.sync();
        if (p.ph_lo == 0) xbar = xcd_barrier_post((unsigned*)(p.ws + OFF_BAR), (volatile LAS unsigned*)(lds + 131072));
      } else xcd_barrier(xbar);
    }
  }
}

extern "C" void kernel_launch(void* const* d_in, const int* in_sizes, int n_in, void* d_out, int out_size, void* d_ws, size_t ws_size, hipStream_t stream) {
  static int grid_blocks = 0;
  if (!grid_blocks) {
    (void)hipFuncSetAttribute((const void*)k_run, hipFuncAttributeMaxDynamicSharedMemorySize, LDS_BYTES);
    int dev = 0, cus = 0, per_cu = 0; (void)hipGetDevice(&dev); (void)hipDeviceGetAttribute(&cus, hipDeviceAttributeMultiprocessorCount, dev);
    (void)hipOccupancyMaxActiveBlocksPerMultiprocessor(&per_cu, (const void*)k_run, 512, LDS_BYTES); if (per_cu < 1) per_cu = 1;
    grid_blocks = cus * per_cu; if (grid_blocks > 256) grid_blocks = 256;
  }
  MParams mp; memset(&mp, 0, sizeof(mp));
  for (int i = 0; i < 21; ++i) mp.in[i] = (const float*)d_in[i];
  mp.out = (float*)d_out; mp.ws = (unsigned char*)d_ws; mp.ph_lo = 0; mp.ph_hi = 1 + 6 * NLAYER;
  void* args[] = {&mp};
  hipError_t e = hipLaunchCooperativeKernel((const void*)k_run, dim3(grid_blocks), dim3(512), args, LDS_BYTES, stream);
  if (e != hipSuccess) fprintf(stderr, "cooperative launch failed: %s (grid %d)\n", hipGetErrorString(e), grid_blocks);
}
```

```cpp
#include <hip/hip_runtime.h>
#include <hip/hip_cooperative_groups.h>
#include <cstdio>
#include <cmath>
#include <cstring>

typedef unsigned short bf16_t;
#define DI __device__ __forceinline__

constexpr int T_TOK = 32768, DM = 1024, SEQ = 2048, DFF = 2816, INW = 2560, NLAYER = 4;
constexpr float EPS = 1e-6f;
constexpr float QSCALE = 0.125f * 1.4426950408889634f;

constexpr size_t MiB = 1024ull * 1024ull;
constexpr size_t OFF_XB = 0;
constexpr size_t OFF_R = 64 * MiB;
constexpr size_t OFF_U = OFF_R, OFF_Q = OFF_R + 32 * MiB, OFF_KB = OFF_R + 64 * MiB, OFF_GVT = OFF_R + 96 * MiB, OFF_VT = OFF_R + 128 * MiB, OFF_MIX = OFF_R + 160 * MiB;
constexpr size_t OFF_F = OFF_R, OFF_GB = OFF_R + 176 * MiB, OFF_PB = OFF_R + 188 * MiB, OFF_UB = OFF_R + 200 * MiB;
constexpr size_t OFF_W = 288 * MiB, W_STRIDE = 24 * MiB;
constexpr size_t WO_IN = 0, WO_OUT = 5 * MiB, WO_GU = 7 * MiB, WO_DN = 18 * MiB, WO_SP = 23 * MiB + 512 * 1024;
constexpr size_t OFF_SS1 = 384 * MiB, OFF_SS2 = OFF_SS1 + 256 * 1024, OFF_SSV = OFF_SS2 + 256 * 1024;
constexpr size_t OFF_BAR = 385 * MiB + 512 * 1024;
constexpr size_t OFF_TMP1 = 386 * MiB, OFF_TMP2 = 418 * MiB;

DI int tid_opaque() { int t = threadIdx.x; asm volatile("" : "+v"(t)); return t; }
DI float bf2f(bf16_t b) { return __uint_as_float(((unsigned)b) << 16); }
DI bf16_t f2bf(float f) { unsigned u = __float_as_uint(f); u += 0x7FFFu + ((u >> 16) & 1u); return (bf16_t)(u >> 16); }
DI float gelu_exact(float x) { return 0.5f * x * (1.0f + erff(x * 0.70710678118654752f)); }
DI int permpos16(int k) { return (k & 3) + 4 * (k >> 3) + 8 * ((k >> 2) & 1); }
DI float wave_sum(float v) { for (int o = 32; o >= 1; o >>= 1) v += __shfl_xor(v, o); return v; }

namespace pg8 {
#define PG8_LAS __attribute__((address_space(3)))
typedef unsigned short bf16_t;
typedef short bf16x8 __attribute__((ext_vector_type(8)));
typedef float f32x4 __attribute__((ext_vector_type(4)));
typedef unsigned u32x4 __attribute__((ext_vector_type(4)));
constexpr int BM = 256, BK = 64, HALF = 128, HTB = HALF * BK * 2  , STAGE_BYTES = 8 * HTB, NXCD = 8, WGM = 8;

__host__ __device__ __forceinline__ int lds_byte(int r, int c) { const int st = (r >> 4) * 2 + (c >> 5), rr = r & 15, cc = c & 31, ob = rr * 64 + cc * 2; return st * 1024 + (ob ^ (((ob >> 9) & 1) << 5)); }
__host__ __device__ __forceinline__ void stage_rc(int b, int& R, int& C) { const int st = b / 1024, sb = b % 1024, swz = sb ^ (((sb >> 9) & 1) << 5); R = (st >> 1) * 16 + swz / 64; C = (st & 1) * 32 + (swz % 64) / 2; }
__host__ __device__ __forceinline__ int perm32(int rho) { const int n = rho >> 4, i = rho & 15; return 8 * (i >> 2) + 4 * n + (i & 3); }

struct Unit { int pm, pn; };
struct Gemm { const bf16_t* A; const bf16_t* Bt; int M, N, K; };

struct StaticOrder {
    int nM, nN, nwg, G, c;
    __host__ __device__ void init(int M, int N, int G_, int c_) { nM = M / BM; nN = N / BM; nwg = nM * nN; G = G_; c = c_; }
    __host__ __device__ bool next(int i, Unit& u) const {
        const long L = (long)i * G + c; if (L >= nwg) return false;
        int wgid = (int)L; { const int q = nwg / NXCD, r = nwg % NXCD, xcd = wgid % NXCD, off = wgid / NXCD; wgid = (xcd < r ? xcd * (q + 1) : r * (q + 1) + (xcd - r) * q) + off; }
        const int nig = WGM * nN, gid = wgid / nig, fm = gid * WGM, gsz = (nM - fm) < WGM ? (nM - fm) : WGM;
        u.pm = fm + ((wgid % nig) % gsz); u.pn = (wgid % nig) / gsz; return true;
    }
    __device__ __forceinline__ void a_ready(const Unit&) const {}
    __device__ __forceinline__ void done(const Unit&) const {}
};
template <class Epi, class Sched>
__device__ __forceinline__ void gemm_phase(PG8_LAS unsigned char* lds, const Gemm g, const Sched& S, const Epi& E) {
    const int tid = tid_opaque(), wid = __builtin_amdgcn_readfirstlane(tid >> 6), lane = tid & 63, wr = wid >> 2, wc = wid & 3, fr = lane & 15, fq = lane >> 4;
    const int K = g.K, nt = K / BK;
    unsigned voffA[2], voffB[2];
#pragma unroll
    for (int i = 0; i < 2; ++i) { int R, C; stage_rc(tid * 16 + i * 8192, R, C); const int Rb = Epi::PERM ? ((R & ~31) + perm32(R & 31)) : R;
        voffA[i] = (unsigned)(R * K + C) * 2u; voffB[i] = (unsigned)(Rb * K + C) * 2u; }
    const size_t kstep = (size_t)(BK * 2);
    const size_t hstep = (size_t)HALF * K * 2;
    const size_t tstep = 2 * hstep;
    const unsigned ldsw = (unsigned)wid * 1024u;
    const int aoff = lds_byte(wr * 64 + fr, fq * 8), boff = lds_byte(wc * 32 + fr, fq * 8);
#define PG8_SA(b, h) (((b) * 2 + (h)) * HTB)
#define PG8_SB(b, h) ((4 + (b) * 2 + (h)) * HTB)
#define PG8_STAGE(bufoff, gbase, voff) do { _Pragma("unroll") for (int _i = 0; _i < 2; ++_i) \
        __builtin_amdgcn_global_load_lds((const unsigned*)((const char*)(gbase) + (voff)[_i]), (PG8_LAS unsigned*)(lds + (bufoff) + ldsw + _i * 8192), 16, 0, 0); } while (0)
#define PG8_LDA(dst, b, h) do { _Pragma("unroll") for (int m = 0; m < 4; ++m) _Pragma("unroll") for (int k = 0; k < 2; ++k) dst[m][k] = *(const PG8_LAS bf16x8*)(lds + PG8_SA(b, h) + aoff + m * 2048 + k * 1024); } while (0)
#define PG8_LDB(dst, b, h) do { _Pragma("unroll") for (int n = 0; n < 2; ++n) _Pragma("unroll") for (int k = 0; k < 2; ++k) dst[n][k] = *(const PG8_LAS bf16x8*)(lds + PG8_SB(b, h) + boff + n * 2048 + k * 1024); } while (0)
#define PG8_MMA(ai, bj, At, Bt) do { __builtin_amdgcn_s_setprio(1); _Pragma("unroll") for (int m = 0; m < 4; ++m) _Pragma("unroll") for (int n = 0; n < 2; ++n) _Pragma("unroll") for (int k = 0; k < 2; ++k) \
        acc[ai][bj][m][n] = __builtin_amdgcn_mfma_f32_16x16x32_bf16(Bt[n][k], At[m][k], acc[ai][bj][m][n], 0, 0, 0); __builtin_amdgcn_s_setprio(0); } while (0)
#define PG8_WAIT_V(n) asm volatile("s_waitcnt vmcnt(" #n ")" ::: "memory")
#define PG8_WAIT_L(n) asm volatile("s_waitcnt lgkmcnt(" #n ")" ::: "memory")
#define PG8_BAR __builtin_amdgcn_s_barrier()
#define PG8_SCHED __builtin_amdgcn_sched_barrier(0)
    Unit cur, nxt; int ui = 0;
    if (!S.next(0, cur)) return;
    f32x4 acc[2][2][4][2];
#pragma unroll
    for (int a = 0; a < 2; ++a)
#pragma unroll
        for (int b = 0; b < 2; ++b)
#pragma unroll
            for (int m = 0; m < 4; ++m)
#pragma unroll
                for (int n = 0; n < 2; ++n) acc[a][b][m][n] = (f32x4){0.f, 0.f, 0.f, 0.f};
    bf16x8 At[4][2], B0[2][2], B1[2][2];
    const char* cA = (const char*)g.A + (size_t)cur.pm * tstep; const char* cB = (const char*)g.Bt + (size_t)cur.pn * tstep;
    S.a_ready(cur);
    PG8_STAGE(PG8_SB(0, 0), cB, voffB); PG8_STAGE(PG8_SA(0, 0), cA, voffA); PG8_STAGE(PG8_SB(0, 1), cB + hstep, voffB); PG8_STAGE(PG8_SA(0, 1), cA + hstep, voffA);
    if (wr == 1) PG8_BAR;
    PG8_WAIT_V(4); PG8_BAR;
    PG8_STAGE(PG8_SB(1, 0), cB + kstep, voffB); PG8_STAGE(PG8_SA(1, 0), cA + kstep, voffA); PG8_STAGE(PG8_SB(1, 1), cB + hstep + kstep, voffB);
    PG8_WAIT_V(6); PG8_BAR;
    for (;;) {
        const bool has_next = S.next(ui + 1, nxt);
        const char* nA = has_next ? (const char*)g.A + (size_t)nxt.pm * tstep : cA; const char* nB = has_next ? (const char*)g.Bt + (size_t)nxt.pn * tstep : cB;
        for (int t = 0; t < nt; t += 2) {
            const bool last = (t == nt - 2);
            const char* a1 = cA + (size_t)(t + 1) * kstep;
            const char* a2 = last ? nA : cA + (size_t)(t + 2) * kstep; const char* b2 = last ? nB : cB + (size_t)(t + 2) * kstep;
            const char* a3 = a2 + kstep; const char* b3 = b2 + kstep;
            if (last && has_next) S.a_ready(nxt);
            PG8_LDB(B0, 0, 0); PG8_SCHED; PG8_LDA(At, 0, 0); PG8_STAGE(PG8_SA(1, 1), a1 + hstep, voffA);
            PG8_WAIT_L(8); PG8_BAR; PG8_WAIT_L(0); PG8_MMA(0, 0, At, B0); PG8_BAR; PG8_SCHED;
            PG8_LDB(B1, 0, 1); PG8_STAGE(PG8_SB(0, 0), b2, voffB);
            PG8_BAR; PG8_WAIT_L(0); PG8_MMA(0, 1, At, B1); PG8_BAR;
            PG8_LDA(At, 0, 1); PG8_STAGE(PG8_SA(0, 0), a2, voffA);
            PG8_BAR; PG8_WAIT_L(0); PG8_MMA(1, 0, At, B0); PG8_BAR; PG8_SCHED;
            PG8_STAGE(PG8_SB(0, 1), b2 + hstep, voffB);
            PG8_WAIT_V(6); PG8_BAR; PG8_MMA(1, 1, At, B1); PG8_BAR;
            PG8_LDB(B0, 1, 0); PG8_SCHED; PG8_LDA(At, 1, 0); PG8_STAGE(PG8_SA(0, 1), a2 + hstep, voffA);
            PG8_WAIT_L(8); PG8_BAR; PG8_WAIT_L(0); PG8_MMA(0, 0, At, B0); PG8_BAR; PG8_SCHED;
            PG8_LDB(B1, 1, 1); PG8_STAGE(PG8_SB(1, 0), b3, voffB);
            PG8_BAR; PG8_WAIT_L(0); PG8_MMA(0, 1, At, B1); PG8_BAR;
            PG8_LDA(At, 1, 1); PG8_STAGE(PG8_SA(1, 0), a3, voffA);
            PG8_BAR; PG8_WAIT_L(0); PG8_MMA(1, 0, At, B0); PG8_BAR; PG8_SCHED;
            PG8_STAGE(PG8_SB(1, 1), b3 + hstep, voffB);
            PG8_WAIT_V(6); PG8_BAR; PG8_MMA(1, 1, At, B1); PG8_BAR;
        }
        if constexpr (!Epi::AFTER_DRAIN) { if (!Epi::TWICE || (ui & 1)) E(acc, cur, wr, wc, fr, fq); S.done(cur); }
        if (!has_next) break;
#pragma unroll
        for (int a = 0; a < 2; ++a)
#pragma unroll
            for (int b = 0; b < 2; ++b)
#pragma unroll
                for (int m = 0; m < 4; ++m)
#pragma unroll
                    for (int n = 0; n < 2; ++n) acc[a][b][m][n] = (f32x4){0.f, 0.f, 0.f, 0.f};
        cur = nxt; cA = nA; cB = nB; ++ui;
    }
    PG8_WAIT_V(0);
    if (wr == 0) PG8_BAR;
    PG8_BAR;
    if constexpr (Epi::AFTER_DRAIN) { E.fused(acc, cur, wr, wc, fr, fq, lds, wid, lane); S.done(cur); }
#undef PG8_SA
#undef PG8_SB
#undef PG8_STAGE
#undef PG8_LDA
#undef PG8_LDB
#undef PG8_MMA
#undef PG8_WAIT_V
#undef PG8_WAIT_L
#undef PG8_BAR
#undef PG8_SCHED
}
}

namespace cg = cooperative_groups;
using pg8::f32x4; using pg8::bf16x8; using pg8::Unit;
typedef unsigned u32x2_t __attribute__((ext_vector_type(2)));
typedef unsigned u32x4_t __attribute__((ext_vector_type(4)));
typedef float f32x16 __attribute__((ext_vector_type(16)));
typedef float f32x2_t __attribute__((ext_vector_type(2)));
#define LAS PG8_LAS
constexpr int LDS_BYTES = 131072 + 16;
#ifndef EN_MASK
#define EN_MASK 0x7f
#endif
#ifndef PROBE_EPI_ACE
#define PROBE_EPI_ACE 0
#endif
#ifndef PROBE_EPI_D
#define PROBE_EPI_D 0
#endif
#ifndef PROBE_SYNC
#define PROBE_SYNC 0
#endif
#ifndef PROBE_MASK
#define PROBE_MASK 0x00
#endif

DI unsigned pk2(float lo, float hi) { unsigned r; asm volatile("s_nop 0\n\tv_cvt_pk_bf16_f32 %0, %1, %2\n\ts_nop 1" : "=v"(r) : "v"(lo), "v"(hi)); return r; }
DI float bflo(unsigned w) { return __uint_as_float(w << 16); }
DI float bfhi(unsigned w) { return __uint_as_float(w & 0xffff0000u); }
DI float gelu1(float v) {
  const float av = fabsf(v), t = __builtin_amdgcn_rcpf(av * 0.2316418882f + 1.0f);
  float q = t * 0.5307027145f + (-0.7265760135f); q = q * t + 0.7107068705f; q = q * t + (-0.142248368f); q = q * t + 0.127414796f; q = q * t;
  const float e = __builtin_amdgcn_exp2f((v * v) * (-0.72134752044f));
  const float m = v * (q * e);
  return v < 0.f ? m : v - m;
}
DI float dpp_ror1(float v) { return __builtin_bit_cast(float, __builtin_amdgcn_update_dpp(0, __builtin_bit_cast(int, v), 0x121, 0xf, 0xf, false)); }
DI float dpp_ror2(float v) { return __builtin_bit_cast(float, __builtin_amdgcn_update_dpp(0, __builtin_bit_cast(int, v), 0x122, 0xf, 0xf, false)); }
typedef unsigned long long u64;
DI float fx2f(u64 v) { return (float)v * (1.0f / 1048576.0f); }
DI u64 f2fx(float v) { return (u64)(v * 1048576.0f + 0.5f); }
DI void fx_add(u64* p, float v) { __hip_atomic_fetch_add(p, f2fx(v), __ATOMIC_RELAXED, __HIP_MEMORY_SCOPE_AGENT); }
DI float rs1024(u64 ss) { return rsqrtf(fx2f(ss) * (1.0f / 1024.0f) + EPS); }

struct MParams { const float* in[21]; float* out; unsigned char* ws; int ph_lo, ph_hi; };
struct LP {
  const float *norm_attn_w, *w_in, *v_norm_w, *sp_w, *sp_b, *out_norm_w, *q_norm_w, *k_norm_w, *lq1, *lk1, *lq2, *lk2, *diff_norm_w, *w_out, *norm_ffn_w, *w_gate, *w_up, *conv_w, *conv_b, *w_down;
  float lambda_init;
  const bf16_t *WinT, *WoutT, *WguT, *WdT, *Wsp;
};
DI LP make_lp(const MParams& p, int l) {
  LP L;
  L.norm_attn_w = p.in[1] + (size_t)l * DM; L.w_in = p.in[2] + (size_t)l * DM * INW; L.v_norm_w = p.in[3] + (size_t)l * 512; L.sp_w = p.in[4] + (size_t)l * 65536; L.sp_b = p.in[5] + (size_t)l * 512;
  L.out_norm_w = p.in[6] + (size_t)l * 512; L.q_norm_w = p.in[7] + (size_t)l * 64; L.k_norm_w = p.in[8] + (size_t)l * 64; L.lq1 = p.in[9] + (size_t)l * 64; L.lk1 = p.in[10] + (size_t)l * 64;
  L.lq2 = p.in[11] + (size_t)l * 64; L.lk2 = p.in[12] + (size_t)l * 64; L.diff_norm_w = p.in[13] + (size_t)l * 128; L.w_out = p.in[14] + (size_t)l * DM * DM; L.norm_ffn_w = p.in[15] + (size_t)l * DM;
  L.w_gate = p.in[16] + (size_t)l * DM * DFF; L.w_up = p.in[17] + (size_t)l * DM * DFF; L.conv_w = p.in[18] + (size_t)l * 3 * DFF; L.conv_b = p.in[19] + (size_t)l * DFF; L.w_down = p.in[20] + (size_t)l * DFF * DM;
  L.lambda_init = 0.8f - 0.6f * expf(-0.3f * (float)(l + 1));
  const unsigned char* wb = p.ws + OFF_W + (size_t)l * W_STRIDE;
  L.WinT = (const bf16_t*)(wb + WO_IN); L.WoutT = (const bf16_t*)(wb + WO_OUT); L.WguT = (const bf16_t*)(wb + WO_GU); L.WdT = (const bf16_t*)(wb + WO_DN); L.Wsp = (const bf16_t*)(wb + WO_SP);
  return L;
}
DI float lam_of(const LP& lp) {
  const int lane = threadIdx.x & 63;
  float a = lp.lq1[lane] * lp.lk1[lane], b = lp.lq2[lane] * lp.lk2[lane];
  a = wave_sum(a); b = wave_sum(b);
  return expf(a) - expf(b) + lp.lambda_init;
}

DI void conv_item(bf16_t* dst, int K, int row, int kg, const float* src, int ld, int col, const float* ks) {
  float v[32];
#pragma unroll
  for (int i = 0; i < 32; ++i) v[i] = src[(size_t)(kg * 32 + i) * ld + col];
  if (ks) {
#pragma unroll
    for (int i = 0; i < 32; i += 4) { const f32x4 s = *(const f32x4*)(ks + kg * 32 + i); v[i] *= s[0]; v[i + 1] *= s[1]; v[i + 2] *= s[2]; v[i + 3] *= s[3]; }
  }
  u32x4_t* d = (u32x4_t*)(dst + (size_t)row * K + kg * 32);
#pragma unroll
  for (int i = 0; i < 4; ++i) { u32x4_t w; w.x = pk2(v[8 * i], v[8 * i + 1]); w.y = pk2(v[8 * i + 2], v[8 * i + 3]); w.z = pk2(v[8 * i + 4], v[8 * i + 5]); w.w = pk2(v[8 * i + 6], v[8 * i + 7]); d[i] = w; }
}
DI int perm_logical(int p) {
  const int bj = p >> 7, wc = (p >> 5) & 3, n = (p >> 4) & 1, fq = (p >> 2) & 3, e = p & 3;
  return 64 * wc + 32 * bj + 8 * fq + 4 * n + e;
}
DI void prologue(const MParams& p) {
  const int tidp = tid_opaque(); const int gtid = blockIdx.x * 512 + tidp, gsz = gridDim.x * 512;
  unsigned char* ws = p.ws;
  { const int gw = gtid >> 6, nw = gsz >> 6, lane = threadIdx.x & 63; bf16_t* XB = (bf16_t*)(ws + OFF_XB); u64* SS1 = (u64*)(ws + OFF_SS1);
    for (int row = gw; row < T_TOK; row += nw) { const float* xp = p.in[0] + (size_t)row * DM; float s = 0.f;
#pragma unroll
      for (int i = 0; i < 4; ++i) { const f32x4 v = *(const f32x4*)(xp + i * 256 + lane * 4); s += v[0] * v[0] + v[1] * v[1] + v[2] * v[2] + v[3] * v[3];
        u32x2_t w; w.x = pk2(v[0], v[1]); w.y = pk2(v[2], v[3]); *(u32x2_t*)(XB + (size_t)row * DM + i * 256 + lane * 4) = w; }
      s = wave_sum(s); if (lane == 0) SS1[row] = f2fx(s); } }
  { u64* SSV = (u64*)(ws + OFF_SSV); for (int i = gtid; i < T_TOK * 4; i += gsz) SSV[i] = 0ull; }
  for (int l = 0; l < NLAYER; ++l) {
    const LP lp = make_lp(p, l);
    for (int w = gtid; w < 2560 * 32; w += gsz) { const int row = w % 2560, kg = w / 2560; int col;
      if (row < 1536) { const int L = (row & ~255) + perm_logical(row & 255); col = L < 512 ? L : L + 512; }
      else { const int r = row - 1536; col = r < 512 ? 512 + r : 1536 + r; }
      conv_item((bf16_t*)lp.WinT, 1024, row, kg, lp.w_in, INW, col, lp.norm_attn_w); }
    for (int w = gtid; w < 1024 * 32; w += gsz) { const int row = w % 1024, kg = w / 1024; conv_item((bf16_t*)lp.WoutT, 1024, row, kg, lp.w_out, DM, row, nullptr); }
    for (int w = gtid; w < 5632 * 32; w += gsz) { const int row = w % 5632, kg = w / 5632; const int pn = row >> 8, pp = row & 255, bj = pp >> 7;
      const int q = pp & 127, wc = (q >> 5) & 3, n = (q >> 4) & 1, fq = (q >> 2) & 3, e = q & 3; const int cc = 128 * pn + 32 * wc + 8 * fq + 4 * n + e;
      conv_item((bf16_t*)lp.WguT, 1024, row, kg, bj ? lp.w_up : lp.w_gate, DFF, cc, lp.norm_ffn_w); }
    for (int w = gtid; w < 1024 * 88; w += gsz) { const int row = w % 1024, kg = w / 1024; conv_item((bf16_t*)lp.WdT, DFF, row, kg, lp.w_down, DM, row, nullptr); }
    for (int i = gtid; i < 65536; i += gsz) { const int jj = i & 127, ii = (i >> 7) & 127; ((bf16_t*)lp.Wsp)[i] = ((jj >> 6) <= (ii >> 6)) ? f2bf(lp.sp_w[i]) : (bf16_t)0; }
  }
}

struct DupOrder : pg8::StaticOrder {
  __device__ bool next(int i, Unit& u) const { return pg8::StaticOrder::next(i >> 1, u); }
};
struct EpiResid {
  static constexpr bool PERM = false, AFTER_DRAIN = false, TWICE = (PROBE_EPI_ACE != 0);
  const float* base32; float* out32; bf16_t* XB; u64* SS;
  DI void operator()(const f32x4 (&acc)[2][2][4][2], const Unit& u, int wr, int wc, int fr, int fq) const {
    const int row0 = u.pm * 256 + wr * 64 + fr, col0 = u.pn * 256 + wc * 32 + 4 * fq;
    if (base32) {
      f32x4 nb[2][2];
#pragma unroll
      for (int bj = 0; bj < 2; ++bj)
#pragma unroll
        for (int n = 0; n < 2; ++n) nb[bj][n] = *(const f32x4*)(base32 + (size_t)row0 * DM + col0 + bj * 128 + n * 16);
#pragma unroll
      for (int g = 0; g < 8; ++g) { const int ai = g >> 2, m = g & 3; const int row = row0 + ai * 128 + m * 16; const size_t ro = (size_t)row * DM + col0; float ss = 0.f;
        f32x4 cbv[2][2];
#pragma unroll
        for (int bj = 0; bj < 2; ++bj)
#pragma unroll
          for (int n = 0; n < 2; ++n) cbv[bj][n] = nb[bj][n];
        if (g < 7) { const int r2 = row0 + ((g + 1) >> 2) * 128 + ((g + 1) & 3) * 16;
#pragma unroll
          for (int bj = 0; bj < 2; ++bj)
#pragma unroll
            for (int n = 0; n < 2; ++n) nb[bj][n] = *(const f32x4*)(base32 + (size_t)r2 * DM + col0 + bj * 128 + n * 16); }
#pragma unroll
        for (int bj = 0; bj < 2; ++bj)
#pragma unroll
          for (int n = 0; n < 2; ++n) { const size_t o = ro + bj * 128 + n * 16; const f32x4 v = acc[ai][bj][m][n] + cbv[bj][n];
            u32x2_t w; w.x = pk2(v[0], v[1]); w.y = pk2(v[2], v[3]); *(u32x2_t*)(XB + o) = w; ss += (v[0] * v[0] + v[1] * v[1]) + (v[2] * v[2] + v[3] * v[3]); }
        ss += __shfl_xor(ss, 16); ss += __shfl_xor(ss, 32); if (fq == 0) fx_add(SS + row, ss);
        asm volatile("" ::: "memory"); }
    } else {
      u32x2_t nb[2][2];
#pragma unroll
      for (int bj = 0; bj < 2; ++bj)
#pragma unroll
        for (int n = 0; n < 2; ++n) nb[bj][n] = *(const u32x2_t*)(XB + (size_t)row0 * DM + col0 + bj * 128 + n * 16);
#pragma unroll
      for (int g = 0; g < 8; ++g) { const int ai = g >> 2, m = g & 3; const int row = row0 + ai * 128 + m * 16; const size_t ro = (size_t)row * DM + col0; float ss = 0.f;
        u32x2_t cbv[2][2];
#pragma unroll
        for (int bj = 0; bj < 2; ++bj)
#pragma unroll
          for (int n = 0; n < 2; ++n) cbv[bj][n] = nb[bj][n];
        if (g < 7) { const int r2 = row0 + ((g + 1) >> 2) * 128 + ((g + 1) & 3) * 16;
#pragma unroll
          for (int bj = 0; bj < 2; ++bj)
#pragma unroll
            for (int n = 0; n < 2; ++n) nb[bj][n] = *(const u32x2_t*)(XB + (size_t)r2 * DM + col0 + bj * 128 + n * 16); }
#pragma unroll
        for (int bj = 0; bj < 2; ++bj)
#pragma unroll
          for (int n = 0; n < 2; ++n) { const size_t o = ro + bj * 128 + n * 16; const u32x2_t c = cbv[bj][n];
            const f32x4 v = acc[ai][bj][m][n] + (f32x4){bflo(c.x), bfhi(c.x), bflo(c.y), bfhi(c.y)};
            if (out32) *(f32x4*)(out32 + o) = v;
            else { u32x2_t w; w.x = pk2(v[0], v[1]); w.y = pk2(v[2], v[3]); *(u32x2_t*)(XB + o) = w; ss += (v[0] * v[0] + v[1] * v[1]) + (v[2] * v[2] + v[3] * v[3]); } }
        if (!out32) { ss += __shfl_xor(ss, 16); ss += __shfl_xor(ss, 32); if (fq == 0) fx_add(SS + row, ss); }
        asm volatile("" ::: "memory"); }
    }
  }
};
struct EpiA1 {
  static constexpr bool PERM = false, AFTER_DRAIN = false, TWICE = (PROBE_EPI_ACE != 0);
  const u64* SS1; bf16_t *U, *Q, *KB; const float *qw, *kw;
  DI void operator()(const f32x4 (&acc)[2][2][4][2], const Unit& u, int wr, int wc, int fr, int fq) const {
    const int row0 = u.pm * 256 + wr * 64 + fr, lc0 = wc * 64 + 8 * fq, region = u.pn >> 1;
    u64 rsv[8];
#pragma unroll
    for (int g = 0; g < 8; ++g) rsv[g] = SS1[row0 + (g >> 2) * 128 + (g & 3) * 16];
    if (region == 0) {
#pragma unroll
      for (int g = 0; g < 8; ++g) { const int ai = g >> 2, m = g & 3; const int row = row0 + ai * 128 + m * 16; const float rs = rs1024(rsv[g]);
#pragma unroll
        for (int bj = 0; bj < 2; ++bj) { const f32x4 a = acc[ai][bj][m][0] * rs, b = acc[ai][bj][m][1] * rs; u32x4_t w;
          w.x = pk2(gelu1(a[0]), gelu1(a[1])); w.y = pk2(gelu1(a[2]), gelu1(a[3])); w.z = pk2(gelu1(b[0]), gelu1(b[1])); w.w = pk2(gelu1(b[2]), gelu1(b[3]));
          *(u32x4_t*)(U + (size_t)row * 512 + u.pn * 256 + lc0 + 32 * bj) = w; } }
    } else {
      const bool isq = region == 1; const float* wp = (isq ? qw : kw) + 8 * fq; bf16_t* dst = (isq ? Q : KB) + (u.pn & 1) * 256 + lc0; const float sc = isq ? QSCALE : 1.0f;
      f32x4 wv[2][2];
#pragma unroll
      for (int bj = 0; bj < 2; ++bj)
#pragma unroll
        for (int n = 0; n < 2; ++n) wv[bj][n] = *(const f32x4*)(wp + 32 * bj + 4 * n);
#pragma unroll
      for (int g = 0; g < 8; ++g) { const int ai = g >> 2, m = g & 3; const int row = row0 + ai * 128 + m * 16; const float rs = rs1024(rsv[g]); float ss = 0.f; f32x4 v[2][2];
#pragma unroll
        for (int bj = 0; bj < 2; ++bj)
#pragma unroll
          for (int n = 0; n < 2; ++n) { v[bj][n] = acc[ai][bj][m][n] * rs; const f32x4 t = v[bj][n]; ss += (t[0] * t[0] + t[1] * t[1]) + (t[2] * t[2] + t[3] * t[3]); }
        ss += __shfl_xor(ss, 16); ss += __shfl_xor(ss, 32);
        const float r2 = rsqrtf(ss * (1.0f / 64.0f) + EPS) * sc;
#pragma unroll
        for (int bj = 0; bj < 2; ++bj) { const f32x4 a = v[bj][0] * r2 * wv[bj][0], b = v[bj][1] * r2 * wv[bj][1]; u32x4_t w;
          w.x = pk2(a[0], a[1]); w.y = pk2(a[2], a[3]); w.z = pk2(b[0], b[1]); w.w = pk2(b[2], b[3]);
          *(u32x4_t*)(dst + (size_t)row * 512 + 32 * bj) = w; } }
    }
  }
};
struct EpiA2 {
  static constexpr bool PERM = false, AFTER_DRAIN = false, TWICE = (PROBE_EPI_ACE != 0);
  const u64* SS1; bf16_t *GVT, *VT; u64* SSV;
  DI void operator()(const f32x4 (&acc)[2][2][4][2], const Unit& u, int wr, int wc, int fr, int fq) const {
    const int colbase = u.pn * 256 + wc * 32;
    f32x4 rs[2][2];
#pragma unroll
    for (int bj = 0; bj < 2; ++bj)
#pragma unroll
      for (int n = 0; n < 2; ++n) { const u64* sp = SS1 + colbase + bj * 128 + n * 16 + 4 * fq; rs[bj][n] = (f32x4){rs1024(sp[0]), rs1024(sp[1]), rs1024(sp[2]), rs1024(sp[3])}; }
    if (u.pm < 2) {
#pragma unroll
      for (int ai = 0; ai < 2; ++ai) { const int head = 2 * u.pm + ai;
#pragma unroll
        for (int bj = 0; bj < 2; ++bj)
#pragma unroll
          for (int n = 0; n < 2; ++n) { f32x4 sq = (f32x4){0.f, 0.f, 0.f, 0.f}; const int tok = colbase + bj * 128 + n * 16 + 4 * fq;
#pragma unroll
            for (int m = 0; m < 4; ++m) { const int row = u.pm * 256 + ai * 128 + wr * 64 + m * 16 + fr;
              const f32x4 a = acc[ai][bj][m][n] * rs[bj][n]; f32x4 g; g[0] = gelu1(a[0]); g[1] = gelu1(a[1]); g[2] = gelu1(a[2]); g[3] = gelu1(a[3]);
              u32x2_t w; w.x = pk2(g[0], g[1]); w.y = pk2(g[2], g[3]); *(u32x2_t*)(GVT + (size_t)row * T_TOK + tok) = w; sq += g * g; }
#pragma unroll
            for (int e = 0; e < 4; ++e) { float s = sq[e]; s += __shfl_xor(s, 1); s += __shfl_xor(s, 2); s += __shfl_xor(s, 4); s += __shfl_xor(s, 8); sq[e] = s; }
            if (fr == 0) {
#pragma unroll
              for (int e = 0; e < 4; ++e) fx_add(SSV + (size_t)(tok + e) * 4 + head, sq[e]); }
            asm volatile("" ::: "memory"); } }
    } else {
#pragma unroll
      for (int ai = 0; ai < 2; ++ai)
#pragma unroll
        for (int m = 0; m < 4; ++m) { const int row = (u.pm - 2) * 256 + ai * 128 + wr * 64 + m * 16 + fr;
#pragma unroll
          for (int bj = 0; bj < 2; ++bj)
#pragma unroll
            for (int n = 0; n < 2; ++n) { const f32x4 a = acc[ai][bj][m][n] * rs[bj][n]; u32x2_t w; w.x = pk2(a[0], a[1]); w.y = pk2(a[2], a[3]);
              *(u32x2_t*)(VT + (size_t)row * T_TOK + colbase + bj * 128 + n * 16 + 8 * (fq & 1) + 4 * (fq >> 1)) = w; } }
    }
  }
};
struct EpiD {
  static constexpr bool PERM = false, AFTER_DRAIN = false, TWICE = (PROBE_EPI_D != 0);
  const u64* SS2; const float *cw, *cb; bf16_t* F; float *GB, *PB, *UB;
  DI void operator()(const f32x4 (&acc)[2][2][4][2], const Unit& u, int wr, int wc, int fr, int fq) const {
    const int cbase = u.pn * 128 + wc * 32 + 8 * fq;
    const int rb0 = u.pm * 256 + wr * 64;
    u64 rsv[8]; f32x4 w0[2], w1[2], w2[2], bb[2];
#pragma unroll
    for (int g = 0; g < 8; ++g) rsv[g] = SS2[rb0 + (g >> 2) * 128 + (g & 3) * 16 + fr];
#pragma unroll
    for (int n = 0; n < 2; ++n) { w0[n] = *(const f32x4*)(cw + cbase + 4 * n); w1[n] = *(const f32x4*)(cw + DFF + cbase + 4 * n); w2[n] = *(const f32x4*)(cw + 2 * DFF + cbase + 4 * n); bb[n] = *(const f32x4*)(cb + cbase + 4 * n); }
#pragma unroll
    for (int ai = 0; ai < 2; ++ai) {
      const int rb = rb0 + ai * 128, bd = rb >> 6;
      float rs[4];
#pragma unroll
      for (int m = 0; m < 4; ++m) rs[m] = rs1024(rsv[ai * 4 + m]);
      unsigned fo[4][4];
#pragma unroll
      for (int n = 0; n < 2; ++n) {
        const int cn = cbase + 4 * n;
        f32x4 pg, ug, gg; float fv[4][4];
#pragma unroll
        for (int e = 0; e < 4; ++e) {
          float G[4], r1[4], r2[4];
#pragma unroll
          for (int m = 0; m < 4; ++m) { G[m] = acc[ai][0][m][n][e] * rs[m]; r1[m] = dpp_ror1(G[m]); r2[m] = dpp_ror2(G[m]); }
#pragma unroll
          for (int m = 0; m < 4; ++m) {
            const float p1 = (fr >= 1) ? r1[m] : (m > 0 ? r1[m > 0 ? m - 1 : 0] : 0.f);
            const float p2 = (fr >= 2) ? r2[m] : (m > 0 ? r2[m > 0 ? m - 1 : 0] : 0.f);
            const float g = w2[n][e] * G[m] + w1[n][e] * p1 + w0[n][e] * p2 + bb[n][e];
            const float uv = acc[ai][1][m][n][e] * rs[m];
            if (m == 0) { pg[e] = g; ug[e] = uv; }
            if (m == 3) gg[e] = G[3];
            fv[m][e] = g * __builtin_amdgcn_rcpf(1.0f + __expf(-g)) * uv;
          }
        }
#pragma unroll
        for (int m = 0; m < 4; ++m) { fo[m][2 * n] = pk2(fv[m][0], fv[m][1]); fo[m][2 * n + 1] = pk2(fv[m][2], fv[m][3]); }
        if (fr < 2) { *(f32x4*)(PB + (size_t)(bd * 2 + fr) * DFF + cn) = pg; *(f32x4*)(UB + (size_t)(bd * 2 + fr) * DFF + cn) = ug; }
        if (fr >= 14) { *(f32x4*)(GB + (size_t)(bd * 2 + fr - 14) * DFF + cn) = gg; }
      }
#pragma unroll
      for (int m = 0; m < 4; ++m) {
        if (!(m == 0 && fr < 2)) { u32x4_t w; w.x = fo[m][0]; w.y = fo[m][1]; w.z = fo[m][2]; w.w = fo[m][3]; *(u32x4_t*)(F + (size_t)(rb + 16 * m + fr) * DFF + cbase) = w; }
      }
    }
  }
};
DI void fixup_phase(const LP& lp, unsigned char* ws) {
  const float *GB = (const float*)(ws + OFF_GB), *PB = (const float*)(ws + OFF_PB), *UB = (const float*)(ws + OFF_UB); bf16_t* F = (bf16_t*)(ws + OFF_F);
  const int gtid = blockIdx.x * 512 + tid_opaque(), gsz = gridDim.x * 512;
  for (int w = gtid; w < 512 * 2 * 704; w += gsz) {
    const int c = (w % 704) * 4, j = (w / 704) & 1, bd = w / 1408;
    f32x4 g = *(const f32x4*)(PB + (size_t)(bd * 2 + j) * DFF + c);
    if (bd & 31) { const f32x4 gm1 = *(const f32x4*)(GB + (size_t)((bd - 1) * 2 + 1) * DFF + c); const f32x4 w0 = *(const f32x4*)(lp.conv_w + c);
      if (j == 0) { const f32x4 gm2 = *(const f32x4*)(GB + (size_t)((bd - 1) * 2) * DFF + c); const f32x4 w1 = *(const f32x4*)(lp.conv_w + DFF + c); g += w1 * gm1 + w0 * gm2; }
      else g += w0 * gm1; }
    const f32x4 uv = *(const f32x4*)(UB + (size_t)(bd * 2 + j) * DFF + c); float f[4];
#pragma unroll
    for (int e = 0; e < 4; ++e) f[e] = g[e] * __builtin_amdgcn_rcpf(1.0f + __expf(-g[e])) * uv[e];
    u32x2_t o; o.x = pk2(f[0], f[1]); o.y = pk2(f[2], f[3]);
    *(u32x2_t*)(F + (size_t)(bd * 64 + j) * DFF + c) = o;
  }
}

DI void spatial_phase(const LP& lp, unsigned char* ws, LAS unsigned char* lds) {
  const bf16_t *U = (const bf16_t*)(ws + OFF_U), *GVT = (const bf16_t*)(ws + OFF_GVT); const u64* SSV = (const u64*)(ws + OFF_SSV); bf16_t* MIX = (bf16_t*)(ws + OFF_MIX);
  LAS float* sr = (LAS float*)lds;
  const int tid = tid_opaque(), lane = tid & 63, w = __builtin_amdgcn_readfirstlane(tid >> 6), l15 = lane & 15, kq = lane >> 4;
  for (int it = blockIdx.x; it < 1024; it += gridDim.x) {
    const int h = it & 3, tok0 = (it >> 2) * 128;
    if (tid < 128) sr[tid] = rsqrtf(fx2f(SSV[(size_t)(tok0 + tid) * 4 + h]) * (1.0f / 128.0f) + EPS);
    __syncthreads();
    const int i0 = 16 * w, nks = (w < 4) ? 2 : 4, irow = tok0 + i0 + l15;
    bf16x8 yf[4];
#pragma unroll
    for (int ks = 0; ks < 4; ++ks) {
      u32x4_t o = (u32x4_t){0u, 0u, 0u, 0u};
      if (ks < nks) { const u32x4_t raw = *(const u32x4_t*)(lp.Wsp + (size_t)(h * 128 + i0 + l15) * 128 + ks * 32 + kq * 8);
        const LAS float* s = sr + ks * 32 + kq * 8;
        o.x = pk2(bflo(raw.x) * s[0], bfhi(raw.x) * s[1]); o.y = pk2(bflo(raw.y) * s[2], bfhi(raw.y) * s[3]); o.z = pk2(bflo(raw.z) * s[4], bfhi(raw.z) * s[5]); o.w = pk2(bflo(raw.w) * s[6], bfhi(raw.w) * s[7]); }
      yf[ks] = __builtin_bit_cast(bf16x8, o);
    }
    const float bias = lp.sp_b[h * 128 + i0 + l15];
    float o[8][4]; float ss = 0.f;
#pragma unroll
    for (int dt = 0; dt < 8; ++dt) {
      f32x4 acc = (f32x4){0.f, 0.f, 0.f, 0.f};
#pragma unroll
      for (int ks = 0; ks < 4; ++ks) if (ks < nks) {
        const bf16x8 xf = *(const bf16x8*)(GVT + (size_t)(h * 128 + 16 * dt + l15) * T_TOK + tok0 + ks * 32 + kq * 8);
        acc = __builtin_amdgcn_mfma_f32_16x16x32_bf16(xf, yf[ks], acc, 0, 0, 0); }
      const int d0 = 16 * dt + 4 * kq; const f32x4 wv = *(const f32x4*)(lp.v_norm_w + h * 128 + d0);
      const u32x2_t ur = *(const u32x2_t*)(U + (size_t)irow * 512 + h * 128 + d0);
      o[dt][0] = bflo(ur.x) * (acc[0] * wv[0] + bias); o[dt][1] = bfhi(ur.x) * (acc[1] * wv[1] + bias); o[dt][2] = bflo(ur.y) * (acc[2] * wv[2] + bias); o[dt][3] = bfhi(ur.y) * (acc[3] * wv[3] + bias);
      ss += (o[dt][0] * o[dt][0] + o[dt][1] * o[dt][1]) + (o[dt][2] * o[dt][2] + o[dt][3] * o[dt][3]);
    }
    ss += __shfl_xor(ss, 16); ss += __shfl_xor(ss, 32);
    const float rs = rsqrtf(ss * (1.0f / 128.0f) + EPS);
#pragma unroll
    for (int dt = 0; dt < 8; ++dt) { const int d0 = 16 * dt + 4 * kq; const f32x4 wo = *(const f32x4*)(lp.out_norm_w + h * 128 + d0);
      u32x2_t q; q.x = pk2(o[dt][0] * rs * wo[0], o[dt][1] * rs * wo[1]); q.y = pk2(o[dt][2] * rs * wo[2], o[dt][3] * rs * wo[3]);
      *(u32x2_t*)(MIX + (size_t)irow * 1024 + h * 128 + d0) = q; }
    __syncthreads();
  }
}

DI void attn_phase(const MParams& p, int l, LAS unsigned char* lds) {
  unsigned char* ws = p.ws;
  const bf16_t *Q = (const bf16_t*)(ws + OFF_Q), *KB = (const bf16_t*)(ws + OFF_KB), *VT = (const bf16_t*)(ws + OFF_VT); bf16_t* MIX = (bf16_t*)(ws + OFF_MIX);
  constexpr int KBUF = 16384, VBUF = 16384, STG = KBUF + VBUF, QOFF = 2 * STG;
  static_assert(QOFF + 65536 <= LDS_BYTES, "attention LDS");
  const float lambda_init = 0.8f - 0.6f * expf(-0.3f * (float)(l + 1));
  const float* dnw = p.in[13] + l * 128;
#pragma unroll 1
  for (int pi = blockIdx.x; pi < 256; pi += gridDim.x) {
    const int b = pi >> 4, h = (pi >> 2) & 3, j = pi & 3;
#pragma unroll 1
    for (int it = 0; it < 2; ++it) {
      const int tid = tid_opaque(), lane = tid & 63, w = __builtin_amdgcn_readfirstlane(tid >> 6), l31 = lane & 31, hh = lane >> 5;
      const int qb = it ? j : 7 - j, t0 = b * 2048 + 256 * qb, ntl = 4 * qb + 4, ntw = 4 * qb + (w >> 1) + 1;
#pragma unroll
      for (int i = 0; i < 8; ++i) { const int P = (w * 8 + i) * 64 + lane, row = P >> 4, pos = P & 15, pc = pos ^ (row & 15);
        __builtin_amdgcn_global_load_lds((const unsigned*)(Q + (size_t)(t0 + row) * 512 + h * 128 + pc * 8), (LAS unsigned*)(lds + QOFF + (w * 8 + i) * 1024), 16, 0, 0); }
      const bf16_t* kbase = KB + (size_t)(b * 2048) * 512 + h * 128; const bf16_t* vbase = VT + (size_t)(h * 128) * T_TOK + b * 2048;
      int koff[2], voff[2];
#pragma unroll
      for (int i = 0; i < 2; ++i) { const int P = (w * 2 + i) * 64 + lane; { const int row = P >> 4, pos = P & 15, pc = pos ^ (row & 15); koff[i] = row * 512 + pc * 8; }
        { const int row = P >> 3, pos = P & 7, pc = pos ^ ((row >> 1) & 7); voff[i] = row * T_TOK + pc * 8; } }
#define ATT_STAGE(kt, buf) do { _Pragma("unroll") for (int i = 0; i < 2; ++i) { \
        __builtin_amdgcn_global_load_lds((const unsigned*)(kbase + (size_t)(kt) * (64 * 512) + koff[i]), (LAS unsigned*)(lds + (buf) * STG + (w * 2 + i) * 1024), 16, 0, 0); \
        __builtin_amdgcn_global_load_lds((const unsigned*)(vbase + (kt) * 64 + voff[i]), (LAS unsigned*)(lds + (buf) * STG + KBUF + (w * 2 + i) * 1024), 16, 0, 0); } } while (0)
      ATT_STAGE(0, 0);
      asm volatile("s_waitcnt vmcnt(0)" ::: "memory");
      __syncthreads();
      f32x16 O[2][4];
#pragma unroll
      for (int c = 0; c < 2; ++c)
#pragma unroll
        for (int bk = 0; bk < 4; ++bk)
#pragma unroll
          for (int i = 0; i < 16; ++i) O[c][bk][i] = 0.f;
      float lsum[2] = {0.f, 0.f};
      const int qr = 32 * w + l31;
      int k_lane = l31 * 256 + ((hh ^ (l31 & 15)) << 4), q_lane = QOFF + qr * 256 + ((hh ^ (qr & 15)) << 4), v_lane = KBUF + l31 * 128 + ((hh ^ ((l31 >> 1) & 7)) << 4);
#pragma unroll 1
      for (int kt = 0; kt < ntl; ++kt) {
        if (kt + 1 < ntl) ATT_STAGE(kt + 1, (kt + 1) & 1);
        if (kt < ntw) {
          asm volatile("" : "+v"(k_lane), "+v"(q_lane), "+v"(v_lane));
          const LAS unsigned char* tb = lds + (kt & 1) * STG;
#pragma unroll
          for (int kb = 0; kb < 2; ++kb) {
            bf16x8 pf[2][2];
#pragma unroll
            for (int c = 0; c < 2; ++c) {
              f32x16 S;
#pragma unroll
              for (int i = 0; i < 16; ++i) S[i] = 0.f;
#pragma unroll
              for (int ks = 0; ks < 4; ++ks) {
                const int xo = (c * 8 + ks * 2) << 4;
                const bf16x8 qf = *(const LAS bf16x8*)(lds + (q_lane ^ xo));
                const bf16x8 kf = *(const LAS bf16x8*)(tb + (k_lane ^ xo) + kb * 8192);
                S = __builtin_amdgcn_mfma_f32_32x32x16_bf16(kf, qf, S, 0, 0, 0);
              }
              float ls = 0.f;
#pragma unroll
              for (int hs = 0; hs < 2; ++hs) { u32x4_t pw;
#pragma unroll
                for (int t = 0; t < 4; ++t) { const float a = __builtin_amdgcn_exp2f(S[8 * hs + 2 * t]), bq = __builtin_amdgcn_exp2f(S[8 * hs + 2 * t + 1]); ls += a + bq; pw[t] = pk2(a, bq); }
                pf[c][hs] = __builtin_bit_cast(bf16x8, pw); }
              lsum[c] += ls;
              __builtin_amdgcn_sched_barrier(0);
            }
#pragma unroll
            for (int bk = 0; bk < 4; ++bk) {
              const bf16x8 v0 = *(const LAS bf16x8*)(tb + (v_lane ^ ((2 * kb) << 5)) + bk * 4096);
              const bf16x8 v1 = *(const LAS bf16x8*)(tb + (v_lane ^ ((2 * kb + 1) << 5)) + bk * 4096);
              O[0][bk] = __builtin_amdgcn_mfma_f32_32x32x16_bf16(v0, pf[0][0], O[0][bk], 0, 0, 0);
              O[1][bk] = __builtin_amdgcn_mfma_f32_32x32x16_bf16(v0, pf[1][0], O[1][bk], 0, 0, 0);
              O[0][bk] = __builtin_amdgcn_mfma_f32_32x32x16_bf16(v1, pf[0][1], O[0][bk], 0, 0, 0);
              O[1][bk] = __builtin_amdgcn_mfma_f32_32x32x16_bf16(v1, pf[1][1], O[1][bk], 0, 0, 0);
              __builtin_amdgcn_sched_barrier(0);
            }
          }
        }
        asm volatile("s_waitcnt vmcnt(0)" ::: "memory");
        __syncthreads();
      }
#undef ATT_STAGE
      const int tid2 = tid_opaque(), lane2 = tid2 & 63, w2 = __builtin_amdgcn_readfirstlane(tid2 >> 6), hh2 = lane2 >> 5, qr2 = 32 * w2 + (lane2 & 31);
      float lam;
      { const float* q1 = p.in[9] + l * 64; const float* k1 = p.in[10] + l * 64; const float* q2 = p.in[11] + l * 64; const float* k2 = p.in[12] + l * 64;
        float a = q1[lane2] * k1[lane2], bq = q2[lane2] * k2[lane2]; a = wave_sum(a); bq = wave_sum(bq); lam = expf(a) - expf(bq) + lambda_init; }
      float l1 = lsum[0], l2 = lsum[1]; l1 += __shfl_xor(l1, 32); l2 += __shfl_xor(l2, 32);
      const float inv1 = 1.0f / l1, inv2 = lam / l2; float ss = 0.f;
#pragma unroll
      for (int bk = 0; bk < 4; ++bk)
#pragma unroll
        for (int i = 0; i < 16; ++i) { const float o = O[0][bk][i] * inv1 - O[1][bk][i] * inv2; O[0][bk][i] = o; ss += o * o; }
      ss += __shfl_xor(ss, 32);
      const float rs = rsqrtf(ss * (1.0f / 128.0f) + EPS) * (1.0f - lambda_init);
      bf16_t* orow = MIX + (size_t)(t0 + qr2) * 1024 + 512 + h * 128;
#pragma unroll
      for (int bk = 0; bk < 4; ++bk)
#pragma unroll
        for (int g = 0; g < 4; ++g) { const int dv0 = 32 * bk + 8 * g + 4 * hh2; const f32x4 wv = *(const f32x4*)(dnw + dv0);
          u32x2_t q; q.x = pk2(O[0][bk][4 * g] * rs * wv[0], O[0][bk][4 * g + 1] * rs * wv[1]); q.y = pk2(O[0][bk][4 * g + 2] * rs * wv[2], O[0][bk][4 * g + 3] * rs * wv[3]);
          *(u32x2_t*)(orow + dv0) = q; }
    }
  }
}


#define XB_TMO      128
#define XB_XCNT(j)  (256  + 64 * (j))
#define XB_XSUB(j)  (1280 + 64 * (j))
#define XB_XGEN(j)  (2304 + 64 * (j))
#define XB_TOP      3328
#define XB_TOPGEN   3392
#define XCD_BAR_WORDS 3456
#define XB_SPIN_CAP (1u << 18)

__device__ __forceinline__ unsigned xb_ld(unsigned* p)              { return __hip_atomic_load(p, __ATOMIC_RELAXED, __HIP_MEMORY_SCOPE_AGENT); }
__device__ __forceinline__ unsigned xb_add(unsigned* p, unsigned v) { return __hip_atomic_fetch_add(p, v, __ATOMIC_RELAXED, __HIP_MEMORY_SCOPE_AGENT); }
__device__ __forceinline__ unsigned xb_xcc_id() { return (unsigned)__builtin_amdgcn_s_getreg((3 << 11) | 20) & 0xFu; }
#define XB_SPIN(cond, bar) do { unsigned _sp = 0; while (cond) { __builtin_amdgcn_s_sleep(1); \
    if ((++_sp & 255u) == 0u) { if (xb_ld(&(bar)[XB_TMO])) break; if (_sp > XB_SPIN_CAP) { atomicAdd(&(bar)[XB_TMO], 1u); break; } } } } while (0)

struct XcdBarrier {
    unsigned* bar; unsigned x;
    volatile LAS unsigned* st;
};

__device__ __forceinline__ XcdBarrier xcd_barrier_post(unsigned* bar, volatile LAS unsigned* st) {
    XcdBarrier b; b.bar = bar; b.x = xb_xcc_id(); b.st = st;
    if (threadIdx.x == 0) (void)xb_add(&bar[XB_XCNT(b.x)], 1u);
    return b;
}
__device__ __forceinline__ void xcd_barrier_complete(unsigned* bar, unsigned x, unsigned& nloc, unsigned& nx) {
    const unsigned G = gridDim.x * gridDim.y * gridDim.z;
    unsigned sum, cnt, mine, sp = 0u;
    for (;;) {
        sum = 0u; cnt = 0u; mine = 0u;
#pragma unroll
        for (unsigned j = 0; j < 16; ++j) { const unsigned c = xb_ld(&bar[XB_XCNT(j)]); sum += c; cnt += (c > 0u) ? 1u : 0u; mine = (j == x) ? c : mine; }
        if (sum == G) break;
        __builtin_amdgcn_s_sleep(1);
        if ((++sp & 255u) == 0u) { if (xb_ld(&bar[XB_TMO])) break; if (sp > XB_SPIN_CAP) { atomicAdd(&bar[XB_TMO], 1u); break; } }
    }
    nloc = mine > 0u ? mine : 1u; nx = cnt > 0u ? cnt : 1u;
}

__device__ __forceinline__ void xcd_barrier(const XcdBarrier& b) {
    asm volatile("s_waitcnt vmcnt(0)" ::: "memory");
    __syncthreads();
    if (threadIdx.x == 0) {
        unsigned* bar = b.bar;
        __builtin_amdgcn_s_waitcnt(0);
        unsigned nloc = b.st[0], nx = b.st[1];
        if (nloc == 0u) { xcd_barrier_complete(bar, b.x, nloc, nx); b.st[0] = nloc; b.st[1] = nx; }
        const unsigned old = xb_add(&bar[XB_XSUB(b.x)], 1u);
        const unsigned gen = old / nloc;
        if (old + 1u == (gen + 1u) * nloc) {
            __builtin_amdgcn_fence(__ATOMIC_RELEASE, "agent");
            asm volatile("s_waitcnt vmcnt(0)" ::: "memory");
            const unsigned og = xb_add(&bar[XB_TOP], 1u);
            const unsigned tg = og / nx;
            if (og + 1u == (tg + 1u) * nx) xb_add(&bar[XB_TOPGEN], 1u);
            else XB_SPIN(xb_ld(&bar[XB_TOPGEN]) == tg, bar);
            __builtin_amdgcn_fence(__ATOMIC_ACQUIRE, "agent");
            xb_add(&bar[XB_XGEN(b.x)], 1u);
            asm volatile("s_waitcnt vmcnt(0)" ::: "memory");
        } else {
            XB_SPIN(xb_ld(&bar[XB_XGEN(b.x)]) == gen, bar);
            __builtin_amdgcn_fence(__ATOMIC_ACQUIRE, "agent");
            asm volatile("s_waitcnt vmcnt(0)" ::: "memory");
        }
    }
    __syncthreads();
}

DI void zero_u64(u64* p, int n) { for (int i = blockIdx.x * 512 + tid_opaque(); i < n; i += gridDim.x * 512) p[i] = 0ull; }

#if PROBE_EPI_ACE
typedef DupOrder OrderACE;
#else
typedef pg8::StaticOrder OrderACE;
#endif
DI void phaseA(const MParams& p, int l, LAS unsigned char* lds) {
  unsigned char* ws = p.ws; const bf16_t* XB = (const bf16_t*)(ws + OFF_XB); const bf16_t* WinT = (const bf16_t*)(ws + OFF_W + (size_t)l * W_STRIDE + WO_IN); const u64* SS1 = (const u64*)(ws + OFF_SS1);
  zero_u64((u64*)(ws + OFF_SS2), T_TOK);
  { pg8::Gemm g{XB, WinT, T_TOK, 1536, DM}; OrderACE S; S.init(T_TOK, 1536, gridDim.x, blockIdx.x);
    EpiA1 E{SS1, (bf16_t*)(ws + OFF_U), (bf16_t*)(ws + OFF_Q), (bf16_t*)(ws + OFF_KB), p.in[7] + l * 64, p.in[8] + l * 64}; pg8::gemm_phase<EpiA1, OrderACE>(lds, g, S, E); }
  { pg8::Gemm g{WinT + (size_t)1536 * DM, XB, 1024, T_TOK, DM}; OrderACE S; S.init(1024, T_TOK, gridDim.x, blockIdx.x);
    EpiA2 E{SS1, (bf16_t*)(ws + OFF_GVT), (bf16_t*)(ws + OFF_VT), (u64*)(ws + OFF_SSV)}; pg8::gemm_phase<EpiA2, OrderACE>(lds, g, S, E); }
}
DI void phaseCE(const MParams& p, int l, bool isC, LAS unsigned char* lds) {
  unsigned char* ws = p.ws; const unsigned char* wb = ws + OFF_W + (size_t)l * W_STRIDE;
  if (isC) zero_u64((u64*)(ws + OFF_SS1), T_TOK);
  pg8::Gemm g{(const bf16_t*)(ws + (isC ? OFF_MIX : OFF_F)), (const bf16_t*)(wb + (isC ? WO_OUT : WO_DN)), T_TOK, DM, isC ? DM : DFF}; OrderACE S; S.init(T_TOK, DM, gridDim.x, blockIdx.x);
  EpiResid E{(isC && l == 0) ? p.in[0] : nullptr, (!isC && l == NLAYER - 1) ? p.out : nullptr, (bf16_t*)(ws + OFF_XB), (u64*)(ws + (isC ? OFF_SS2 : OFF_SS1))}; pg8::gemm_phase<EpiResid, OrderACE>(lds, g, S, E);
}
DI void phaseD(const MParams& p, int l, LAS unsigned char* lds) {
  unsigned char* ws = p.ws;
  zero_u64((u64*)(ws + OFF_SSV), T_TOK * 4);
  pg8::Gemm g{(const bf16_t*)(ws + OFF_XB), (const bf16_t*)(ws + OFF_W + (size_t)l * W_STRIDE + WO_GU), T_TOK, 2 * DFF, DM};
#if PROBE_EPI_D
  DupOrder S;
#else
  pg8::StaticOrder S;
#endif
  S.init(T_TOK, 2 * DFF, gridDim.x, blockIdx.x);
  EpiD E{(const u64*)(ws + OFF_SS2), p.in[18] + (size_t)l * 3 * DFF, p.in[19] + (size_t)l * DFF, (bf16_t*)(ws + OFF_F), (float*)(ws + OFF_GB), (float*)(ws + OFF_PB), (float*)(ws + OFF_UB)};
#if PROBE_EPI_D
  pg8::gemm_phase<EpiD, DupOrder>(lds, g, S, E);
#else
  pg8::gemm_phase<EpiD, pg8::StaticOrder>(lds, g, S, E);
#endif
}

__global__ void __launch_bounds__(512) k_run(MParams p) {
  extern __shared__ __attribute__((aligned(16))) unsigned char lds_raw[];
  LAS unsigned char* lds = (LAS unsigned char*)lds_raw;
  cg::grid_group grid = cg::this_grid();
  if (threadIdx.x < 4) ((LAS unsigned*)(lds + 131072))[threadIdx.x] = 0u;
  __syncthreads();
  XcdBarrier xbar = xcd_barrier_post((unsigned*)(p.ws + OFF_BAR), (volatile LAS unsigned*)(lds + 131072));
  if (p.ph_lo < 0) grid.sync();
  for (int ph = p.ph_lo; ph < p.ph_hi; ++ph) {
    for (int rep = 0; rep < 1 + ((PROBE_MASK >> (ph == 0 ? 6 : (ph - 1) % 6)) & 1); ++rep) {
    if (ph == 0) { if (EN_MASK & 1) prologue(p); }
    else {
      const int l = (ph - 1) / 6, s = (ph - 1) % 6;
      if (s == 0) { if (EN_MASK & 2) phaseA(p, l, lds); }
      else if (s == 1) { if (EN_MASK & 4) attn_phase(p, l, lds); if (EN_MASK & 8) { const LP lp = make_lp(p, l); spatial_phase(lp, p.ws, lds); } }
      else if (s == 2 || s == 5) { if (EN_MASK & 16) phaseCE(p, l, s == 2, lds); }
      else if (s == 3) { if (EN_MASK & 32) phaseD(p, l, lds); }
      else { if (EN_MASK & 64) { const LP lp = make_lp(p, l); fixup_phase(lp, p.ws); } }
    }
    }
    if (ph + 1 < p.ph_hi) xcd_barrier(xbar);
  }
}

extern "C" void kernel_launch(void* const* d_in, const int* in_sizes, int n_in, void* d_out, int out_size, void* d_ws, size_t ws_size, hipStream_t stream) {
  static int grid_blocks = 0;
  if (!grid_blocks) {
    (void)hipFuncSetAttribute((const void*)k_run, hipFuncAttributeMaxDynamicSharedMemorySize, LDS_BYTES);
    int dev = 0, cus = 0, per_cu = 0; (void)hipGetDevice(&dev); (void)hipDeviceGetAttribute(&cus, hipDeviceAttributeMultiprocessorCount, dev);
    (void)hipOccupancyMaxActiveBlocksPerMultiprocessor(&per_cu, (const void*)k_run, 512, LDS_BYTES); if (per_cu < 1) per_cu = 1;
    grid_blocks = cus * per_cu; if (grid_blocks > 256) grid_blocks = 256;
  }
  MParams mp; memset(&mp, 0, sizeof(mp));
  for (int i = 0; i < 21; ++i) mp.in[i] = (const float*)d_in[i];
  mp.out = (float*)d_out; mp.ws = (unsigned char*)d_ws; mp.ph_lo = 0; mp.ph_hi = 1 + 6 * NLAYER;
  (void)hipMemsetAsync((unsigned char*)d_ws + OFF_BAR, 0, 3456 * sizeof(unsigned), stream);
  void* args[] = {&mp};
  hipError_t e = hipLaunchCooperativeKernel((const void*)k_run, dim3(grid_blocks), dim3(512), args, LDS_BYTES, stream);
  if (e != hipSuccess) fprintf(stderr, "cooperative launch failed: %s (grid %d)\n", hipGetErrorString(e), grid_blocks);
}
```

```cpp
#include <hip/hip_runtime.h>
#include <hip/hip_cooperative_groups.h>
#include <cstdio>
#include <cmath>
#include <cstring>

typedef unsigned short bf16_t;
#define DI __device__ __forceinline__

constexpr int T_TOK = 32768, DM = 1024, SEQ = 2048, DFF = 2816, INW = 2560, NLAYER = 4;
constexpr float EPS = 1e-6f;
constexpr float QSCALE = 0.125f * 1.4426950408889634f;

constexpr size_t MiB = 1024ull * 1024ull;
constexpr size_t OFF_XB = 0;
constexpr size_t OFF_R = 64 * MiB;
constexpr size_t OFF_U = OFF_R, OFF_Q = OFF_R + 32 * MiB, OFF_KB = OFF_R + 64 * MiB, OFF_GVT = OFF_R + 96 * MiB, OFF_VT = OFF_R + 128 * MiB, OFF_MIX = OFF_R + 160 * MiB;
constexpr size_t OFF_F = OFF_R, OFF_GB = OFF_R + 176 * MiB, OFF_PB = OFF_R + 188 * MiB, OFF_UB = OFF_R + 200 * MiB;
constexpr size_t OFF_W = 288 * MiB, W_STRIDE = 24 * MiB;
constexpr size_t WO_IN = 0, WO_OUT = 5 * MiB, WO_GU = 7 * MiB, WO_DN = 18 * MiB, WO_SP = 23 * MiB + 512 * 1024;
constexpr size_t OFF_SS1 = 384 * MiB, OFF_SS2 = OFF_SS1 + 256 * 1024, OFF_SSV = OFF_SS2 + 256 * 1024;
constexpr size_t OFF_BAR = 385 * MiB + 512 * 1024;
constexpr size_t OFF_TMP1 = 386 * MiB, OFF_TMP2 = 418 * MiB;

DI int tid_opaque() { int t = threadIdx.x; asm volatile("" : "+v"(t)); return t; }
DI float bf2f(bf16_t b) { return __uint_as_float(((unsigned)b) << 16); }
DI bf16_t f2bf(float f) { unsigned u = __float_as_uint(f); u += 0x7FFFu + ((u >> 16) & 1u); return (bf16_t)(u >> 16); }
DI float gelu_exact(float x) { return 0.5f * x * (1.0f + erff(x * 0.70710678118654752f)); }
DI int permpos16(int k) { return (k & 3) + 4 * (k >> 3) + 8 * ((k >> 2) & 1); }
DI float wave_sum(float v) { for (int o = 32; o >= 1; o >>= 1) v += __shfl_xor(v, o); return v; }

namespace pg8 {
#define PG8_LAS __attribute__((address_space(3)))
typedef unsigned short bf16_t;
typedef short bf16x8 __attribute__((ext_vector_type(8)));
typedef float f32x4 __attribute__((ext_vector_type(4)));
typedef unsigned u32x4 __attribute__((ext_vector_type(4)));
constexpr int BM = 256, BK = 64, HALF = 128, HTB = HALF * BK * 2  , STAGE_BYTES = 8 * HTB, NXCD = 8, WGM = 8;

__host__ __device__ __forceinline__ int lds_byte(int r, int c) { const int st = (r >> 4) * 2 + (c >> 5), rr = r & 15, cc = c & 31, ob = rr * 64 + cc * 2; return st * 1024 + (ob ^ (((ob >> 9) & 1) << 5)); }
__host__ __device__ __forceinline__ void stage_rc(int b, int& R, int& C) { const int st = b / 1024, sb = b % 1024, swz = sb ^ (((sb >> 9) & 1) << 5); R = (st >> 1) * 16 + swz / 64; C = (st & 1) * 32 + (swz % 64) / 2; }
__host__ __device__ __forceinline__ int perm32(int rho) { const int n = rho >> 4, i = rho & 15; return 8 * (i >> 2) + 4 * n + (i & 3); }

struct Unit { int pm, pn; };
struct Gemm { const bf16_t* A; const bf16_t* Bt; int M, N, K; };

struct StaticOrder {
    int nM, nN, nwg, G, c;
    __host__ __device__ void init(int M, int N, int G_, int c_) { nM = M / BM; nN = N / BM; nwg = nM * nN; G = G_; c = c_; }
    __host__ __device__ bool next(int i, Unit& u) const {
        const long L = (long)i * G + c; if (L >= nwg) return false;
        int wgid = (int)L; { const int q = nwg / NXCD, r = nwg % NXCD, xcd = wgid % NXCD, off = wgid / NXCD; wgid = (xcd < r ? xcd * (q + 1) : r * (q + 1) + (xcd - r) * q) + off; }
        const int nig = WGM * nN, gid = wgid / nig, fm = gid * WGM, gsz = (nM - fm) < WGM ? (nM - fm) : WGM;
        u.pm = fm + ((wgid % nig) % gsz); u.pn = (wgid % nig) / gsz; return true;
    }
    __device__ __forceinline__ void a_ready(const Unit&) const {}
    __device__ __forceinline__ void done(const Unit&) const {}
};
template <class Epi, class Sched>
__device__ __forceinline__ void gemm_phase(PG8_LAS unsigned char* lds, const Gemm g, const Sched& S, const Epi& E) {
    const int tid = tid_opaque(), wid = __builtin_amdgcn_readfirstlane(tid >> 6), lane = tid & 63, wr = wid >> 2, wc = wid & 3, fr = lane & 15, fq = lane >> 4;
    const int K = g.K, nt = K / BK;
    unsigned voffA[2], voffB[2];
#pragma unroll
    for (int i = 0; i < 2; ++i) { int R, C; stage_rc(tid * 16 + i * 8192, R, C); const int Rb = Epi::PERM ? ((R & ~31) + perm32(R & 31)) : R;
        voffA[i] = (unsigned)(R * K + C) * 2u; voffB[i] = (unsigned)(Rb * K + C) * 2u; }
    const size_t kstep = (size_t)(BK * 2);
    const size_t hstep = (size_t)HALF * K * 2;
    const size_t tstep = 2 * hstep;
    const unsigned ldsw = (unsigned)wid * 1024u;
    const int aoff = lds_byte(wr * 64 + fr, fq * 8), boff = lds_byte(wc * 32 + fr, fq * 8);
#define PG8_SA(b, h) (((b) * 2 + (h)) * HTB)
#define PG8_SB(b, h) ((4 + (b) * 2 + (h)) * HTB)
#define PG8_STAGE(bufoff, gbase, voff) do { _Pragma("unroll") for (int _i = 0; _i < 2; ++_i) \
        __builtin_amdgcn_global_load_lds((const unsigned*)((const char*)(gbase) + (voff)[_i]), (PG8_LAS unsigned*)(lds + (bufoff) + ldsw + _i * 8192), 16, 0, 0); } while (0)
#define PG8_LDA(dst, b, h) do { _Pragma("unroll") for (int m = 0; m < 4; ++m) _Pragma("unroll") for (int k = 0; k < 2; ++k) dst[m][k] = *(const PG8_LAS bf16x8*)(lds + PG8_SA(b, h) + aoff + m * 2048 + k * 1024); } while (0)
#define PG8_LDB(dst, b, h) do { _Pragma("unroll") for (int n = 0; n < 2; ++n) _Pragma("unroll") for (int k = 0; k < 2; ++k) dst[n][k] = *(const PG8_LAS bf16x8*)(lds + PG8_SB(b, h) + boff + n * 2048 + k * 1024); } while (0)
#define PG8_MMA(ai, bj, At, Bt) do { __builtin_amdgcn_s_setprio(1); _Pragma("unroll") for (int m = 0; m < 4; ++m) _Pragma("unroll") for (int n = 0; n < 2; ++n) _Pragma("unroll") for (int k = 0; k < 2; ++k) \
        acc[ai][bj][m][n] = __builtin_amdgcn_mfma_f32_16x16x32_bf16(Bt[n][k], At[m][k], acc[ai][bj][m][n], 0, 0, 0); __builtin_amdgcn_s_setprio(0); } while (0)
#define PG8_WAIT_V(n) asm volatile("s_waitcnt vmcnt(" #n ")" ::: "memory")
#define PG8_WAIT_L(n) asm volatile("s_waitcnt lgkmcnt(" #n ")" ::: "memory")
#define PG8_BAR __builtin_amdgcn_s_barrier()
#define PG8_SCHED __builtin_amdgcn_sched_barrier(0)
    Unit cur, nxt; int ui = 0;
    if (!S.next(0, cur)) return;
    f32x4 acc[2][2][4][2];
#pragma unroll
    for (int a = 0; a < 2; ++a)
#pragma unroll
        for (int b = 0; b < 2; ++b)
#pragma unroll
            for (int m = 0; m < 4; ++m)
#pragma unroll
                for (int n = 0; n < 2; ++n) acc[a][b][m][n] = (f32x4){0.f, 0.f, 0.f, 0.f};
    bf16x8 At[4][2], B0[2][2], B1[2][2];
    const char* cA = (const char*)g.A + (size_t)cur.pm * tstep; const char* cB = (const char*)g.Bt + (size_t)cur.pn * tstep;
    S.a_ready(cur);
    PG8_STAGE(PG8_SB(0, 0), cB, voffB); PG8_STAGE(PG8_SA(0, 0), cA, voffA); PG8_STAGE(PG8_SB(0, 1), cB + hstep, voffB); PG8_STAGE(PG8_SA(0, 1), cA + hstep, voffA);
    if (wr == 1) PG8_BAR;
    PG8_WAIT_V(4); PG8_BAR;
    PG8_STAGE(PG8_SB(1, 0), cB + kstep, voffB); PG8_STAGE(PG8_SA(1, 0), cA + kstep, voffA); PG8_STAGE(PG8_SB(1, 1), cB + hstep + kstep, voffB);
    PG8_WAIT_V(6); PG8_BAR;
    for (;;) {
        const bool has_next = S.next(ui + 1, nxt);
        const char* nA = has_next ? (const char*)g.A + (size_t)nxt.pm * tstep : cA; const char* nB = has_next ? (const char*)g.Bt + (size_t)nxt.pn * tstep : cB;
        for (int t = 0; t < nt; t += 2) {
            const bool last = (t == nt - 2);
            const char* a1 = cA + (size_t)(t + 1) * kstep;
            const char* a2 = last ? nA : cA + (size_t)(t + 2) * kstep; const char* b2 = last ? nB : cB + (size_t)(t + 2) * kstep;
            const char* a3 = a2 + kstep; const char* b3 = b2 + kstep;
            if (last && has_next) S.a_ready(nxt);
            PG8_LDB(B0, 0, 0); PG8_SCHED; PG8_LDA(At, 0, 0); PG8_STAGE(PG8_SA(1, 1), a1 + hstep, voffA);
            PG8_WAIT_L(8); PG8_BAR; PG8_WAIT_L(0); PG8_MMA(0, 0, At, B0); PG8_BAR; PG8_SCHED;
            PG8_LDB(B1, 0, 1); PG8_STAGE(PG8_SB(0, 0), b2, voffB);
            PG8_BAR; PG8_WAIT_L(0); PG8_MMA(0, 1, At, B1); PG8_BAR;
            PG8_LDA(At, 0, 1); PG8_STAGE(PG8_SA(0, 0), a2, voffA);
            PG8_BAR; PG8_WAIT_L(0); PG8_MMA(1, 0, At, B0); PG8_BAR; PG8_SCHED;
            PG8_STAGE(PG8_SB(0, 1), b2 + hstep, voffB);
            PG8_WAIT_V(6); PG8_BAR; PG8_MMA(1, 1, At, B1); PG8_BAR;
            PG8_LDB(B0, 1, 0); PG8_SCHED; PG8_LDA(At, 1, 0); PG8_STAGE(PG8_SA(0, 1), a2 + hstep, voffA);
            PG8_WAIT_L(8); PG8_BAR; PG8_WAIT_L(0); PG8_MMA(0, 0, At, B0); PG8_BAR; PG8_SCHED;
            PG8_LDB(B1, 1, 1); PG8_STAGE(PG8_SB(1, 0), b3, voffB);
            PG8_BAR; PG8_WAIT_L(0); PG8_MMA(0, 1, At, B1); PG8_BAR;
            PG8_LDA(At, 1, 1); PG8_STAGE(PG8_SA(1, 0), a3, voffA);
            PG8_BAR; PG8_WAIT_L(0); PG8_MMA(1, 0, At, B0); PG8_BAR; PG8_SCHED;
            PG8_STAGE(PG8_SB(1, 1), b3 + hstep, voffB);
            PG8_WAIT_V(6); PG8_BAR; PG8_MMA(1, 1, At, B1); PG8_BAR;
        }
        if constexpr (!Epi::AFTER_DRAIN) { if (!Epi::TWICE || (ui & 1)) E(acc, cur, wr, wc, fr, fq); S.done(cur); }
        if (!has_next) break;
#pragma unroll
        for (int a = 0; a < 2; ++a)
#pragma unroll
            for (int b = 0; b < 2; ++b)
#pragma unroll
                for (int m = 0; m < 4; ++m)
#pragma unroll
                    for (int n = 0; n < 2; ++n) acc[a][b][m][n] = (f32x4){0.f, 0.f, 0.f, 0.f};
        cur = nxt; cA = nA; cB = nB; ++ui;
    }
    PG8_WAIT_V(0);
    if (wr == 0) PG8_BAR;
    PG8_BAR;
    if constexpr (Epi::AFTER_DRAIN) { E.fused(acc, cur, wr, wc, fr, fq, lds, wid, lane); S.done(cur); }
#undef PG8_SA
#undef PG8_SB
#undef PG8_STAGE
#undef PG8_LDA
#undef PG8_LDB
#undef PG8_MMA
#undef PG8_WAIT_V
#undef PG8_WAIT_L
#undef PG8_BAR
#undef PG8_SCHED
}
}

namespace cg = cooperative_groups;
using pg8::f32x4; using pg8::bf16x8; using pg8::Unit;
typedef unsigned u32x2_t __attribute__((ext_vector_type(2)));
typedef unsigned u32x4_t __attribute__((ext_vector_type(4)));
typedef float f32x16 __attribute__((ext_vector_type(16)));
typedef float f32x2_t __attribute__((ext_vector_type(2)));
#define LAS PG8_LAS
constexpr int LDS_BYTES = 131072 + 16;
#ifndef EN_MASK
#define EN_MASK 0x7f
#endif
#ifndef PROBE_EPI_ACE
#define PROBE_EPI_ACE 0
#endif
#ifndef PROBE_EPI_D
#define PROBE_EPI_D 0
#endif
#ifndef PROBE_SYNC
#define PROBE_SYNC 0
#endif
#ifndef PROBE_MASK
#define PROBE_MASK 0x00
#endif

DI unsigned pk2(float lo, float hi) { unsigned r; asm volatile("s_nop 0\n\tv_cvt_pk_bf16_f32 %0, %1, %2\n\ts_nop 1" : "=v"(r) : "v"(lo), "v"(hi)); return r; }
DI float bflo(unsigned w) { return __uint_as_float(w << 16); }
DI float bfhi(unsigned w) { return __uint_as_float(w & 0xffff0000u); }
DI float gelu1(float v) {
  const float av = fabsf(v), t = __builtin_amdgcn_rcpf(av * 0.2316418882f + 1.0f);
  float q = t * 0.5307027145f + (-0.7265760135f); q = q * t + 0.7107068705f; q = q * t + (-0.142248368f); q = q * t + 0.127414796f; q = q * t;
  const float e = __builtin_amdgcn_exp2f((v * v) * (-0.72134752044f));
  const float m = v * (q * e);
  return v < 0.f ? m : v - m;
}
DI float dpp_ror1(float v) { return __builtin_bit_cast(float, __builtin_amdgcn_update_dpp(0, __builtin_bit_cast(int, v), 0x121, 0xf, 0xf, false)); }
DI float dpp_ror2(float v) { return __builtin_bit_cast(float, __builtin_amdgcn_update_dpp(0, __builtin_bit_cast(int, v), 0x122, 0xf, 0xf, false)); }
typedef unsigned long long u64;
DI float fx2f(u64 v) { return (float)v * (1.0f / 1048576.0f); }
DI u64 f2fx(float v) { return (u64)(v * 1048576.0f + 0.5f); }
DI void fx_add(u64* p, float v) { __hip_atomic_fetch_add(p, f2fx(v), __ATOMIC_RELAXED, __HIP_MEMORY_SCOPE_AGENT); }
DI float rs1024(u64 ss) { return rsqrtf(fx2f(ss) * (1.0f / 1024.0f) + EPS); }

struct MParams { const float* in[21]; float* out; unsigned char* ws; int ph_lo, ph_hi; };
struct LP {
  const float *norm_attn_w, *w_in, *v_norm_w, *sp_w, *sp_b, *out_norm_w, *q_norm_w, *k_norm_w, *lq1, *lk1, *lq2, *lk2, *diff_norm_w, *w_out, *norm_ffn_w, *w_gate, *w_up, *conv_w, *conv_b, *w_down;
  float lambda_init;
  const bf16_t *WinT, *WoutT, *WguT, *WdT, *Wsp;
};
DI LP make_lp(const MParams& p, int l) {
  LP L;
  L.norm_attn_w = p.in[1] + (size_t)l * DM; L.w_in = p.in[2] + (size_t)l * DM * INW; L.v_norm_w = p.in[3] + (size_t)l * 512; L.sp_w = p.in[4] + (size_t)l * 65536; L.sp_b = p.in[5] + (size_t)l * 512;
  L.out_norm_w = p.in[6] + (size_t)l * 512; L.q_norm_w = p.in[7] + (size_t)l * 64; L.k_norm_w = p.in[8] + (size_t)l * 64; L.lq1 = p.in[9] + (size_t)l * 64; L.lk1 = p.in[10] + (size_t)l * 64;
  L.lq2 = p.in[11] + (size_t)l * 64; L.lk2 = p.in[12] + (size_t)l * 64; L.diff_norm_w = p.in[13] + (size_t)l * 128; L.w_out = p.in[14] + (size_t)l * DM * DM; L.norm_ffn_w = p.in[15] + (size_t)l * DM;
  L.w_gate = p.in[16] + (size_t)l * DM * DFF; L.w_up = p.in[17] + (size_t)l * DM * DFF; L.conv_w = p.in[18] + (size_t)l * 3 * DFF; L.conv_b = p.in[19] + (size_t)l * DFF; L.w_down = p.in[20] + (size_t)l * DFF * DM;
  L.lambda_init = 0.8f - 0.6f * expf(-0.3f * (float)(l + 1));
  const unsigned char* wb = p.ws + OFF_W + (size_t)l * W_STRIDE;
  L.WinT = (const bf16_t*)(wb + WO_IN); L.WoutT = (const bf16_t*)(wb + WO_OUT); L.WguT = (const bf16_t*)(wb + WO_GU); L.WdT = (const bf16_t*)(wb + WO_DN); L.Wsp = (const bf16_t*)(wb + WO_SP);
  return L;
}
DI float lam_of(const LP& lp) {
  const int lane = threadIdx.x & 63;
  float a = lp.lq1[lane] * lp.lk1[lane], b = lp.lq2[lane] * lp.lk2[lane];
  a = wave_sum(a); b = wave_sum(b);
  return expf(a) - expf(b) + lp.lambda_init;
}

DI void conv_item(bf16_t* dst, int K, int row, int kg, const float* src, int ld, int col, const float* ks) {
  float v[32];
#pragma unroll
  for (int i = 0; i < 32; ++i) v[i] = src[(size_t)(kg * 32 + i) * ld + col];
  if (ks) {
#pragma unroll
    for (int i = 0; i < 32; i += 4) { const f32x4 s = *(const f32x4*)(ks + kg * 32 + i); v[i] *= s[0]; v[i + 1] *= s[1]; v[i + 2] *= s[2]; v[i + 3] *= s[3]; }
  }
  u32x4_t* d = (u32x4_t*)(dst + (size_t)row * K + kg * 32);
#pragma unroll
  for (int i = 0; i < 4; ++i) { u32x4_t w; w.x = pk2(v[8 * i], v[8 * i + 1]); w.y = pk2(v[8 * i + 2], v[8 * i + 3]); w.z = pk2(v[8 * i + 4], v[8 * i + 5]); w.w = pk2(v[8 * i + 6], v[8 * i + 7]); d[i] = w; }
}
DI int perm_logical(int p) {
  const int bj = p >> 7, wc = (p >> 5) & 3, n = (p >> 4) & 1, fq = (p >> 2) & 3, e = p & 3;
  return 64 * wc + 32 * bj + 8 * fq + 4 * n + e;
}
DI void prologue(const MParams& p) {
  const int tidp = tid_opaque(); const int gtid = blockIdx.x * 512 + tidp, gsz = gridDim.x * 512;
  unsigned char* ws = p.ws;
  { const int gw = gtid >> 6, nw = gsz >> 6, lane = threadIdx.x & 63; bf16_t* XB = (bf16_t*)(ws + OFF_XB); u64* SS1 = (u64*)(ws + OFF_SS1);
    for (int row = gw; row < T_TOK; row += nw) { const float* xp = p.in[0] + (size_t)row * DM; float s = 0.f;
#pragma unroll
      for (int i = 0; i < 4; ++i) { const f32x4 v = *(const f32x4*)(xp + i * 256 + lane * 4); s += v[0] * v[0] + v[1] * v[1] + v[2] * v[2] + v[3] * v[3];
        u32x2_t w; w.x = pk2(v[0], v[1]); w.y = pk2(v[2], v[3]); *(u32x2_t*)(XB + (size_t)row * DM + i * 256 + lane * 4) = w; }
      s = wave_sum(s); if (lane == 0) SS1[row] = f2fx(s); } }
  { u64* SSV = (u64*)(ws + OFF_SSV); for (int i = gtid; i < T_TOK * 4; i += gsz) SSV[i] = 0ull; }
  for (int l = 0; l < NLAYER; ++l) {
    const LP lp = make_lp(p, l);
    for (int w = gtid; w < 2560 * 32; w += gsz) { const int row = w % 2560, kg = w / 2560; int col;
      if (row < 1536) { const int L = (row & ~255) + perm_logical(row & 255); col = L < 512 ? L : L + 512; }
      else { const int r = row - 1536; col = r < 512 ? 512 + r : 1536 + r; }
      conv_item((bf16_t*)lp.WinT, 1024, row, kg, lp.w_in, INW, col, lp.norm_attn_w); }
    for (int w = gtid; w < 1024 * 32; w += gsz) { const int row = w % 1024, kg = w / 1024; conv_item((bf16_t*)lp.WoutT, 1024, row, kg, lp.w_out, DM, row, nullptr); }
    for (int w = gtid; w < 5632 * 32; w += gsz) { const int row = w % 5632, kg = w / 5632; const int pn = row >> 8, pp = row & 255, bj = pp >> 7;
      const int q = pp & 127, wc = (q >> 5) & 3, n = (q >> 4) & 1, fq = (q >> 2) & 3, e = q & 3; const int cc = 128 * pn + 32 * wc + 8 * fq + 4 * n + e;
      conv_item((bf16_t*)lp.WguT, 1024, row, kg, bj ? lp.w_up : lp.w_gate, DFF, cc, lp.norm_ffn_w); }
    for (int w = gtid; w < 1024 * 88; w += gsz) { const int row = w % 1024, kg = w / 1024; conv_item((bf16_t*)lp.WdT, DFF, row, kg, lp.w_down, DM, row, nullptr); }
    for (int i = gtid; i < 65536; i += gsz) { const int jj = i & 127, ii = (i >> 7) & 127; ((bf16_t*)lp.Wsp)[i] = ((jj >> 6) <= (ii >> 6)) ? f2bf(lp.sp_w[i]) : (bf16_t)0; }
  }
}

struct DupOrder : pg8::StaticOrder {
  __device__ bool next(int i, Unit& u) const { return pg8::StaticOrder::next(i >> 1, u); }
};
struct EpiResid {
  static constexpr bool PERM = false, AFTER_DRAIN = false, TWICE = (PROBE_EPI_ACE != 0);
  const float* base32; float* out32; bf16_t* XB; u64* SS;
  DI void operator()(const f32x4 (&acc)[2][2][4][2], const Unit& u, int wr, int wc, int fr, int fq) const {
    const int row0 = u.pm * 256 + wr * 64 + fr, col0 = u.pn * 256 + wc * 32 + 4 * fq;
    if (base32) {
      f32x4 nb[2][2];
#pragma unroll
      for (int bj = 0; bj < 2; ++bj)
#pragma unroll
        for (int n = 0; n < 2; ++n) nb[bj][n] = *(const f32x4*)(base32 + (size_t)row0 * DM + col0 + bj * 128 + n * 16);
#pragma unroll
      for (int g = 0; g < 8; ++g) { const int ai = g >> 2, m = g & 3; const int row = row0 + ai * 128 + m * 16; const size_t ro = (size_t)row * DM + col0; float ss = 0.f;
        f32x4 cbv[2][2];
#pragma unroll
        for (int bj = 0; bj < 2; ++bj)
#pragma unroll
          for (int n = 0; n < 2; ++n) cbv[bj][n] = nb[bj][n];
        if (g < 7) { const int r2 = row0 + ((g + 1) >> 2) * 128 + ((g + 1) & 3) * 16;
#pragma unroll
          for (int bj = 0; bj < 2; ++bj)
#pragma unroll
            for (int n = 0; n < 2; ++n) nb[bj][n] = *(const f32x4*)(base32 + (size_t)r2 * DM + col0 + bj * 128 + n * 16); }
#pragma unroll
        for (int bj = 0; bj < 2; ++bj)
#pragma unroll
          for (int n = 0; n < 2; ++n) { const size_t o = ro + bj * 128 + n * 16; const f32x4 v = acc[ai][bj][m][n] + cbv[bj][n];
            u32x2_t w; w.x = pk2(v[0], v[1]); w.y = pk2(v[2], v[3]); *(u32x2_t*)(XB + o) = w; ss += (v[0] * v[0] + v[1] * v[1]) + (v[2] * v[2] + v[3] * v[3]); }
        ss += __shfl_xor(ss, 16); ss += __shfl_xor(ss, 32); if (fq == 0) fx_add(SS + row, ss);
        asm volatile("" ::: "memory"); }
    } else {
      u32x2_t nb[2][2];
#pragma unroll
      for (int bj = 0; bj < 2; ++bj)
#pragma unroll
        for (int n = 0; n < 2; ++n) nb[bj][n] = *(const u32x2_t*)(XB + (size_t)row0 * DM + col0 + bj * 128 + n * 16);
#pragma unroll
      for (int g = 0; g < 8; ++g) { const int ai = g >> 2, m = g & 3; const int row = row0 + ai * 128 + m * 16; const size_t ro = (size_t)row * DM + col0; float ss = 0.f;
        u32x2_t cbv[2][2];
#pragma unroll
        for (int bj = 0; bj < 2; ++bj)
#pragma unroll
          for (int n = 0; n < 2; ++n) cbv[bj][n] = nb[bj][n];
        if (g < 7) { const int r2 = row0 + ((g + 1) >> 2) * 128 + ((g + 1) & 3) * 16;
#pragma unroll
          for (int bj = 0; bj < 2; ++bj)
#pragma unroll
            for (int n = 0; n < 2; ++n) nb[bj][n] = *(const u32x2_t*)(XB + (size_t)r2 * DM + col0 + bj * 128 + n * 16); }
#pragma unroll
        for (int bj = 0; bj < 2; ++bj)
#pragma unroll
          for (int n = 0; n < 2; ++n) { const size_t o = ro + bj * 128 + n * 16; const u32x2_t c = cbv[bj][n];
            const f32x4 v = acc[ai][bj][m][n] + (f32x4){bflo(c.x), bfhi(c.x), bflo(c.y), bfhi(c.y)};
            if (out32) *(f32x4*)(out32 + o) = v;
            else { u32x2_t w; w.x = pk2(v[0], v[1]); w.y = pk2(v[2], v[3]); *(u32x2_t*)(XB + o) = w; ss += (v[0] * v[0] + v[1] * v[1]) + (v[2] * v[2] + v[3] * v[3]); } }
        if (!out32) { ss += __shfl_xor(ss, 16); ss += __shfl_xor(ss, 32); if (fq == 0) fx_add(SS + row, ss); }
        asm volatile("" ::: "memory"); }
    }
  }
};
struct EpiA1 {
  static constexpr bool PERM = false, AFTER_DRAIN = false, TWICE = (PROBE_EPI_ACE != 0);
  const u64* SS1; bf16_t *U, *Q, *KB; const float *qw, *kw;
  DI void operator()(const f32x4 (&acc)[2][2][4][2], const Unit& u, int wr, int wc, int fr, int fq) const {
    const int row0 = u.pm * 256 + wr * 64 + fr, lc0 = wc * 64 + 8 * fq, region = u.pn >> 1;
    u64 rsv[8];
#pragma unroll
    for (int g = 0; g < 8; ++g) rsv[g] = SS1[row0 + (g >> 2) * 128 + (g & 3) * 16];
    if (region == 0) {
#pragma unroll
      for (int g = 0; g < 8; ++g) { const int ai = g >> 2, m = g & 3; const int row = row0 + ai * 128 + m * 16; const float rs = rs1024(rsv[g]);
#pragma unroll
        for (int bj = 0; bj < 2; ++bj) { const f32x4 a = acc[ai][bj][m][0] * rs, b = acc[ai][bj][m][1] * rs; u32x4_t w;
          w.x = pk2(gelu1(a[0]), gelu1(a[1])); w.y = pk2(gelu1(a[2]), gelu1(a[3])); w.z = pk2(gelu1(b[0]), gelu1(b[1])); w.w = pk2(gelu1(b[2]), gelu1(b[3]));
          *(u32x4_t*)(U + (size_t)row * 512 + u.pn * 256 + lc0 + 32 * bj) = w; } }
    } else {
      const bool isq = region == 1; const float* wp = (isq ? qw : kw) + 8 * fq; bf16_t* dst = (isq ? Q : KB) + (u.pn & 1) * 256 + lc0; const float sc = isq ? QSCALE : 1.0f;
      f32x4 wv[2][2];
#pragma unroll
      for (int bj = 0; bj < 2; ++bj)
#pragma unroll
        for (int n = 0; n < 2; ++n) wv[bj][n] = *(const f32x4*)(wp + 32 * bj + 4 * n);
#pragma unroll
      for (int g = 0; g < 8; ++g) { const int ai = g >> 2, m = g & 3; const int row = row0 + ai * 128 + m * 16; const float rs = rs1024(rsv[g]); float ss = 0.f; f32x4 v[2][2];
#pragma unroll
        for (int bj = 0; bj < 2; ++bj)
#pragma unroll
          for (int n = 0; n < 2; ++n) { v[bj][n] = acc[ai][bj][m][n] * rs; const f32x4 t = v[bj][n]; ss += (t[0] * t[0] + t[1] * t[1]) + (t[2] * t[2] + t[3] * t[3]); }
        ss += __shfl_xor(ss, 16); ss += __shfl_xor(ss, 32);
        const float r2 = rsqrtf(ss * (1.0f / 64.0f) + EPS) * sc;
#pragma unroll
        for (int bj = 0; bj < 2; ++bj) { const f32x4 a = v[bj][0] * r2 * wv[bj][0], b = v[bj][1] * r2 * wv[bj][1]; u32x4_t w;
          w.x = pk2(a[0], a[1]); w.y = pk2(a[2], a[3]); w.z = pk2(b[0], b[1]); w.w = pk2(b[2], b[3]);
          *(u32x4_t*)(dst + (size_t)row * 512 + 32 * bj) = w; } }
    }
  }
};
struct EpiA2 {
  static constexpr bool PERM = false, AFTER_DRAIN = false, TWICE = (PROBE_EPI_ACE != 0);
  const u64* SS1; bf16_t *GVT, *VT; u64* SSV;
  DI void operator()(const f32x4 (&acc)[2][2][4][2], const Unit& u, int wr, int wc, int fr, int fq) const {
    const int colbase = u.pn * 256 + wc * 32;
    f32x4 rs[2][2];
#pragma unroll
    for (int bj = 0; bj < 2; ++bj)
#pragma unroll
      for (int n = 0; n < 2; ++n) { const u64* sp = SS1 + colbase + bj * 128 + n * 16 + 4 * fq; rs[bj][n] = (f32x4){rs1024(sp[0]), rs1024(sp[1]), rs1024(sp[2]), rs1024(sp[3])}; }
    if (u.pm < 2) {
#pragma unroll
      for (int ai = 0; ai < 2; ++ai) { const int head = 2 * u.pm + ai;
#pragma unroll
        for (int bj = 0; bj < 2; ++bj)
#pragma unroll
          for (int n = 0; n < 2; ++n) { f32x4 sq = (f32x4){0.f, 0.f, 0.f, 0.f}; const int tok = colbase + bj * 128 + n * 16 + 4 * fq;
#pragma unroll
            for (int m = 0; m < 4; ++m) { const int row = u.pm * 256 + ai * 128 + wr * 64 + m * 16 + fr;
              const f32x4 a = acc[ai][bj][m][n] * rs[bj][n]; f32x4 g; g[0] = gelu1(a[0]); g[1] = gelu1(a[1]); g[2] = gelu1(a[2]); g[3] = gelu1(a[3]);
              u32x2_t w; w.x = pk2(g[0], g[1]); w.y = pk2(g[2], g[3]); *(u32x2_t*)(GVT + (size_t)row * T_TOK + tok) = w; sq += g * g; }
#pragma unroll
            for (int e = 0; e < 4; ++e) { float s = sq[e]; s += __shfl_xor(s, 1); s += __shfl_xor(s, 2); s += __shfl_xor(s, 4); s += __shfl_xor(s, 8); sq[e] = s; }
            if (fr == 0) {
#pragma unroll
              for (int e = 0; e < 4; ++e) fx_add(SSV + (size_t)(tok + e) * 4 + head, sq[e]); }
            asm volatile("" ::: "memory"); } }
    } else {
#pragma unroll
      for (int ai = 0; ai < 2; ++ai)
#pragma unroll
        for (int m = 0; m < 4; ++m) { const int row = (u.pm - 2) * 256 + ai * 128 + wr * 64 + m * 16 + fr;
#pragma unroll
          for (int bj = 0; bj < 2; ++bj)
#pragma unroll
            for (int n = 0; n < 2; ++n) { const f32x4 a = acc[ai][bj][m][n] * rs[bj][n]; u32x2_t w; w.x = pk2(a[0], a[1]); w.y = pk2(a[2], a[3]);
              *(u32x2_t*)(VT + (size_t)row * T_TOK + colbase + bj * 128 + n * 16 + 8 * (fq & 1) + 4 * (fq >> 1)) = w; } }
    }
  }
};
struct EpiD {
  static constexpr bool PERM = false, AFTER_DRAIN = false, TWICE = (PROBE_EPI_D != 0);
  const u64* SS2; const float *cw, *cb; bf16_t* F; float *GB, *PB, *UB;
  DI void operator()(const f32x4 (&acc)[2][2][4][2], const Unit& u, int wr, int wc, int fr, int fq) const {
    const int cbase = u.pn * 128 + wc * 32 + 8 * fq;
    const int rb0 = u.pm * 256 + wr * 64;
    u64 rsv[8]; f32x4 w0[2], w1[2], w2[2], bb[2];
#pragma unroll
    for (int g = 0; g < 8; ++g) rsv[g] = SS2[rb0 + (g >> 2) * 128 + (g & 3) * 16 + fr];
#pragma unroll
    for (int n = 0; n < 2; ++n) { w0[n] = *(const f32x4*)(cw + cbase + 4 * n); w1[n] = *(const f32x4*)(cw + DFF + cbase + 4 * n); w2[n] = *(const f32x4*)(cw + 2 * DFF + cbase + 4 * n); bb[n] = *(const f32x4*)(cb + cbase + 4 * n); }
#pragma unroll
    for (int ai = 0; ai < 2; ++ai) {
      const int rb = rb0 + ai * 128, bd = rb >> 6;
      float rs[4];
#pragma unroll
      for (int m = 0; m < 4; ++m) rs[m] = rs1024(rsv[ai * 4 + m]);
      unsigned fo[4][4];
#pragma unroll
      for (int n = 0; n < 2; ++n) {
        const int cn = cbase + 4 * n;
        f32x4 pg, ug, gg; float fv[4][4];
#pragma unroll
        for (int e = 0; e < 4; ++e) {
          float G[4], r1[4], r2[4];
#pragma unroll
          for (int m = 0; m < 4; ++m) { G[m] = acc[ai][0][m][n][e] * rs[m]; r1[m] = dpp_ror1(G[m]); r2[m] = dpp_ror2(G[m]); }
#pragma unroll
          for (int m = 0; m < 4; ++m) {
            const float p1 = (fr >= 1) ? r1[m] : (m > 0 ? r1[m > 0 ? m - 1 : 0] : 0.f);
            const float p2 = (fr >= 2) ? r2[m] : (m > 0 ? r2[m > 0 ? m - 1 : 0] : 0.f);
            const float g = w2[n][e] * G[m] + w1[n][e] * p1 + w0[n][e] * p2 + bb[n][e];
            const float uv = acc[ai][1][m][n][e] * rs[m];
            if (m == 0) { pg[e] = g; ug[e] = uv; }
            if (m == 3) gg[e] = G[3];
            fv[m][e] = g * __builtin_amdgcn_rcpf(1.0f + __expf(-g)) * uv;
          }
        }
#pragma unroll
        for (int m = 0; m < 4; ++m) { fo[m][2 * n] = pk2(fv[m][0], fv[m][1]); fo[m][2 * n + 1] = pk2(fv[m][2], fv[m][3]); }
        if (fr < 2) { *(f32x4*)(PB + (size_t)(bd * 2 + fr) * DFF + cn) = pg; *(f32x4*)(UB + (size_t)(bd * 2 + fr) * DFF + cn) = ug; }
        if (fr >= 14) { *(f32x4*)(GB + (size_t)(bd * 2 + fr - 14) * DFF + cn) = gg; }
      }
#pragma unroll
      for (int m = 0; m < 4; ++m) {
        if (!(m == 0 && fr < 2)) { u32x4_t w; w.x = fo[m][0]; w.y = fo[m][1]; w.z = fo[m][2]; w.w = fo[m][3]; *(u32x4_t*)(F + (size_t)(rb + 16 * m + fr) * DFF + cbase) = w; }
      }
    }
  }
};
DI void fixup_panel(const float* conv_w, unsigned char* ws, int pm, int tid) {
  const float *GB = (const float*)(ws + OFF_GB), *PB = (const float*)(ws + OFF_PB), *UB = (const float*)(ws + OFF_UB); bf16_t* F = (bf16_t*)(ws + OFF_F);
#pragma unroll 1
  for (int k0 = 0; k0 < 11; k0 += 4) {
    f32x4 g[4], gm1[4], gm2[4], uv[4], w0[4], w1[4]; int cc[4], jj[4], bb[4];
#pragma unroll
    for (int k = 0; k < 4; ++k) { const int w = tid + 512 * (k0 + k < 11 ? k0 + k : 10); const int c = (w % 704) * 4, j = (w / 704) & 1, bd = pm * 4 + w / 1408; cc[k] = c; jj[k] = j; bb[k] = bd;
      const int bp = (bd & 31) ? bd - 1 : bd;
      g[k] = *(const f32x4*)(PB + (size_t)(bd * 2 + j) * DFF + c); uv[k] = *(const f32x4*)(UB + (size_t)(bd * 2 + j) * DFF + c);
      gm1[k] = *(const f32x4*)(GB + (size_t)(bp * 2 + 1) * DFF + c); gm2[k] = *(const f32x4*)(GB + (size_t)(bp * 2) * DFF + c);
      w0[k] = *(const f32x4*)(conv_w + c); w1[k] = *(const f32x4*)(conv_w + DFF + c); }
#pragma unroll
    for (int k = 0; k < 4; ++k) if (k0 + k < 11) { f32x4 gg = g[k];
      if (bb[k] & 31) { if (jj[k] == 0) gg += w1[k] * gm1[k] + w0[k] * gm2[k]; else gg += w0[k] * gm1[k]; }
      float f[4];
#pragma unroll
      for (int e = 0; e < 4; ++e) f[e] = gg[e] * __builtin_amdgcn_rcpf(1.0f + __expf(-gg[e])) * uv[k][e];
      u32x2_t o; o.x = pk2(f[0], f[1]); o.y = pk2(f[2], f[3]);
      *(u32x2_t*)(F + (size_t)(bb[k] * 64 + jj[k]) * DFF + cc[k]) = o; }
  }
}

DI void spatial_phase(const LP& lp, unsigned char* ws, LAS unsigned char* lds) {
  const bf16_t *U = (const bf16_t*)(ws + OFF_U), *GVT = (const bf16_t*)(ws + OFF_GVT); const u64* SSV = (const u64*)(ws + OFF_SSV); bf16_t* MIX = (bf16_t*)(ws + OFF_MIX);
  LAS float* sr = (LAS float*)lds;
  const int tid = tid_opaque(), lane = tid & 63, w = __builtin_amdgcn_readfirstlane(tid >> 6), l15 = lane & 15, kq = lane >> 4;
  for (int it = blockIdx.x; it < 1024; it += gridDim.x) {
    const int h = it & 3, tok0 = (it >> 2) * 128;
    if (tid < 128) sr[tid] = rsqrtf(fx2f(SSV[(size_t)(tok0 + tid) * 4 + h]) * (1.0f / 128.0f) + EPS);
    __syncthreads();
    const int i0 = 16 * w, nks = (w < 4) ? 2 : 4, irow = tok0 + i0 + l15;
    bf16x8 yf[4];
#pragma unroll
    for (int ks = 0; ks < 4; ++ks) {
      u32x4_t o = (u32x4_t){0u, 0u, 0u, 0u};
      if (ks < nks) { const u32x4_t raw = *(const u32x4_t*)(lp.Wsp + (size_t)(h * 128 + i0 + l15) * 128 + ks * 32 + kq * 8);
        const LAS float* s = sr + ks * 32 + kq * 8;
        o.x = pk2(bflo(raw.x) * s[0], bfhi(raw.x) * s[1]); o.y = pk2(bflo(raw.y) * s[2], bfhi(raw.y) * s[3]); o.z = pk2(bflo(raw.z) * s[4], bfhi(raw.z) * s[5]); o.w = pk2(bflo(raw.w) * s[6], bfhi(raw.w) * s[7]); }
      yf[ks] = __builtin_bit_cast(bf16x8, o);
    }
    const float bias = lp.sp_b[h * 128 + i0 + l15];
    float o[8][4]; float ss = 0.f;
#pragma unroll
    for (int dt = 0; dt < 8; ++dt) {
      f32x4 acc = (f32x4){0.f, 0.f, 0.f, 0.f};
#pragma unroll
      for (int ks = 0; ks < 4; ++ks) if (ks < nks) {
        const bf16x8 xf = *(const bf16x8*)(GVT + (size_t)(h * 128 + 16 * dt + l15) * T_TOK + tok0 + ks * 32 + kq * 8);
        acc = __builtin_amdgcn_mfma_f32_16x16x32_bf16(xf, yf[ks], acc, 0, 0, 0); }
      const int d0 = 16 * dt + 4 * kq; const f32x4 wv = *(const f32x4*)(lp.v_norm_w + h * 128 + d0);
      const u32x2_t ur = *(const u32x2_t*)(U + (size_t)irow * 512 + h * 128 + d0);
      o[dt][0] = bflo(ur.x) * (acc[0] * wv[0] + bias); o[dt][1] = bfhi(ur.x) * (acc[1] * wv[1] + bias); o[dt][2] = bflo(ur.y) * (acc[2] * wv[2] + bias); o[dt][3] = bfhi(ur.y) * (acc[3] * wv[3] + bias);
      ss += (o[dt][0] * o[dt][0] + o[dt][1] * o[dt][1]) + (o[dt][2] * o[dt][2] + o[dt][3] * o[dt][3]);
    }
    ss += __shfl_xor(ss, 16); ss += __shfl_xor(ss, 32);
    const float rs = rsqrtf(ss * (1.0f / 128.0f) + EPS);
#pragma unroll
    for (int dt = 0; dt < 8; ++dt) { const int d0 = 16 * dt + 4 * kq; const f32x4 wo = *(const f32x4*)(lp.out_norm_w + h * 128 + d0);
      u32x2_t q; q.x = pk2(o[dt][0] * rs * wo[0], o[dt][1] * rs * wo[1]); q.y = pk2(o[dt][2] * rs * wo[2], o[dt][3] * rs * wo[3]);
      *(u32x2_t*)(MIX + (size_t)irow * 1024 + h * 128 + d0) = q; }
    __syncthreads();
  }
}

DI void attn_phase(const MParams& p, int l, LAS unsigned char* lds) {
  unsigned char* ws = p.ws;
  const bf16_t *Q = (const bf16_t*)(ws + OFF_Q), *KB = (const bf16_t*)(ws + OFF_KB), *VT = (const bf16_t*)(ws + OFF_VT); bf16_t* MIX = (bf16_t*)(ws + OFF_MIX);
  constexpr int KBUF = 16384, VBUF = 16384, STG = KBUF + VBUF, QOFF = 2 * STG;
  static_assert(QOFF + 65536 <= LDS_BYTES, "attention LDS");
  const float lambda_init = 0.8f - 0.6f * expf(-0.3f * (float)(l + 1));
  const float* dnw = p.in[13] + l * 128;
#pragma unroll 1
  for (int pi = blockIdx.x; pi < 256; pi += gridDim.x) {
    const int b = pi >> 4, h = (pi >> 2) & 3, j = pi & 3;
#pragma unroll 1
    for (int it = 0; it < 2; ++it) {
      const int tid = tid_opaque(), lane = tid & 63, w = __builtin_amdgcn_readfirstlane(tid >> 6), l31 = lane & 31, hh = lane >> 5;
      const int qb = it ? j : 7 - j, t0 = b * 2048 + 256 * qb, ntl = 4 * qb + 4, ntw = 4 * qb + (w >> 1) + 1;
#pragma unroll
      for (int i = 0; i < 8; ++i) { const int P = (w * 8 + i) * 64 + lane, row = P >> 4, pos = P & 15, pc = pos ^ (row & 15);
        __builtin_amdgcn_global_load_lds((const unsigned*)(Q + (size_t)(t0 + row) * 512 + h * 128 + pc * 8), (LAS unsigned*)(lds + QOFF + (w * 8 + i) * 1024), 16, 0, 0); }
      const bf16_t* kbase = KB + (size_t)(b * 2048) * 512 + h * 128; const bf16_t* vbase = VT + (size_t)(h * 128) * T_TOK + b * 2048;
      int koff[2], voff[2];
#pragma unroll
      for (int i = 0; i < 2; ++i) { const int P = (w * 2 + i) * 64 + lane; { const int row = P >> 4, pos = P & 15, pc = pos ^ (row & 15); koff[i] = row * 512 + pc * 8; }
        { const int row = P >> 3, pos = P & 7, pc = pos ^ ((row >> 1) & 7); voff[i] = row * T_TOK + pc * 8; } }
#define ATT_STAGE(kt, buf) do { _Pragma("unroll") for (int i = 0; i < 2; ++i) { \
        __builtin_amdgcn_global_load_lds((const unsigned*)(kbase + (size_t)(kt) * (64 * 512) + koff[i]), (LAS unsigned*)(lds + (buf) * STG + (w * 2 + i) * 1024), 16, 0, 0); \
        __builtin_amdgcn_global_load_lds((const unsigned*)(vbase + (kt) * 64 + voff[i]), (LAS unsigned*)(lds + (buf) * STG + KBUF + (w * 2 + i) * 1024), 16, 0, 0); } } while (0)
      ATT_STAGE(0, 0);
      asm volatile("s_waitcnt vmcnt(0)" ::: "memory");
      __syncthreads();
      f32x16 O[2][4];
#pragma unroll
      for (int c = 0; c < 2; ++c)
#pragma unroll
        for (int bk = 0; bk < 4; ++bk)
#pragma unroll
          for (int i = 0; i < 16; ++i) O[c][bk][i] = 0.f;
      float lsum[2] = {0.f, 0.f};
      const int qr = 32 * w + l31;
      int k_lane = l31 * 256 + ((hh ^ (l31 & 15)) << 4), q_lane = QOFF + qr * 256 + ((hh ^ (qr & 15)) << 4), v_lane = KBUF + l31 * 128 + ((hh ^ ((l31 >> 1) & 7)) << 4);
#pragma unroll 1
      for (int kt = 0; kt < ntl; ++kt) {
        if (kt + 1 < ntl) ATT_STAGE(kt + 1, (kt + 1) & 1);
        if (kt < ntw) {
          asm volatile("" : "+v"(k_lane), "+v"(q_lane), "+v"(v_lane));
          const LAS unsigned char* tb = lds + (kt & 1) * STG;
#pragma unroll
          for (int kb = 0; kb < 2; ++kb) {
            bf16x8 pf[2][2];
#pragma unroll
            for (int c = 0; c < 2; ++c) {
              f32x16 S;
#pragma unroll
              for (int i = 0; i < 16; ++i) S[i] = 0.f;
#pragma unroll
              for (int ks = 0; ks < 4; ++ks) {
                const int xo = (c * 8 + ks * 2) << 4;
                const bf16x8 qf = *(const LAS bf16x8*)(lds + (q_lane ^ xo));
                const bf16x8 kf = *(const LAS bf16x8*)(tb + (k_lane ^ xo) + kb * 8192);
                S = __builtin_amdgcn_mfma_f32_32x32x16_bf16(kf, qf, S, 0, 0, 0);
              }
              float ls = 0.f;
#pragma unroll
              for (int hs = 0; hs < 2; ++hs) { u32x4_t pw;
#pragma unroll
                for (int t = 0; t < 4; ++t) { const float a = __builtin_amdgcn_exp2f(S[8 * hs + 2 * t]), bq = __builtin_amdgcn_exp2f(S[8 * hs + 2 * t + 1]); ls += a + bq; pw[t] = pk2(a, bq); }
                pf[c][hs] = __builtin_bit_cast(bf16x8, pw); }
              lsum[c] += ls;
              __builtin_amdgcn_sched_barrier(0);
            }
#pragma unroll
            for (int bk = 0; bk < 4; ++bk) {
              const bf16x8 v0 = *(const LAS bf16x8*)(tb + (v_lane ^ ((2 * kb) << 5)) + bk * 4096);
              const bf16x8 v1 = *(const LAS bf16x8*)(tb + (v_lane ^ ((2 * kb + 1) << 5)) + bk * 4096);
              O[0][bk] = __builtin_amdgcn_mfma_f32_32x32x16_bf16(v0, pf[0][0], O[0][bk], 0, 0, 0);
              O[1][bk] = __builtin_amdgcn_mfma_f32_32x32x16_bf16(v0, pf[1][0], O[1][bk], 0, 0, 0);
              O[0][bk] = __builtin_amdgcn_mfma_f32_32x32x16_bf16(v1, pf[0][1], O[0][bk], 0, 0, 0);
              O[1][bk] = __builtin_amdgcn_mfma_f32_32x32x16_bf16(v1, pf[1][1], O[1][bk], 0, 0, 0);
              __builtin_amdgcn_sched_barrier(0);
            }
          }
        }
        asm volatile("s_waitcnt vmcnt(0)" ::: "memory");
        __syncthreads();
      }
#undef ATT_STAGE
      const int tid2 = tid_opaque(), lane2 = tid2 & 63, w2 = __builtin_amdgcn_readfirstlane(tid2 >> 6), hh2 = lane2 >> 5, qr2 = 32 * w2 + (lane2 & 31);
      float lam;
      { const float* q1 = p.in[9] + l * 64; const float* k1 = p.in[10] + l * 64; const float* q2 = p.in[11] + l * 64; const float* k2 = p.in[12] + l * 64;
        float a = q1[lane2] * k1[lane2], bq = q2[lane2] * k2[lane2]; a = wave_sum(a); bq = wave_sum(bq); lam = expf(a) - expf(bq) + lambda_init; }
      float l1 = lsum[0], l2 = lsum[1]; l1 += __shfl_xor(l1, 32); l2 += __shfl_xor(l2, 32);
      const float inv1 = 1.0f / l1, inv2 = lam / l2; float ss = 0.f;
#pragma unroll
      for (int bk = 0; bk < 4; ++bk)
#pragma unroll
        for (int i = 0; i < 16; ++i) { const float o = O[0][bk][i] * inv1 - O[1][bk][i] * inv2; O[0][bk][i] = o; ss += o * o; }
      ss += __shfl_xor(ss, 32);
      const float rs = rsqrtf(ss * (1.0f / 128.0f) + EPS) * (1.0f - lambda_init);
      bf16_t* orow = MIX + (size_t)(t0 + qr2) * 1024 + 512 + h * 128;
#pragma unroll
      for (int bk = 0; bk < 4; ++bk)
#pragma unroll
        for (int g = 0; g < 4; ++g) { const int dv0 = 32 * bk + 8 * g + 4 * hh2; const f32x4 wv = *(const f32x4*)(dnw + dv0);
          u32x2_t q; q.x = pk2(O[0][bk][4 * g] * rs * wv[0], O[0][bk][4 * g + 1] * rs * wv[1]); q.y = pk2(O[0][bk][4 * g + 2] * rs * wv[2], O[0][bk][4 * g + 3] * rs * wv[3]);
          *(u32x2_t*)(orow + dv0) = q; }
    }
  }
}


#define XB_TMO      128
#define XB_XCNT(j)  (256  + 64 * (j))
#define XB_XSUB(j)  (1280 + 64 * (j))
#define XB_XGEN(j)  (2304 + 64 * (j))
#define XB_TOP      3328
#define XB_TOPGEN   3392
#define XCD_BAR_WORDS 3456
#define XB_SPIN_CAP (1u << 18)

__device__ __forceinline__ unsigned xb_ld(unsigned* p)              { return __hip_atomic_load(p, __ATOMIC_RELAXED, __HIP_MEMORY_SCOPE_AGENT); }
__device__ __forceinline__ unsigned xb_add(unsigned* p, unsigned v) { return __hip_atomic_fetch_add(p, v, __ATOMIC_RELAXED, __HIP_MEMORY_SCOPE_AGENT); }
__device__ __forceinline__ unsigned xb_xcc_id() { return (unsigned)__builtin_amdgcn_s_getreg((3 << 11) | 20) & 0xFu; }
#define XB_SPIN(cond, bar) do { unsigned _sp = 0; while (cond) { __builtin_amdgcn_s_sleep(1); \
    if ((++_sp & 255u) == 0u) { if (xb_ld(&(bar)[XB_TMO])) break; if (_sp > XB_SPIN_CAP) { atomicAdd(&(bar)[XB_TMO], 1u); break; } } } } while (0)

struct XcdBarrier {
    unsigned* bar; unsigned x;
    volatile LAS unsigned* st;
};

__device__ __forceinline__ XcdBarrier xcd_barrier_post(unsigned* bar, volatile LAS unsigned* st) {
    XcdBarrier b; b.bar = bar; b.x = xb_xcc_id(); b.st = st;
    if (threadIdx.x == 0) (void)xb_add(&bar[XB_XCNT(b.x)], 1u);
    return b;
}
__device__ __forceinline__ void xcd_barrier_complete(unsigned* bar, unsigned x, unsigned& nloc, unsigned& nx) {
    const unsigned G = gridDim.x * gridDim.y * gridDim.z;
    unsigned sum, cnt, mine, sp = 0u;
    for (;;) {
        sum = 0u; cnt = 0u; mine = 0u;
#pragma unroll
        for (unsigned j = 0; j < 16; ++j) { const unsigned c = xb_ld(&bar[XB_XCNT(j)]); sum += c; cnt += (c > 0u) ? 1u : 0u; mine = (j == x) ? c : mine; }
        if (sum == G) break;
        __builtin_amdgcn_s_sleep(1);
        if ((++sp & 255u) == 0u) { if (xb_ld(&bar[XB_TMO])) break; if (sp > XB_SPIN_CAP) { atomicAdd(&bar[XB_TMO], 1u); break; } }
    }
    nloc = mine > 0u ? mine : 1u; nx = cnt > 0u ? cnt : 1u;
}

__device__ __forceinline__ void xcd_barrier(const XcdBarrier& b) {
    asm volatile("s_waitcnt vmcnt(0)" ::: "memory");
    __syncthreads();
    if (threadIdx.x == 0) {
        unsigned* bar = b.bar;
        __builtin_amdgcn_s_waitcnt(0);
        unsigned nloc = b.st[0], nx = b.st[1];
        if (nloc == 0u) { xcd_barrier_complete(bar, b.x, nloc, nx); b.st[0] = nloc; b.st[1] = nx; }
        const unsigned old = xb_add(&bar[XB_XSUB(b.x)], 1u);
        const unsigned gen = old / nloc;
        if (old + 1u == (gen + 1u) * nloc) {
            __builtin_amdgcn_fence(__ATOMIC_RELEASE, "agent");
            asm volatile("s_waitcnt vmcnt(0)" ::: "memory");
            const unsigned og = xb_add(&bar[XB_TOP], 1u);
            const unsigned tg = og / nx;
            if (og + 1u == (tg + 1u) * nx) xb_add(&bar[XB_TOPGEN], 1u);
            else XB_SPIN(xb_ld(&bar[XB_TOPGEN]) == tg, bar);
            __builtin_amdgcn_fence(__ATOMIC_ACQUIRE, "agent");
            xb_add(&bar[XB_XGEN(b.x)], 1u);
            asm volatile("s_waitcnt vmcnt(0)" ::: "memory");
        } else {
            XB_SPIN(xb_ld(&bar[XB_XGEN(b.x)]) == gen, bar);
            __builtin_amdgcn_fence(__ATOMIC_ACQUIRE, "agent");
            asm volatile("s_waitcnt vmcnt(0)" ::: "memory");
        }
    }
    __syncthreads();
}

DI void zero_u64(u64* p, int n) { for (int i = blockIdx.x * 512 + tid_opaque(); i < n; i += gridDim.x * 512) p[i] = 0ull; }

#if PROBE_EPI_ACE
typedef DupOrder OrderACE;
#else
typedef pg8::StaticOrder OrderACE;
#endif
DI void phaseA(const MParams& p, int l, LAS unsigned char* lds) {
  unsigned char* ws = p.ws; const bf16_t* XB = (const bf16_t*)(ws + OFF_XB); const bf16_t* WinT = (const bf16_t*)(ws + OFF_W + (size_t)l * W_STRIDE + WO_IN); const u64* SS1 = (const u64*)(ws + OFF_SS1);
  zero_u64((u64*)(ws + OFF_SS2), T_TOK);
  { pg8::Gemm g{XB, WinT, T_TOK, 1536, DM}; OrderACE S; S.init(T_TOK, 1536, gridDim.x, blockIdx.x);
    EpiA1 E{SS1, (bf16_t*)(ws + OFF_U), (bf16_t*)(ws + OFF_Q), (bf16_t*)(ws + OFF_KB), p.in[7] + l * 64, p.in[8] + l * 64}; pg8::gemm_phase<EpiA1, OrderACE>(lds, g, S, E); }
  { pg8::Gemm g{WinT + (size_t)1536 * DM, XB, 1024, T_TOK, DM}; OrderACE S; S.init(1024, T_TOK, gridDim.x, blockIdx.x);
    EpiA2 E{SS1, (bf16_t*)(ws + OFF_GVT), (bf16_t*)(ws + OFF_VT), (u64*)(ws + OFF_SSV)}; pg8::gemm_phase<EpiA2, OrderACE>(lds, g, S, E); }
}
DI void phaseCE(const MParams& p, int l, bool isC, LAS unsigned char* lds) {
  unsigned char* ws = p.ws; const unsigned char* wb = ws + OFF_W + (size_t)l * W_STRIDE;
  if (isC) zero_u64((u64*)(ws + OFF_SS1), T_TOK);
  pg8::Gemm g{(const bf16_t*)(ws + (isC ? OFF_MIX : OFF_F)), (const bf16_t*)(wb + (isC ? WO_OUT : WO_DN)), T_TOK, DM, isC ? DM : DFF}; OrderACE S; S.init(T_TOK, DM, gridDim.x, blockIdx.x);
  if (!isC) { const int tid = tid_opaque(); Unit uu; for (int i = 0; S.next(i, uu); ++i) fixup_panel(p.in[18] + (size_t)l * 3 * DFF, ws, uu.pm, tid);
    asm volatile("s_waitcnt vmcnt(0)" ::: "memory"); __syncthreads(); }
  EpiResid E{(isC && l == 0) ? p.in[0] : nullptr, (!isC && l == NLAYER - 1) ? p.out : nullptr, (bf16_t*)(ws + OFF_XB), (u64*)(ws + (isC ? OFF_SS2 : OFF_SS1))}; pg8::gemm_phase<EpiResid, OrderACE>(lds, g, S, E);
}
DI void phaseD(const MParams& p, int l, LAS unsigned char* lds) {
  unsigned char* ws = p.ws;
  zero_u64((u64*)(ws + OFF_SSV), T_TOK * 4);
  pg8::Gemm g{(const bf16_t*)(ws + OFF_XB), (const bf16_t*)(ws + OFF_W + (size_t)l * W_STRIDE + WO_GU), T_TOK, 2 * DFF, DM};
#if PROBE_EPI_D
  DupOrder S;
#else
  pg8::StaticOrder S;
#endif
  S.init(T_TOK, 2 * DFF, gridDim.x, blockIdx.x);
  EpiD E{(const u64*)(ws + OFF_SS2), p.in[18] + (size_t)l * 3 * DFF, p.in[19] + (size_t)l * DFF, (bf16_t*)(ws + OFF_F), (float*)(ws + OFF_GB), (float*)(ws + OFF_PB), (float*)(ws + OFF_UB)};
#if PROBE_EPI_D
  pg8::gemm_phase<EpiD, DupOrder>(lds, g, S, E);
#else
  pg8::gemm_phase<EpiD, pg8::StaticOrder>(lds, g, S, E);
#endif
}

__global__ void __launch_bounds__(512) k_run(MParams p) {
  extern __shared__ __attribute__((aligned(16))) unsigned char lds_raw[];
  LAS unsigned char* lds = (LAS unsigned char*)lds_raw;
  cg::grid_group grid = cg::this_grid();
  if (threadIdx.x < 4) ((LAS unsigned*)(lds + 131072))[threadIdx.x] = 0u;
  __syncthreads();
  XcdBarrier xbar = xcd_barrier_post((unsigned*)(p.ws + OFF_BAR), (volatile LAS unsigned*)(lds + 131072));
  if (p.ph_lo < 0) grid.sync();
  for (int ph = p.ph_lo; ph < p.ph_hi; ++ph) {
    if (ph == 0) prologue(p);
    else {
      const int l = (ph - 1) / 5, s = (ph - 1) % 5;
      if (s == 0) phaseA(p, l, lds);
      else if (s == 1) { attn_phase(p, l, lds); const LP lp = make_lp(p, l); spatial_phase(lp, p.ws, lds); }
      else if (s == 2 || s == 4) phaseCE(p, l, s == 2, lds);
      else phaseD(p, l, lds);
    }
    if (ph + 1 < p.ph_hi) xcd_barrier(xbar);
  }
}

extern "C" void kernel_launch(void* const* d_in, const int* in_sizes, int n_in, void* d_out, int out_size, void* d_ws, size_t ws_size, hipStream_t stream) {
  static int grid_blocks = 0;
  if (!grid_blocks) {
    (void)hipFuncSetAttribute((const void*)k_run, hipFuncAttributeMaxDynamicSharedMemorySize, LDS_BYTES);
    int dev = 0, cus = 0, per_cu = 0; (void)hipGetDevice(&dev); (void)hipDeviceGetAttribute(&cus, hipDeviceAttributeMultiprocessorCount, dev);
    (void)hipOccupancyMaxActiveBlocksPerMultiprocessor(&per_cu, (const void*)k_run, 512, LDS_BYTES); if (per_cu < 1) per_cu = 1;
    grid_blocks = cus * per_cu; if (grid_blocks > 256) grid_blocks = 256;
  }
  MParams mp; memset(&mp, 0, sizeof(mp));
  for (int i = 0; i < 21; ++i) mp.in[i] = (const float*)d_in[i];
  mp.out = (float*)d_out; mp.ws = (unsigned char*)d_ws; mp.ph_lo = 0; mp.ph_hi = 1 + 5 * NLAYER;
  (void)hipMemsetAsync((unsigned char*)d_ws + OFF_BAR, 0, 3456 * sizeof(unsigned), stream);
  void* args[] = {&mp};
  hipError_t e = hipLaunchCooperativeKernel((const void*)k_run, dim3(grid_blocks), dim3(512), args, LDS_BYTES, stream);
  if (e != hipSuccess) fprintf(stderr, "cooperative launch failed: %s (grid %d)\n", hipGetErrorString(e), grid_blocks);
}
```

```cpp
#include <hip/hip_runtime.h>
#include <hip/hip_cooperative_groups.h>
#include <cstdio>
#include <cmath>
#include <cstring>

typedef unsigned short bf16_t;
#define DI __device__ __forceinline__

constexpr int T_TOK = 32768, DM = 1024, SEQ = 2048, DFF = 2816, INW = 2560, NLAYER = 4;
constexpr float EPS = 1e-6f;
constexpr float QSCALE = 0.125f * 1.4426950408889634f;

constexpr size_t MiB = 1024ull * 1024ull;
constexpr size_t OFF_XB = 0;
constexpr size_t OFF_R = 64 * MiB;
constexpr size_t OFF_U = OFF_R, OFF_Q = OFF_R + 32 * MiB, OFF_KB = OFF_R + 64 * MiB, OFF_GVT = OFF_R + 96 * MiB, OFF_VT = OFF_R + 128 * MiB, OFF_MIX = OFF_R + 160 * MiB;
constexpr size_t OFF_F = OFF_R, OFF_GB = OFF_R + 176 * MiB, OFF_PB = OFF_R + 188 * MiB, OFF_UB = OFF_R + 200 * MiB;
constexpr size_t OFF_W = 288 * MiB, W_STRIDE = 24 * MiB;
constexpr size_t WO_IN = 0, WO_OUT = 5 * MiB, WO_GU = 7 * MiB, WO_DN = 18 * MiB, WO_SP = 23 * MiB + 512 * 1024;
constexpr size_t OFF_SS1 = 384 * MiB, OFF_SS2 = OFF_SS1 + 256 * 1024, OFF_SSV = OFF_SS2 + 256 * 1024;
constexpr size_t OFF_BAR = 385 * MiB + 512 * 1024;
constexpr size_t OFF_TMP1 = 386 * MiB, OFF_TMP2 = 418 * MiB;

DI int tid_opaque() { int t = threadIdx.x; asm volatile("" : "+v"(t)); return t; }
DI float bf2f(bf16_t b) { return __uint_as_float(((unsigned)b) << 16); }
DI bf16_t f2bf(float f) { unsigned u = __float_as_uint(f); u += 0x7FFFu + ((u >> 16) & 1u); return (bf16_t)(u >> 16); }
DI float gelu_exact(float x) { return 0.5f * x * (1.0f + erff(x * 0.70710678118654752f)); }
DI int permpos16(int k) { return (k & 3) + 4 * (k >> 3) + 8 * ((k >> 2) & 1); }
DI float wave_sum(float v) { for (int o = 32; o >= 1; o >>= 1) v += __shfl_xor(v, o); return v; }

namespace pg8 {
#define PG8_LAS __attribute__((address_space(3)))
typedef unsigned short bf16_t;
typedef short bf16x8 __attribute__((ext_vector_type(8)));
typedef float f32x4 __attribute__((ext_vector_type(4)));
typedef unsigned u32x4 __attribute__((ext_vector_type(4)));
constexpr int BM = 256, BK = 64, HALF = 128, HTB = HALF * BK * 2  , STAGE_BYTES = 8 * HTB, NXCD = 8, WGM = 8;

__host__ __device__ __forceinline__ int lds_byte(int r, int c) { const int st = (r >> 4) * 2 + (c >> 5), rr = r & 15, cc = c & 31, ob = rr * 64 + cc * 2; return st * 1024 + (ob ^ (((ob >> 9) & 1) << 5)); }
__host__ __device__ __forceinline__ void stage_rc(int b, int& R, int& C) { const int st = b / 1024, sb = b % 1024, swz = sb ^ (((sb >> 9) & 1) << 5); R = (st >> 1) * 16 + swz / 64; C = (st & 1) * 32 + (swz % 64) / 2; }
__host__ __device__ __forceinline__ int perm32(int rho) { const int n = rho >> 4, i = rho & 15; return 8 * (i >> 2) + 4 * n + (i & 3); }

struct Unit { int pm, pn; };
struct Gemm { const bf16_t* A; const bf16_t* Bt; int M, N, K; };

struct StaticOrder {
    int nM, nN, nwg, G, c;
    __host__ __device__ void init(int M, int N, int G_, int c_) { nM = M / BM; nN = N / BM; nwg = nM * nN; G = G_; c = c_; }
    __host__ __device__ bool next(int i, Unit& u) const {
        const long L = (long)i * G + c; if (L >= nwg) return false;
        int wgid = (int)L; { const int q = nwg / NXCD, r = nwg % NXCD, xcd = wgid % NXCD, off = wgid / NXCD; wgid = (xcd < r ? xcd * (q + 1) : r * (q + 1) + (xcd - r) * q) + off; }
        const int nig = WGM * nN, gid = wgid / nig, fm = gid * WGM, gsz = (nM - fm) < WGM ? (nM - fm) : WGM;
        u.pm = fm + ((wgid % nig) % gsz); u.pn = (wgid % nig) / gsz; return true;
    }
    __device__ __forceinline__ void a_ready(const Unit&) const {}
    __device__ __forceinline__ void done(const Unit&) const {}
};
template <class Epi, class Sched>
__device__ __forceinline__ void gemm_phase(PG8_LAS unsigned char* lds, const Gemm g, const Sched& S, const Epi& E) {
    const int tid = tid_opaque(), wid = __builtin_amdgcn_readfirstlane(tid >> 6), lane = tid & 63, wr = wid >> 2, wc = wid & 3, fr = lane & 15, fq = lane >> 4;
    const int K = g.K, nt = K / BK;
    unsigned voffA[2], voffB[2];
#pragma unroll
    for (int i = 0; i < 2; ++i) { int R, C; stage_rc(tid * 16 + i * 8192, R, C); const int Rb = Epi::PERM ? ((R & ~31) + perm32(R & 31)) : R;
        voffA[i] = (unsigned)(R * K + C) * 2u; voffB[i] = (unsigned)(Rb * K + C) * 2u; }
    const size_t kstep = (size_t)(BK * 2);
    const size_t hstep = (size_t)HALF * K * 2;
    const size_t tstep = 2 * hstep;
    const unsigned ldsw = (unsigned)wid * 1024u;
    const int aoff = lds_byte(wr * 64 + fr, fq * 8), boff = lds_byte(wc * 32 + fr, fq * 8);
#define PG8_SA(b, h) (((b) * 2 + (h)) * HTB)
#define PG8_SB(b, h) ((4 + (b) * 2 + (h)) * HTB)
#define PG8_STAGE(bufoff, gbase, voff) do { _Pragma("unroll") for (int _i = 0; _i < 2; ++_i) \
        __builtin_amdgcn_global_load_lds((const unsigned*)((const char*)(gbase) + (voff)[_i]), (PG8_LAS unsigned*)(lds + (bufoff) + ldsw + _i * 8192), 16, 0, 0); } while (0)
#define PG8_LDA(dst, b, h) do { _Pragma("unroll") for (int m = 0; m < 4; ++m) _Pragma("unroll") for (int k = 0; k < 2; ++k) dst[m][k] = *(const PG8_LAS bf16x8*)(lds + PG8_SA(b, h) + aoff + m * 2048 + k * 1024); } while (0)
#define PG8_LDB(dst, b, h) do { _Pragma("unroll") for (int n = 0; n < 2; ++n) _Pragma("unroll") for (int k = 0; k < 2; ++k) dst[n][k] = *(const PG8_LAS bf16x8*)(lds + PG8_SB(b, h) + boff + n * 2048 + k * 1024); } while (0)
#define PG8_MMA(ai, bj, At, Bt) do { __builtin_amdgcn_s_setprio(1); _Pragma("unroll") for (int m = 0; m < 4; ++m) _Pragma("unroll") for (int n = 0; n < 2; ++n) _Pragma("unroll") for (int k = 0; k < 2; ++k) \
        acc[ai][bj][m][n] = __builtin_amdgcn_mfma_f32_16x16x32_bf16(Bt[n][k], At[m][k], acc[ai][bj][m][n], 0, 0, 0); __builtin_amdgcn_s_setprio(0); } while (0)
#define PG8_WAIT_V(n) asm volatile("s_waitcnt vmcnt(" #n ")" ::: "memory")
#define PG8_WAIT_L(n) asm volatile("s_waitcnt lgkmcnt(" #n ")" ::: "memory")
#define PG8_BAR __builtin_amdgcn_s_barrier()
#define PG8_SCHED __builtin_amdgcn_sched_barrier(0)
    Unit cur, nxt; int ui = 0;
    if (!S.next(0, cur)) return;
    f32x4 acc[2][2][4][2];
#pragma unroll
    for (int a = 0; a < 2; ++a)
#pragma unroll
        for (int b = 0; b < 2; ++b)
#pragma unroll
            for (int m = 0; m < 4; ++m)
#pragma unroll
                for (int n = 0; n < 2; ++n) acc[a][b][m][n] = (f32x4){0.f, 0.f, 0.f, 0.f};
    bf16x8 At[4][2], B0[2][2], B1[2][2];
    const char* cA = (const char*)g.A + (size_t)cur.pm * tstep; const char* cB = (const char*)g.Bt + (size_t)cur.pn * tstep;
    S.a_ready(cur);
    PG8_STAGE(PG8_SB(0, 0), cB, voffB); PG8_STAGE(PG8_SA(0, 0), cA, voffA); PG8_STAGE(PG8_SB(0, 1), cB + hstep, voffB); PG8_STAGE(PG8_SA(0, 1), cA + hstep, voffA);
    if (wr == 1) PG8_BAR;
    PG8_WAIT_V(4); PG8_BAR;
    PG8_STAGE(PG8_SB(1, 0), cB + kstep, voffB); PG8_STAGE(PG8_SA(1, 0), cA + kstep, voffA); PG8_STAGE(PG8_SB(1, 1), cB + hstep + kstep, voffB);
    PG8_WAIT_V(6); PG8_BAR;
    for (;;) {
        const bool has_next = S.next(ui + 1, nxt);
        const char* nA = has_next ? (const char*)g.A + (size_t)nxt.pm * tstep : cA; const char* nB = has_next ? (const char*)g.Bt + (size_t)nxt.pn * tstep : cB;
        for (int t = 0; t < nt; t += 2) {
            const bool last = (t == nt - 2);
            const char* a1 = cA + (size_t)(t + 1) * kstep;
            const char* a2 = last ? nA : cA + (size_t)(t + 2) * kstep; const char* b2 = last ? nB : cB + (size_t)(t + 2) * kstep;
            const char* a3 = a2 + kstep; const char* b3 = b2 + kstep;
            if (last && has_next) S.a_ready(nxt);
            PG8_LDB(B0, 0, 0); PG8_SCHED; PG8_LDA(At, 0, 0); PG8_STAGE(PG8_SA(1, 1), a1 + hstep, voffA);
            PG8_WAIT_L(8); PG8_BAR; PG8_WAIT_L(0); PG8_MMA(0, 0, At, B0); PG8_BAR; PG8_SCHED;
            PG8_LDB(B1, 0, 1); PG8_STAGE(PG8_SB(0, 0), b2, voffB);
            PG8_BAR; PG8_WAIT_L(0); PG8_MMA(0, 1, At, B1); PG8_BAR;
            PG8_LDA(At, 0, 1); PG8_STAGE(PG8_SA(0, 0), a2, voffA);
            PG8_BAR; PG8_WAIT_L(0); PG8_MMA(1, 0, At, B0); PG8_BAR; PG8_SCHED;
            PG8_STAGE(PG8_SB(0, 1), b2 + hstep, voffB);
            PG8_WAIT_V(6); PG8_BAR; PG8_MMA(1, 1, At, B1); PG8_BAR;
            PG8_LDB(B0, 1, 0); PG8_SCHED; PG8_LDA(At, 1, 0); PG8_STAGE(PG8_SA(0, 1), a2 + hstep, voffA);
            PG8_WAIT_L(8); PG8_BAR; PG8_WAIT_L(0); PG8_MMA(0, 0, At, B0); PG8_BAR; PG8_SCHED;
            PG8_LDB(B1, 1, 1); PG8_STAGE(PG8_SB(1, 0), b3, voffB);
            PG8_BAR; PG8_WAIT_L(0); PG8_MMA(0, 1, At, B1); PG8_BAR;
            PG8_LDA(At, 1, 1); PG8_STAGE(PG8_SA(1, 0), a3, voffA);
            PG8_BAR; PG8_WAIT_L(0); PG8_MMA(1, 0, At, B0); PG8_BAR; PG8_SCHED;
            PG8_STAGE(PG8_SB(1, 1), b3 + hstep, voffB);
            PG8_WAIT_V(6); PG8_BAR; PG8_MMA(1, 1, At, B1); PG8_BAR;
        }
        if constexpr (!Epi::AFTER_DRAIN) { if (!Epi::TWICE || (ui & 1)) E(acc, cur, wr, wc, fr, fq); S.done(cur); }
        if (!has_next) break;
#pragma unroll
        for (int a = 0; a < 2; ++a)
#pragma unroll
            for (int b = 0; b < 2; ++b)
#pragma unroll
                for (int m = 0; m < 4; ++m)
#pragma unroll
                    for (int n = 0; n < 2; ++n) acc[a][b][m][n] = (f32x4){0.f, 0.f, 0.f, 0.f};
        cur = nxt; cA = nA; cB = nB; ++ui;
    }
    PG8_WAIT_V(0);
    if (wr == 0) PG8_BAR;
    PG8_BAR;
    if constexpr (Epi::AFTER_DRAIN) { E.fused(acc, cur, wr, wc, fr, fq, lds, wid, lane); S.done(cur); }
#undef PG8_SA
#undef PG8_SB
#undef PG8_STAGE
#undef PG8_LDA
#undef PG8_LDB
#undef PG8_MMA
#undef PG8_WAIT_V
#undef PG8_WAIT_L
#undef PG8_BAR
#undef PG8_SCHED
}
}

namespace cg = cooperative_groups;
using pg8::f32x4; using pg8::bf16x8; using pg8::Unit;
typedef unsigned u32x2_t __attribute__((ext_vector_type(2)));
typedef unsigned u32x4_t __attribute__((ext_vector_type(4)));
typedef float f32x16 __attribute__((ext_vector_type(16)));
typedef float f32x2_t __attribute__((ext_vector_type(2)));
#define LAS PG8_LAS
constexpr int LDS_BYTES = 163840;
#ifndef EN_MASK
#define EN_MASK 0x7f
#endif
#ifndef PROBE_EPI_ACE
#define PROBE_EPI_ACE 0
#endif
#ifndef PROBE_EPI_D
#define PROBE_EPI_D 0
#endif
#ifndef PROBE_SYNC
#define PROBE_SYNC 0
#endif
#ifndef PROBE_MASK
#define PROBE_MASK 0x00
#endif

DI unsigned pk2(float lo, float hi) { unsigned r; asm volatile("s_nop 0\n\tv_cvt_pk_bf16_f32 %0, %1, %2\n\ts_nop 1" : "=v"(r) : "v"(lo), "v"(hi)); return r; }
DI float bflo(unsigned w) { return __uint_as_float(w << 16); }
DI float bfhi(unsigned w) { return __uint_as_float(w & 0xffff0000u); }
DI float gelu1(float v) {
  const float av = fabsf(v), t = __builtin_amdgcn_rcpf(av * 0.2316418882f + 1.0f);
  float q = t * 0.5307027145f + (-0.7265760135f); q = q * t + 0.7107068705f; q = q * t + (-0.142248368f); q = q * t + 0.127414796f; q = q * t;
  const float e = __builtin_amdgcn_exp2f((v * v) * (-0.72134752044f));
  const float m = v * (q * e);
  return v < 0.f ? m : v - m;
}
DI float dpp_ror1(float v) { return __builtin_bit_cast(float, __builtin_amdgcn_update_dpp(0, __builtin_bit_cast(int, v), 0x121, 0xf, 0xf, false)); }
DI float dpp_ror2(float v) { return __builtin_bit_cast(float, __builtin_amdgcn_update_dpp(0, __builtin_bit_cast(int, v), 0x122, 0xf, 0xf, false)); }
typedef unsigned long long u64;
DI float fx2f(u64 v) { return (float)v * (1.0f / 1048576.0f); }
DI u64 f2fx(float v) { return (u64)(v * 1048576.0f + 0.5f); }
DI void fx_add(u64* p, float v) { __hip_atomic_fetch_add(p, f2fx(v), __ATOMIC_RELAXED, __HIP_MEMORY_SCOPE_AGENT); }
DI float rs1024(u64 ss) { return rsqrtf(fx2f(ss) * (1.0f / 1024.0f) + EPS); }

struct MParams { const float* in[21]; float* out; unsigned char* ws; int ph_lo, ph_hi; };
struct LP {
  const float *norm_attn_w, *w_in, *v_norm_w, *sp_w, *sp_b, *out_norm_w, *q_norm_w, *k_norm_w, *lq1, *lk1, *lq2, *lk2, *diff_norm_w, *w_out, *norm_ffn_w, *w_gate, *w_up, *conv_w, *conv_b, *w_down;
  float lambda_init;
  const bf16_t *WinT, *WoutT, *WguT, *WdT, *Wsp;
};
DI LP make_lp(const MParams& p, int l) {
  LP L;
  L.norm_attn_w = p.in[1] + (size_t)l * DM; L.w_in = p.in[2] + (size_t)l * DM * INW; L.v_norm_w = p.in[3] + (size_t)l * 512; L.sp_w = p.in[4] + (size_t)l * 65536; L.sp_b = p.in[5] + (size_t)l * 512;
  L.out_norm_w = p.in[6] + (size_t)l * 512; L.q_norm_w = p.in[7] + (size_t)l * 64; L.k_norm_w = p.in[8] + (size_t)l * 64; L.lq1 = p.in[9] + (size_t)l * 64; L.lk1 = p.in[10] + (size_t)l * 64;
  L.lq2 = p.in[11] + (size_t)l * 64; L.lk2 = p.in[12] + (size_t)l * 64; L.diff_norm_w = p.in[13] + (size_t)l * 128; L.w_out = p.in[14] + (size_t)l * DM * DM; L.norm_ffn_w = p.in[15] + (size_t)l * DM;
  L.w_gate = p.in[16] + (size_t)l * DM * DFF; L.w_up = p.in[17] + (size_t)l * DM * DFF; L.conv_w = p.in[18] + (size_t)l * 3 * DFF; L.conv_b = p.in[19] + (size_t)l * DFF; L.w_down = p.in[20] + (size_t)l * DFF * DM;
  L.lambda_init = 0.8f - 0.6f * expf(-0.3f * (float)(l + 1));
  const unsigned char* wb = p.ws + OFF_W + (size_t)l * W_STRIDE;
  L.WinT = (const bf16_t*)(wb + WO_IN); L.WoutT = (const bf16_t*)(wb + WO_OUT); L.WguT = (const bf16_t*)(wb + WO_GU); L.WdT = (const bf16_t*)(wb + WO_DN); L.Wsp = (const bf16_t*)(wb + WO_SP);
  return L;
}
DI float lam_of(const LP& lp) {
  const int lane = threadIdx.x & 63;
  float a = lp.lq1[lane] * lp.lk1[lane], b = lp.lq2[lane] * lp.lk2[lane];
  a = wave_sum(a); b = wave_sum(b);
  return expf(a) - expf(b) + lp.lambda_init;
}

DI void conv_item(bf16_t* dst, int K, int row, int kg, const float* src, int ld, int col, const float* ks) {
  float v[32];
#pragma unroll
  for (int i = 0; i < 32; ++i) v[i] = src[(size_t)(kg * 32 + i) * ld + col];
  if (ks) {
#pragma unroll
    for (int i = 0; i < 32; i += 4) { const f32x4 s = *(const f32x4*)(ks + kg * 32 + i); v[i] *= s[0]; v[i + 1] *= s[1]; v[i + 2] *= s[2]; v[i + 3] *= s[3]; }
  }
  u32x4_t* d = (u32x4_t*)(dst + (size_t)row * K + kg * 32);
#pragma unroll
  for (int i = 0; i < 4; ++i) { u32x4_t w; w.x = pk2(v[8 * i], v[8 * i + 1]); w.y = pk2(v[8 * i + 2], v[8 * i + 3]); w.z = pk2(v[8 * i + 4], v[8 * i + 5]); w.w = pk2(v[8 * i + 6], v[8 * i + 7]); d[i] = w; }
}
DI int perm_logical(int p) {
  const int bj = p >> 7, wc = (p >> 5) & 3, n = (p >> 4) & 1, fq = (p >> 2) & 3, e = p & 3;
  return 64 * wc + 32 * bj + 8 * fq + 4 * n + e;
}
DI void prologue(const MParams& p) {
  const int tidp = tid_opaque(); const int gtid = blockIdx.x * 512 + tidp, gsz = gridDim.x * 512;
  unsigned char* ws = p.ws;
  { const int gw = gtid >> 6, nw = gsz >> 6, lane = threadIdx.x & 63; bf16_t* XB = (bf16_t*)(ws + OFF_XB); u64* SS1 = (u64*)(ws + OFF_SS1);
    for (int row = gw; row < T_TOK; row += nw) { const float* xp = p.in[0] + (size_t)row * DM; float s = 0.f;
#pragma unroll
      for (int i = 0; i < 4; ++i) { const f32x4 v = *(const f32x4*)(xp + i * 256 + lane * 4); s += v[0] * v[0] + v[1] * v[1] + v[2] * v[2] + v[3] * v[3];
        u32x2_t w; w.x = pk2(v[0], v[1]); w.y = pk2(v[2], v[3]); *(u32x2_t*)(XB + (size_t)row * DM + i * 256 + lane * 4) = w; }
      s = wave_sum(s); if (lane == 0) SS1[row] = f2fx(s); } }
  { u64* SSV = (u64*)(ws + OFF_SSV); for (int i = gtid; i < T_TOK * 4; i += gsz) SSV[i] = 0ull; }
  for (int l = 0; l < NLAYER; ++l) {
    const LP lp = make_lp(p, l);
    for (int w = gtid; w < 2560 * 32; w += gsz) { const int row = w % 2560, kg = w / 2560; int col;
      if (row < 1536) { const int L = (row & ~255) + perm_logical(row & 255); col = L < 512 ? L : L + 512; }
      else { const int r = row - 1536; col = r < 512 ? 512 + r : 1536 + r; }
      conv_item((bf16_t*)lp.WinT, 1024, row, kg, lp.w_in, INW, col, lp.norm_attn_w); }
    for (int w = gtid; w < 1024 * 32; w += gsz) { const int row = w % 1024, kg = w / 1024; conv_item((bf16_t*)lp.WoutT, 1024, row, kg, lp.w_out, DM, row, nullptr); }
    for (int w = gtid; w < 5632 * 32; w += gsz) { const int row = w % 5632, kg = w / 5632; const int pn = row >> 8, pp = row & 255, bj = pp >> 7;
      const int q = pp & 127, wc = (q >> 5) & 3, n = (q >> 4) & 1, fq = (q >> 2) & 3, e = q & 3; const int cc = 128 * pn + 32 * wc + 8 * fq + 4 * n + e;
      conv_item((bf16_t*)lp.WguT, 1024, row, kg, bj ? lp.w_up : lp.w_gate, DFF, cc, lp.norm_ffn_w); }
    for (int w = gtid; w < 1024 * 88; w += gsz) { const int row = w % 1024, kg = w / 1024; conv_item((bf16_t*)lp.WdT, DFF, row, kg, lp.w_down, DM, row, nullptr); }
    for (int i = gtid; i < 65536; i += gsz) { const int jj = i & 127, ii = (i >> 7) & 127; ((bf16_t*)lp.Wsp)[i] = ((jj >> 6) <= (ii >> 6)) ? f2bf(lp.sp_w[i]) : (bf16_t)0; }
  }
}

struct DupOrder : pg8::StaticOrder {
  __device__ bool next(int i, Unit& u) const { return pg8::StaticOrder::next(i >> 1, u); }
};
struct EpiResid {
  static constexpr bool PERM = false, AFTER_DRAIN = false, TWICE = (PROBE_EPI_ACE != 0);
  const float* base32; float* out32; bf16_t* XB; u64* SS;
  DI void operator()(const f32x4 (&acc)[2][2][4][2], const Unit& u, int wr, int wc, int fr, int fq) const {
    const int row0 = u.pm * 256 + wr * 64 + fr, col0 = u.pn * 256 + wc * 32 + 4 * fq;
    if (base32) {
      f32x4 nb[2][2];
#pragma unroll
      for (int bj = 0; bj < 2; ++bj)
#pragma unroll
        for (int n = 0; n < 2; ++n) nb[bj][n] = *(const f32x4*)(base32 + (size_t)row0 * DM + col0 + bj * 128 + n * 16);
#pragma unroll
      for (int g = 0; g < 8; ++g) { const int ai = g >> 2, m = g & 3; const int row = row0 + ai * 128 + m * 16; const size_t ro = (size_t)row * DM + col0; float ss = 0.f;
        f32x4 cbv[2][2];
#pragma unroll
        for (int bj = 0; bj < 2; ++bj)
#pragma unroll
          for (int n = 0; n < 2; ++n) cbv[bj][n] = nb[bj][n];
        if (g < 7) { const int r2 = row0 + ((g + 1) >> 2) * 128 + ((g + 1) & 3) * 16;
#pragma unroll
          for (int bj = 0; bj < 2; ++bj)
#pragma unroll
            for (int n = 0; n < 2; ++n) nb[bj][n] = *(const f32x4*)(base32 + (size_t)r2 * DM + col0 + bj * 128 + n * 16); }
#pragma unroll
        for (int bj = 0; bj < 2; ++bj)
#pragma unroll
          for (int n = 0; n < 2; ++n) { const size_t o = ro + bj * 128 + n * 16; const f32x4 v = acc[ai][bj][m][n] + cbv[bj][n];
            u32x2_t w; w.x = pk2(v[0], v[1]); w.y = pk2(v[2], v[3]); *(u32x2_t*)(XB + o) = w; ss += (v[0] * v[0] + v[1] * v[1]) + (v[2] * v[2] + v[3] * v[3]); }
        ss += __shfl_xor(ss, 16); ss += __shfl_xor(ss, 32); if (fq == 0) fx_add(SS + row, ss);
        asm volatile("" ::: "memory"); }
    } else {
      u32x2_t nb[2][2];
#pragma unroll
      for (int bj = 0; bj < 2; ++bj)
#pragma unroll
        for (int n = 0; n < 2; ++n) nb[bj][n] = *(const u32x2_t*)(XB + (size_t)row0 * DM + col0 + bj * 128 + n * 16);
#pragma unroll
      for (int g = 0; g < 8; ++g) { const int ai = g >> 2, m = g & 3; const int row = row0 + ai * 128 + m * 16; const size_t ro = (size_t)row * DM + col0; float ss = 0.f;
        u32x2_t cbv[2][2];
#pragma unroll
        for (int bj = 0; bj < 2; ++bj)
#pragma unroll
          for (int n = 0; n < 2; ++n) cbv[bj][n] = nb[bj][n];
        if (g < 7) { const int r2 = row0 + ((g + 1) >> 2) * 128 + ((g + 1) & 3) * 16;
#pragma unroll
          for (int bj = 0; bj < 2; ++bj)
#pragma unroll
            for (int n = 0; n < 2; ++n) nb[bj][n] = *(const u32x2_t*)(XB + (size_t)r2 * DM + col0 + bj * 128 + n * 16); }
#pragma unroll
        for (int bj = 0; bj < 2; ++bj)
#pragma unroll
          for (int n = 0; n < 2; ++n) { const size_t o = ro + bj * 128 + n * 16; const u32x2_t c = cbv[bj][n];
            const f32x4 v = acc[ai][bj][m][n] + (f32x4){bflo(c.x), bfhi(c.x), bflo(c.y), bfhi(c.y)};
            if (out32) *(f32x4*)(out32 + o) = v;
            else { u32x2_t w; w.x = pk2(v[0], v[1]); w.y = pk2(v[2], v[3]); *(u32x2_t*)(XB + o) = w; ss += (v[0] * v[0] + v[1] * v[1]) + (v[2] * v[2] + v[3] * v[3]); } }
        if (!out32) { ss += __shfl_xor(ss, 16); ss += __shfl_xor(ss, 32); if (fq == 0) fx_add(SS + row, ss); }
        asm volatile("" ::: "memory"); }
    }
  }
};
struct EpiA1 {
  static constexpr bool PERM = false, AFTER_DRAIN = false, TWICE = (PROBE_EPI_ACE != 0);
  const u64* SS1; bf16_t *U, *Q, *KB; const float *qw, *kw;
  DI void operator()(const f32x4 (&acc)[2][2][4][2], const Unit& u, int wr, int wc, int fr, int fq) const {
    const int row0 = u.pm * 256 + wr * 64 + fr, lc0 = wc * 64 + 8 * fq, region = u.pn >> 1;
    u64 rsv[8];
#pragma unroll
    for (int g = 0; g < 8; ++g) rsv[g] = SS1[row0 + (g >> 2) * 128 + (g & 3) * 16];
    if (region == 0) {
#pragma unroll
      for (int g = 0; g < 8; ++g) { const int ai = g >> 2, m = g & 3; const int row = row0 + ai * 128 + m * 16; const float rs = rs1024(rsv[g]);
#pragma unroll
        for (int bj = 0; bj < 2; ++bj) { const f32x4 a = acc[ai][bj][m][0] * rs, b = acc[ai][bj][m][1] * rs; u32x4_t w;
          w.x = pk2(gelu1(a[0]), gelu1(a[1])); w.y = pk2(gelu1(a[2]), gelu1(a[3])); w.z = pk2(gelu1(b[0]), gelu1(b[1])); w.w = pk2(gelu1(b[2]), gelu1(b[3]));
          *(u32x4_t*)(U + (size_t)row * 512 + u.pn * 256 + lc0 + 32 * bj) = w; } }
    } else {
      const bool isq = region == 1; const float* wp = (isq ? qw : kw) + 8 * fq; bf16_t* dst = (isq ? Q : KB) + (u.pn & 1) * 256 + lc0; const float sc = isq ? QSCALE : 1.0f;
      f32x4 wv[2][2];
#pragma unroll
      for (int bj = 0; bj < 2; ++bj)
#pragma unroll
        for (int n = 0; n < 2; ++n) wv[bj][n] = *(const f32x4*)(wp + 32 * bj + 4 * n);
#pragma unroll
      for (int g = 0; g < 8; ++g) { const int ai = g >> 2, m = g & 3; const int row = row0 + ai * 128 + m * 16; const float rs = rs1024(rsv[g]); float ss = 0.f; f32x4 v[2][2];
#pragma unroll
        for (int bj = 0; bj < 2; ++bj)
#pragma unroll
          for (int n = 0; n < 2; ++n) { v[bj][n] = acc[ai][bj][m][n] * rs; const f32x4 t = v[bj][n]; ss += (t[0] * t[0] + t[1] * t[1]) + (t[2] * t[2] + t[3] * t[3]); }
        ss += __shfl_xor(ss, 16); ss += __shfl_xor(ss, 32);
        const float r2 = rsqrtf(ss * (1.0f / 64.0f) + EPS) * sc;
#pragma unroll
        for (int bj = 0; bj < 2; ++bj) { const f32x4 a = v[bj][0] * r2 * wv[bj][0], b = v[bj][1] * r2 * wv[bj][1]; u32x4_t w;
          w.x = pk2(a[0], a[1]); w.y = pk2(a[2], a[3]); w.z = pk2(b[0], b[1]); w.w = pk2(b[2], b[3]);
          *(u32x4_t*)(dst + (size_t)row * 512 + 32 * bj) = w; } }
    }
  }
};
struct EpiA2 {
  static constexpr bool PERM = false, AFTER_DRAIN = false, TWICE = (PROBE_EPI_ACE != 0);
  const u64* SS1; bf16_t *GVT, *VT; u64* SSV;
  DI void operator()(const f32x4 (&acc)[2][2][4][2], const Unit& u, int wr, int wc, int fr, int fq) const {
    const int colbase = u.pn * 256 + wc * 32;
    f32x4 rs[2][2];
#pragma unroll
    for (int bj = 0; bj < 2; ++bj)
#pragma unroll
      for (int n = 0; n < 2; ++n) { const u64* sp = SS1 + colbase + bj * 128 + n * 16 + 4 * fq; rs[bj][n] = (f32x4){rs1024(sp[0]), rs1024(sp[1]), rs1024(sp[2]), rs1024(sp[3])}; }
    if (u.pm < 2) {
#pragma unroll
      for (int ai = 0; ai < 2; ++ai) { const int head = 2 * u.pm + ai;
#pragma unroll
        for (int bj = 0; bj < 2; ++bj)
#pragma unroll
          for (int n = 0; n < 2; ++n) { f32x4 sq = (f32x4){0.f, 0.f, 0.f, 0.f}; const int tok = colbase + bj * 128 + n * 16 + 4 * fq;
#pragma unroll
            for (int m = 0; m < 4; ++m) { const int row = u.pm * 256 + ai * 128 + wr * 64 + m * 16 + fr;
              const f32x4 a = acc[ai][bj][m][n] * rs[bj][n]; f32x4 g; g[0] = gelu1(a[0]); g[1] = gelu1(a[1]); g[2] = gelu1(a[2]); g[3] = gelu1(a[3]);
              u32x2_t w; w.x = pk2(g[0], g[1]); w.y = pk2(g[2], g[3]); *(u32x2_t*)(GVT + (size_t)row * T_TOK + tok) = w; sq += g * g; }
#pragma unroll
            for (int e = 0; e < 4; ++e) { float s = sq[e]; s += __shfl_xor(s, 1); s += __shfl_xor(s, 2); s += __shfl_xor(s, 4); s += __shfl_xor(s, 8); sq[e] = s; }
            if (fr == 0) {
#pragma unroll
              for (int e = 0; e < 4; ++e) fx_add(SSV + (size_t)(tok + e) * 4 + head, sq[e]); }
            asm volatile("" ::: "memory"); } }
    } else {
#pragma unroll
      for (int ai = 0; ai < 2; ++ai)
#pragma unroll
        for (int m = 0; m < 4; ++m) { const int row = (u.pm - 2) * 256 + ai * 128 + wr * 64 + m * 16 + fr;
#pragma unroll
          for (int bj = 0; bj < 2; ++bj)
#pragma unroll
            for (int n = 0; n < 2; ++n) { const f32x4 a = acc[ai][bj][m][n] * rs[bj][n]; u32x2_t w; w.x = pk2(a[0], a[1]); w.y = pk2(a[2], a[3]);
              *(u32x2_t*)(VT + (size_t)row * T_TOK + colbase + bj * 128 + n * 16 + 8 * (fq & 1) + 4 * (fq >> 1)) = w; } }
    }
  }
};
struct EpiD {
  static constexpr bool PERM = false, AFTER_DRAIN = false, TWICE = (PROBE_EPI_D != 0);
  const u64* SS2; const float *cw, *cb; bf16_t* F; float *GB, *PB, *UB;
  DI void operator()(const f32x4 (&acc)[2][2][4][2], const Unit& u, int wr, int wc, int fr, int fq) const {
    const int cbase = u.pn * 128 + wc * 32 + 8 * fq;
    const int rb0 = u.pm * 256 + wr * 64;
    u64 rsv[8]; f32x4 w0[2], w1[2], w2[2], bb[2];
#pragma unroll
    for (int g = 0; g < 8; ++g) rsv[g] = SS2[rb0 + (g >> 2) * 128 + (g & 3) * 16 + fr];
#pragma unroll
    for (int n = 0; n < 2; ++n) { w0[n] = *(const f32x4*)(cw + cbase + 4 * n); w1[n] = *(const f32x4*)(cw + DFF + cbase + 4 * n); w2[n] = *(const f32x4*)(cw + 2 * DFF + cbase + 4 * n); bb[n] = *(const f32x4*)(cb + cbase + 4 * n); }
#pragma unroll
    for (int ai = 0; ai < 2; ++ai) {
      const int rb = rb0 + ai * 128, bd = rb >> 6;
      float rs[4];
#pragma unroll
      for (int m = 0; m < 4; ++m) rs[m] = rs1024(rsv[ai * 4 + m]);
      unsigned fo[4][4];
#pragma unroll
      for (int n = 0; n < 2; ++n) {
        const int cn = cbase + 4 * n;
        f32x4 pg, ug, gg; float fv[4][4];
#pragma unroll
        for (int e = 0; e < 4; ++e) {
          float G[4], r1[4], r2[4];
#pragma unroll
          for (int m = 0; m < 4; ++m) { G[m] = acc[ai][0][m][n][e] * rs[m]; r1[m] = dpp_ror1(G[m]); r2[m] = dpp_ror2(G[m]); }
#pragma unroll
          for (int m = 0; m < 4; ++m) {
            const float p1 = (fr >= 1) ? r1[m] : (m > 0 ? r1[m > 0 ? m - 1 : 0] : 0.f);
            const float p2 = (fr >= 2) ? r2[m] : (m > 0 ? r2[m > 0 ? m - 1 : 0] : 0.f);
            const float g = w2[n][e] * G[m] + w1[n][e] * p1 + w0[n][e] * p2 + bb[n][e];
            const float uv = acc[ai][1][m][n][e] * rs[m];
            if (m == 0) { pg[e] = g; ug[e] = uv; }
            if (m == 3) gg[e] = G[3];
            fv[m][e] = g * __builtin_amdgcn_rcpf(1.0f + __expf(-g)) * uv;
          }
        }
#pragma unroll
        for (int m = 0; m < 4; ++m) { fo[m][2 * n] = pk2(fv[m][0], fv[m][1]); fo[m][2 * n + 1] = pk2(fv[m][2], fv[m][3]); }
        if (fr < 2) { *(f32x4*)(PB + (size_t)(bd * 2 + fr) * DFF + cn) = pg; *(f32x4*)(UB + (size_t)(bd * 2 + fr) * DFF + cn) = ug; }
        if (fr >= 14) { *(f32x4*)(GB + (size_t)(bd * 2 + fr - 14) * DFF + cn) = gg; }
      }
#pragma unroll
      for (int m = 0; m < 4; ++m) {
        if (!(m == 0 && fr < 2)) { u32x4_t w; w.x = fo[m][0]; w.y = fo[m][1]; w.z = fo[m][2]; w.w = fo[m][3]; *(u32x4_t*)(F + (size_t)(rb + 16 * m + fr) * DFF + cbase) = w; }
      }
    }
  }
};
DI void fixup_phase(const LP& lp, unsigned char* ws) {
  const float *GB = (const float*)(ws + OFF_GB), *PB = (const float*)(ws + OFF_PB), *UB = (const float*)(ws + OFF_UB); bf16_t* F = (bf16_t*)(ws + OFF_F);
  const int gtid = blockIdx.x * 512 + tid_opaque(), gsz = gridDim.x * 512;
  for (int w = gtid; w < 512 * 2 * 704; w += gsz) {
    const int c = (w % 704) * 4, j = (w / 704) & 1, bd = w / 1408;
    f32x4 g = *(const f32x4*)(PB + (size_t)(bd * 2 + j) * DFF + c);
    if (bd & 31) { const f32x4 gm1 = *(const f32x4*)(GB + (size_t)((bd - 1) * 2 + 1) * DFF + c); const f32x4 w0 = *(const f32x4*)(lp.conv_w + c);
      if (j == 0) { const f32x4 gm2 = *(const f32x4*)(GB + (size_t)((bd - 1) * 2) * DFF + c); const f32x4 w1 = *(const f32x4*)(lp.conv_w + DFF + c); g += w1 * gm1 + w0 * gm2; }
      else g += w0 * gm1; }
    const f32x4 uv = *(const f32x4*)(UB + (size_t)(bd * 2 + j) * DFF + c); float f[4];
#pragma unroll
    for (int e = 0; e < 4; ++e) f[e] = g[e] * __builtin_amdgcn_rcpf(1.0f + __expf(-g[e])) * uv[e];
    u32x2_t o; o.x = pk2(f[0], f[1]); o.y = pk2(f[2], f[3]);
    *(u32x2_t*)(F + (size_t)(bd * 64 + j) * DFF + c) = o;
  }
}

DI void spatial_phase(const LP& lp, unsigned char* ws, LAS unsigned char* lds) {
  const bf16_t *U = (const bf16_t*)(ws + OFF_U), *GVT = (const bf16_t*)(ws + OFF_GVT); const u64* SSV = (const u64*)(ws + OFF_SSV); bf16_t* MIX = (bf16_t*)(ws + OFF_MIX);
  constexpr int TB = 32768;
  LAS float* sr = (LAS float*)(lds + 2 * TB);
  const int tid = tid_opaque(), lane = tid & 63, w = __builtin_amdgcn_readfirstlane(tid >> 6), l15 = lane & 15, kq = lane >> 4;
#define SP_STAGE(item, buf) do { const int h_ = (item) & 3, t_ = ((item) >> 2) * 128; _Pragma("unroll") for (int i = 0; i < 4; ++i) { const int P = (w * 4 + i) * 64 + lane, row = P >> 4, pc = (P & 15) ^ (row & 15); \
    __builtin_amdgcn_global_load_lds((const unsigned*)(GVT + (size_t)(h_ * 128 + row) * T_TOK + t_ + pc * 8), (LAS unsigned*)(lds + (buf) * TB + (w * 4 + i) * 1024), 16, 0, 0); } } while (0)
  LAS float* vn_l = sr + 128; LAS float* on_l = vn_l + 512; LAS float* sb_l = on_l + 512;
  int it = blockIdx.x, buf = 0;
  if (it < 1024) SP_STAGE(it, 0);
  { const float a = lp.v_norm_w[tid], b = lp.out_norm_w[tid], c = lp.sp_b[tid]; vn_l[tid] = a; on_l[tid] = b; sb_l[tid] = c; }
  asm volatile("s_waitcnt vmcnt(0)" ::: "memory");
  __syncthreads();
  const int x_lane = l15 * 256 + ((kq ^ l15) << 4);
  const int i0 = 16 * w, nks = (w < 4) ? 2 : 4;
  u32x4_t rawN[4]; u32x2_t urN[8]; u64 ssvN = 0ull;
#define SP_LOADREGS(item) do { const int h_ = (item) & 3, t_ = ((item) >> 2) * 128; \
    _Pragma("unroll") for (int ks = 0; ks < 4; ++ks) rawN[ks] = (ks < nks) ? *(const u32x4_t*)(lp.Wsp + (size_t)(h_ * 128 + i0 + l15) * 128 + ks * 32 + kq * 8) : (u32x4_t){0u, 0u, 0u, 0u}; \
    _Pragma("unroll") for (int dt = 0; dt < 8; ++dt) urN[dt] = *(const u32x2_t*)(U + (size_t)(t_ + i0 + l15) * 512 + h_ * 128 + 16 * dt + 4 * kq); \
    ssvN = (tid < 128) ? SSV[(size_t)(t_ + tid) * 4 + h_] : 0ull; } while (0)
  if (it < 1024) SP_LOADREGS(it);
  for (; it < 1024; it += gridDim.x, buf ^= 1) {
    const int h = it & 3, tok0 = (it >> 2) * 128, irow = tok0 + i0 + l15;
    u32x4_t raw[4]; u32x2_t ur[8];
#pragma unroll
    for (int ks = 0; ks < 4; ++ks) raw[ks] = rawN[ks];
#pragma unroll
    for (int dt = 0; dt < 8; ++dt) ur[dt] = urN[dt];
    const u64 ssv = ssvN;
    const float bias = sb_l[h * 128 + i0 + l15];
    const int nit = it + gridDim.x;
    if (nit < 1024) { SP_STAGE(nit, buf ^ 1); SP_LOADREGS(nit); }
    if (tid < 128) sr[tid] = rsqrtf(fx2f(ssv) * (1.0f / 128.0f) + EPS);
    __syncthreads();
    bf16x8 yf[4];
#pragma unroll
    for (int ks = 0; ks < 4; ++ks) { const LAS float* sp = sr + ks * 32 + kq * 8; const u32x4_t r = raw[ks]; u32x4_t o;
      o.x = pk2(bflo(r.x) * sp[0], bfhi(r.x) * sp[1]); o.y = pk2(bflo(r.y) * sp[2], bfhi(r.y) * sp[3]); o.z = pk2(bflo(r.z) * sp[4], bfhi(r.z) * sp[5]); o.w = pk2(bflo(r.w) * sp[6], bfhi(r.w) * sp[7]);
      yf[ks] = __builtin_bit_cast(bf16x8, o); }
    const LAS unsigned char* tb = lds + buf * TB;
    float o[8][4]; float ss = 0.f;
#pragma unroll
    for (int dt = 0; dt < 8; ++dt) {
      f32x4 acc = (f32x4){0.f, 0.f, 0.f, 0.f};
#pragma unroll
      for (int ks = 0; ks < 4; ++ks) if (ks < nks) {
        const bf16x8 xf = *(const LAS bf16x8*)(tb + dt * 4096 + (x_lane ^ (ks << 6)));
        acc = __builtin_amdgcn_mfma_f32_16x16x32_bf16(xf, yf[ks], acc, 0, 0, 0); }
      const int d0 = 16 * dt + 4 * kq; const f32x4 wv = *(const LAS f32x4*)(vn_l + h * 128 + d0);
      o[dt][0] = bflo(ur[dt].x) * (acc[0] * wv[0] + bias); o[dt][1] = bfhi(ur[dt].x) * (acc[1] * wv[1] + bias); o[dt][2] = bflo(ur[dt].y) * (acc[2] * wv[2] + bias); o[dt][3] = bfhi(ur[dt].y) * (acc[3] * wv[3] + bias);
      ss += (o[dt][0] * o[dt][0] + o[dt][1] * o[dt][1]) + (o[dt][2] * o[dt][2] + o[dt][3] * o[dt][3]);
    }
    ss += __shfl_xor(ss, 16); ss += __shfl_xor(ss, 32);
    const float rs = rsqrtf(ss * (1.0f / 128.0f) + EPS);
#pragma unroll
    for (int dt = 0; dt < 8; ++dt) { const int d0 = 16 * dt + 4 * kq; const f32x4 wo = *(const LAS f32x4*)(on_l + h * 128 + d0);
      u32x2_t q; q.x = pk2(o[dt][0] * rs * wo[0], o[dt][1] * rs * wo[1]); q.y = pk2(o[dt][2] * rs * wo[2], o[dt][3] * rs * wo[3]);
      *(u32x2_t*)(MIX + (size_t)irow * 1024 + h * 128 + d0) = q; }
    asm volatile("s_waitcnt vmcnt(8)" ::: "memory");
    __syncthreads();
  }
#undef SP_STAGE
#undef SP_LOADREGS
}

DI void attn_phase(const MParams& p, int l, LAS unsigned char* lds) {
  unsigned char* ws = p.ws;
  const bf16_t *Q = (const bf16_t*)(ws + OFF_Q), *KB = (const bf16_t*)(ws + OFF_KB), *VT = (const bf16_t*)(ws + OFF_VT); bf16_t* MIX = (bf16_t*)(ws + OFF_MIX);
  constexpr int KBUF = 16384, VBUF = 16384, STG = KBUF + VBUF, QOFF = 3 * STG;
  static_assert(QOFF + 65536 <= LDS_BYTES, "attention LDS");
  const unsigned sv0 = __builtin_amdgcn_readfirstlane(((volatile LAS unsigned*)(lds + 131072))[0]), sv1 = __builtin_amdgcn_readfirstlane(((volatile LAS unsigned*)(lds + 131072))[1]), sv2 = __builtin_amdgcn_readfirstlane(((volatile LAS unsigned*)(lds + 131072))[2]);
  __syncthreads();
  const float lambda_init = 0.8f - 0.6f * expf(-0.3f * (float)(l + 1));
  const float* dnw = p.in[13] + l * 128;
#pragma unroll 1
  for (int pi = blockIdx.x; pi < 256; pi += gridDim.x) {
    const int b = pi >> 4, h = (pi >> 2) & 3, j = pi & 3;
#pragma unroll 1
    for (int it = 0; it < 2; ++it) {
      const int tid = tid_opaque(), lane = tid & 63, w = __builtin_amdgcn_readfirstlane(tid >> 6), l31 = lane & 31, hh = lane >> 5;
      const int qb = it ? j : 7 - j, t0 = b * 2048 + 256 * qb, ntl = 4 * qb + 4, ntw = 4 * qb + (w >> 1) + 1;
#pragma unroll
      for (int i = 0; i < 8; ++i) { const int P = (w * 8 + i) * 64 + lane, row = P >> 4, pos = P & 15, pc = pos ^ (row & 15);
        __builtin_amdgcn_global_load_lds((const unsigned*)(Q + (size_t)(t0 + row) * 512 + h * 128 + pc * 8), (LAS unsigned*)(lds + QOFF + (w * 8 + i) * 1024), 16, 0, 0); }
      const bf16_t* kbase = KB + (size_t)(b * 2048) * 512 + h * 128; const bf16_t* vbase = VT + (size_t)(h * 128) * T_TOK + b * 2048;
      int koff[2], voff[2];
#pragma unroll
      for (int i = 0; i < 2; ++i) { const int P = (w * 2 + i) * 64 + lane; { const int row = P >> 4, pos = P & 15, pc = pos ^ (row & 15); koff[i] = row * 512 + pc * 8; }
        { const int row = P >> 3, pos = P & 7, pc = pos ^ ((row >> 1) & 7); voff[i] = row * T_TOK + pc * 8; } }
#define ATT_STAGE(kt, buf) do { _Pragma("unroll") for (int i = 0; i < 2; ++i) { \
        __builtin_amdgcn_global_load_lds((const unsigned*)(kbase + (size_t)(kt) * (64 * 512) + koff[i]), (LAS unsigned*)(lds + (buf) * STG + (w * 2 + i) * 1024), 16, 0, 0); \
        __builtin_amdgcn_global_load_lds((const unsigned*)(vbase + (kt) * 64 + voff[i]), (LAS unsigned*)(lds + (buf) * STG + KBUF + (w * 2 + i) * 1024), 16, 0, 0); } } while (0)
#define ATT_STAGE_AT(kt, soff) do { _Pragma("unroll") for (int i = 0; i < 2; ++i) { \
        __builtin_amdgcn_global_load_lds((const unsigned*)(kbase + (size_t)(kt) * (64 * 512) + koff[i]), (LAS unsigned*)(lds + (soff) + (w * 2 + i) * 1024), 16, 0, 0); \
        __builtin_amdgcn_global_load_lds((const unsigned*)(vbase + (kt) * 64 + voff[i]), (LAS unsigned*)(lds + (soff) + KBUF + (w * 2 + i) * 1024), 16, 0, 0); } } while (0)
      ATT_STAGE(0, 0);
      if (ntl > 1) { ATT_STAGE(1, 1); asm volatile("s_waitcnt vmcnt(4)" ::: "memory"); } else asm volatile("s_waitcnt vmcnt(0)" ::: "memory");
      __syncthreads();
      int st_cur = 0, st_pre = 2 * STG;
      f32x16 O[2][4];
#pragma unroll
      for (int c = 0; c < 2; ++c)
#pragma unroll
        for (int bk = 0; bk < 4; ++bk)
#pragma unroll
          for (int i = 0; i < 16; ++i) O[c][bk][i] = 0.f;
      float lsum[2] = {0.f, 0.f};
      const int qr = 32 * w + l31;
      int k_lane = l31 * 256 + ((hh ^ (l31 & 15)) << 4), q_lane = QOFF + qr * 256 + ((hh ^ (qr & 15)) << 4), v_lane = KBUF + l31 * 128 + ((hh ^ ((l31 >> 1) & 7)) << 4);
#pragma unroll 1
      for (int kt = 0; kt < ntl; ++kt) {
        if (kt + 2 < ntl) ATT_STAGE_AT(kt + 2, st_pre);
        if (kt < ntw) {
          asm volatile("" : "+v"(k_lane), "+v"(q_lane), "+v"(v_lane));
          const LAS unsigned char* tb = lds + st_cur;
#pragma unroll
          for (int kb = 0; kb < 2; ++kb) {
            bf16x8 pf[2][2];
#pragma unroll
            for (int c = 0; c < 2; ++c) {
              f32x16 S;
#pragma unroll
              for (int i = 0; i < 16; ++i) S[i] = 0.f;
#pragma unroll
              for (int ks = 0; ks < 4; ++ks) {
                const int xo = (c * 8 + ks * 2) << 4;
                const bf16x8 qf = *(const LAS bf16x8*)(lds + (q_lane ^ xo));
                const bf16x8 kf = *(const LAS bf16x8*)(tb + (k_lane ^ xo) + kb * 8192);
                S = __builtin_amdgcn_mfma_f32_32x32x16_bf16(kf, qf, S, 0, 0, 0);
              }
              float ls = 0.f;
#pragma unroll
              for (int hs = 0; hs < 2; ++hs) { u32x4_t pw;
#pragma unroll
                for (int t = 0; t < 4; ++t) { const float a = __builtin_amdgcn_exp2f(S[8 * hs + 2 * t]), bq = __builtin_amdgcn_exp2f(S[8 * hs + 2 * t + 1]); ls += a + bq; pw[t] = pk2(a, bq); }
                pf[c][hs] = __builtin_bit_cast(bf16x8, pw); }
              lsum[c] += ls;
              __builtin_amdgcn_sched_barrier(0);
            }
#pragma unroll
            for (int bk = 0; bk < 4; ++bk) {
              const bf16x8 v0 = *(const LAS bf16x8*)(tb + (v_lane ^ ((2 * kb) << 5)) + bk * 4096);
              const bf16x8 v1 = *(const LAS bf16x8*)(tb + (v_lane ^ ((2 * kb + 1) << 5)) + bk * 4096);
              O[0][bk] = __builtin_amdgcn_mfma_f32_32x32x16_bf16(v0, pf[0][0], O[0][bk], 0, 0, 0);
              O[1][bk] = __builtin_amdgcn_mfma_f32_32x32x16_bf16(v0, pf[1][0], O[1][bk], 0, 0, 0);
              O[0][bk] = __builtin_amdgcn_mfma_f32_32x32x16_bf16(v1, pf[0][1], O[0][bk], 0, 0, 0);
              O[1][bk] = __builtin_amdgcn_mfma_f32_32x32x16_bf16(v1, pf[1][1], O[1][bk], 0, 0, 0);
              __builtin_amdgcn_sched_barrier(0);
            }
          }
        }
        if (kt + 2 < ntl) asm volatile("s_waitcnt vmcnt(4)" ::: "memory"); else asm volatile("s_waitcnt vmcnt(0)" ::: "memory");
        __syncthreads();
        st_pre = st_cur; st_cur = (st_cur == 2 * STG) ? 0 : st_cur + STG;
      }
#undef ATT_STAGE
#undef ATT_STAGE_AT
      const int tid2 = tid_opaque(), lane2 = tid2 & 63, w2 = __builtin_amdgcn_readfirstlane(tid2 >> 6), hh2 = lane2 >> 5, qr2 = 32 * w2 + (lane2 & 31);
      float lam;
      { const float* q1 = p.in[9] + l * 64; const float* k1 = p.in[10] + l * 64; const float* q2 = p.in[11] + l * 64; const float* k2 = p.in[12] + l * 64;
        float a = q1[lane2] * k1[lane2], bq = q2[lane2] * k2[lane2]; a = wave_sum(a); bq = wave_sum(bq); lam = expf(a) - expf(bq) + lambda_init; }
      float l1 = lsum[0], l2 = lsum[1]; l1 += __shfl_xor(l1, 32); l2 += __shfl_xor(l2, 32);
      const float inv1 = 1.0f / l1, inv2 = lam / l2; float ss = 0.f;
#pragma unroll
      for (int bk = 0; bk < 4; ++bk)
#pragma unroll
        for (int i = 0; i < 16; ++i) { const float o = O[0][bk][i] * inv1 - O[1][bk][i] * inv2; O[0][bk][i] = o; ss += o * o; }
      ss += __shfl_xor(ss, 32);
      const float rs = rsqrtf(ss * (1.0f / 128.0f) + EPS) * (1.0f - lambda_init);
      bf16_t* orow = MIX + (size_t)(t0 + qr2) * 1024 + 512 + h * 128;
#pragma unroll
      for (int bk = 0; bk < 4; ++bk)
#pragma unroll
        for (int g = 0; g < 4; ++g) { const int dv0 = 32 * bk + 8 * g + 4 * hh2; const f32x4 wv = *(const f32x4*)(dnw + dv0);
          u32x2_t q; q.x = pk2(O[0][bk][4 * g] * rs * wv[0], O[0][bk][4 * g + 1] * rs * wv[1]); q.y = pk2(O[0][bk][4 * g + 2] * rs * wv[2], O[0][bk][4 * g + 3] * rs * wv[3]);
          *(u32x2_t*)(orow + dv0) = q; }
    }
  }
  __syncthreads();
  if (threadIdx.x == 0) { volatile LAS unsigned* stw = (volatile LAS unsigned*)(lds + 131072); stw[0] = sv0; stw[1] = sv1; stw[2] = sv2; }
  __syncthreads();
}


#define XB_TMO      128
#define XB_XCNT(j)  (256  + 64 * (j))
#define XB_XSUB(j)  (1280 + 64 * (j))
#define XB_XGEN(j)  (2304 + 64 * (j))
#define XB_TOP      3328
#define XB_TOPGEN   3392
#define XCD_BAR_WORDS 3456
#define XB_SPIN_CAP (1u << 18)

__device__ __forceinline__ unsigned xb_ld(unsigned* p)              { return __hip_atomic_load(p, __ATOMIC_RELAXED, __HIP_MEMORY_SCOPE_AGENT); }
__device__ __forceinline__ unsigned xb_add(unsigned* p, unsigned v) { return __hip_atomic_fetch_add(p, v, __ATOMIC_RELAXED, __HIP_MEMORY_SCOPE_AGENT); }
__device__ __forceinline__ unsigned xb_xcc_id() { return (unsigned)__builtin_amdgcn_s_getreg((3 << 11) | 20) & 0xFu; }
#define XB_SPIN(cond, bar) do { unsigned _sp = 0; while (cond) { __builtin_amdgcn_s_sleep(1); \
    if ((++_sp & 255u) == 0u) { if (xb_ld(&(bar)[XB_TMO])) break; if (_sp > XB_SPIN_CAP) { atomicAdd(&(bar)[XB_TMO], 1u); break; } } } } while (0)

struct XcdBarrier {
    unsigned* bar; unsigned x;
    volatile LAS unsigned* st;
};

__device__ __forceinline__ XcdBarrier xcd_barrier_post(unsigned* bar, volatile LAS unsigned* st) {
    XcdBarrier b; b.bar = bar; b.x = xb_xcc_id(); b.st = st;
    if (threadIdx.x == 0) (void)xb_add(&bar[XB_XCNT(b.x)], 1u);
    return b;
}
__device__ __forceinline__ void xcd_barrier_complete(unsigned* bar, unsigned x, unsigned& nloc, unsigned& nx) {
    const unsigned G = gridDim.x * gridDim.y * gridDim.z;
    unsigned sum, cnt, mine, sp = 0u;
    for (;;) {
        sum = 0u; cnt = 0u; mine = 0u;
#pragma unroll
        for (unsigned j = 0; j < 16; ++j) { const unsigned c = xb_ld(&bar[XB_XCNT(j)]); sum += c; cnt += (c > 0u) ? 1u : 0u; mine = (j == x) ? c : mine; }
        if (sum == G) break;
        __builtin_amdgcn_s_sleep(1);
        if ((++sp & 255u) == 0u) { if (xb_ld(&bar[XB_TMO])) break; if (sp > XB_SPIN_CAP) { atomicAdd(&bar[XB_TMO], 1u); break; } }
    }
    nloc = mine > 0u ? mine : 1u; nx = cnt > 0u ? cnt : 1u;
}

__device__ __forceinline__ void xcd_barrier(const XcdBarrier& b) {
    asm volatile("s_waitcnt vmcnt(0)" ::: "memory");
    __syncthreads();
    if (threadIdx.x == 0) {
        unsigned* bar = b.bar;
        __builtin_amdgcn_s_waitcnt(0);
        unsigned nloc = b.st[0], nx = b.st[1];
        if (nloc == 0u) { xcd_barrier_complete(bar, b.x, nloc, nx); b.st[0] = nloc; b.st[1] = nx; }
        const unsigned old = xb_add(&bar[XB_XSUB(b.x)], 1u);
        const unsigned gen = old / nloc;
        if (old + 1u == (gen + 1u) * nloc) {
            __builtin_amdgcn_fence(__ATOMIC_RELEASE, "agent");
            asm volatile("s_waitcnt vmcnt(0)" ::: "memory");
            const unsigned og = xb_add(&bar[XB_TOP], 1u);
            const unsigned tg = og / nx;
            if (og + 1u == (tg + 1u) * nx) xb_add(&bar[XB_TOPGEN], 1u);
            else XB_SPIN(xb_ld(&bar[XB_TOPGEN]) == tg, bar);
            __builtin_amdgcn_fence(__ATOMIC_ACQUIRE, "agent");
            xb_add(&bar[XB_XGEN(b.x)], 1u);
            asm volatile("s_waitcnt vmcnt(0)" ::: "memory");
        } else {
            XB_SPIN(xb_ld(&bar[XB_XGEN(b.x)]) == gen, bar);
            __builtin_amdgcn_fence(__ATOMIC_ACQUIRE, "agent");
            asm volatile("s_waitcnt vmcnt(0)" ::: "memory");
        }
    }
    __syncthreads();
}

DI void zero_u64(u64* p, int n) { for (int i = blockIdx.x * 512 + tid_opaque(); i < n; i += gridDim.x * 512) p[i] = 0ull; }

#if PROBE_EPI_ACE
typedef DupOrder OrderACE;
#else
typedef pg8::StaticOrder OrderACE;
#endif
DI void phaseA(const MParams& p, int l, LAS unsigned char* lds) {
  unsigned char* ws = p.ws; const bf16_t* XB = (const bf16_t*)(ws + OFF_XB); const bf16_t* WinT = (const bf16_t*)(ws + OFF_W + (size_t)l * W_STRIDE + WO_IN); const u64* SS1 = (const u64*)(ws + OFF_SS1);
  zero_u64((u64*)(ws + OFF_SS2), T_TOK);
  { pg8::Gemm g{XB, WinT, T_TOK, 1536, DM}; OrderACE S; S.init(T_TOK, 1536, gridDim.x, blockIdx.x);
    EpiA1 E{SS1, (bf16_t*)(ws + OFF_U), (bf16_t*)(ws + OFF_Q), (bf16_t*)(ws + OFF_KB), p.in[7] + l * 64, p.in[8] + l * 64}; pg8::gemm_phase<EpiA1, OrderACE>(lds, g, S, E); }
  { pg8::Gemm g{WinT + (size_t)1536 * DM, XB, 1024, T_TOK, DM}; OrderACE S; S.init(1024, T_TOK, gridDim.x, blockIdx.x);
    EpiA2 E{SS1, (bf16_t*)(ws + OFF_GVT), (bf16_t*)(ws + OFF_VT), (u64*)(ws + OFF_SSV)}; pg8::gemm_phase<EpiA2, OrderACE>(lds, g, S, E); }
}
DI void phaseCE(const MParams& p, int l, bool isC, LAS unsigned char* lds) {
  unsigned char* ws = p.ws; const unsigned char* wb = ws + OFF_W + (size_t)l * W_STRIDE;
  if (isC) zero_u64((u64*)(ws + OFF_SS1), T_TOK);
  pg8::Gemm g{(const bf16_t*)(ws + (isC ? OFF_MIX : OFF_F)), (const bf16_t*)(wb + (isC ? WO_OUT : WO_DN)), T_TOK, DM, isC ? DM : DFF}; OrderACE S; S.init(T_TOK, DM, gridDim.x, blockIdx.x);
  EpiResid E{(isC && l == 0) ? p.in[0] : nullptr, (!isC && l == NLAYER - 1) ? p.out : nullptr, (bf16_t*)(ws + OFF_XB), (u64*)(ws + (isC ? OFF_SS2 : OFF_SS1))}; pg8::gemm_phase<EpiResid, OrderACE>(lds, g, S, E);
}
DI void phaseD(const MParams& p, int l, LAS unsigned char* lds) {
  unsigned char* ws = p.ws;
  zero_u64((u64*)(ws + OFF_SSV), T_TOK * 4);
  pg8::Gemm g{(const bf16_t*)(ws + OFF_XB), (const bf16_t*)(ws + OFF_W + (size_t)l * W_STRIDE + WO_GU), T_TOK, 2 * DFF, DM};
#if PROBE_EPI_D
  DupOrder S;
#else
  pg8::StaticOrder S;
#endif
  S.init(T_TOK, 2 * DFF, gridDim.x, blockIdx.x);
  EpiD E{(const u64*)(ws + OFF_SS2), p.in[18] + (size_t)l * 3 * DFF, p.in[19] + (size_t)l * DFF, (bf16_t*)(ws + OFF_F), (float*)(ws + OFF_GB), (float*)(ws + OFF_PB), (float*)(ws + OFF_UB)};
#if PROBE_EPI_D
  pg8::gemm_phase<EpiD, DupOrder>(lds, g, S, E);
#else
  pg8::gemm_phase<EpiD, pg8::StaticOrder>(lds, g, S, E);
#endif
}

__global__ void __launch_bounds__(512) k_run(MParams p) {
  extern __shared__ __attribute__((aligned(16))) unsigned char lds_raw[];
  LAS unsigned char* lds = (LAS unsigned char*)lds_raw;
  cg::grid_group grid = cg::this_grid();
  if (threadIdx.x < 4) ((LAS unsigned*)(lds + 131072))[threadIdx.x] = 0u;
  __syncthreads();
  XcdBarrier xbar = xcd_barrier_post((unsigned*)(p.ws + OFF_BAR), (volatile LAS unsigned*)(lds + 131072));
  if (p.ph_lo < 0) grid.sync();
  for (int ph = p.ph_lo; ph < p.ph_hi; ++ph) {
    for (int rep = 0; rep < 1 + ((PROBE_MASK >> (ph == 0 ? 6 : (ph - 1) % 6)) & 1); ++rep) {
    if (ph == 0) { if (EN_MASK & 1) prologue(p); }
    else {
      const int l = (ph - 1) / 6, s = (ph - 1) % 6;
      if (s == 0) { if (EN_MASK & 2) phaseA(p, l, lds); }
      else if (s == 1) { if (EN_MASK & 4) attn_phase(p, l, lds); if (EN_MASK & 8) { const LP lp = make_lp(p, l); spatial_phase(lp, p.ws, lds); } }
      else if (s == 2 || s == 5) { if (EN_MASK & 16) phaseCE(p, l, s == 2, lds); }
      else if (s == 3) { if (EN_MASK & 32) phaseD(p, l, lds); }
      else { if (EN_MASK & 64) { const LP lp = make_lp(p, l); fixup_phase(lp, p.ws); } }
    }
    }
    if (ph + 1 < p.ph_hi) xcd_barrier(xbar);
  }
}

extern "C" void kernel_launch(void* const* d_in, const int* in_sizes, int n_in, void* d_out, int out_size, void* d_ws, size_t ws_size, hipStream_t stream) {
  static int grid_blocks = 0;
  if (!grid_blocks) {
    (void)hipFuncSetAttribute((const void*)k_run, hipFuncAttributeMaxDynamicSharedMemorySize, LDS_BYTES);
    int dev = 0, cus = 0, per_cu = 0; (void)hipGetDevice(&dev); (void)hipDeviceGetAttribute(&cus, hipDeviceAttributeMultiprocessorCount, dev);
    (void)hipOccupancyMaxActiveBlocksPerMultiprocessor(&per_cu, (const void*)k_run, 512, LDS_BYTES); if (per_cu < 1) per_cu = 1;
    grid_blocks = cus * per_cu; if (grid_blocks > 256) grid_blocks = 256;
  }
  MParams mp; memset(&mp, 0, sizeof(mp));
  for (int i = 0; i < 21; ++i) mp.in[i] = (const float*)d_in[i];
  mp.out = (float*)d_out; mp.ws = (unsigned char*)d_ws; mp.ph_lo = 0; mp.ph_hi = 1 + 6 * NLAYER;
  (void)hipMemsetAsync((unsigned char*)d_ws + OFF_BAR, 0, 3456 * sizeof(unsigned), stream);
  void* args[] = {&mp};
  hipError_t e = hipLaunchCooperativeKernel((const void*)k_run, dim3(grid_blocks), dim3(512), args, LDS_BYTES, stream);
  if (e != hipSuccess) fprintf(stderr, "cooperative launch failed: %s (grid %d)\n", hipGetErrorString(e), grid_blocks);
}
```

```cpp
#include <hip/hip_runtime.h>
#include <hip/hip_cooperative_groups.h>
#include <cstdio>
#include <cmath>
#include <cstring>

typedef unsigned short bf16_t;
#define DI __device__ __forceinline__

constexpr int T_TOK = 32768, DM = 1024, SEQ = 2048, DFF = 2816, INW = 2560, NLAYER = 4;
constexpr float EPS = 1e-6f;
constexpr float QSCALE = 0.125f * 1.4426950408889634f;

constexpr size_t MiB = 1024ull * 1024ull;
constexpr size_t OFF_XB = 0;
constexpr size_t OFF_R = 64 * MiB;
constexpr size_t OFF_U = OFF_R, OFF_Q = OFF_R + 32 * MiB, OFF_KB = OFF_R + 64 * MiB, OFF_GVT = OFF_R + 96 * MiB, OFF_VT = OFF_R + 128 * MiB, OFF_MIX = OFF_R + 160 * MiB;
constexpr size_t OFF_F = OFF_R, OFF_GB = OFF_R + 176 * MiB, OFF_PB = OFF_R + 188 * MiB, OFF_UB = OFF_R + 200 * MiB;
constexpr size_t OFF_W = 288 * MiB, W_STRIDE = 24 * MiB;
constexpr size_t WO_IN = 0, WO_OUT = 5 * MiB, WO_GU = 7 * MiB, WO_DN = 18 * MiB, WO_SP = 23 * MiB + 512 * 1024;
constexpr size_t OFF_SS1 = 384 * MiB, OFF_SS2 = OFF_SS1 + 256 * 1024, OFF_SSV = OFF_SS2 + 256 * 1024;
constexpr size_t OFF_BAR = 385 * MiB + 512 * 1024;
constexpr size_t OFF_TMP1 = 386 * MiB, OFF_TMP2 = 418 * MiB;

DI int tid_opaque() { int t = threadIdx.x; asm volatile("" : "+v"(t)); return t; }
DI float bf2f(bf16_t b) { return __uint_as_float(((unsigned)b) << 16); }
DI bf16_t f2bf(float f) { unsigned u = __float_as_uint(f); u += 0x7FFFu + ((u >> 16) & 1u); return (bf16_t)(u >> 16); }
DI float gelu_exact(float x) { return 0.5f * x * (1.0f + erff(x * 0.70710678118654752f)); }
DI int permpos16(int k) { return (k & 3) + 4 * (k >> 3) + 8 * ((k >> 2) & 1); }
DI float wave_sum(float v) { for (int o = 32; o >= 1; o >>= 1) v += __shfl_xor(v, o); return v; }

namespace pg8 {
#define PG8_LAS __attribute__((address_space(3)))
typedef unsigned short bf16_t;
typedef short bf16x8 __attribute__((ext_vector_type(8)));
typedef float f32x4 __attribute__((ext_vector_type(4)));
typedef unsigned u32x4 __attribute__((ext_vector_type(4)));
constexpr int BM = 256, BK = 64, HALF = 128, HTB = HALF * BK * 2  , STAGE_BYTES = 8 * HTB, NXCD = 8, WGM = 8;

__host__ __device__ __forceinline__ int lds_byte(int r, int c) { const int st = (r >> 4) * 2 + (c >> 5), rr = r & 15, cc = c & 31, ob = rr * 64 + cc * 2; return st * 1024 + (ob ^ (((ob >> 9) & 1) << 5)); }
__host__ __device__ __forceinline__ void stage_rc(int b, int& R, int& C) { const int st = b / 1024, sb = b % 1024, swz = sb ^ (((sb >> 9) & 1) << 5); R = (st >> 1) * 16 + swz / 64; C = (st & 1) * 32 + (swz % 64) / 2; }
__host__ __device__ __forceinline__ int perm32(int rho) { const int n = rho >> 4, i = rho & 15; return 8 * (i >> 2) + 4 * n + (i & 3); }

struct Unit { int pm, pn; };
struct Gemm { const bf16_t* A; const bf16_t* Bt; int M, N, K; };

struct StaticOrder {
    int nM, nN, nwg, G, c;
    __host__ __device__ void init(int M, int N, int G_, int c_) { nM = M / BM; nN = N / BM; nwg = nM * nN; G = G_; c = c_; }
    __host__ __device__ bool next(int i, Unit& u) const {
        const long L = (long)i * G + c; if (L >= nwg) return false;
        int wgid = (int)L; { const int q = nwg / NXCD, r = nwg % NXCD, xcd = wgid % NXCD, off = wgid / NXCD; wgid = (xcd < r ? xcd * (q + 1) : r * (q + 1) + (xcd - r) * q) + off; }
        const int nig = WGM * nN, gid = wgid / nig, fm = gid * WGM, gsz = (nM - fm) < WGM ? (nM - fm) : WGM;
        u.pm = fm + ((wgid % nig) % gsz); u.pn = (wgid % nig) / gsz; return true;
    }
    __device__ __forceinline__ void a_ready(const Unit&) const {}
    __device__ __forceinline__ void done(const Unit&) const {}
};
template <class Epi, class Sched>
__device__ __forceinline__ void gemm_phase(PG8_LAS unsigned char* lds, const Gemm g, const Sched& S, const Epi& E) {
    const int tid = tid_opaque(), wid = __builtin_amdgcn_readfirstlane(tid >> 6), lane = tid & 63, wr = wid >> 2, wc = wid & 3, fr = lane & 15, fq = lane >> 4;
    const int K = g.K, nt = K / BK;
    unsigned voffA[2], voffB[2];
#pragma unroll
    for (int i = 0; i < 2; ++i) { int R, C; stage_rc(tid * 16 + i * 8192, R, C); const int Rb = Epi::PERM ? ((R & ~31) + perm32(R & 31)) : R;
        voffA[i] = (unsigned)(R * K + C) * 2u; voffB[i] = (unsigned)(Rb * K + C) * 2u; }
    const size_t kstep = (size_t)(BK * 2);
    const size_t hstep = (size_t)HALF * K * 2;
    const size_t tstep = 2 * hstep;
    const unsigned ldsw = (unsigned)wid * 1024u;
    const int aoff = lds_byte(wr * 64 + fr, fq * 8), boff = lds_byte(wc * 32 + fr, fq * 8);
#define PG8_SA(b, h) (((b) * 2 + (h)) * HTB)
#define PG8_SB(b, h) ((4 + (b) * 2 + (h)) * HTB)
#define PG8_STAGE(bufoff, gbase, voff) do { _Pragma("unroll") for (int _i = 0; _i < 2; ++_i) \
        __builtin_amdgcn_global_load_lds((const unsigned*)((const char*)(gbase) + (voff)[_i]), (PG8_LAS unsigned*)(lds + (bufoff) + ldsw + _i * 8192), 16, 0, 0); } while (0)
#define PG8_LDA(dst, b, h) do { _Pragma("unroll") for (int m = 0; m < 4; ++m) _Pragma("unroll") for (int k = 0; k < 2; ++k) dst[m][k] = *(const PG8_LAS bf16x8*)(lds + PG8_SA(b, h) + aoff + m * 2048 + k * 1024); } while (0)
#define PG8_LDB(dst, b, h) do { _Pragma("unroll") for (int n = 0; n < 2; ++n) _Pragma("unroll") for (int k = 0; k < 2; ++k) dst[n][k] = *(const PG8_LAS bf16x8*)(lds + PG8_SB(b, h) + boff + n * 2048 + k * 1024); } while (0)
#define PG8_MMA(ai, bj, At, Bt) do { __builtin_amdgcn_s_setprio(1); _Pragma("unroll") for (int m = 0; m < 4; ++m) _Pragma("unroll") for (int n = 0; n < 2; ++n) _Pragma("unroll") for (int k = 0; k < 2; ++k) \
        acc[ai][bj][m][n] = __builtin_amdgcn_mfma_f32_16x16x32_bf16(Bt[n][k], At[m][k], acc[ai][bj][m][n], 0, 0, 0); __builtin_amdgcn_s_setprio(0); } while (0)
#define PG8_WAIT_V(n) asm volatile("s_waitcnt vmcnt(" #n ")" ::: "memory")
#define PG8_WAIT_L(n) asm volatile("s_waitcnt lgkmcnt(" #n ")" ::: "memory")
#define PG8_BAR __builtin_amdgcn_s_barrier()
#define PG8_SCHED __builtin_amdgcn_sched_barrier(0)
    Unit cur, nxt; int ui = 0;
    if (!S.next(0, cur)) return;
    f32x4 acc[2][2][4][2];
#pragma unroll
    for (int a = 0; a < 2; ++a)
#pragma unroll
        for (int b = 0; b < 2; ++b)
#pragma unroll
            for (int m = 0; m < 4; ++m)
#pragma unroll
                for (int n = 0; n < 2; ++n) acc[a][b][m][n] = (f32x4){0.f, 0.f, 0.f, 0.f};
    bf16x8 At[4][2], B0[2][2], B1[2][2];
    const char* cA = (const char*)g.A + (size_t)cur.pm * tstep; const char* cB = (const char*)g.Bt + (size_t)cur.pn * tstep;
    S.a_ready(cur);
    PG8_STAGE(PG8_SB(0, 0), cB, voffB); PG8_STAGE(PG8_SA(0, 0), cA, voffA); PG8_STAGE(PG8_SB(0, 1), cB + hstep, voffB); PG8_STAGE(PG8_SA(0, 1), cA + hstep, voffA);
    if (wr == 1) PG8_BAR;
    PG8_WAIT_V(4); PG8_BAR;
    PG8_STAGE(PG8_SB(1, 0), cB + kstep, voffB); PG8_STAGE(PG8_SA(1, 0), cA + kstep, voffA); PG8_STAGE(PG8_SB(1, 1), cB + hstep + kstep, voffB);
    PG8_WAIT_V(6); PG8_BAR;
    for (;;) {
        const bool has_next = S.next(ui + 1, nxt);
        const char* nA = has_next ? (const char*)g.A + (size_t)nxt.pm * tstep : cA; const char* nB = has_next ? (const char*)g.Bt + (size_t)nxt.pn * tstep : cB;
        for (int t = 0; t < nt; t += 2) {
            const bool last = (t == nt - 2);
            const char* a1 = cA + (size_t)(t + 1) * kstep;
            const char* a2 = last ? nA : cA + (size_t)(t + 2) * kstep; const char* b2 = last ? nB : cB + (size_t)(t + 2) * kstep;
            const char* a3 = a2 + kstep; const char* b3 = b2 + kstep;
            if (last && has_next) S.a_ready(nxt);
            PG8_LDB(B0, 0, 0); PG8_SCHED; PG8_LDA(At, 0, 0); PG8_STAGE(PG8_SA(1, 1), a1 + hstep, voffA);
            PG8_WAIT_L(8); PG8_BAR; PG8_WAIT_L(0); PG8_MMA(0, 0, At, B0); PG8_BAR; PG8_SCHED;
            PG8_LDB(B1, 0, 1); PG8_STAGE(PG8_SB(0, 0), b2, voffB);
            PG8_BAR; PG8_WAIT_L(0); PG8_MMA(0, 1, At, B1); PG8_BAR;
            PG8_LDA(At, 0, 1); PG8_STAGE(PG8_SA(0, 0), a2, voffA);
            PG8_BAR; PG8_WAIT_L(0); PG8_MMA(1, 0, At, B0); PG8_BAR; PG8_SCHED;
            PG8_STAGE(PG8_SB(0, 1), b2 + hstep, voffB);
            PG8_WAIT_V(6); PG8_BAR; PG8_MMA(1, 1, At, B1); PG8_BAR;
            PG8_LDB(B0, 1, 0); PG8_SCHED; PG8_LDA(At, 1, 0); PG8_STAGE(PG8_SA(0, 1), a2 + hstep, voffA);
            PG8_WAIT_L(8); PG8_BAR; PG8_WAIT_L(0); PG8_MMA(0, 0, At, B0); PG8_BAR; PG8_SCHED;
            PG8_LDB(B1, 1, 1); PG8_STAGE(PG8_SB(1, 0), b3, voffB);
            PG8_BAR; PG8_WAIT_L(0); PG8_MMA(0, 1, At, B1); PG8_BAR;
            PG8_LDA(At, 1, 1); PG8_STAGE(PG8_SA(1, 0), a3, voffA);
            PG8_BAR; PG8_WAIT_L(0); PG8_MMA(1, 0, At, B0); PG8_BAR; PG8_SCHED;
            PG8_STAGE(PG8_SB(1, 1), b3 + hstep, voffB);
            PG8_WAIT_V(6); PG8_BAR; PG8_MMA(1, 1, At, B1); PG8_BAR;
        }
        if constexpr (!Epi::AFTER_DRAIN) { if (!Epi::TWICE || (ui & 1)) E(acc, cur, wr, wc, fr, fq); S.done(cur); }
        if (!has_next) break;
#pragma unroll
        for (int a = 0; a < 2; ++a)
#pragma unroll
            for (int b = 0; b < 2; ++b)
#pragma unroll
                for (int m = 0; m < 4; ++m)
#pragma unroll
                    for (int n = 0; n < 2; ++n) acc[a][b][m][n] = (f32x4){0.f, 0.f, 0.f, 0.f};
        cur = nxt; cA = nA; cB = nB; ++ui;
    }
    PG8_WAIT_V(0);
    if (wr == 0) PG8_BAR;
    PG8_BAR;
    if constexpr (Epi::AFTER_DRAIN) { E.fused(acc, cur, wr, wc, fr, fq, lds, wid, lane); S.done(cur); }
#undef PG8_SA
#undef PG8_SB
#undef PG8_STAGE
#undef PG8_LDA
#undef PG8_LDB
#undef PG8_MMA
#undef PG8_WAIT_V
#undef PG8_WAIT_L
#undef PG8_BAR
#undef PG8_SCHED
}
}

namespace cg = cooperative_groups;
using pg8::f32x4; using pg8::bf16x8; using pg8::Unit;
typedef unsigned u32x2_t __attribute__((ext_vector_type(2)));
typedef unsigned u32x4_t __attribute__((ext_vector_type(4)));
typedef float f32x16 __attribute__((ext_vector_type(16)));
typedef float f32x2_t __attribute__((ext_vector_type(2)));
#define LAS PG8_LAS
constexpr int LDS_BYTES = 163840;
#ifndef EN_MASK
#define EN_MASK 0x7f
#endif
#ifndef PROBE_EPI_ACE
#define PROBE_EPI_ACE 0
#endif
#ifndef PROBE_EPI_D
#define PROBE_EPI_D 0
#endif
#ifndef PROBE_SYNC
#define PROBE_SYNC 0
#endif
#ifndef PROBE_MASK
#define PROBE_MASK 0x00
#endif

DI unsigned pk2(float lo, float hi) { unsigned r; asm volatile("s_nop 0\n\tv_cvt_pk_bf16_f32 %0, %1, %2\n\ts_nop 1" : "=v"(r) : "v"(lo), "v"(hi)); return r; }
DI float bflo(unsigned w) { return __uint_as_float(w << 16); }
DI float bfhi(unsigned w) { return __uint_as_float(w & 0xffff0000u); }
DI float gelu1(float v) {
  const float av = fabsf(v), t = __builtin_amdgcn_rcpf(av * 0.2316418882f + 1.0f);
  float q = t * 0.5307027145f + (-0.7265760135f); q = q * t + 0.7107068705f; q = q * t + (-0.142248368f); q = q * t + 0.127414796f; q = q * t;
  const float e = __builtin_amdgcn_exp2f((v * v) * (-0.72134752044f));
  const float m = v * (q * e);
  return v < 0.f ? m : v - m;
}
DI float dpp_ror1(float v) { return __builtin_bit_cast(float, __builtin_amdgcn_update_dpp(0, __builtin_bit_cast(int, v), 0x121, 0xf, 0xf, false)); }
DI float dpp_ror2(float v) { return __builtin_bit_cast(float, __builtin_amdgcn_update_dpp(0, __builtin_bit_cast(int, v), 0x122, 0xf, 0xf, false)); }
typedef unsigned long long u64;
DI float fx2f(u64 v) { return (float)v * (1.0f / 1048576.0f); }
DI u64 f2fx(float v) { return (u64)(v * 1048576.0f + 0.5f); }
DI void fx_add(u64* p, float v) { __hip_atomic_fetch_add(p, f2fx(v), __ATOMIC_RELAXED, __HIP_MEMORY_SCOPE_AGENT); }
DI float rs1024(u64 ss) { return rsqrtf(fx2f(ss) * (1.0f / 1024.0f) + EPS); }

struct MParams { const float* in[21]; float* out; unsigned char* ws; int ph_lo, ph_hi; };
struct LP {
  const float *norm_attn_w, *w_in, *v_norm_w, *sp_w, *sp_b, *out_norm_w, *q_norm_w, *k_norm_w, *lq1, *lk1, *lq2, *lk2, *diff_norm_w, *w_out, *norm_ffn_w, *w_gate, *w_up, *conv_w, *conv_b, *w_down;
  float lambda_init;
  const bf16_t *WinT, *WoutT, *WguT, *WdT, *Wsp;
};
DI LP make_lp(const MParams& p, int l) {
  LP L;
  L.norm_attn_w = p.in[1] + (size_t)l * DM; L.w_in = p.in[2] + (size_t)l * DM * INW; L.v_norm_w = p.in[3] + (size_t)l * 512; L.sp_w = p.in[4] + (size_t)l * 65536; L.sp_b = p.in[5] + (size_t)l * 512;
  L.out_norm_w = p.in[6] + (size_t)l * 512; L.q_norm_w = p.in[7] + (size_t)l * 64; L.k_norm_w = p.in[8] + (size_t)l * 64; L.lq1 = p.in[9] + (size_t)l * 64; L.lk1 = p.in[10] + (size_t)l * 64;
  L.lq2 = p.in[11] + (size_t)l * 64; L.lk2 = p.in[12] + (size_t)l * 64; L.diff_norm_w = p.in[13] + (size_t)l * 128; L.w_out = p.in[14] + (size_t)l * DM * DM; L.norm_ffn_w = p.in[15] + (size_t)l * DM;
  L.w_gate = p.in[16] + (size_t)l * DM * DFF; L.w_up = p.in[17] + (size_t)l * DM * DFF; L.conv_w = p.in[18] + (size_t)l * 3 * DFF; L.conv_b = p.in[19] + (size_t)l * DFF; L.w_down = p.in[20] + (size_t)l * DFF * DM;
  L.lambda_init = 0.8f - 0.6f * expf(-0.3f * (float)(l + 1));
  const unsigned char* wb = p.ws + OFF_W + (size_t)l * W_STRIDE;
  L.WinT = (const bf16_t*)(wb + WO_IN); L.WoutT = (const bf16_t*)(wb + WO_OUT); L.WguT = (const bf16_t*)(wb + WO_GU); L.WdT = (const bf16_t*)(wb + WO_DN); L.Wsp = (const bf16_t*)(wb + WO_SP);
  return L;
}
DI float lam_of(const LP& lp) {
  const int lane = threadIdx.x & 63;
  float a = lp.lq1[lane] * lp.lk1[lane], b = lp.lq2[lane] * lp.lk2[lane];
  a = wave_sum(a); b = wave_sum(b);
  return expf(a) - expf(b) + lp.lambda_init;
}

DI void conv_item(bf16_t* dst, int K, int row, int kg, const float* src, int ld, int col, const float* ks) {
  float v[32];
#pragma unroll
  for (int i = 0; i < 32; ++i) v[i] = src[(size_t)(kg * 32 + i) * ld + col];
  if (ks) {
#pragma unroll
    for (int i = 0; i < 32; i += 4) { const f32x4 s = *(const f32x4*)(ks + kg * 32 + i); v[i] *= s[0]; v[i + 1] *= s[1]; v[i + 2] *= s[2]; v[i + 3] *= s[3]; }
  }
  u32x4_t* d = (u32x4_t*)(dst + (size_t)row * K + kg * 32);
#pragma unroll
  for (int i = 0; i < 4; ++i) { u32x4_t w; w.x = pk2(v[8 * i], v[8 * i + 1]); w.y = pk2(v[8 * i + 2], v[8 * i + 3]); w.z = pk2(v[8 * i + 4], v[8 * i + 5]); w.w = pk2(v[8 * i + 6], v[8 * i + 7]); d[i] = w; }
}
DI int perm_logical(int p) {
  const int bj = p >> 7, wc = (p >> 5) & 3, n = (p >> 4) & 1, fq = (p >> 2) & 3, e = p & 3;
  return 64 * wc + 32 * bj + 8 * fq + 4 * n + e;
}
DI int perm_res(int p) { return (p & ~31) + 8 * ((p >> 2) & 3) + 4 * ((p >> 4) & 1) + (p & 3); }
DI void prologue(const MParams& p) {
  const int tidp = tid_opaque(); const int gtid = blockIdx.x * 512 + tidp, gsz = gridDim.x * 512;
  unsigned char* ws = p.ws;
  { const int gw = gtid >> 6, nw = gsz >> 6, lane = threadIdx.x & 63; bf16_t* XB = (bf16_t*)(ws + OFF_XB); u64* SS1 = (u64*)(ws + OFF_SS1);
    for (int row = gw; row < T_TOK; row += nw) { const float* xp = p.in[0] + (size_t)row * DM; float s = 0.f;
#pragma unroll
      for (int i = 0; i < 4; ++i) { const f32x4 v = *(const f32x4*)(xp + i * 256 + lane * 4); s += v[0] * v[0] + v[1] * v[1] + v[2] * v[2] + v[3] * v[3];
        u32x2_t w; w.x = pk2(v[0], v[1]); w.y = pk2(v[2], v[3]); *(u32x2_t*)(XB + (size_t)row * DM + i * 256 + lane * 4) = w; }
      s = wave_sum(s); if (lane == 0) SS1[row] = f2fx(s); } }
  { u64* SSV = (u64*)(ws + OFF_SSV); for (int i = gtid; i < T_TOK * 4; i += gsz) SSV[i] = 0ull; }
  for (int l = 0; l < NLAYER; ++l) {
    const LP lp = make_lp(p, l);
    for (int w = gtid; w < 2560 * 32; w += gsz) { const int row = w % 2560, kg = w / 2560; int col;
      if (row < 1536) { const int L = (row & ~255) + perm_logical(row & 255); col = L < 512 ? L : L + 512; }
      else { const int r = row - 1536; col = r < 512 ? 512 + r : 1536 + r; }
      conv_item((bf16_t*)lp.WinT, 1024, row, kg, lp.w_in, INW, col, lp.norm_attn_w); }
    for (int w = gtid; w < 1024 * 32; w += gsz) { const int row = w % 1024, kg = w / 1024; conv_item((bf16_t*)lp.WoutT, 1024, row, kg, lp.w_out, DM, perm_res(row), nullptr); }
    for (int w = gtid; w < 5632 * 32; w += gsz) { const int row = w % 5632, kg = w / 5632; const int pn = row >> 8, pp = row & 255, bj = pp >> 7;
      const int q = pp & 127, wc = (q >> 5) & 3, n = (q >> 4) & 1, fq = (q >> 2) & 3, e = q & 3; const int cc = 128 * pn + 32 * wc + 8 * fq + 4 * n + e;
      conv_item((bf16_t*)lp.WguT, 1024, row, kg, bj ? lp.w_up : lp.w_gate, DFF, cc, lp.norm_ffn_w); }
    for (int w = gtid; w < 1024 * 88; w += gsz) { const int row = w % 1024, kg = w / 1024; conv_item((bf16_t*)lp.WdT, DFF, row, kg, lp.w_down, DM, perm_res(row), nullptr); }
    for (int i = gtid; i < 65536; i += gsz) { const int jj = i & 127, ii = (i >> 7) & 127; ((bf16_t*)lp.Wsp)[i] = ((jj >> 6) <= (ii >> 6)) ? f2bf(lp.sp_w[i]) : (bf16_t)0; }
  }
}

struct DupOrder : pg8::StaticOrder {
  __device__ bool next(int i, Unit& u) const { return pg8::StaticOrder::next(i >> 1, u); }
};
struct EpiResid {
  static constexpr bool PERM = false, AFTER_DRAIN = false, TWICE = (PROBE_EPI_ACE != 0);
  const float* base32; float* out32; bf16_t* XB; u64* SS;
  DI void operator()(const f32x4 (&acc)[2][2][4][2], const Unit& u, int wr, int wc, int fr, int fq) const {
    const int row0 = u.pm * 256 + wr * 64 + fr, col0 = u.pn * 256 + wc * 32 + 8 * fq;
    if (base32) {
      f32x4 nb[2][2];
#pragma unroll
      for (int bj = 0; bj < 2; ++bj)
#pragma unroll
        for (int n = 0; n < 2; ++n) nb[bj][n] = *(const f32x4*)(base32 + (size_t)row0 * DM + col0 + bj * 128 + n * 4);
#pragma unroll
      for (int g = 0; g < 8; ++g) { const int ai = g >> 2, m = g & 3; const int row = row0 + ai * 128 + m * 16; const size_t ro = (size_t)row * DM + col0; float ss = 0.f;
        f32x4 cbv[2][2];
#pragma unroll
        for (int bj = 0; bj < 2; ++bj)
#pragma unroll
          for (int n = 0; n < 2; ++n) cbv[bj][n] = nb[bj][n];
        if (g < 7) { const int r2 = row0 + ((g + 1) >> 2) * 128 + ((g + 1) & 3) * 16;
#pragma unroll
          for (int bj = 0; bj < 2; ++bj)
#pragma unroll
            for (int n = 0; n < 2; ++n) nb[bj][n] = *(const f32x4*)(base32 + (size_t)r2 * DM + col0 + bj * 128 + n * 4); }
#pragma unroll
        for (int bj = 0; bj < 2; ++bj) { const f32x4 v0 = acc[ai][bj][m][0] + cbv[bj][0], v1 = acc[ai][bj][m][1] + cbv[bj][1];
          u32x4_t w; w.x = pk2(v0[0], v0[1]); w.y = pk2(v0[2], v0[3]); w.z = pk2(v1[0], v1[1]); w.w = pk2(v1[2], v1[3]); *(u32x4_t*)(XB + ro + bj * 128) = w;
          ss += ((v0[0] * v0[0] + v0[1] * v0[1]) + (v0[2] * v0[2] + v0[3] * v0[3])) + ((v1[0] * v1[0] + v1[1] * v1[1]) + (v1[2] * v1[2] + v1[3] * v1[3])); }
        ss += __shfl_xor(ss, 16); ss += __shfl_xor(ss, 32); if (fq == 0) fx_add(SS + row, ss);
        asm volatile("" ::: "memory"); }
    } else {
      u32x4_t nb[2];
#pragma unroll
      for (int bj = 0; bj < 2; ++bj) nb[bj] = *(const u32x4_t*)(XB + (size_t)row0 * DM + col0 + bj * 128);
#pragma unroll
      for (int g = 0; g < 8; ++g) { const int ai = g >> 2, m = g & 3; const int row = row0 + ai * 128 + m * 16; const size_t ro = (size_t)row * DM + col0; float ss = 0.f;
        u32x4_t cbv[2];
#pragma unroll
        for (int bj = 0; bj < 2; ++bj) cbv[bj] = nb[bj];
        if (g < 7) { const int r2 = row0 + ((g + 1) >> 2) * 128 + ((g + 1) & 3) * 16;
#pragma unroll
          for (int bj = 0; bj < 2; ++bj) nb[bj] = *(const u32x4_t*)(XB + (size_t)r2 * DM + col0 + bj * 128); }
#pragma unroll
        for (int bj = 0; bj < 2; ++bj) { const u32x4_t c = cbv[bj];
          const f32x4 v0 = acc[ai][bj][m][0] + (f32x4){bflo(c.x), bfhi(c.x), bflo(c.y), bfhi(c.y)}, v1 = acc[ai][bj][m][1] + (f32x4){bflo(c.z), bfhi(c.z), bflo(c.w), bfhi(c.w)};
          if (out32) { *(f32x4*)(out32 + ro + bj * 128) = v0; *(f32x4*)(out32 + ro + bj * 128 + 4) = v1; }
          else { u32x4_t w; w.x = pk2(v0[0], v0[1]); w.y = pk2(v0[2], v0[3]); w.z = pk2(v1[0], v1[1]); w.w = pk2(v1[2], v1[3]); *(u32x4_t*)(XB + ro + bj * 128) = w;
            ss += ((v0[0] * v0[0] + v0[1] * v0[1]) + (v0[2] * v0[2] + v0[3] * v0[3])) + ((v1[0] * v1[0] + v1[1] * v1[1]) + (v1[2] * v1[2] + v1[3] * v1[3])); } }
        if (!out32) { ss += __shfl_xor(ss, 16); ss += __shfl_xor(ss, 32); if (fq == 0) fx_add(SS + row, ss); }
        asm volatile("" ::: "memory"); }
    }
  }
};
struct EpiA1 {
  static constexpr bool PERM = false, AFTER_DRAIN = false, TWICE = (PROBE_EPI_ACE != 0);
  const u64* SS1; bf16_t *U, *Q, *KB; const float *qw, *kw;
  DI void operator()(const f32x4 (&acc)[2][2][4][2], const Unit& u, int wr, int wc, int fr, int fq) const {
    const int row0 = u.pm * 256 + wr * 64 + fr, lc0 = wc * 64 + 8 * fq, region = u.pn >> 1;
    u64 rsv[8];
#pragma unroll
    for (int g = 0; g < 8; ++g) rsv[g] = SS1[row0 + (g >> 2) * 128 + (g & 3) * 16];
    if (region == 0) {
#pragma unroll
      for (int g = 0; g < 8; ++g) { const int ai = g >> 2, m = g & 3; const int row = row0 + ai * 128 + m * 16; const float rs = rs1024(rsv[g]);
#pragma unroll
        for (int bj = 0; bj < 2; ++bj) { const f32x4 a = acc[ai][bj][m][0] * rs, b = acc[ai][bj][m][1] * rs; u32x4_t w;
          w.x = pk2(gelu1(a[0]), gelu1(a[1])); w.y = pk2(gelu1(a[2]), gelu1(a[3])); w.z = pk2(gelu1(b[0]), gelu1(b[1])); w.w = pk2(gelu1(b[2]), gelu1(b[3]));
          *(u32x4_t*)(U + (size_t)row * 512 + u.pn * 256 + lc0 + 32 * bj) = w; } }
    } else {
      const bool isq = region == 1; const float* wp = (isq ? qw : kw) + 8 * fq; bf16_t* dst = (isq ? Q : KB) + (u.pn & 1) * 256 + lc0; const float sc = isq ? QSCALE : 1.0f;
      f32x4 wv[2][2];
#pragma unroll
      for (int bj = 0; bj < 2; ++bj)
#pragma unroll
        for (int n = 0; n < 2; ++n) wv[bj][n] = *(const f32x4*)(wp + 32 * bj + 4 * n);
#pragma unroll
      for (int g = 0; g < 8; ++g) { const int ai = g >> 2, m = g & 3; const int row = row0 + ai * 128 + m * 16; const float rs = rs1024(rsv[g]); float ss = 0.f; f32x4 v[2][2];
#pragma unroll
        for (int bj = 0; bj < 2; ++bj)
#pragma unroll
          for (int n = 0; n < 2; ++n) { v[bj][n] = acc[ai][bj][m][n] * rs; const f32x4 t = v[bj][n]; ss += (t[0] * t[0] + t[1] * t[1]) + (t[2] * t[2] + t[3] * t[3]); }
        ss += __shfl_xor(ss, 16); ss += __shfl_xor(ss, 32);
        const float r2 = rsqrtf(ss * (1.0f / 64.0f) + EPS) * sc;
#pragma unroll
        for (int bj = 0; bj < 2; ++bj) { const f32x4 a = v[bj][0] * r2 * wv[bj][0], b = v[bj][1] * r2 * wv[bj][1]; u32x4_t w;
          w.x = pk2(a[0], a[1]); w.y = pk2(a[2], a[3]); w.z = pk2(b[0], b[1]); w.w = pk2(b[2], b[3]);
          *(u32x4_t*)(dst + (size_t)row * 512 + 32 * bj) = w; } }
    }
  }
};
struct EpiA2 {
  static constexpr bool PERM = false, AFTER_DRAIN = false, TWICE = (PROBE_EPI_ACE != 0);
  const u64* SS1; bf16_t *GVT, *VT; u64* SSV;
  DI void operator()(const f32x4 (&acc)[2][2][4][2], const Unit& u, int wr, int wc, int fr, int fq) const {
    const int colbase = u.pn * 256 + wc * 32;
    f32x4 rs[2][2];
#pragma unroll
    for (int bj = 0; bj < 2; ++bj)
#pragma unroll
      for (int n = 0; n < 2; ++n) { const u64* sp = SS1 + colbase + bj * 128 + n * 16 + 4 * fq; rs[bj][n] = (f32x4){rs1024(sp[0]), rs1024(sp[1]), rs1024(sp[2]), rs1024(sp[3])}; }
    if (u.pm < 2) {
#pragma unroll
      for (int ai = 0; ai < 2; ++ai) { const int head = 2 * u.pm + ai;
#pragma unroll
        for (int bj = 0; bj < 2; ++bj)
#pragma unroll
          for (int n = 0; n < 2; ++n) { f32x4 sq = (f32x4){0.f, 0.f, 0.f, 0.f}; const int tok = colbase + bj * 128 + n * 16 + 4 * fq;
#pragma unroll
            for (int m = 0; m < 4; ++m) { const int row = u.pm * 256 + ai * 128 + wr * 64 + m * 16 + fr;
              const f32x4 a = acc[ai][bj][m][n] * rs[bj][n]; f32x4 g; g[0] = gelu1(a[0]); g[1] = gelu1(a[1]); g[2] = gelu1(a[2]); g[3] = gelu1(a[3]);
              u32x2_t w; w.x = pk2(g[0], g[1]); w.y = pk2(g[2], g[3]); *(u32x2_t*)(GVT + (size_t)row * T_TOK + tok) = w; sq += g * g; }
#pragma unroll
            for (int e = 0; e < 4; ++e) { float s = sq[e]; s += __shfl_xor(s, 1); s += __shfl_xor(s, 2); s += __shfl_xor(s, 4); s += __shfl_xor(s, 8); sq[e] = s; }
            if (fr == 0) {
#pragma unroll
              for (int e = 0; e < 4; ++e) fx_add(SSV + (size_t)(tok + e) * 4 + head, sq[e]); }
            asm volatile("" ::: "memory"); } }
    } else {
#pragma unroll
      for (int ai = 0; ai < 2; ++ai)
#pragma unroll
        for (int m = 0; m < 4; ++m) { const int row = (u.pm - 2) * 256 + ai * 128 + wr * 64 + m * 16 + fr;
#pragma unroll
          for (int bj = 0; bj < 2; ++bj)
#pragma unroll
            for (int n = 0; n < 2; ++n) { const f32x4 a = acc[ai][bj][m][n] * rs[bj][n]; u32x2_t w; w.x = pk2(a[0], a[1]); w.y = pk2(a[2], a[3]);
              *(u32x2_t*)(VT + (size_t)row * T_TOK + colbase + bj * 128 + n * 16 + 8 * (fq & 1) + 4 * (fq >> 1)) = w; } }
    }
  }
};
struct EpiD {
  static constexpr bool PERM = false, AFTER_DRAIN = false, TWICE = (PROBE_EPI_D != 0);
  const u64* SS2; const float *cw, *cb; bf16_t* F; float *GB, *PB, *UB;
  DI void operator()(const f32x4 (&acc)[2][2][4][2], const Unit& u, int wr, int wc, int fr, int fq) const {
    const int cbase = u.pn * 128 + wc * 32 + 8 * fq;
    const int rb0 = u.pm * 256 + wr * 64;
    u64 rsv[8]; f32x4 w0[2], w1[2], w2[2], bb[2];
#pragma unroll
    for (int g = 0; g < 8; ++g) rsv[g] = SS2[rb0 + (g >> 2) * 128 + (g & 3) * 16 + fr];
#pragma unroll
    for (int n = 0; n < 2; ++n) { w0[n] = *(const f32x4*)(cw + cbase + 4 * n); w1[n] = *(const f32x4*)(cw + DFF + cbase + 4 * n); w2[n] = *(const f32x4*)(cw + 2 * DFF + cbase + 4 * n); bb[n] = *(const f32x4*)(cb + cbase + 4 * n); }
#pragma unroll
    for (int ai = 0; ai < 2; ++ai) {
      const int rb = rb0 + ai * 128, bd = rb >> 6;
      float rs[4];
#pragma unroll
      for (int m = 0; m < 4; ++m) rs[m] = rs1024(rsv[ai * 4 + m]);
      unsigned fo[4][4];
#pragma unroll
      for (int n = 0; n < 2; ++n) {
        const int cn = cbase + 4 * n;
        f32x4 pg, ug, gg; float fv[4][4];
#pragma unroll
        for (int e = 0; e < 4; ++e) {
          float G[4], r1[4], r2[4];
#pragma unroll
          for (int m = 0; m < 4; ++m) { G[m] = acc[ai][0][m][n][e] * rs[m]; r1[m] = dpp_ror1(G[m]); r2[m] = dpp_ror2(G[m]); }
#pragma unroll
          for (int m = 0; m < 4; ++m) {
            const float p1 = (fr >= 1) ? r1[m] : (m > 0 ? r1[m > 0 ? m - 1 : 0] : 0.f);
            const float p2 = (fr >= 2) ? r2[m] : (m > 0 ? r2[m > 0 ? m - 1 : 0] : 0.f);
            const float g = w2[n][e] * G[m] + w1[n][e] * p1 + w0[n][e] * p2 + bb[n][e];
            const float uv = acc[ai][1][m][n][e] * rs[m];
            if (m == 0) { pg[e] = g; ug[e] = uv; }
            if (m == 3) gg[e] = G[3];
            fv[m][e] = g * __builtin_amdgcn_rcpf(1.0f + __expf(-g)) * uv;
          }
        }
#pragma unroll
        for (int m = 0; m < 4; ++m) { fo[m][2 * n] = pk2(fv[m][0], fv[m][1]); fo[m][2 * n + 1] = pk2(fv[m][2], fv[m][3]); }
        if (fr < 2) { *(f32x4*)(PB + (size_t)(bd * 2 + fr) * DFF + cn) = pg; *(f32x4*)(UB + (size_t)(bd * 2 + fr) * DFF + cn) = ug; }
        if (fr >= 14) { *(f32x4*)(GB + (size_t)(bd * 2 + fr - 14) * DFF + cn) = gg; }
      }
#pragma unroll
      for (int m = 0; m < 4; ++m) {
        if (!(m == 0 && fr < 2)) { u32x4_t w; w.x = fo[m][0]; w.y = fo[m][1]; w.z = fo[m][2]; w.w = fo[m][3]; *(u32x4_t*)(F + (size_t)(rb + 16 * m + fr) * DFF + cbase) = w; }
      }
    }
  }
};
DI void fixup_phase(const LP& lp, unsigned char* ws) {
  const float *GB = (const float*)(ws + OFF_GB), *PB = (const float*)(ws + OFF_PB), *UB = (const float*)(ws + OFF_UB); bf16_t* F = (bf16_t*)(ws + OFF_F);
  const int gtid = blockIdx.x * 512 + tid_opaque(), gsz = gridDim.x * 512;
  for (int w = gtid; w < 512 * 2 * 704; w += gsz) {
    const int c = (w % 704) * 4, j = (w / 704) & 1, bd = w / 1408;
    f32x4 g = *(const f32x4*)(PB + (size_t)(bd * 2 + j) * DFF + c);
    if (bd & 31) { const f32x4 gm1 = *(const f32x4*)(GB + (size_t)((bd - 1) * 2 + 1) * DFF + c); const f32x4 w0 = *(const f32x4*)(lp.conv_w + c);
      if (j == 0) { const f32x4 gm2 = *(const f32x4*)(GB + (size_t)((bd - 1) * 2) * DFF + c); const f32x4 w1 = *(const f32x4*)(lp.conv_w + DFF + c); g += w1 * gm1 + w0 * gm2; }
      else g += w0 * gm1; }
    const f32x4 uv = *(const f32x4*)(UB + (size_t)(bd * 2 + j) * DFF + c); float f[4];
#pragma unroll
    for (int e = 0; e < 4; ++e) f[e] = g[e] * __builtin_amdgcn_rcpf(1.0f + __expf(-g[e])) * uv[e];
    u32x2_t o; o.x = pk2(f[0], f[1]); o.y = pk2(f[2], f[3]);
    *(u32x2_t*)(F + (size_t)(bd * 64 + j) * DFF + c) = o;
  }
}

DI void spatial_phase(const LP& lp, unsigned char* ws, LAS unsigned char* lds) {
  const bf16_t *U = (const bf16_t*)(ws + OFF_U), *GVT = (const bf16_t*)(ws + OFF_GVT); const u64* SSV = (const u64*)(ws + OFF_SSV); bf16_t* MIX = (bf16_t*)(ws + OFF_MIX);
  constexpr int TB = 32768;
  LAS float* sr = (LAS float*)(lds + 2 * TB);
  const int tid = tid_opaque(), lane = tid & 63, w = __builtin_amdgcn_readfirstlane(tid >> 6), l15 = lane & 15, kq = lane >> 4;
#define SP_STAGE(item, buf) do { const int h_ = (item) & 3, t_ = ((item) >> 2) * 128; _Pragma("unroll") for (int i = 0; i < 4; ++i) { const int P = (w * 4 + i) * 64 + lane, row = P >> 4, pc = (P & 15) ^ (row & 15); \
    __builtin_amdgcn_global_load_lds((const unsigned*)(GVT + (size_t)(h_ * 128 + row) * T_TOK + t_ + pc * 8), (LAS unsigned*)(lds + (buf) * TB + (w * 4 + i) * 1024), 16, 0, 0); } } while (0)
  LAS float* vn_l = sr + 128; LAS float* on_l = vn_l + 512; LAS float* sb_l = on_l + 512;
  int it = blockIdx.x, buf = 0;
  if (it < 1024) SP_STAGE(it, 0);
  { const float a = lp.v_norm_w[tid], b = lp.out_norm_w[tid], c = lp.sp_b[tid]; vn_l[tid] = a; on_l[tid] = b; sb_l[tid] = c; }
  asm volatile("s_waitcnt vmcnt(0)" ::: "memory");
  __syncthreads();
  const int x_lane = l15 * 256 + ((kq ^ l15) << 4);
  const int i0 = 16 * w, nks = (w < 4) ? 2 : 4;
  u32x4_t rawN[4]; u32x2_t urN[8]; u64 ssvN = 0ull;
#define SP_LOADREGS(item) do { const int h_ = (item) & 3, t_ = ((item) >> 2) * 128; \
    _Pragma("unroll") for (int ks = 0; ks < 4; ++ks) rawN[ks] = (ks < nks) ? *(const u32x4_t*)(lp.Wsp + (size_t)(h_ * 128 + i0 + l15) * 128 + ks * 32 + kq * 8) : (u32x4_t){0u, 0u, 0u, 0u}; \
    _Pragma("unroll") for (int dt = 0; dt < 8; ++dt) urN[dt] = *(const u32x2_t*)(U + (size_t)(t_ + i0 + l15) * 512 + h_ * 128 + 16 * dt + 4 * kq); \
    ssvN = (tid < 128) ? SSV[(size_t)(t_ + tid) * 4 + h_] : 0ull; } while (0)
  if (it < 1024) SP_LOADREGS(it);
  for (; it < 1024; it += gridDim.x, buf ^= 1) {
    const int h = it & 3, tok0 = (it >> 2) * 128, irow = tok0 + i0 + l15;
    u32x4_t raw[4]; u32x2_t ur[8];
#pragma unroll
    for (int ks = 0; ks < 4; ++ks) raw[ks] = rawN[ks];
#pragma unroll
    for (int dt = 0; dt < 8; ++dt) ur[dt] = urN[dt];
    const u64 ssv = ssvN;
    const float bias = sb_l[h * 128 + i0 + l15];
    const int nit = it + gridDim.x;
    if (nit < 1024) { SP_STAGE(nit, buf ^ 1); SP_LOADREGS(nit); }
    if (tid < 128) sr[tid] = rsqrtf(fx2f(ssv) * (1.0f / 128.0f) + EPS);
    __syncthreads();
    bf16x8 yf[4];
#pragma unroll
    for (int ks = 0; ks < 4; ++ks) { const LAS float* sp = sr + ks * 32 + kq * 8; const u32x4_t r = raw[ks]; u32x4_t o;
      o.x = pk2(bflo(r.x) * sp[0], bfhi(r.x) * sp[1]); o.y = pk2(bflo(r.y) * sp[2], bfhi(r.y) * sp[3]); o.z = pk2(bflo(r.z) * sp[4], bfhi(r.z) * sp[5]); o.w = pk2(bflo(r.w) * sp[6], bfhi(r.w) * sp[7]);
      yf[ks] = __builtin_bit_cast(bf16x8, o); }
    const LAS unsigned char* tb = lds + buf * TB;
    float o[8][4]; float ss = 0.f;
#pragma unroll
    for (int dt = 0; dt < 8; ++dt) {
      f32x4 acc = (f32x4){0.f, 0.f, 0.f, 0.f};
#pragma unroll
      for (int ks = 0; ks < 4; ++ks) if (ks < nks) {
        const bf16x8 xf = *(const LAS bf16x8*)(tb + dt * 4096 + (x_lane ^ (ks << 6)));
        acc = __builtin_amdgcn_mfma_f32_16x16x32_bf16(xf, yf[ks], acc, 0, 0, 0); }
      const int d0 = 16 * dt + 4 * kq; const f32x4 wv = *(const LAS f32x4*)(vn_l + h * 128 + d0);
      o[dt][0] = bflo(ur[dt].x) * (acc[0] * wv[0] + bias); o[dt][1] = bfhi(ur[dt].x) * (acc[1] * wv[1] + bias); o[dt][2] = bflo(ur[dt].y) * (acc[2] * wv[2] + bias); o[dt][3] = bfhi(ur[dt].y) * (acc[3] * wv[3] + bias);
      ss += (o[dt][0] * o[dt][0] + o[dt][1] * o[dt][1]) + (o[dt][2] * o[dt][2] + o[dt][3] * o[dt][3]);
    }
    ss += __shfl_xor(ss, 16); ss += __shfl_xor(ss, 32);
    const float rs = rsqrtf(ss * (1.0f / 128.0f) + EPS);
#pragma unroll
    for (int dt = 0; dt < 8; ++dt) { const int d0 = 16 * dt + 4 * kq; const f32x4 wo = *(const LAS f32x4*)(on_l + h * 128 + d0);
      u32x2_t q; q.x = pk2(o[dt][0] * rs * wo[0], o[dt][1] * rs * wo[1]); q.y = pk2(o[dt][2] * rs * wo[2], o[dt][3] * rs * wo[3]);
      *(u32x2_t*)(MIX + (size_t)irow * 1024 + h * 128 + d0) = q; }
    asm volatile("s_waitcnt vmcnt(8)" ::: "memory");
    __syncthreads();
  }
#undef SP_STAGE
#undef SP_LOADREGS
}

DI void attn_phase(const MParams& p, int l, LAS unsigned char* lds) {
  unsigned char* ws = p.ws;
  const bf16_t *Q = (const bf16_t*)(ws + OFF_Q), *KB = (const bf16_t*)(ws + OFF_KB), *VT = (const bf16_t*)(ws + OFF_VT); bf16_t* MIX = (bf16_t*)(ws + OFF_MIX);
  constexpr int KBUF = 16384, VBUF = 16384, STG = KBUF + VBUF, QOFF = 3 * STG;
  static_assert(QOFF + 65536 <= LDS_BYTES, "attention LDS");
  const unsigned sv0 = __builtin_amdgcn_readfirstlane(((volatile LAS unsigned*)(lds + 131072))[0]), sv1 = __builtin_amdgcn_readfirstlane(((volatile LAS unsigned*)(lds + 131072))[1]), sv2 = __builtin_amdgcn_readfirstlane(((volatile LAS unsigned*)(lds + 131072))[2]);
  __syncthreads();
  const float lambda_init = 0.8f - 0.6f * expf(-0.3f * (float)(l + 1));
  const float* dnw = p.in[13] + l * 128;
#pragma unroll 1
  for (int pi = blockIdx.x; pi < 256; pi += gridDim.x) {
    const int b = pi >> 4, h = (pi >> 2) & 3, j = pi & 3;
#pragma unroll 1
    for (int it = 0; it < 2; ++it) {
      const int tid = tid_opaque(), lane = tid & 63, w = __builtin_amdgcn_readfirstlane(tid >> 6), l31 = lane & 31, hh = lane >> 5;
      const int qb = it ? j : 7 - j, t0 = b * 2048 + 256 * qb, ntl = 4 * qb + 4, ntw = 4 * qb + (w >> 1) + 1;
#pragma unroll
      for (int i = 0; i < 8; ++i) { const int P = (w * 8 + i) * 64 + lane, row = P >> 4, pos = P & 15, pc = pos ^ (row & 15);
        __builtin_amdgcn_global_load_lds((const unsigned*)(Q + (size_t)(t0 + row) * 512 + h * 128 + pc * 8), (LAS unsigned*)(lds + QOFF + (w * 8 + i) * 1024), 16, 0, 0); }
      const bf16_t* kbase = KB + (size_t)(b * 2048) * 512 + h * 128; const bf16_t* vbase = VT + (size_t)(h * 128) * T_TOK + b * 2048;
      int koff[2], voff[2];
#pragma unroll
      for (int i = 0; i < 2; ++i) { const int P = (w * 2 + i) * 64 + lane; { const int row = P >> 4, pos = P & 15, pc = pos ^ (row & 15); koff[i] = row * 512 + pc * 8; }
        { const int row = P >> 3, pos = P & 7, pc = pos ^ ((row >> 1) & 7); voff[i] = row * T_TOK + pc * 8; } }
#define ATT_STAGE(kt, buf) do { _Pragma("unroll") for (int i = 0; i < 2; ++i) { \
        __builtin_amdgcn_global_load_lds((const unsigned*)(kbase + (size_t)(kt) * (64 * 512) + koff[i]), (LAS unsigned*)(lds + (buf) * STG + (w * 2 + i) * 1024), 16, 0, 0); \
        __builtin_amdgcn_global_load_lds((const unsigned*)(vbase + (kt) * 64 + voff[i]), (LAS unsigned*)(lds + (buf) * STG + KBUF + (w * 2 + i) * 1024), 16, 0, 0); } } while (0)
#define ATT_STAGE_AT(kt, soff) do { _Pragma("unroll") for (int i = 0; i < 2; ++i) { \
        __builtin_amdgcn_global_load_lds((const unsigned*)(kbase + (size_t)(kt) * (64 * 512) + koff[i]), (LAS unsigned*)(lds + (soff) + (w * 2 + i) * 1024), 16, 0, 0); \
        __builtin_amdgcn_global_load_lds((const unsigned*)(vbase + (kt) * 64 + voff[i]), (LAS unsigned*)(lds + (soff) + KBUF + (w * 2 + i) * 1024), 16, 0, 0); } } while (0)
      ATT_STAGE(0, 0);
      if (ntl > 1) { ATT_STAGE(1, 1); asm volatile("s_waitcnt vmcnt(4)" ::: "memory"); } else asm volatile("s_waitcnt vmcnt(0)" ::: "memory");
      __syncthreads();
      int st_cur = 0, st_pre = 2 * STG;
      f32x16 O[2][4];
#pragma unroll
      for (int c = 0; c < 2; ++c)
#pragma unroll
        for (int bk = 0; bk < 4; ++bk)
#pragma unroll
          for (int i = 0; i < 16; ++i) O[c][bk][i] = 0.f;
      float lsum[2] = {0.f, 0.f};
      const int qr = 32 * w + l31;
      int k_lane = l31 * 256 + ((hh ^ (l31 & 15)) << 4), q_lane = QOFF + qr * 256 + ((hh ^ (qr & 15)) << 4), v_lane = KBUF + l31 * 128 + ((hh ^ ((l31 >> 1) & 7)) << 4);
#pragma unroll 1
      for (int kt = 0; kt < ntl; ++kt) {
        if (kt + 2 < ntl) ATT_STAGE_AT(kt + 2, st_pre);
        if (kt < ntw) {
          asm volatile("" : "+v"(k_lane), "+v"(q_lane), "+v"(v_lane));
          const LAS unsigned char* tb = lds + st_cur;
#pragma unroll
          for (int kb = 0; kb < 2; ++kb) {
            bf16x8 pf[2][2];
#pragma unroll
            for (int c = 0; c < 2; ++c) {
              f32x16 S;
#pragma unroll
              for (int i = 0; i < 16; ++i) S[i] = 0.f;
#pragma unroll
              for (int ks = 0; ks < 4; ++ks) {
                const int xo = (c * 8 + ks * 2) << 4;
                const bf16x8 qf = *(const LAS bf16x8*)(lds + (q_lane ^ xo));
                const bf16x8 kf = *(const LAS bf16x8*)(tb + (k_lane ^ xo) + kb * 8192);
                S = __builtin_amdgcn_mfma_f32_32x32x16_bf16(kf, qf, S, 0, 0, 0);
              }
              float ls = 0.f;
#pragma unroll
              for (int hs = 0; hs < 2; ++hs) { u32x4_t pw;
#pragma unroll
                for (int t = 0; t < 4; ++t) { const float a = __builtin_amdgcn_exp2f(S[8 * hs + 2 * t]), bq = __builtin_amdgcn_exp2f(S[8 * hs + 2 * t + 1]); ls += a + bq; pw[t] = pk2(a, bq); }
                pf[c][hs] = __builtin_bit_cast(bf16x8, pw); }
              lsum[c] += ls;
              __builtin_amdgcn_sched_barrier(0);
            }
#pragma unroll
            for (int bk = 0; bk < 4; ++bk) {
              const bf16x8 v0 = *(const LAS bf16x8*)(tb + (v_lane ^ ((2 * kb) << 5)) + bk * 4096);
              const bf16x8 v1 = *(const LAS bf16x8*)(tb + (v_lane ^ ((2 * kb + 1) << 5)) + bk * 4096);
              O[0][bk] = __builtin_amdgcn_mfma_f32_32x32x16_bf16(v0, pf[0][0], O[0][bk], 0, 0, 0);
              O[1][bk] = __builtin_amdgcn_mfma_f32_32x32x16_bf16(v0, pf[1][0], O[1][bk], 0, 0, 0);
              O[0][bk] = __builtin_amdgcn_mfma_f32_32x32x16_bf16(v1, pf[0][1], O[0][bk], 0, 0, 0);
              O[1][bk] = __builtin_amdgcn_mfma_f32_32x32x16_bf16(v1, pf[1][1], O[1][bk], 0, 0, 0);
              __builtin_amdgcn_sched_barrier(0);
            }
          }
        }
        if (kt + 2 < ntl) asm volatile("s_waitcnt vmcnt(4)" ::: "memory"); else asm volatile("s_waitcnt vmcnt(0)" ::: "memory");
        __syncthreads();
        st_pre = st_cur; st_cur = (st_cur == 2 * STG) ? 0 : st_cur + STG;
      }
#undef ATT_STAGE
#undef ATT_STAGE_AT
      const int tid2 = tid_opaque(), lane2 = tid2 & 63, w2 = __builtin_amdgcn_readfirstlane(tid2 >> 6), hh2 = lane2 >> 5, qr2 = 32 * w2 + (lane2 & 31);
      float lam;
      { const float* q1 = p.in[9] + l * 64; const float* k1 = p.in[10] + l * 64; const float* q2 = p.in[11] + l * 64; const float* k2 = p.in[12] + l * 64;
        float a = q1[lane2] * k1[lane2], bq = q2[lane2] * k2[lane2]; a = wave_sum(a); bq = wave_sum(bq); lam = expf(a) - expf(bq) + lambda_init; }
      float l1 = lsum[0], l2 = lsum[1]; l1 += __shfl_xor(l1, 32); l2 += __shfl_xor(l2, 32);
      const float inv1 = 1.0f / l1, inv2 = lam / l2; float ss = 0.f;
#pragma unroll
      for (int bk = 0; bk < 4; ++bk)
#pragma unroll
        for (int i = 0; i < 16; ++i) { const float o = O[0][bk][i] * inv1 - O[1][bk][i] * inv2; O[0][bk][i] = o; ss += o * o; }
      ss += __shfl_xor(ss, 32);
      const float rs = rsqrtf(ss * (1.0f / 128.0f) + EPS) * (1.0f - lambda_init);
      bf16_t* orow = MIX + (size_t)(t0 + qr2) * 1024 + 512 + h * 128;
#pragma unroll
      for (int bk = 0; bk < 4; ++bk)
#pragma unroll
        for (int g = 0; g < 4; ++g) { const int dv0 = 32 * bk + 8 * g + 4 * hh2; const f32x4 wv = *(const f32x4*)(dnw + dv0);
          u32x2_t q; q.x = pk2(O[0][bk][4 * g] * rs * wv[0], O[0][bk][4 * g + 1] * rs * wv[1]); q.y = pk2(O[0][bk][4 * g + 2] * rs * wv[2], O[0][bk][4 * g + 3] * rs * wv[3]);
          *(u32x2_t*)(orow + dv0) = q; }
    }
  }
  __syncthreads();
  if (threadIdx.x == 0) { volatile LAS unsigned* stw = (volatile LAS unsigned*)(lds + 131072); stw[0] = sv0; stw[1] = sv1; stw[2] = sv2; }
  __syncthreads();
}


#define XB_TMO      128
#define XB_XCNT(j)  (256  + 64 * (j))
#define XB_XSUB(j)  (1280 + 64 * (j))
#define XB_XGEN(j)  (2304 + 64 * (j))
#define XB_TOP      3328
#define XB_TOPGEN   3392
#define XCD_BAR_WORDS 3456
#define XB_SPIN_CAP (1u << 18)

__device__ __forceinline__ unsigned xb_ld(unsigned* p)              { return __hip_atomic_load(p, __ATOMIC_RELAXED, __HIP_MEMORY_SCOPE_AGENT); }
__device__ __forceinline__ unsigned xb_add(unsigned* p, unsigned v) { return __hip_atomic_fetch_add(p, v, __ATOMIC_RELAXED, __HIP_MEMORY_SCOPE_AGENT); }
__device__ __forceinline__ unsigned xb_xcc_id() { return (unsigned)__builtin_amdgcn_s_getreg((3 << 11) | 20) & 0xFu; }
#define XB_SPIN(cond, bar) do { unsigned _sp = 0; while (cond) { __builtin_amdgcn_s_sleep(1); \
    if ((++_sp & 255u) == 0u) { if (xb_ld(&(bar)[XB_TMO])) break; if (_sp > XB_SPIN_CAP) { atomicAdd(&(bar)[XB_TMO], 1u); break; } } } } while (0)

struct XcdBarrier {
    unsigned* bar; unsigned x;
    volatile LAS unsigned* st;
};

__device__ __forceinline__ XcdBarrier xcd_barrier_post(unsigned* bar, volatile LAS unsigned* st) {
    XcdBarrier b; b.bar = bar; b.x = xb_xcc_id(); b.st = st;
    if (threadIdx.x == 0) (void)xb_add(&bar[XB_XCNT(b.x)], 1u);
    return b;
}
__device__ __forceinline__ void xcd_barrier_complete(unsigned* bar, unsigned x, unsigned& nloc, unsigned& nx) {
    const unsigned G = gridDim.x * gridDim.y * gridDim.z;
    unsigned sum, cnt, mine, sp = 0u;
    for (;;) {
        sum = 0u; cnt = 0u; mine = 0u;
#pragma unroll
        for (unsigned j = 0; j < 16; ++j) { const unsigned c = xb_ld(&bar[XB_XCNT(j)]); sum += c; cnt += (c > 0u) ? 1u : 0u; mine = (j == x) ? c : mine; }
        if (sum == G) break;
        __builtin_amdgcn_s_sleep(1);
        if ((++sp & 255u) == 0u) { if (xb_ld(&bar[XB_TMO])) break; if (sp > XB_SPIN_CAP) { atomicAdd(&bar[XB_TMO], 1u); break; } }
    }
    nloc = mine > 0u ? mine : 1u; nx = cnt > 0u ? cnt : 1u;
}

__device__ __forceinline__ void xcd_barrier(const XcdBarrier& b) {
    asm volatile("s_waitcnt vmcnt(0)" ::: "memory");
    __syncthreads();
    if (threadIdx.x == 0) {
        unsigned* bar = b.bar;
        __builtin_amdgcn_s_waitcnt(0);
        unsigned nloc = b.st[0], nx = b.st[1];
        if (nloc == 0u) { xcd_barrier_complete(bar, b.x, nloc, nx); b.st[0] = nloc; b.st[1] = nx; }
        const unsigned old = xb_add(&bar[XB_XSUB(b.x)], 1u);
        const unsigned gen = old / nloc;
        if (old + 1u == (gen + 1u) * nloc) {
            __builtin_amdgcn_fence(__ATOMIC_RELEASE, "agent");
            asm volatile("s_waitcnt vmcnt(0)" ::: "memory");
            const unsigned og = xb_add(&bar[XB_TOP], 1u);
            const unsigned tg = og / nx;
            if (og + 1u == (tg + 1u) * nx) xb_add(&bar[XB_TOPGEN], 1u);
            else XB_SPIN(xb_ld(&bar[XB_TOPGEN]) == tg, bar);
            __builtin_amdgcn_fence(__ATOMIC_ACQUIRE, "agent");
            xb_add(&bar[XB_XGEN(b.x)], 1u);
            asm volatile("s_waitcnt vmcnt(0)" ::: "memory");
        } else {
            XB_SPIN(xb_ld(&bar[XB_XGEN(b.x)]) == gen, bar);
            __builtin_amdgcn_fence(__ATOMIC_ACQUIRE, "agent");
            asm volatile("s_waitcnt vmcnt(0)" ::: "memory");
        }
    }
    __syncthreads();
}

DI void zero_u64(u64* p, int n) { for (int i = blockIdx.x * 512 + tid_opaque(); i < n; i += gridDim.x * 512) p[i] = 0ull; }

#if PROBE_EPI_ACE
typedef DupOrder OrderACE;
#else
typedef pg8::StaticOrder OrderACE;
#endif
DI void phaseA(const MParams& p, int l, LAS unsigned char* lds) {
  unsigned char* ws = p.ws; const bf16_t* XB = (const bf16_t*)(ws + OFF_XB); const bf16_t* WinT = (const bf16_t*)(ws + OFF_W + (size_t)l * W_STRIDE + WO_IN); const u64* SS1 = (const u64*)(ws + OFF_SS1);
  zero_u64((u64*)(ws + OFF_SS2), T_TOK);
  { pg8::Gemm g{XB, WinT, T_TOK, 1536, DM}; OrderACE S; S.init(T_TOK, 1536, gridDim.x, blockIdx.x);
    EpiA1 E{SS1, (bf16_t*)(ws + OFF_U), (bf16_t*)(ws + OFF_Q), (bf16_t*)(ws + OFF_KB), p.in[7] + l * 64, p.in[8] + l * 64}; pg8::gemm_phase<EpiA1, OrderACE>(lds, g, S, E); }
  { pg8::Gemm g{WinT + (size_t)1536 * DM, XB, 1024, T_TOK, DM}; OrderACE S; S.init(1024, T_TOK, gridDim.x, blockIdx.x);
    EpiA2 E{SS1, (bf16_t*)(ws + OFF_GVT), (bf16_t*)(ws + OFF_VT), (u64*)(ws + OFF_SSV)}; pg8::gemm_phase<EpiA2, OrderACE>(lds, g, S, E); }
}
DI void phaseCE(const MParams& p, int l, bool isC, LAS unsigned char* lds) {
  unsigned char* ws = p.ws; const unsigned char* wb = ws + OFF_W + (size_t)l * W_STRIDE;
  if (isC) zero_u64((u64*)(ws + OFF_SS1), T_TOK);
  pg8::Gemm g{(const bf16_t*)(ws + (isC ? OFF_MIX : OFF_F)), (const bf16_t*)(wb + (isC ? WO_OUT : WO_DN)), T_TOK, DM, isC ? DM : DFF}; OrderACE S; S.init(T_TOK, DM, gridDim.x, blockIdx.x);
  EpiResid E{(isC && l == 0) ? p.in[0] : nullptr, (!isC && l == NLAYER - 1) ? p.out : nullptr, (bf16_t*)(ws + OFF_XB), (u64*)(ws + (isC ? OFF_SS2 : OFF_SS1))}; pg8::gemm_phase<EpiResid, OrderACE>(lds, g, S, E);
}
DI void phaseD(const MParams& p, int l, LAS unsigned char* lds) {
  unsigned char* ws = p.ws;
  zero_u64((u64*)(ws + OFF_SSV), T_TOK * 4);
  pg8::Gemm g{(const bf16_t*)(ws + OFF_XB), (const bf16_t*)(ws + OFF_W + (size_t)l * W_STRIDE + WO_GU), T_TOK, 2 * DFF, DM};
#if PROBE_EPI_D
  DupOrder S;
#else
  pg8::StaticOrder S;
#endif
  S.init(T_TOK, 2 * DFF, gridDim.x, blockIdx.x);
  EpiD E{(const u64*)(ws + OFF_SS2), p.in[18] + (size_t)l * 3 * DFF, p.in[19] + (size_t)l * DFF, (bf16_t*)(ws + OFF_F), (float*)(ws + OFF_GB), (float*)(ws + OFF_PB), (float*)(ws + OFF_UB)};
#if PROBE_EPI_D
  pg8::gemm_phase<EpiD, DupOrder>(lds, g, S, E);
#else
  pg8::gemm_phase<EpiD, pg8::StaticOrder>(lds, g, S, E);
#endif
}

__global__ void __launch_bounds__(512) k_run(MParams p) {
  extern __shared__ __attribute__((aligned(16))) unsigned char lds_raw[];
  LAS unsigned char* lds = (LAS unsigned char*)lds_raw;
  cg::grid_group grid = cg::this_grid();
  if (threadIdx.x < 4) ((LAS unsigned*)(lds + 131072))[threadIdx.x] = 0u;
  __syncthreads();
  XcdBarrier xbar = xcd_barrier_post((unsigned*)(p.ws + OFF_BAR), (volatile LAS unsigned*)(lds + 131072));
  if (p.ph_lo < 0) grid.sync();
  for (int ph = p.ph_lo; ph < p.ph_hi; ++ph) {
    for (int rep = 0; rep < 1 + ((PROBE_MASK >> (ph == 0 ? 6 : (ph - 1) % 6)) & 1); ++rep) {
    if (ph == 0) { if (EN_MASK & 1) prologue(p); }
    else {
      const int l = (ph - 1) / 6, s = (ph - 1) % 6;
      if (s == 0) { if (EN_MASK & 2) phaseA(p, l, lds); }
      else if (s == 1) { if (EN_MASK & 4) attn_phase(p, l, lds); if (EN_MASK & 8) { const LP lp = make_lp(p, l); spatial_phase(lp, p.ws, lds); } }
      else if (s == 2 || s == 5) { if (EN_MASK & 16) phaseCE(p, l, s == 2, lds); }
      else if (s == 3) { if (EN_MASK & 32) phaseD(p, l, lds); }
      else { if (EN_MASK & 64) { const LP lp = make_lp(p, l); fixup_phase(lp, p.ws); } }
    }
    }
    if (ph + 1 < p.ph_hi) xcd_barrier(xbar);
  }
}

extern "C" void kernel_launch(void* const* d_in, const int* in_sizes, int n_in, void* d_out, int out_size, void* d_ws, size_t ws_size, hipStream_t stream) {
  static int grid_blocks = 0;
  if (!grid_blocks) {
    (void)hipFuncSetAttribute((const void*)k_run, hipFuncAttributeMaxDynamicSharedMemorySize, LDS_BYTES);
    int dev = 0, cus = 0, per_cu = 0; (void)hipGetDevice(&dev); (void)hipDeviceGetAttribute(&cus, hipDeviceAttributeMultiprocessorCount, dev);
    (void)hipOccupancyMaxActiveBlocksPerMultiprocessor(&per_cu, (const void*)k_run, 512, LDS_BYTES); if (per_cu < 1) per_cu = 1;
    grid_blocks = cus * per_cu; if (grid_blocks > 256) grid_blocks = 256;
  }
  MParams mp; memset(&mp, 0, sizeof(mp));
  for (int i = 0; i < 21; ++i) mp.in[i] = (const float*)d_in[i];
  mp.out = (float*)d_out; mp.ws = (unsigned char*)d_ws; mp.ph_lo = 0; mp.ph_hi = 1 + 6 * NLAYER;
  (void)hipMemsetAsync((unsigned char*)d_ws + OFF_BAR, 0, 3456 * sizeof(unsigned), stream);
  void* args[] = {&mp};
  hipError_t e = hipLaunchCooperativeKernel((const void*)k_run, dim3(grid_blocks), dim3(512), args, LDS_BYTES, stream);
  if (e != hipSuccess) fprintf(stderr, "cooperative launch failed: %s (grid %d)\n", hipGetErrorString(e), grid_blocks);
}
```

```cpp
#include <hip/hip_runtime.h>
#include <hip/hip_cooperative_groups.h>
#include <cstdio>
#include <cmath>
#include <cstring>

typedef unsigned short bf16_t;
#define DI __device__ __forceinline__

constexpr int T_TOK = 32768, DM = 1024, SEQ = 2048, DFF = 2816, INW = 2560, NLAYER = 4;
constexpr float EPS = 1e-6f;
constexpr float QSCALE = 0.125f * 1.4426950408889634f;

constexpr size_t MiB = 1024ull * 1024ull;
constexpr size_t OFF_XB = 0;
constexpr size_t OFF_R = 64 * MiB;
constexpr size_t OFF_U = OFF_R, OFF_Q = OFF_R + 32 * MiB, OFF_KB = OFF_R + 64 * MiB, OFF_GVT = OFF_R + 96 * MiB, OFF_VT = OFF_R + 128 * MiB, OFF_MIX = OFF_R + 160 * MiB;
constexpr size_t OFF_F = OFF_R, OFF_GB = OFF_R + 176 * MiB, OFF_PB = OFF_R + 188 * MiB, OFF_UB = OFF_R + 200 * MiB;
constexpr size_t OFF_W = 288 * MiB, W_STRIDE = 24 * MiB;
constexpr size_t WO_IN = 0, WO_OUT = 5 * MiB, WO_GU = 7 * MiB, WO_DN = 18 * MiB, WO_SP = 23 * MiB + 512 * 1024;
constexpr size_t OFF_SS1 = 384 * MiB, OFF_SS2 = OFF_SS1 + 256 * 1024, OFF_SSV = OFF_SS2 + 256 * 1024;
constexpr size_t OFF_BAR = 385 * MiB + 512 * 1024;
constexpr size_t OFF_TMP1 = 386 * MiB, OFF_TMP2 = 418 * MiB;

DI int tid_opaque() { int t = threadIdx.x; asm volatile("" : "+v"(t)); return t; }
DI float bf2f(bf16_t b) { return __uint_as_float(((unsigned)b) << 16); }
DI bf16_t f2bf(float f) { unsigned u = __float_as_uint(f); u += 0x7FFFu + ((u >> 16) & 1u); return (bf16_t)(u >> 16); }
DI float gelu_exact(float x) { return 0.5f * x * (1.0f + erff(x * 0.70710678118654752f)); }
DI int permpos16(int k) { return (k & 3) + 4 * (k >> 3) + 8 * ((k >> 2) & 1); }
DI float wave_sum(float v) { for (int o = 32; o >= 1; o >>= 1) v += __shfl_xor(v, o); return v; }

namespace pg8 {
#define PG8_LAS __attribute__((address_space(3)))
typedef unsigned short bf16_t;
typedef short bf16x8 __attribute__((ext_vector_type(8)));
typedef float f32x4 __attribute__((ext_vector_type(4)));
typedef unsigned u32x4 __attribute__((ext_vector_type(4)));
constexpr int BM = 256, BK = 64, HALF = 128, HTB = HALF * BK * 2  , STAGE_BYTES = 8 * HTB, NXCD = 8, WGM = 8;

__host__ __device__ __forceinline__ int lds_byte(int r, int c) { const int st = (r >> 4) * 2 + (c >> 5), rr = r & 15, cc = c & 31, ob = rr * 64 + cc * 2; return st * 1024 + (ob ^ (((ob >> 9) & 1) << 5)); }
__host__ __device__ __forceinline__ void stage_rc(int b, int& R, int& C) { const int st = b / 1024, sb = b % 1024, swz = sb ^ (((sb >> 9) & 1) << 5); R = (st >> 1) * 16 + swz / 64; C = (st & 1) * 32 + (swz % 64) / 2; }
__host__ __device__ __forceinline__ int perm32(int rho) { const int n = rho >> 4, i = rho & 15; return 8 * (i >> 2) + 4 * n + (i & 3); }

struct Unit { int pm, pn; };
struct Gemm { const bf16_t* A; const bf16_t* Bt; int M, N, K; };

struct StaticOrder {
    int nM, nN, nwg, G, c;
    __host__ __device__ void init(int M, int N, int G_, int c_) { nM = M / BM; nN = N / BM; nwg = nM * nN; G = G_; c = c_; }
    __host__ __device__ bool next(int i, Unit& u) const {
        const long L = (long)i * G + c; if (L >= nwg) return false;
        int wgid = (int)L; { const int q = nwg / NXCD, r = nwg % NXCD, xcd = wgid % NXCD, off = wgid / NXCD; wgid = (xcd < r ? xcd * (q + 1) : r * (q + 1) + (xcd - r) * q) + off; }
        const int nig = WGM * nN, gid = wgid / nig, fm = gid * WGM, gsz = (nM - fm) < WGM ? (nM - fm) : WGM;
        u.pm = fm + ((wgid % nig) % gsz); u.pn = (wgid % nig) / gsz; return true;
    }
    __device__ __forceinline__ void a_ready(const Unit&) const {}
    __device__ __forceinline__ void done(const Unit&) const {}
};
template <class Epi, class Sched>
__device__ __forceinline__ void gemm_phase(PG8_LAS unsigned char* lds, const Gemm g, const Sched& S, const Epi& E) {
    const int tid = tid_opaque(), wid = __builtin_amdgcn_readfirstlane(tid >> 6), lane = tid & 63, wr = wid >> 2, wc = wid & 3, fr = lane & 15, fq = lane >> 4;
    const int K = g.K, nt = K / BK;
    unsigned voffA[2], voffB[2];
#pragma unroll
    for (int i = 0; i < 2; ++i) { int R, C; stage_rc(tid * 16 + i * 8192, R, C); const int Rb = Epi::PERM ? ((R & ~31) + perm32(R & 31)) : R;
        voffA[i] = (unsigned)(R * K + C) * 2u; voffB[i] = (unsigned)(Rb * K + C) * 2u; }
    const size_t kstep = (size_t)(BK * 2);
    const size_t hstep = (size_t)HALF * K * 2;
    const size_t tstep = 2 * hstep;
    const unsigned ldsw = (unsigned)wid * 1024u;
    const int aoff = lds_byte(wr * 64 + fr, fq * 8), boff = lds_byte(wc * 32 + fr, fq * 8);
#define PG8_SA(b, h) (((b) * 2 + (h)) * HTB)
#define PG8_SB(b, h) ((4 + (b) * 2 + (h)) * HTB)
#define PG8_STAGE(bufoff, gbase, voff) do { _Pragma("unroll") for (int _i = 0; _i < 2; ++_i) \
        __builtin_amdgcn_global_load_lds((const unsigned*)((const char*)(gbase) + (voff)[_i]), (PG8_LAS unsigned*)(lds + (bufoff) + ldsw + _i * 8192), 16, 0, 0); } while (0)
#define PG8_LDA(dst, b, h) do { _Pragma("unroll") for (int m = 0; m < 4; ++m) _Pragma("unroll") for (int k = 0; k < 2; ++k) dst[m][k] = *(const PG8_LAS bf16x8*)(lds + PG8_SA(b, h) + aoff + m * 2048 + k * 1024); } while (0)
#define PG8_LDB(dst, b, h) do { _Pragma("unroll") for (int n = 0; n < 2; ++n) _Pragma("unroll") for (int k = 0; k < 2; ++k) dst[n][k] = *(const PG8_LAS bf16x8*)(lds + PG8_SB(b, h) + boff + n * 2048 + k * 1024); } while (0)
#define PG8_MMA(ai, bj, At, Bt) do { __builtin_amdgcn_s_setprio(1); _Pragma("unroll") for (int m = 0; m < 4; ++m) _Pragma("unroll") for (int n = 0; n < 2; ++n) _Pragma("unroll") for (int k = 0; k < 2; ++k) \
        acc[ai][bj][m][n] = __builtin_amdgcn_mfma_f32_16x16x32_bf16(Bt[n][k], At[m][k], acc[ai][bj][m][n], 0, 0, 0); __builtin_amdgcn_s_setprio(0); } while (0)
#define PG8_WAIT_V(n) asm volatile("s_waitcnt vmcnt(" #n ")" ::: "memory")
#define PG8_WAIT_L(n) asm volatile("s_waitcnt lgkmcnt(" #n ")" ::: "memory")
#define PG8_BAR __builtin_amdgcn_s_barrier()
#define PG8_SCHED __builtin_amdgcn_sched_barrier(0)
    Unit cur, nxt; int ui = 0;
    if (!S.next(0, cur)) return;
    f32x4 acc[2][2][4][2];
#pragma unroll
    for (int a = 0; a < 2; ++a)
#pragma unroll
        for (int b = 0; b < 2; ++b)
#pragma unroll
            for (int m = 0; m < 4; ++m)
#pragma unroll
                for (int n = 0; n < 2; ++n) acc[a][b][m][n] = (f32x4){0.f, 0.f, 0.f, 0.f};
    bf16x8 At[4][2], B0[2][2], B1[2][2];
    const char* cA = (const char*)g.A + (size_t)cur.pm * tstep; const char* cB = (const char*)g.Bt + (size_t)cur.pn * tstep;
    S.a_ready(cur);
    PG8_STAGE(PG8_SB(0, 0), cB, voffB); PG8_STAGE(PG8_SA(0, 0), cA, voffA); PG8_STAGE(PG8_SB(0, 1), cB + hstep, voffB); PG8_STAGE(PG8_SA(0, 1), cA + hstep, voffA);
    if (wr == 1) PG8_BAR;
    PG8_WAIT_V(4); PG8_BAR;
    PG8_STAGE(PG8_SB(1, 0), cB + kstep, voffB); PG8_STAGE(PG8_SA(1, 0), cA + kstep, voffA); PG8_STAGE(PG8_SB(1, 1), cB + hstep + kstep, voffB);
    PG8_WAIT_V(6); PG8_BAR;
    for (;;) {
        const bool has_next = S.next(ui + 1, nxt);
        const char* nA = has_next ? (const char*)g.A + (size_t)nxt.pm * tstep : cA; const char* nB = has_next ? (const char*)g.Bt + (size_t)nxt.pn * tstep : cB;
        for (int t = 0; t < nt; t += 2) {
            const bool last = (t == nt - 2);
            const char* a1 = cA + (size_t)(t + 1) * kstep;
            const char* a2 = last ? nA : cA + (size_t)(t + 2) * kstep; const char* b2 = last ? nB : cB + (size_t)(t + 2) * kstep;
            const char* a3 = a2 + kstep; const char* b3 = b2 + kstep;
            if (last && has_next) S.a_ready(nxt);
            PG8_LDB(B0, 0, 0); PG8_SCHED; PG8_LDA(At, 0, 0); PG8_STAGE(PG8_SA(1, 1), a1 + hstep, voffA);
            PG8_WAIT_L(8); PG8_BAR; PG8_WAIT_L(0); PG8_MMA(0, 0, At, B0); PG8_BAR; PG8_SCHED;
            PG8_LDB(B1, 0, 1); PG8_STAGE(PG8_SB(0, 0), b2, voffB);
            PG8_BAR; PG8_WAIT_L(0); PG8_MMA(0, 1, At, B1); PG8_BAR;
            PG8_LDA(At, 0, 1); PG8_STAGE(PG8_SA(0, 0), a2, voffA);
            PG8_BAR; PG8_WAIT_L(0); PG8_MMA(1, 0, At, B0); PG8_BAR; PG8_SCHED;
            PG8_STAGE(PG8_SB(0, 1), b2 + hstep, voffB);
            PG8_WAIT_V(6); PG8_BAR; PG8_MMA(1, 1, At, B1); PG8_BAR;
            PG8_LDB(B0, 1, 0); PG8_SCHED; PG8_LDA(At, 1, 0); PG8_STAGE(PG8_SA(0, 1), a2 + hstep, voffA);
            PG8_WAIT_L(8); PG8_BAR; PG8_WAIT_L(0); PG8_MMA(0, 0, At, B0); PG8_BAR; PG8_SCHED;
            PG8_LDB(B1, 1, 1); PG8_STAGE(PG8_SB(1, 0), b3, voffB);
            PG8_BAR; PG8_WAIT_L(0); PG8_MMA(0, 1, At, B1); PG8_BAR;
            PG8_LDA(At, 1, 1); PG8_STAGE(PG8_SA(1, 0), a3, voffA);
            PG8_BAR; PG8_WAIT_L(0); PG8_MMA(1, 0, At, B0); PG8_BAR; PG8_SCHED;
            PG8_STAGE(PG8_SB(1, 1), b3 + hstep, voffB);
            PG8_WAIT_V(6); PG8_BAR; PG8_MMA(1, 1, At, B1); PG8_BAR;
        }
        if constexpr (!Epi::AFTER_DRAIN) { if (!Epi::TWICE || (ui & 1)) E(acc, cur, wr, wc, fr, fq); S.done(cur); }
        if (!has_next) break;
#pragma unroll
        for (int a = 0; a < 2; ++a)
#pragma unroll
            for (int b = 0; b < 2; ++b)
#pragma unroll
                for (int m = 0; m < 4; ++m)
#pragma unroll
                    for (int n = 0; n < 2; ++n) acc[a][b][m][n] = (f32x4){0.f, 0.f, 0.f, 0.f};
        cur = nxt; cA = nA; cB = nB; ++ui;
    }
    PG8_WAIT_V(0);
    if (wr == 0) PG8_BAR;
    PG8_BAR;
    if constexpr (Epi::AFTER_DRAIN) { E.fused(acc, cur, wr, wc, fr, fq, lds, wid, lane); S.done(cur); }
#undef PG8_SA
#undef PG8_SB
#undef PG8_STAGE
#undef PG8_LDA
#undef PG8_LDB
#undef PG8_MMA
#undef PG8_WAIT_V
#undef PG8_WAIT_L
#undef PG8_BAR
#undef PG8_SCHED
}
}

namespace cg = cooperative_groups;
using pg8::f32x4; using pg8::bf16x8; using pg8::Unit;
typedef unsigned u32x2_t __attribute__((ext_vector_type(2)));
typedef unsigned u32x4_t __attribute__((ext_vector_type(4)));
typedef float f32x16 __attribute__((ext_vector_type(16)));
typedef float f32x2_t __attribute__((ext_vector_type(2)));
#define LAS PG8_LAS
constexpr int LDS_BYTES = 163840;
#ifndef EN_MASK
#define EN_MASK 0x7f
#endif
#ifndef PROBE_EPI_ACE
#define PROBE_EPI_ACE 0
#endif
#ifndef PROBE_EPI_D
#define PROBE_EPI_D 0
#endif
#ifndef PROBE_SYNC
#define PROBE_SYNC 0
#endif
#ifndef PROBE_MASK
#define PROBE_MASK 0x00
#endif

DI unsigned pk2(float lo, float hi) { unsigned r; asm volatile("s_nop 0\n\tv_cvt_pk_bf16_f32 %0, %1, %2\n\ts_nop 1" : "=v"(r) : "v"(lo), "v"(hi)); return r; }
DI float bflo(unsigned w) { return __uint_as_float(w << 16); }
DI float bfhi(unsigned w) { return __uint_as_float(w & 0xffff0000u); }
DI float gelu1(float v) {
  const float av = fabsf(v), t = __builtin_amdgcn_rcpf(av * 0.2316418882f + 1.0f);
  float q = t * 0.5307027145f + (-0.7265760135f); q = q * t + 0.7107068705f; q = q * t + (-0.142248368f); q = q * t + 0.127414796f; q = q * t;
  const float e = __builtin_amdgcn_exp2f((v * v) * (-0.72134752044f));
  const float m = v * (q * e);
  return v < 0.f ? m : v - m;
}
DI float dpp_ror1(float v) { return __builtin_bit_cast(float, __builtin_amdgcn_update_dpp(0, __builtin_bit_cast(int, v), 0x121, 0xf, 0xf, false)); }
DI float dpp_ror2(float v) { return __builtin_bit_cast(float, __builtin_amdgcn_update_dpp(0, __builtin_bit_cast(int, v), 0x122, 0xf, 0xf, false)); }
typedef unsigned long long u64;
DI float fx2f(u64 v) { return (float)v * (1.0f / 1048576.0f); }
DI u64 f2fx(float v) { return (u64)(v * 1048576.0f + 0.5f); }
DI void fx_add(u64* p, float v) { __hip_atomic_fetch_add(p, f2fx(v), __ATOMIC_RELAXED, __HIP_MEMORY_SCOPE_AGENT); }
DI float rs1024(u64 ss) { return rsqrtf(fx2f(ss) * (1.0f / 1024.0f) + EPS); }

struct MParams { const float* in[21]; float* out; unsigned char* ws; int ph_lo, ph_hi; };
struct LP {
  const float *norm_attn_w, *w_in, *v_norm_w, *sp_w, *sp_b, *out_norm_w, *q_norm_w, *k_norm_w, *lq1, *lk1, *lq2, *lk2, *diff_norm_w, *w_out, *norm_ffn_w, *w_gate, *w_up, *conv_w, *conv_b, *w_down;
  float lambda_init;
  const bf16_t *WinT, *WoutT, *WguT, *WdT, *Wsp;
};
DI LP make_lp(const MParams& p, int l) {
  LP L;
  L.norm_attn_w = p.in[1] + (size_t)l * DM; L.w_in = p.in[2] + (size_t)l * DM * INW; L.v_norm_w = p.in[3] + (size_t)l * 512; L.sp_w = p.in[4] + (size_t)l * 65536; L.sp_b = p.in[5] + (size_t)l * 512;
  L.out_norm_w = p.in[6] + (size_t)l * 512; L.q_norm_w = p.in[7] + (size_t)l * 64; L.k_norm_w = p.in[8] + (size_t)l * 64; L.lq1 = p.in[9] + (size_t)l * 64; L.lk1 = p.in[10] + (size_t)l * 64;
  L.lq2 = p.in[11] + (size_t)l * 64; L.lk2 = p.in[12] + (size_t)l * 64; L.diff_norm_w = p.in[13] + (size_t)l * 128; L.w_out = p.in[14] + (size_t)l * DM * DM; L.norm_ffn_w = p.in[15] + (size_t)l * DM;
  L.w_gate = p.in[16] + (size_t)l * DM * DFF; L.w_up = p.in[17] + (size_t)l * DM * DFF; L.conv_w = p.in[18] + (size_t)l * 3 * DFF; L.conv_b = p.in[19] + (size_t)l * DFF; L.w_down = p.in[20] + (size_t)l * DFF * DM;
  L.lambda_init = 0.8f - 0.6f * expf(-0.3f * (float)(l + 1));
  const unsigned char* wb = p.ws + OFF_W + (size_t)l * W_STRIDE;
  L.WinT = (const bf16_t*)(wb + WO_IN); L.WoutT = (const bf16_t*)(wb + WO_OUT); L.WguT = (const bf16_t*)(wb + WO_GU); L.WdT = (const bf16_t*)(wb + WO_DN); L.Wsp = (const bf16_t*)(wb + WO_SP);
  return L;
}
DI float lam_of(const LP& lp) {
  const int lane = threadIdx.x & 63;
  float a = lp.lq1[lane] * lp.lk1[lane], b = lp.lq2[lane] * lp.lk2[lane];
  a = wave_sum(a); b = wave_sum(b);
  return expf(a) - expf(b) + lp.lambda_init;
}

DI void conv_item(bf16_t* dst, int K, int row, int kg, const float* src, int ld, int col, const float* ks) {
  float v[32];
#pragma unroll
  for (int i = 0; i < 32; ++i) v[i] = src[(size_t)(kg * 32 + i) * ld + col];
  if (ks) {
#pragma unroll
    for (int i = 0; i < 32; i += 4) { const f32x4 s = *(const f32x4*)(ks + kg * 32 + i); v[i] *= s[0]; v[i + 1] *= s[1]; v[i + 2] *= s[2]; v[i + 3] *= s[3]; }
  }
  u32x4_t* d = (u32x4_t*)(dst + (size_t)row * K + kg * 32);
#pragma unroll
  for (int i = 0; i < 4; ++i) { u32x4_t w; w.x = pk2(v[8 * i], v[8 * i + 1]); w.y = pk2(v[8 * i + 2], v[8 * i + 3]); w.z = pk2(v[8 * i + 4], v[8 * i + 5]); w.w = pk2(v[8 * i + 6], v[8 * i + 7]); d[i] = w; }
}
DI int perm_logical(int p) {
  const int bj = p >> 7, wc = (p >> 5) & 3, n = (p >> 4) & 1, fq = (p >> 2) & 3, e = p & 3;
  return 64 * wc + 32 * bj + 8 * fq + 4 * n + e;
}
DI int perm_res(int p) { return (p & ~31) + 8 * ((p >> 2) & 3) + 4 * ((p >> 4) & 1) + (p & 3); }
DI void prologue(const MParams& p, LAS unsigned char* lds) {
  const int tidp = tid_opaque(); const int gtid = blockIdx.x * 512 + tidp, gsz = gridDim.x * 512;
  unsigned char* ws = p.ws;
  { const int gw = gtid >> 6, nw = gsz >> 6, lane = threadIdx.x & 63; bf16_t* XB = (bf16_t*)(ws + OFF_XB); u64* SS1 = (u64*)(ws + OFF_SS1);
    for (int row = gw; row < T_TOK; row += nw) { const float* xp = p.in[0] + (size_t)row * DM; float s = 0.f;
#pragma unroll
      for (int i = 0; i < 4; ++i) { const f32x4 v = *(const f32x4*)(xp + i * 256 + lane * 4); s += v[0] * v[0] + v[1] * v[1] + v[2] * v[2] + v[3] * v[3];
        u32x2_t w; w.x = pk2(v[0], v[1]); w.y = pk2(v[2], v[3]); *(u32x2_t*)(XB + (size_t)row * DM + i * 256 + lane * 4) = w; }
      s = wave_sum(s); if (lane == 0) SS1[row] = f2fx(s); } }
  { u64* SSV = (u64*)(ws + OFF_SSV); for (int i = gtid; i < T_TOK * 4; i += gsz) SSV[i] = 0ull; }
  { const int lane = tidp & 63, wv = tidp >> 6, n4 = lane & 15, kq = lane >> 4; LAS unsigned char* wl = lds + wv * 9216;
    for (int t = blockIdx.x * 8 + wv; t < NLAYER * 3008; t += gridDim.x * 8) {
      const int l = t / 3008; int r = t - l * 3008; const LP lp = make_lp(p, l);
      const float* src; const float* ks; bf16_t* dst; int ld, K, rt, kt, col;
      if (r < 640) { rt = r % 40; kt = r / 40; dst = (bf16_t*)lp.WinT; K = 1024; ld = INW; ks = lp.norm_attn_w; src = lp.w_in; const int row = 64 * rt + 4 * n4;
        if (row < 1536) { const int L = (row & ~255) + perm_logical(row & 255); col = L < 512 ? L : L + 512; } else { const int q = row - 1536; col = q < 512 ? 512 + q : 1536 + q; } }
      else if (r < 896) { r -= 640; rt = r & 15; kt = r >> 4; dst = (bf16_t*)lp.WoutT; K = 1024; ld = DM; ks = nullptr; src = lp.w_out; col = perm_res(64 * rt + 4 * n4); }
      else if (r < 2304) { r -= 896; rt = r % 88; kt = r / 88; dst = (bf16_t*)lp.WguT; K = 1024; ld = DFF; ks = lp.norm_ffn_w; const int row = 64 * rt + 4 * n4, pn = row >> 8, pp = row & 255;
        src = (pp >> 7) ? lp.w_up : lp.w_gate; const int q = pp & 127; col = 128 * pn + 32 * ((q >> 5) & 3) + 8 * ((q >> 2) & 3) + 4 * ((q >> 4) & 1) + (q & 3); }
      else { r -= 2304; rt = r & 15; kt = r >> 4; dst = (bf16_t*)lp.WdT; K = DFF; ld = DM; ks = nullptr; src = lp.w_down; col = perm_res(64 * rt + 4 * n4); }
      const float* sp = src + (size_t)(64 * kt + 16 * kq) * ld + col;
      f32x4 v[16];
#pragma unroll
      for (int j = 0; j < 16; ++j) v[j] = *(const f32x4*)(sp + (size_t)j * ld);
      if (ks) {
#pragma unroll
        for (int i = 0; i < 4; ++i) { const f32x4 sc = *(const f32x4*)(ks + 64 * kt + 16 * kq + 4 * i); v[4 * i] *= sc[0]; v[4 * i + 1] *= sc[1]; v[4 * i + 2] *= sc[2]; v[4 * i + 3] *= sc[3]; } }
#pragma unroll
      for (int n = 0; n < 4; ++n)
#pragma unroll
        for (int hh = 0; hh < 2; ++hh) { u32x4_t w; w.x = pk2(v[8 * hh][n], v[8 * hh + 1][n]); w.y = pk2(v[8 * hh + 2][n], v[8 * hh + 3][n]); w.z = pk2(v[8 * hh + 4][n], v[8 * hh + 5][n]); w.w = pk2(v[8 * hh + 6][n], v[8 * hh + 7][n]);
          *(LAS u32x4_t*)(wl + (4 * n4 + n) * 144 + (16 * kq + 8 * hh) * 2) = w; }
#pragma unroll
      for (int i = 0; i < 8; ++i) { const int row = 8 * i + (lane >> 3), pc = lane & 7; const u32x4_t w = *(const LAS u32x4_t*)(wl + row * 144 + pc * 16);
        *(u32x4_t*)(dst + (size_t)(64 * rt + row) * K + 64 * kt + pc * 8) = w; }
    }
  }
  for (int l = 0; l < NLAYER; ++l) { const LP lp = make_lp(p, l);
    for (int i = gtid; i < 65536; i += gsz) { const int jj = i & 127, ii = (i >> 7) & 127; ((bf16_t*)lp.Wsp)[i] = ((jj >> 6) <= (ii >> 6)) ? f2bf(lp.sp_w[i]) : (bf16_t)0; } }
}

struct DupOrder : pg8::StaticOrder {
  __device__ bool next(int i, Unit& u) const { return pg8::StaticOrder::next(i >> 1, u); }
};
struct EpiResid {
  static constexpr bool PERM = false, AFTER_DRAIN = false, TWICE = (PROBE_EPI_ACE != 0);
  const float* base32; float* out32; bf16_t* XB; u64* SS;
  DI void operator()(const f32x4 (&acc)[2][2][4][2], const Unit& u, int wr, int wc, int fr, int fq) const {
    const int row0 = u.pm * 256 + wr * 64 + fr, col0 = u.pn * 256 + wc * 32 + 8 * fq;
    if (base32) {
      f32x4 nb[2][2];
#pragma unroll
      for (int bj = 0; bj < 2; ++bj)
#pragma unroll
        for (int n = 0; n < 2; ++n) nb[bj][n] = *(const f32x4*)(base32 + (size_t)row0 * DM + col0 + bj * 128 + n * 4);
#pragma unroll
      for (int g = 0; g < 8; ++g) { const int ai = g >> 2, m = g & 3; const int row = row0 + ai * 128 + m * 16; const size_t ro = (size_t)row * DM + col0; float ss = 0.f;
        f32x4 cbv[2][2];
#pragma unroll
        for (int bj = 0; bj < 2; ++bj)
#pragma unroll
          for (int n = 0; n < 2; ++n) cbv[bj][n] = nb[bj][n];
        if (g < 7) { const int r2 = row0 + ((g + 1) >> 2) * 128 + ((g + 1) & 3) * 16;
#pragma unroll
          for (int bj = 0; bj < 2; ++bj)
#pragma unroll
            for (int n = 0; n < 2; ++n) nb[bj][n] = *(const f32x4*)(base32 + (size_t)r2 * DM + col0 + bj * 128 + n * 4); }
#pragma unroll
        for (int bj = 0; bj < 2; ++bj) { const f32x4 v0 = acc[ai][bj][m][0] + cbv[bj][0], v1 = acc[ai][bj][m][1] + cbv[bj][1];
          u32x4_t w; w.x = pk2(v0[0], v0[1]); w.y = pk2(v0[2], v0[3]); w.z = pk2(v1[0], v1[1]); w.w = pk2(v1[2], v1[3]); *(u32x4_t*)(XB + ro + bj * 128) = w;
          ss += ((v0[0] * v0[0] + v0[1] * v0[1]) + (v0[2] * v0[2] + v0[3] * v0[3])) + ((v1[0] * v1[0] + v1[1] * v1[1]) + (v1[2] * v1[2] + v1[3] * v1[3])); }
        ss += __shfl_xor(ss, 16); ss += __shfl_xor(ss, 32); if (fq == 0) fx_add(SS + row, ss);
        asm volatile("" ::: "memory"); }
    } else {
      u32x4_t nb[2];
#pragma unroll
      for (int bj = 0; bj < 2; ++bj) nb[bj] = *(const u32x4_t*)(XB + (size_t)row0 * DM + col0 + bj * 128);
#pragma unroll
      for (int g = 0; g < 8; ++g) { const int ai = g >> 2, m = g & 3; const int row = row0 + ai * 128 + m * 16; const size_t ro = (size_t)row * DM + col0; float ss = 0.f;
        u32x4_t cbv[2];
#pragma unroll
        for (int bj = 0; bj < 2; ++bj) cbv[bj] = nb[bj];
        if (g < 7) { const int r2 = row0 + ((g + 1) >> 2) * 128 + ((g + 1) & 3) * 16;
#pragma unroll
          for (int bj = 0; bj < 2; ++bj) nb[bj] = *(const u32x4_t*)(XB + (size_t)r2 * DM + col0 + bj * 128); }
#pragma unroll
        for (int bj = 0; bj < 2; ++bj) { const u32x4_t c = cbv[bj];
          const f32x4 v0 = acc[ai][bj][m][0] + (f32x4){bflo(c.x), bfhi(c.x), bflo(c.y), bfhi(c.y)}, v1 = acc[ai][bj][m][1] + (f32x4){bflo(c.z), bfhi(c.z), bflo(c.w), bfhi(c.w)};
          if (out32) { *(f32x4*)(out32 + ro + bj * 128) = v0; *(f32x4*)(out32 + ro + bj * 128 + 4) = v1; }
          else { u32x4_t w; w.x = pk2(v0[0], v0[1]); w.y = pk2(v0[2], v0[3]); w.z = pk2(v1[0], v1[1]); w.w = pk2(v1[2], v1[3]); *(u32x4_t*)(XB + ro + bj * 128) = w;
            ss += ((v0[0] * v0[0] + v0[1] * v0[1]) + (v0[2] * v0[2] + v0[3] * v0[3])) + ((v1[0] * v1[0] + v1[1] * v1[1]) + (v1[2] * v1[2] + v1[3] * v1[3])); } }
        if (!out32) { ss += __shfl_xor(ss, 16); ss += __shfl_xor(ss, 32); if (fq == 0) fx_add(SS + row, ss); }
        asm volatile("" ::: "memory"); }
    }
  }
};
struct EpiA1 {
  static constexpr bool PERM = false, AFTER_DRAIN = false, TWICE = (PROBE_EPI_ACE != 0);
  const u64* SS1; bf16_t *U, *Q, *KB; const float *qw, *kw;
  DI void operator()(const f32x4 (&acc)[2][2][4][2], const Unit& u, int wr, int wc, int fr, int fq) const {
    const int row0 = u.pm * 256 + wr * 64 + fr, lc0 = wc * 64 + 8 * fq, region = u.pn >> 1;
    u64 rsv[8];
#pragma unroll
    for (int g = 0; g < 8; ++g) rsv[g] = SS1[row0 + (g >> 2) * 128 + (g & 3) * 16];
    if (region == 0) {
#pragma unroll
      for (int g = 0; g < 8; ++g) { const int ai = g >> 2, m = g & 3; const int row = row0 + ai * 128 + m * 16; const float rs = rs1024(rsv[g]);
#pragma unroll
        for (int bj = 0; bj < 2; ++bj) { const f32x4 a = acc[ai][bj][m][0] * rs, b = acc[ai][bj][m][1] * rs; u32x4_t w;
          w.x = pk2(gelu1(a[0]), gelu1(a[1])); w.y = pk2(gelu1(a[2]), gelu1(a[3])); w.z = pk2(gelu1(b[0]), gelu1(b[1])); w.w = pk2(gelu1(b[2]), gelu1(b[3]));
          *(u32x4_t*)(U + (size_t)row * 512 + u.pn * 256 + lc0 + 32 * bj) = w; } }
    } else {
      const bool isq = region == 1; const float* wp = (isq ? qw : kw) + 8 * fq; bf16_t* dst = (isq ? Q : KB) + (u.pn & 1) * 256 + lc0; const float sc = isq ? QSCALE : 1.0f;
      f32x4 wv[2][2];
#pragma unroll
      for (int bj = 0; bj < 2; ++bj)
#pragma unroll
        for (int n = 0; n < 2; ++n) wv[bj][n] = *(const f32x4*)(wp + 32 * bj + 4 * n);
#pragma unroll
      for (int g = 0; g < 8; ++g) { const int ai = g >> 2, m = g & 3; const int row = row0 + ai * 128 + m * 16; const float rs = rs1024(rsv[g]); float ss = 0.f; f32x4 v[2][2];
#pragma unroll
        for (int bj = 0; bj < 2; ++bj)
#pragma unroll
          for (int n = 0; n < 2; ++n) { v[bj][n] = acc[ai][bj][m][n] * rs; const f32x4 t = v[bj][n]; ss += (t[0] * t[0] + t[1] * t[1]) + (t[2] * t[2] + t[3] * t[3]); }
        ss += __shfl_xor(ss, 16); ss += __shfl_xor(ss, 32);
        const float r2 = rsqrtf(ss * (1.0f / 64.0f) + EPS) * sc;
#pragma unroll
        for (int bj = 0; bj < 2; ++bj) { const f32x4 a = v[bj][0] * r2 * wv[bj][0], b = v[bj][1] * r2 * wv[bj][1]; u32x4_t w;
          w.x = pk2(a[0], a[1]); w.y = pk2(a[2], a[3]); w.z = pk2(b[0], b[1]); w.w = pk2(b[2], b[3]);
          *(u32x4_t*)(dst + (size_t)row * 512 + 32 * bj) = w; } }
    }
  }
};
struct EpiA2 {
  static constexpr bool PERM = false, AFTER_DRAIN = false, TWICE = (PROBE_EPI_ACE != 0);
  const u64* SS1; bf16_t *GVT, *VT; u64* SSV;
  DI void operator()(const f32x4 (&acc)[2][2][4][2], const Unit& u, int wr, int wc, int fr, int fq) const {
    const int colbase = u.pn * 256 + wc * 32;
    f32x4 rs[2][2];
#pragma unroll
    for (int bj = 0; bj < 2; ++bj)
#pragma unroll
      for (int n = 0; n < 2; ++n) { const u64* sp = SS1 + colbase + bj * 128 + n * 16 + 4 * fq; rs[bj][n] = (f32x4){rs1024(sp[0]), rs1024(sp[1]), rs1024(sp[2]), rs1024(sp[3])}; }
    if (u.pm < 2) {
#pragma unroll
      for (int ai = 0; ai < 2; ++ai) { const int head = 2 * u.pm + ai;
#pragma unroll
        for (int bj = 0; bj < 2; ++bj)
#pragma unroll
          for (int n = 0; n < 2; ++n) { f32x4 sq = (f32x4){0.f, 0.f, 0.f, 0.f}; const int tok = colbase + bj * 128 + n * 16 + 4 * fq;
#pragma unroll
            for (int m = 0; m < 4; ++m) { const int row = u.pm * 256 + ai * 128 + wr * 64 + m * 16 + fr;
              const f32x4 a = acc[ai][bj][m][n] * rs[bj][n]; f32x4 g; g[0] = gelu1(a[0]); g[1] = gelu1(a[1]); g[2] = gelu1(a[2]); g[3] = gelu1(a[3]);
              u32x2_t w; w.x = pk2(g[0], g[1]); w.y = pk2(g[2], g[3]); *(u32x2_t*)(GVT + (size_t)row * T_TOK + tok) = w; sq += g * g; }
#pragma unroll
            for (int e = 0; e < 4; ++e) { float s = sq[e]; s += __shfl_xor(s, 1); s += __shfl_xor(s, 2); s += __shfl_xor(s, 4); s += __shfl_xor(s, 8); sq[e] = s; }
            if (fr == 0) {
#pragma unroll
              for (int e = 0; e < 4; ++e) fx_add(SSV + (size_t)(tok + e) * 4 + head, sq[e]); }
            asm volatile("" ::: "memory"); } }
    } else {
#pragma unroll
      for (int ai = 0; ai < 2; ++ai)
#pragma unroll
        for (int m = 0; m < 4; ++m) { const int row = (u.pm - 2) * 256 + ai * 128 + wr * 64 + m * 16 + fr;
#pragma unroll
          for (int bj = 0; bj < 2; ++bj)
#pragma unroll
            for (int n = 0; n < 2; ++n) { const f32x4 a = acc[ai][bj][m][n] * rs[bj][n]; u32x2_t w; w.x = pk2(a[0], a[1]); w.y = pk2(a[2], a[3]);
              *(u32x2_t*)(VT + (size_t)row * T_TOK + colbase + bj * 128 + n * 16 + 8 * (fq & 1) + 4 * (fq >> 1)) = w; } }
    }
  }
};
struct EpiD {
  static constexpr bool PERM = false, AFTER_DRAIN = false, TWICE = (PROBE_EPI_D != 0);
  const u64* SS2; const float *cw, *cb; bf16_t* F; float *GB, *PB, *UB;
  DI void operator()(const f32x4 (&acc)[2][2][4][2], const Unit& u, int wr, int wc, int fr, int fq) const {
    const int cbase = u.pn * 128 + wc * 32 + 8 * fq;
    const int rb0 = u.pm * 256 + wr * 64;
    u64 rsv[8]; f32x4 w0[2], w1[2], w2[2], bb[2];
#pragma unroll
    for (int g = 0; g < 8; ++g) rsv[g] = SS2[rb0 + (g >> 2) * 128 + (g & 3) * 16 + fr];
#pragma unroll
    for (int n = 0; n < 2; ++n) { w0[n] = *(const f32x4*)(cw + cbase + 4 * n); w1[n] = *(const f32x4*)(cw + DFF + cbase + 4 * n); w2[n] = *(const f32x4*)(cw + 2 * DFF + cbase + 4 * n); bb[n] = *(const f32x4*)(cb + cbase + 4 * n); }
#pragma unroll
    for (int ai = 0; ai < 2; ++ai) {
      const int rb = rb0 + ai * 128, bd = rb >> 6;
      float rs[4];
#pragma unroll
      for (int m = 0; m < 4; ++m) rs[m] = rs1024(rsv[ai * 4 + m]);
      unsigned fo[4][4];
#pragma unroll
      for (int n = 0; n < 2; ++n) {
        const int cn = cbase + 4 * n;
        f32x4 pg, ug, gg; float fv[4][4];
#pragma unroll
        for (int e = 0; e < 4; ++e) {
          float G[4], r1[4], r2[4];
#pragma unroll
          for (int m = 0; m < 4; ++m) { G[m] = acc[ai][0][m][n][e] * rs[m]; r1[m] = dpp_ror1(G[m]); r2[m] = dpp_ror2(G[m]); }
#pragma unroll
          for (int m = 0; m < 4; ++m) {
            const float p1 = (fr >= 1) ? r1[m] : (m > 0 ? r1[m > 0 ? m - 1 : 0] : 0.f);
            const float p2 = (fr >= 2) ? r2[m] : (m > 0 ? r2[m > 0 ? m - 1 : 0] : 0.f);
            const float g = w2[n][e] * G[m] + w1[n][e] * p1 + w0[n][e] * p2 + bb[n][e];
            const float uv = acc[ai][1][m][n][e] * rs[m];
            if (m == 0) { pg[e] = g; ug[e] = uv; }
            if (m == 3) gg[e] = G[3];
            fv[m][e] = g * __builtin_amdgcn_rcpf(1.0f + __expf(-g)) * uv;
          }
        }
#pragma unroll
        for (int m = 0; m < 4; ++m) { fo[m][2 * n] = pk2(fv[m][0], fv[m][1]); fo[m][2 * n + 1] = pk2(fv[m][2], fv[m][3]); }
        if (fr < 2) { *(f32x4*)(PB + (size_t)(bd * 2 + fr) * DFF + cn) = pg; *(f32x4*)(UB + (size_t)(bd * 2 + fr) * DFF + cn) = ug; }
        if (fr >= 14) { *(f32x4*)(GB + (size_t)(bd * 2 + fr - 14) * DFF + cn) = gg; }
      }
#pragma unroll
      for (int m = 0; m < 4; ++m) {
        if (!(m == 0 && fr < 2)) { u32x4_t w; w.x = fo[m][0]; w.y = fo[m][1]; w.z = fo[m][2]; w.w = fo[m][3]; *(u32x4_t*)(F + (size_t)(rb + 16 * m + fr) * DFF + cbase) = w; }
      }
    }
  }
};
DI void fixup_phase(const LP& lp, unsigned char* ws) {
  const float *GB = (const float*)(ws + OFF_GB), *PB = (const float*)(ws + OFF_PB), *UB = (const float*)(ws + OFF_UB); bf16_t* F = (bf16_t*)(ws + OFF_F);
  const int gtid = blockIdx.x * 512 + tid_opaque(), gsz = gridDim.x * 512;
  for (int w = gtid; w < 512 * 2 * 704; w += gsz) {
    const int c = (w % 704) * 4, j = (w / 704) & 1, bd = w / 1408;
    f32x4 g = *(const f32x4*)(PB + (size_t)(bd * 2 + j) * DFF + c);
    if (bd & 31) { const f32x4 gm1 = *(const f32x4*)(GB + (size_t)((bd - 1) * 2 + 1) * DFF + c); const f32x4 w0 = *(const f32x4*)(lp.conv_w + c);
      if (j == 0) { const f32x4 gm2 = *(const f32x4*)(GB + (size_t)((bd - 1) * 2) * DFF + c); const f32x4 w1 = *(const f32x4*)(lp.conv_w + DFF + c); g += w1 * gm1 + w0 * gm2; }
      else g += w0 * gm1; }
    const f32x4 uv = *(const f32x4*)(UB + (size_t)(bd * 2 + j) * DFF + c); float f[4];
#pragma unroll
    for (int e = 0; e < 4; ++e) f[e] = g[e] * __builtin_amdgcn_rcpf(1.0f + __expf(-g[e])) * uv[e];
    u32x2_t o; o.x = pk2(f[0], f[1]); o.y = pk2(f[2], f[3]);
    *(u32x2_t*)(F + (size_t)(bd * 64 + j) * DFF + c) = o;
  }
}

DI void spatial_phase(const LP& lp, unsigned char* ws, LAS unsigned char* lds) {
  const bf16_t *U = (const bf16_t*)(ws + OFF_U), *GVT = (const bf16_t*)(ws + OFF_GVT); const u64* SSV = (const u64*)(ws + OFF_SSV); bf16_t* MIX = (bf16_t*)(ws + OFF_MIX);
  constexpr int TB = 32768;
  LAS float* sr = (LAS float*)(lds + 2 * TB);
  const int tid = tid_opaque(), lane = tid & 63, w = __builtin_amdgcn_readfirstlane(tid >> 6), l15 = lane & 15, kq = lane >> 4;
#define SP_STAGE(item, buf) do { const int h_ = (item) & 3, t_ = ((item) >> 2) * 128; _Pragma("unroll") for (int i = 0; i < 4; ++i) { const int P = (w * 4 + i) * 64 + lane, row = P >> 4, pc = (P & 15) ^ (row & 15); \
    __builtin_amdgcn_global_load_lds((const unsigned*)(GVT + (size_t)(h_ * 128 + row) * T_TOK + t_ + pc * 8), (LAS unsigned*)(lds + (buf) * TB + (w * 4 + i) * 1024), 16, 0, 0); } } while (0)
  LAS float* vn_l = sr + 128; LAS float* on_l = vn_l + 512; LAS float* sb_l = on_l + 512;
  int it = blockIdx.x, buf = 0;
  if (it < 1024) SP_STAGE(it, 0);
  { const float a = lp.v_norm_w[tid], b = lp.out_norm_w[tid], c = lp.sp_b[tid]; vn_l[tid] = a; on_l[tid] = b; sb_l[tid] = c; }
  asm volatile("s_waitcnt vmcnt(0)" ::: "memory");
  __syncthreads();
  const int x_lane = l15 * 256 + ((kq ^ l15) << 4);
  const int i0 = 16 * w, nks = (w < 4) ? 2 : 4;
  u32x4_t rawN[4]; u32x2_t urN[8]; u64 ssvN = 0ull;
#define SP_LOADREGS(item) do { const int h_ = (item) & 3, t_ = ((item) >> 2) * 128; \
    _Pragma("unroll") for (int ks = 0; ks < 4; ++ks) rawN[ks] = (ks < nks) ? *(const u32x4_t*)(lp.Wsp + (size_t)(h_ * 128 + i0 + l15) * 128 + ks * 32 + kq * 8) : (u32x4_t){0u, 0u, 0u, 0u}; \
    _Pragma("unroll") for (int dt = 0; dt < 8; ++dt) urN[dt] = *(const u32x2_t*)(U + (size_t)(t_ + i0 + l15) * 512 + h_ * 128 + 16 * dt + 4 * kq); \
    ssvN = (tid < 128) ? SSV[(size_t)(t_ + tid) * 4 + h_] : 0ull; } while (0)
  if (it < 1024) SP_LOADREGS(it);
  for (; it < 1024; it += gridDim.x, buf ^= 1) {
    const int h = it & 3, tok0 = (it >> 2) * 128, irow = tok0 + i0 + l15;
    u32x4_t raw[4]; u32x2_t ur[8];
#pragma unroll
    for (int ks = 0; ks < 4; ++ks) raw[ks] = rawN[ks];
#pragma unroll
    for (int dt = 0; dt < 8; ++dt) ur[dt] = urN[dt];
    const u64 ssv = ssvN;
    const float bias = sb_l[h * 128 + i0 + l15];
    const int nit = it + gridDim.x;
    if (nit < 1024) { SP_STAGE(nit, buf ^ 1); SP_LOADREGS(nit); }
    if (tid < 128) sr[tid] = rsqrtf(fx2f(ssv) * (1.0f / 128.0f) + EPS);
    __syncthreads();
    bf16x8 yf[4];
#pragma unroll
    for (int ks = 0; ks < 4; ++ks) { const LAS float* sp = sr + ks * 32 + kq * 8; const u32x4_t r = raw[ks]; u32x4_t o;
      o.x = pk2(bflo(r.x) * sp[0], bfhi(r.x) * sp[1]); o.y = pk2(bflo(r.y) * sp[2], bfhi(r.y) * sp[3]); o.z = pk2(bflo(r.z) * sp[4], bfhi(r.z) * sp[5]); o.w = pk2(bflo(r.w) * sp[6], bfhi(r.w) * sp[7]);
      yf[ks] = __builtin_bit_cast(bf16x8, o); }
    const LAS unsigned char* tb = lds + buf * TB;
    float o[8][4]; float ss = 0.f;
#pragma unroll
    for (int dt = 0; dt < 8; ++dt) {
      f32x4 acc = (f32x4){0.f, 0.f, 0.f, 0.f};
#pragma unroll
      for (int ks = 0; ks < 4; ++ks) if (ks < nks) {
        const bf16x8 xf = *(const LAS bf16x8*)(tb + dt * 4096 + (x_lane ^ (ks << 6)));
        acc = __builtin_amdgcn_mfma_f32_16x16x32_bf16(xf, yf[ks], acc, 0, 0, 0); }
      const int d0 = 16 * dt + 4 * kq; const f32x4 wv = *(const LAS f32x4*)(vn_l + h * 128 + d0);
      o[dt][0] = bflo(ur[dt].x) * (acc[0] * wv[0] + bias); o[dt][1] = bfhi(ur[dt].x) * (acc[1] * wv[1] + bias); o[dt][2] = bflo(ur[dt].y) * (acc[2] * wv[2] + bias); o[dt][3] = bfhi(ur[dt].y) * (acc[3] * wv[3] + bias);
      ss += (o[dt][0] * o[dt][0] + o[dt][1] * o[dt][1]) + (o[dt][2] * o[dt][2] + o[dt][3] * o[dt][3]);
    }
    ss += __shfl_xor(ss, 16); ss += __shfl_xor(ss, 32);
    const float rs = rsqrtf(ss * (1.0f / 128.0f) + EPS);
#pragma unroll
    for (int dt = 0; dt < 8; ++dt) { const int d0 = 16 * dt + 4 * kq; const f32x4 wo = *(const LAS f32x4*)(on_l + h * 128 + d0);
      u32x2_t q; q.x = pk2(o[dt][0] * rs * wo[0], o[dt][1] * rs * wo[1]); q.y = pk2(o[dt][2] * rs * wo[2], o[dt][3] * rs * wo[3]);
      *(u32x2_t*)(MIX + (size_t)irow * 1024 + h * 128 + d0) = q; }
    asm volatile("s_waitcnt vmcnt(8)" ::: "memory");
    __syncthreads();
  }
#undef SP_STAGE
#undef SP_LOADREGS
}

DI void attn_phase(const MParams& p, int l, LAS unsigned char* lds) {
  unsigned char* ws = p.ws;
  const bf16_t *Q = (const bf16_t*)(ws + OFF_Q), *KB = (const bf16_t*)(ws + OFF_KB), *VT = (const bf16_t*)(ws + OFF_VT); bf16_t* MIX = (bf16_t*)(ws + OFF_MIX);
  constexpr int KBUF = 16384, VBUF = 16384, STG = KBUF + VBUF, QOFF = 3 * STG;
  static_assert(QOFF + 65536 <= LDS_BYTES, "attention LDS");
  const unsigned sv0 = __builtin_amdgcn_readfirstlane(((volatile LAS unsigned*)(lds + 131072))[0]), sv1 = __builtin_amdgcn_readfirstlane(((volatile LAS unsigned*)(lds + 131072))[1]), sv2 = __builtin_amdgcn_readfirstlane(((volatile LAS unsigned*)(lds + 131072))[2]);
  __syncthreads();
  const float lambda_init = 0.8f - 0.6f * expf(-0.3f * (float)(l + 1));
  const float* dnw = p.in[13] + l * 128;
#pragma unroll 1
  for (int pi = blockIdx.x; pi < 256; pi += gridDim.x) {
    const int b = pi >> 4, h = (pi >> 2) & 3, j = pi & 3;
#pragma unroll 1
    for (int it = 0; it < 2; ++it) {
      const int tid = tid_opaque(), lane = tid & 63, w = __builtin_amdgcn_readfirstlane(tid >> 6), l31 = lane & 31, hh = lane >> 5;
      const int qb = it ? j : 7 - j, t0 = b * 2048 + 256 * qb, ntl = 4 * qb + 4, ntw = 4 * qb + (w >> 1) + 1;
#pragma unroll
      for (int i = 0; i < 8; ++i) { const int P = (w * 8 + i) * 64 + lane, row = P >> 4, pos = P & 15, pc = pos ^ (row & 15);
        __builtin_amdgcn_global_load_lds((const unsigned*)(Q + (size_t)(t0 + row) * 512 + h * 128 + pc * 8), (LAS unsigned*)(lds + QOFF + (w * 8 + i) * 1024), 16, 0, 0); }
      const bf16_t* kbase = KB + (size_t)(b * 2048) * 512 + h * 128; const bf16_t* vbase = VT + (size_t)(h * 128) * T_TOK + b * 2048;
      int koff[2], voff[2];
#pragma unroll
      for (int i = 0; i < 2; ++i) { const int P = (w * 2 + i) * 64 + lane; { const int row = P >> 4, pos = P & 15, pc = pos ^ (row & 15); koff[i] = row * 512 + pc * 8; }
        { const int row = P >> 3, pos = P & 7, pc = pos ^ ((row >> 1) & 7); voff[i] = row * T_TOK + pc * 8; } }
#define ATT_STAGE(kt, buf) do { _Pragma("unroll") for (int i = 0; i < 2; ++i) { \
        __builtin_amdgcn_global_load_lds((const unsigned*)(kbase + (size_t)(kt) * (64 * 512) + koff[i]), (LAS unsigned*)(lds + (buf) * STG + (w * 2 + i) * 1024), 16, 0, 0); \
        __builtin_amdgcn_global_load_lds((const unsigned*)(vbase + (kt) * 64 + voff[i]), (LAS unsigned*)(lds + (buf) * STG + KBUF + (w * 2 + i) * 1024), 16, 0, 0); } } while (0)
#define ATT_STAGE_AT(kt, soff) do { _Pragma("unroll") for (int i = 0; i < 2; ++i) { \
        __builtin_amdgcn_global_load_lds((const unsigned*)(kbase + (size_t)(kt) * (64 * 512) + koff[i]), (LAS unsigned*)(lds + (soff) + (w * 2 + i) * 1024), 16, 0, 0); \
        __builtin_amdgcn_global_load_lds((const unsigned*)(vbase + (kt) * 64 + voff[i]), (LAS unsigned*)(lds + (soff) + KBUF + (w * 2 + i) * 1024), 16, 0, 0); } } while (0)
      ATT_STAGE(0, 0);
      if (ntl > 1) { ATT_STAGE(1, 1); asm volatile("s_waitcnt vmcnt(4)" ::: "memory"); } else asm volatile("s_waitcnt vmcnt(0)" ::: "memory");
      __syncthreads();
      int st_cur = 0, st_pre = 2 * STG;
      f32x16 O[2][4];
#pragma unroll
      for (int c = 0; c < 2; ++c)
#pragma unroll
        for (int bk = 0; bk < 4; ++bk)
#pragma unroll
          for (int i = 0; i < 16; ++i) O[c][bk][i] = 0.f;
      float lsum[2] = {0.f, 0.f};
      const int qr = 32 * w + l31;
      int k_lane = l31 * 256 + ((hh ^ (l31 & 15)) << 4), q_lane = QOFF + qr * 256 + ((hh ^ (qr & 15)) << 4), v_lane = KBUF + l31 * 128 + ((hh ^ ((l31 >> 1) & 7)) << 4);
#pragma unroll 1
      for (int kt = 0; kt < ntl; ++kt) {
        if (kt + 2 < ntl) ATT_STAGE_AT(kt + 2, st_pre);
        if (kt < ntw) {
          asm volatile("" : "+v"(k_lane), "+v"(q_lane), "+v"(v_lane));
          const LAS unsigned char* tb = lds + st_cur;
#pragma unroll
          for (int kb = 0; kb < 2; ++kb) {
            bf16x8 pf[2][2];
#pragma unroll
            for (int c = 0; c < 2; ++c) {
              f32x16 S;
#pragma unroll
              for (int i = 0; i < 16; ++i) S[i] = 0.f;
#pragma unroll
              for (int ks = 0; ks < 4; ++ks) {
                const int xo = (c * 8 + ks * 2) << 4;
                const bf16x8 qf = *(const LAS bf16x8*)(lds + (q_lane ^ xo));
                const bf16x8 kf = *(const LAS bf16x8*)(tb + (k_lane ^ xo) + kb * 8192);
                S = __builtin_amdgcn_mfma_f32_32x32x16_bf16(kf, qf, S, 0, 0, 0);
              }
              float ls = 0.f;
#pragma unroll
              for (int hs = 0; hs < 2; ++hs) { u32x4_t pw;
#pragma unroll
                for (int t = 0; t < 4; ++t) { const float a = __builtin_amdgcn_exp2f(S[8 * hs + 2 * t]), bq = __builtin_amdgcn_exp2f(S[8 * hs + 2 * t + 1]); ls += a + bq; pw[t] = pk2(a, bq); }
                pf[c][hs] = __builtin_bit_cast(bf16x8, pw); }
              lsum[c] += ls;
              __builtin_amdgcn_sched_barrier(0);
            }
#pragma unroll
            for (int bk = 0; bk < 4; ++bk) {
              const bf16x8 v0 = *(const LAS bf16x8*)(tb + (v_lane ^ ((2 * kb) << 5)) + bk * 4096);
              const bf16x8 v1 = *(const LAS bf16x8*)(tb + (v_lane ^ ((2 * kb + 1) << 5)) + bk * 4096);
              O[0][bk] = __builtin_amdgcn_mfma_f32_32x32x16_bf16(v0, pf[0][0], O[0][bk], 0, 0, 0);
              O[1][bk] = __builtin_amdgcn_mfma_f32_32x32x16_bf16(v0, pf[1][0], O[1][bk], 0, 0, 0);
              O[0][bk] = __builtin_amdgcn_mfma_f32_32x32x16_bf16(v1, pf[0][1], O[0][bk], 0, 0, 0);
              O[1][bk] = __builtin_amdgcn_mfma_f32_32x32x16_bf16(v1, pf[1][1], O[1][bk], 0, 0, 0);
              __builtin_amdgcn_sched_barrier(0);
            }
          }
        }
        if (kt + 2 < ntl) asm volatile("s_waitcnt vmcnt(4)" ::: "memory"); else asm volatile("s_waitcnt vmcnt(0)" ::: "memory");
        __syncthreads();
        st_pre = st_cur; st_cur = (st_cur == 2 * STG) ? 0 : st_cur + STG;
      }
#undef ATT_STAGE
#undef ATT_STAGE_AT
      const int tid2 = tid_opaque(), lane2 = tid2 & 63, w2 = __builtin_amdgcn_readfirstlane(tid2 >> 6), hh2 = lane2 >> 5, qr2 = 32 * w2 + (lane2 & 31);
      float lam;
      { const float* q1 = p.in[9] + l * 64; const float* k1 = p.in[10] + l * 64; const float* q2 = p.in[11] + l * 64; const float* k2 = p.in[12] + l * 64;
        float a = q1[lane2] * k1[lane2], bq = q2[lane2] * k2[lane2]; a = wave_sum(a); bq = wave_sum(bq); lam = expf(a) - expf(bq) + lambda_init; }
      float l1 = lsum[0], l2 = lsum[1]; l1 += __shfl_xor(l1, 32); l2 += __shfl_xor(l2, 32);
      const float inv1 = 1.0f / l1, inv2 = lam / l2; float ss = 0.f;
#pragma unroll
      for (int bk = 0; bk < 4; ++bk)
#pragma unroll
        for (int i = 0; i < 16; ++i) { const float o = O[0][bk][i] * inv1 - O[1][bk][i] * inv2; O[0][bk][i] = o; ss += o * o; }
      ss += __shfl_xor(ss, 32);
      const float rs = rsqrtf(ss * (1.0f / 128.0f) + EPS) * (1.0f - lambda_init);
      bf16_t* orow = MIX + (size_t)(t0 + qr2) * 1024 + 512 + h * 128;
#pragma unroll
      for (int bk = 0; bk < 4; ++bk)
#pragma unroll
        for (int g = 0; g < 4; ++g) { const int dv0 = 32 * bk + 8 * g + 4 * hh2; const f32x4 wv = *(const f32x4*)(dnw + dv0);
          u32x2_t q; q.x = pk2(O[0][bk][4 * g] * rs * wv[0], O[0][bk][4 * g + 1] * rs * wv[1]); q.y = pk2(O[0][bk][4 * g + 2] * rs * wv[2], O[0][bk][4 * g + 3] * rs * wv[3]);
          *(u32x2_t*)(orow + dv0) = q; }
    }
  }
  __syncthreads();
  if (threadIdx.x == 0) { volatile LAS unsigned* stw = (volatile LAS unsigned*)(lds + 131072); stw[0] = sv0; stw[1] = sv1; stw[2] = sv2; }
  __syncthreads();
}


#define XB_TMO      128
#define XB_XCNT(j)  (256  + 64 * (j))
#define XB_XSUB(j)  (1280 + 64 * (j))
#define XB_XGEN(j)  (2304 + 64 * (j))
#define XB_TOP      3328
#define XB_TOPGEN   3392
#define XCD_BAR_WORDS 3456
#define XB_SPIN_CAP (1u << 18)

__device__ __forceinline__ unsigned xb_ld(unsigned* p)              { return __hip_atomic_load(p, __ATOMIC_RELAXED, __HIP_MEMORY_SCOPE_AGENT); }
__device__ __forceinline__ unsigned xb_add(unsigned* p, unsigned v) { return __hip_atomic_fetch_add(p, v, __ATOMIC_RELAXED, __HIP_MEMORY_SCOPE_AGENT); }
__device__ __forceinline__ unsigned xb_xcc_id() { return (unsigned)__builtin_amdgcn_s_getreg((3 << 11) | 20) & 0xFu; }
#define XB_SPIN(cond, bar) do { unsigned _sp = 0; while (cond) { __builtin_amdgcn_s_sleep(1); \
    if ((++_sp & 255u) == 0u) { if (xb_ld(&(bar)[XB_TMO])) break; if (_sp > XB_SPIN_CAP) { atomicAdd(&(bar)[XB_TMO], 1u); break; } } } } while (0)

struct XcdBarrier {
    unsigned* bar; unsigned x;
    volatile LAS unsigned* st;
};

__device__ __forceinline__ XcdBarrier xcd_barrier_post(unsigned* bar, volatile LAS unsigned* st) {
    XcdBarrier b; b.bar = bar; b.x = xb_xcc_id(); b.st = st;
    if (threadIdx.x == 0) (void)xb_add(&bar[XB_XCNT(b.x)], 1u);
    return b;
}
__device__ __forceinline__ void xcd_barrier_complete(unsigned* bar, unsigned x, unsigned& nloc, unsigned& nx) {
    const unsigned G = gridDim.x * gridDim.y * gridDim.z;
    unsigned sum, cnt, mine, sp = 0u;
    for (;;) {
        sum = 0u; cnt = 0u; mine = 0u;
#pragma unroll
        for (unsigned j = 0; j < 16; ++j) { const unsigned c = xb_ld(&bar[XB_XCNT(j)]); sum += c; cnt += (c > 0u) ? 1u : 0u; mine = (j == x) ? c : mine; }
        if (sum == G) break;
        __builtin_amdgcn_s_sleep(1);
        if ((++sp & 255u) == 0u) { if (xb_ld(&bar[XB_TMO])) break; if (sp > XB_SPIN_CAP) { atomicAdd(&bar[XB_TMO], 1u); break; } }
    }
    nloc = mine > 0u ? mine : 1u; nx = cnt > 0u ? cnt : 1u;
}

__device__ __forceinline__ void xcd_barrier(const XcdBarrier& b) {
    asm volatile("s_waitcnt vmcnt(0)" ::: "memory");
    __syncthreads();
    if (threadIdx.x == 0) {
        unsigned* bar = b.bar;
        __builtin_amdgcn_s_waitcnt(0);
        unsigned nloc = b.st[0], nx = b.st[1];
        if (nloc == 0u) { xcd_barrier_complete(bar, b.x, nloc, nx); b.st[0] = nloc; b.st[1] = nx; }
        const unsigned old = xb_add(&bar[XB_XSUB(b.x)], 1u);
        const unsigned gen = old / nloc;
        if (old + 1u == (gen + 1u) * nloc) {
            __builtin_amdgcn_fence(__ATOMIC_RELEASE, "agent");
            asm volatile("s_waitcnt vmcnt(0)" ::: "memory");
            const unsigned og = xb_add(&bar[XB_TOP], 1u);
            const unsigned tg = og / nx;
            if (og + 1u == (tg + 1u) * nx) xb_add(&bar[XB_TOPGEN], 1u);
            else XB_SPIN(xb_ld(&bar[XB_TOPGEN]) == tg, bar);
            __builtin_amdgcn_fence(__ATOMIC_ACQUIRE, "agent");
            xb_add(&bar[XB_XGEN(b.x)], 1u);
            asm volatile("s_waitcnt vmcnt(0)" ::: "memory");
        } else {
            XB_SPIN(xb_ld(&bar[XB_XGEN(b.x)]) == gen, bar);
            __builtin_amdgcn_fence(__ATOMIC_ACQUIRE, "agent");
            asm volatile("s_waitcnt vmcnt(0)" ::: "memory");
        }
    }
    __syncthreads();
}

DI void zero_u64(u64* p, int n) { for (int i = blockIdx.x * 512 + tid_opaque(); i < n; i += gridDim.x * 512) p[i] = 0ull; }

#if PROBE_EPI_ACE
typedef DupOrder OrderACE;
#else
typedef pg8::StaticOrder OrderACE;
#endif
DI void phaseA(const MParams& p, int l, LAS unsigned char* lds) {
  unsigned char* ws = p.ws; const bf16_t* XB = (const bf16_t*)(ws + OFF_XB); const bf16_t* WinT = (const bf16_t*)(ws + OFF_W + (size_t)l * W_STRIDE + WO_IN); const u64* SS1 = (const u64*)(ws + OFF_SS1);
  zero_u64((u64*)(ws + OFF_SS2), T_TOK);
  { pg8::Gemm g{XB, WinT, T_TOK, 1536, DM}; OrderACE S; S.init(T_TOK, 1536, gridDim.x, blockIdx.x);
    EpiA1 E{SS1, (bf16_t*)(ws + OFF_U), (bf16_t*)(ws + OFF_Q), (bf16_t*)(ws + OFF_KB), p.in[7] + l * 64, p.in[8] + l * 64}; pg8::gemm_phase<EpiA1, OrderACE>(lds, g, S, E); }
  { pg8::Gemm g{WinT + (size_t)1536 * DM, XB, 1024, T_TOK, DM}; OrderACE S; S.init(1024, T_TOK, gridDim.x, blockIdx.x);
    EpiA2 E{SS1, (bf16_t*)(ws + OFF_GVT), (bf16_t*)(ws + OFF_VT), (u64*)(ws + OFF_SSV)}; pg8::gemm_phase<EpiA2, OrderACE>(lds, g, S, E); }
}
DI void phaseCE(const MParams& p, int l, bool isC, LAS unsigned char* lds) {
  unsigned char* ws = p.ws; const unsigned char* wb = ws + OFF_W + (size_t)l * W_STRIDE;
  if (isC) zero_u64((u64*)(ws + OFF_SS1), T_TOK);
  pg8::Gemm g{(const bf16_t*)(ws + (isC ? OFF_MIX : OFF_F)), (const bf16_t*)(wb + (isC ? WO_OUT : WO_DN)), T_TOK, DM, isC ? DM : DFF}; OrderACE S; S.init(T_TOK, DM, gridDim.x, blockIdx.x);
  EpiResid E{(isC && l == 0) ? p.in[0] : nullptr, (!isC && l == NLAYER - 1) ? p.out : nullptr, (bf16_t*)(ws + OFF_XB), (u64*)(ws + (isC ? OFF_SS2 : OFF_SS1))}; pg8::gemm_phase<EpiResid, OrderACE>(lds, g, S, E);
}
DI void phaseD(const MParams& p, int l, LAS unsigned char* lds) {
  unsigned char* ws = p.ws;
  zero_u64((u64*)(ws + OFF_SSV), T_TOK * 4);
  pg8::Gemm g{(const bf16_t*)(ws + OFF_XB), (const bf16_t*)(ws + OFF_W + (size_t)l * W_STRIDE + WO_GU), T_TOK, 2 * DFF, DM};
#if PROBE_EPI_D
  DupOrder S;
#else
  pg8::StaticOrder S;
#endif
  S.init(T_TOK, 2 * DFF, gridDim.x, blockIdx.x);
  EpiD E{(const u64*)(ws + OFF_SS2), p.in[18] + (size_t)l * 3 * DFF, p.in[19] + (size_t)l * DFF, (bf16_t*)(ws + OFF_F), (float*)(ws + OFF_GB), (float*)(ws + OFF_PB), (float*)(ws + OFF_UB)};
#if PROBE_EPI_D
  pg8::gemm_phase<EpiD, DupOrder>(lds, g, S, E);
#else
  pg8::gemm_phase<EpiD, pg8::StaticOrder>(lds, g, S, E);
#endif
}

__global__ void __launch_bounds__(512) k_run(MParams p) {
  extern __shared__ __attribute__((aligned(16))) unsigned char lds_raw[];
  LAS unsigned char* lds = (LAS unsigned char*)lds_raw;
  cg::grid_group grid = cg::this_grid();
  if (threadIdx.x < 4) ((LAS unsigned*)(lds + 131072))[threadIdx.x] = 0u;
  __syncthreads();
  XcdBarrier xbar = xcd_barrier_post((unsigned*)(p.ws + OFF_BAR), (volatile LAS unsigned*)(lds + 131072));
  if (p.ph_lo < 0) grid.sync();
  for (int ph = p.ph_lo; ph < p.ph_hi; ++ph) {
    for (int rep = 0; rep < 1 + ((PROBE_MASK >> (ph == 0 ? 6 : (ph - 1) % 6)) & 1); ++rep) {
    if (ph == 0) { if (EN_MASK & 1) prologue(p, lds); }
    else {
      const int l = (ph - 1) / 6, s = (ph - 1) % 6;
      if (s == 0) { if (EN_MASK & 2) phaseA(p, l, lds); }
      else if (s == 1) { if (EN_MASK & 4) attn_phase(p, l, lds); if (EN_MASK & 8) { const LP lp = make_lp(p, l); spatial_phase(lp, p.ws, lds); } }
      else if (s == 2 || s == 5) { if (EN_MASK & 16) phaseCE(p, l, s == 2, lds); }
      else if (s == 3) { if (EN_MASK & 32) phaseD(p, l, lds); }
      else { if (EN_MASK & 64) { const LP lp = make_lp(p, l); fixup_phase(lp, p.ws); } }
    }
    }
    if (ph + 1 < p.ph_hi) xcd_barrier(xbar);
  }
}

extern "C" void kernel_launch(void* const* d_in, const int* in_sizes, int n_in, void* d_out, int out_size, void* d_ws, size_t ws_size, hipStream_t stream) {
  static int grid_blocks = 0;
  if (!grid_blocks) {
    (void)hipFuncSetAttribute((const void*)k_run, hipFuncAttributeMaxDynamicSharedMemorySize, LDS_BYTES);
    int dev = 0, cus = 0, per_cu = 0; (void)hipGetDevice(&dev); (void)hipDeviceGetAttribute(&cus, hipDeviceAttributeMultiprocessorCount, dev);
    (void)hipOccupancyMaxActiveBlocksPerMultiprocessor(&per_cu, (const void*)k_run, 512, LDS_BYTES); if (per_cu < 1) per_cu = 1;
    grid_blocks = cus * per_cu; if (grid_blocks > 256) grid_blocks = 256;
  }
  MParams mp; memset(&mp, 0, sizeof(mp));
  for (int i = 0; i < 21; ++i) mp.in[i] = (const float*)d_in[i];
  mp.out = (float*)d_out; mp.ws = (unsigned char*)d_ws; mp.ph_lo = 0; mp.ph_hi = 1 + 6 * NLAYER;
  (void)hipMemsetAsync((unsigned char*)d_ws + OFF_BAR, 0, 3456 * sizeof(unsigned), stream);
  void* args[] = {&mp};
  hipError_t e = hipLaunchCooperativeKernel((const void*)k_run, dim3(grid_blocks), dim3(512), args, LDS_BYTES, stream);
  if (e != hipSuccess) fprintf(stderr, "cooperative launch failed: %s (grid %d)\n", hipGetErrorString(e), grid_blocks);
}
```

```cpp
#include <hip/hip_runtime.h>
#include <hip/hip_cooperative_groups.h>
#include <cstdio>
#include <cmath>
#include <cstring>

typedef unsigned short bf16_t;
#define DI __device__ __forceinline__

constexpr int T_TOK = 32768, DM = 1024, SEQ = 2048, DFF = 2816, INW = 2560, NLAYER = 4;
constexpr float EPS = 1e-6f;
constexpr float QSCALE = 0.125f * 1.4426950408889634f;

constexpr size_t MiB = 1024ull * 1024ull;
constexpr size_t OFF_XB = 0;
constexpr size_t OFF_R = 64 * MiB;
constexpr size_t OFF_U = OFF_R, OFF_Q = OFF_R + 32 * MiB, OFF_KB = OFF_R + 64 * MiB, OFF_GVT = OFF_R + 96 * MiB, OFF_VT = OFF_R + 128 * MiB, OFF_MIX = OFF_R + 160 * MiB;
constexpr size_t OFF_F = OFF_R, OFF_GB = OFF_R + 176 * MiB, OFF_PB = OFF_R + 188 * MiB, OFF_UB = OFF_R + 200 * MiB;
constexpr size_t OFF_W = 288 * MiB, W_STRIDE = 24 * MiB;
constexpr size_t WO_IN = 0, WO_OUT = 5 * MiB, WO_GU = 7 * MiB, WO_DN = 18 * MiB, WO_SP = 23 * MiB + 512 * 1024;
constexpr size_t OFF_SS1 = 384 * MiB, OFF_SS2 = OFF_SS1 + 256 * 1024, OFF_SSV = OFF_SS2 + 256 * 1024;
constexpr size_t OFF_BAR = 385 * MiB + 512 * 1024;
constexpr size_t OFF_TMP1 = 386 * MiB, OFF_TMP2 = 418 * MiB;

DI int tid_opaque() { int t = threadIdx.x; asm volatile("" : "+v"(t)); return t; }
DI float bf2f(bf16_t b) { return __uint_as_float(((unsigned)b) << 16); }
DI bf16_t f2bf(float f) { unsigned u = __float_as_uint(f); u += 0x7FFFu + ((u >> 16) & 1u); return (bf16_t)(u >> 16); }
DI float gelu_exact(float x) { return 0.5f * x * (1.0f + erff(x * 0.70710678118654752f)); }
DI int permpos16(int k) { return (k & 3) + 4 * (k >> 3) + 8 * ((k >> 2) & 1); }
DI float wave_sum(float v) { for (int o = 32; o >= 1; o >>= 1) v += __shfl_xor(v, o); return v; }

namespace pg8 {
#define PG8_LAS __attribute__((address_space(3)))
typedef unsigned short bf16_t;
typedef short bf16x8 __attribute__((ext_vector_type(8)));
typedef float f32x4 __attribute__((ext_vector_type(4)));
typedef unsigned u32x4 __attribute__((ext_vector_type(4)));
constexpr int BM = 256, BK = 64, HALF = 128, HTB = HALF * BK * 2  , STAGE_BYTES = 8 * HTB, NXCD = 8, WGM = 8;

__host__ __device__ __forceinline__ int lds_byte(int r, int c) { const int st = (r >> 4) * 2 + (c >> 5), rr = r & 15, cc = c & 31, ob = rr * 64 + cc * 2; return st * 1024 + (ob ^ (((ob >> 9) & 1) << 5)); }
__host__ __device__ __forceinline__ void stage_rc(int b, int& R, int& C) { const int st = b / 1024, sb = b % 1024, swz = sb ^ (((sb >> 9) & 1) << 5); R = (st >> 1) * 16 + swz / 64; C = (st & 1) * 32 + (swz % 64) / 2; }
__host__ __device__ __forceinline__ int perm32(int rho) { const int n = rho >> 4, i = rho & 15; return 8 * (i >> 2) + 4 * n + (i & 3); }

struct Unit { int pm, pn; };
struct Gemm { const bf16_t* A; const bf16_t* Bt; int M, N, K; };

struct StaticOrder {
    int nM, nN, nwg, G, c;
    __host__ __device__ void init(int M, int N, int G_, int c_) { nM = M / BM; nN = N / BM; nwg = nM * nN; G = G_; c = c_; }
    __host__ __device__ bool next(int i, Unit& u) const {
        const long L = (long)i * G + c; if (L >= nwg) return false;
        int wgid = (int)L; { const int q = nwg / NXCD, r = nwg % NXCD, xcd = wgid % NXCD, off = wgid / NXCD; wgid = (xcd < r ? xcd * (q + 1) : r * (q + 1) + (xcd - r) * q) + off; }
        const int nig = WGM * nN, gid = wgid / nig, fm = gid * WGM, gsz = (nM - fm) < WGM ? (nM - fm) : WGM;
        u.pm = fm + ((wgid % nig) % gsz); u.pn = (wgid % nig) / gsz; return true;
    }
    __device__ __forceinline__ void a_ready(const Unit&) const {}
    __device__ __forceinline__ void done(const Unit&) const {}
};
template <class Epi, class Sched>
__device__ __forceinline__ void gemm_phase(PG8_LAS unsigned char* lds, const Gemm g, const Sched& S, const Epi& E) {
    const int tid = tid_opaque(), wid = __builtin_amdgcn_readfirstlane(tid >> 6), lane = tid & 63, wr = wid >> 2, wc = wid & 3, fr = lane & 15, fq = lane >> 4;
    const int K = g.K, nt = K / BK;
    unsigned voffA[2], voffB[2];
#pragma unroll
    for (int i = 0; i < 2; ++i) { int R, C; stage_rc(tid * 16 + i * 8192, R, C); const int Rb = Epi::PERM ? ((R & ~31) + perm32(R & 31)) : R;
        voffA[i] = (unsigned)(R * K + C) * 2u; voffB[i] = (unsigned)(Rb * K + C) * 2u; }
    const size_t kstep = (size_t)(BK * 2);
    const size_t hstep = (size_t)HALF * K * 2;
    const size_t tstep = 2 * hstep;
    const unsigned ldsw = (unsigned)wid * 1024u;
    const int aoff = lds_byte(wr * 64 + fr, fq * 8), boff = lds_byte(wc * 32 + fr, fq * 8);
#define PG8_SA(b, h) (((b) * 2 + (h)) * HTB)
#define PG8_SB(b, h) ((4 + (b) * 2 + (h)) * HTB)
#define PG8_STAGE(bufoff, gbase, voff) do { _Pragma("unroll") for (int _i = 0; _i < 2; ++_i) \
        __builtin_amdgcn_global_load_lds((const unsigned*)((const char*)(gbase) + (voff)[_i]), (PG8_LAS unsigned*)(lds + (bufoff) + ldsw + _i * 8192), 16, 0, 0); } while (0)
#define PG8_LDA(dst, b, h) do { _Pragma("unroll") for (int m = 0; m < 4; ++m) _Pragma("unroll") for (int k = 0; k < 2; ++k) dst[m][k] = *(const PG8_LAS bf16x8*)(lds + PG8_SA(b, h) + aoff + m * 2048 + k * 1024); } while (0)
#define PG8_LDB(dst, b, h) do { _Pragma("unroll") for (int n = 0; n < 2; ++n) _Pragma("unroll") for (int k = 0; k < 2; ++k) dst[n][k] = *(const PG8_LAS bf16x8*)(lds + PG8_SB(b, h) + boff + n * 2048 + k * 1024); } while (0)
#define PG8_MMA(ai, bj, At, Bt) do { __builtin_amdgcn_s_setprio(1); _Pragma("unroll") for (int m = 0; m < 4; ++m) _Pragma("unroll") for (int n = 0; n < 2; ++n) _Pragma("unroll") for (int k = 0; k < 2; ++k) \
        acc[ai][bj][m][n] = __builtin_amdgcn_mfma_f32_16x16x32_bf16(Bt[n][k], At[m][k], acc[ai][bj][m][n], 0, 0, 0); __builtin_amdgcn_s_setprio(0); } while (0)
#define PG8_WAIT_V(n) asm volatile("s_waitcnt vmcnt(" #n ")" ::: "memory")
#define PG8_WAIT_L(n) asm volatile("s_waitcnt lgkmcnt(" #n ")" ::: "memory")
#define PG8_BAR __builtin_amdgcn_s_barrier()
#define PG8_SCHED __builtin_amdgcn_sched_barrier(0)
    Unit cur, nxt; int ui = 0;
    if (!S.next(0, cur)) return;
    f32x4 acc[2][2][4][2];
#pragma unroll
    for (int a = 0; a < 2; ++a)
#pragma unroll
        for (int b = 0; b < 2; ++b)
#pragma unroll
            for (int m = 0; m < 4; ++m)
#pragma unroll
                for (int n = 0; n < 2; ++n) acc[a][b][m][n] = (f32x4){0.f, 0.f, 0.f, 0.f};
    bf16x8 At[4][2], B0[2][2], B1[2][2];
    const char* cA = (const char*)g.A + (size_t)cur.pm * tstep; const char* cB = (const char*)g.Bt + (size_t)cur.pn * tstep;
    S.a_ready(cur);
    PG8_STAGE(PG8_SB(0, 0), cB, voffB); PG8_STAGE(PG8_SA(0, 0), cA, voffA); PG8_STAGE(PG8_SB(0, 1), cB + hstep, voffB); PG8_STAGE(PG8_SA(0, 1), cA + hstep, voffA);
    if (wr == 1) PG8_BAR;
    PG8_WAIT_V(4); PG8_BAR;
    PG8_STAGE(PG8_SB(1, 0), cB + kstep, voffB); PG8_STAGE(PG8_SA(1, 0), cA + kstep, voffA); PG8_STAGE(PG8_SB(1, 1), cB + hstep + kstep, voffB);
    PG8_WAIT_V(6); PG8_BAR;
    for (;;) {
        const bool has_next = S.next(ui + 1, nxt);
        const char* nA = has_next ? (const char*)g.A + (size_t)nxt.pm * tstep : cA; const char* nB = has_next ? (const char*)g.Bt + (size_t)nxt.pn * tstep : cB;
        for (int t = 0; t < nt; t += 2) {
            const bool last = (t == nt - 2);
            const char* a1 = cA + (size_t)(t + 1) * kstep;
            const char* a2 = last ? nA : cA + (size_t)(t + 2) * kstep; const char* b2 = last ? nB : cB + (size_t)(t + 2) * kstep;
            const char* a3 = a2 + kstep; const char* b3 = b2 + kstep;
            if (last && has_next) S.a_ready(nxt);
            PG8_LDB(B0, 0, 0); PG8_SCHED; PG8_LDA(At, 0, 0); PG8_STAGE(PG8_SA(1, 1), a1 + hstep, voffA);
            PG8_WAIT_L(8); PG8_BAR; PG8_WAIT_L(0); PG8_MMA(0, 0, At, B0); PG8_BAR; PG8_SCHED;
            PG8_LDB(B1, 0, 1); PG8_STAGE(PG8_SB(0, 0), b2, voffB);
            PG8_BAR; PG8_WAIT_L(0); PG8_MMA(0, 1, At, B1); PG8_BAR;
            PG8_LDA(At, 0, 1); PG8_STAGE(PG8_SA(0, 0), a2, voffA);
            PG8_BAR; PG8_WAIT_L(0); PG8_MMA(1, 0, At, B0); PG8_BAR; PG8_SCHED;
            PG8_STAGE(PG8_SB(0, 1), b2 + hstep, voffB);
            PG8_WAIT_V(6); PG8_BAR; PG8_MMA(1, 1, At, B1); PG8_BAR;
            PG8_LDB(B0, 1, 0); PG8_SCHED; PG8_LDA(At, 1, 0); PG8_STAGE(PG8_SA(0, 1), a2 + hstep, voffA);
            PG8_WAIT_L(8); PG8_BAR; PG8_WAIT_L(0); PG8_MMA(0, 0, At, B0); PG8_BAR; PG8_SCHED;
            PG8_LDB(B1, 1, 1); PG8_STAGE(PG8_SB(1, 0), b3, voffB);
            PG8_BAR; PG8_WAIT_L(0); PG8_MMA(0, 1, At, B1); PG8_BAR;
            PG8_LDA(At, 1, 1); PG8_STAGE(PG8_SA(1, 0), a3, voffA);
            PG8_BAR; PG8_WAIT_L(0); PG8_MMA(1, 0, At, B0); PG8_BAR; PG8_SCHED;
            PG8_STAGE(PG8_SB(1, 1), b3 + hstep, voffB);
            PG8_WAIT_V(6); PG8_BAR; PG8_MMA(1, 1, At, B1); PG8_BAR;
        }
        if constexpr (!Epi::AFTER_DRAIN) { if (!Epi::TWICE || (ui & 1)) E(acc, cur, wr, wc, fr, fq); S.done(cur); }
        if (!has_next) break;
#pragma unroll
        for (int a = 0; a < 2; ++a)
#pragma unroll
            for (int b = 0; b < 2; ++b)
#pragma unroll
                for (int m = 0; m < 4; ++m)
#pragma unroll
                    for (int n = 0; n < 2; ++n) acc[a][b][m][n] = (f32x4){0.f, 0.f, 0.f, 0.f};
        cur = nxt; cA = nA; cB = nB; ++ui;
    }
    PG8_WAIT_V(0);
    if (wr == 0) PG8_BAR;
    PG8_BAR;
    if constexpr (Epi::AFTER_DRAIN) { E.fused(acc, cur, wr, wc, fr, fq, lds, wid, lane); S.done(cur); }
#undef PG8_SA
#undef PG8_SB
#undef PG8_STAGE
#undef PG8_LDA
#undef PG8_LDB
#undef PG8_MMA
#undef PG8_WAIT_V
#undef PG8_WAIT_L
#undef PG8_BAR
#undef PG8_SCHED
}
}

namespace cg = cooperative_groups;
using pg8::f32x4; using pg8::bf16x8; using pg8::Unit;
typedef unsigned u32x2_t __attribute__((ext_vector_type(2)));
typedef unsigned u32x4_t __attribute__((ext_vector_type(4)));
typedef float f32x16 __attribute__((ext_vector_type(16)));
typedef float f32x2_t __attribute__((ext_vector_type(2)));
#define LAS PG8_LAS
constexpr int LDS_BYTES = 163840;
#ifndef EN_MASK
#define EN_MASK 0x7f
#endif
#ifndef PROBE_EPI_ACE
#define PROBE_EPI_ACE 0
#endif
#ifndef PROBE_EPI_D
#define PROBE_EPI_D 0
#endif
#ifndef PROBE_SYNC
#define PROBE_SYNC 0
#endif
#ifndef PROBE_MASK
#define PROBE_MASK 0x00
#endif

DI unsigned pk2(float lo, float hi) { unsigned r; asm volatile("s_nop 0\n\tv_cvt_pk_bf16_f32 %0, %1, %2\n\ts_nop 1" : "=v"(r) : "v"(lo), "v"(hi)); return r; }
DI float bflo(unsigned w) { return __uint_as_float(w << 16); }
DI float bfhi(unsigned w) { return __uint_as_float(w & 0xffff0000u); }
DI float gelu1(float v) {
  const float av = fabsf(v), t = __builtin_amdgcn_rcpf(av * 0.2316418882f + 1.0f);
  float q = t * 0.5307027145f + (-0.7265760135f); q = q * t + 0.7107068705f; q = q * t + (-0.142248368f); q = q * t + 0.127414796f; q = q * t;
  const float e = __builtin_amdgcn_exp2f((v * v) * (-0.72134752044f));
  const float m = v * (q * e);
  return v < 0.f ? m : v - m;
}
DI float dpp_ror1(float v) { return __builtin_bit_cast(float, __builtin_amdgcn_update_dpp(0, __builtin_bit_cast(int, v), 0x121, 0xf, 0xf, false)); }
DI float dpp_ror2(float v) { return __builtin_bit_cast(float, __builtin_amdgcn_update_dpp(0, __builtin_bit_cast(int, v), 0x122, 0xf, 0xf, false)); }
DI float row_sum16(float v) {
  v += __builtin_bit_cast(float, __builtin_amdgcn_update_dpp(0, __builtin_bit_cast(int, v), 0x128, 0xf, 0xf, false));
  v += __builtin_bit_cast(float, __builtin_amdgcn_update_dpp(0, __builtin_bit_cast(int, v), 0x124, 0xf, 0xf, false));
  v += __builtin_bit_cast(float, __builtin_amdgcn_update_dpp(0, __builtin_bit_cast(int, v), 0x122, 0xf, 0xf, false));
  v += __builtin_bit_cast(float, __builtin_amdgcn_update_dpp(0, __builtin_bit_cast(int, v), 0x121, 0xf, 0xf, false));
  return v; }
typedef unsigned long long u64;
DI float fx2f(u64 v) { return (float)v * (1.0f / 1048576.0f); }
DI u64 f2fx(float v) { return (u64)(v * 1048576.0f + 0.5f); }
DI void fx_add(u64* p, float v) { __hip_atomic_fetch_add(p, f2fx(v), __ATOMIC_RELAXED, __HIP_MEMORY_SCOPE_AGENT); }
DI float rs1024(u64 ss) { return rsqrtf(fx2f(ss) * (1.0f / 1024.0f) + EPS); }

struct MParams { const float* in[21]; float* out; unsigned char* ws; int ph_lo, ph_hi; };
struct LP {
  const float *norm_attn_w, *w_in, *v_norm_w, *sp_w, *sp_b, *out_norm_w, *q_norm_w, *k_norm_w, *lq1, *lk1, *lq2, *lk2, *diff_norm_w, *w_out, *norm_ffn_w, *w_gate, *w_up, *conv_w, *conv_b, *w_down;
  float lambda_init;
  const bf16_t *WinT, *WoutT, *WguT, *WdT, *Wsp;
};
DI LP make_lp(const MParams& p, int l) {
  LP L;
  L.norm_attn_w = p.in[1] + (size_t)l * DM; L.w_in = p.in[2] + (size_t)l * DM * INW; L.v_norm_w = p.in[3] + (size_t)l * 512; L.sp_w = p.in[4] + (size_t)l * 65536; L.sp_b = p.in[5] + (size_t)l * 512;
  L.out_norm_w = p.in[6] + (size_t)l * 512; L.q_norm_w = p.in[7] + (size_t)l * 64; L.k_norm_w = p.in[8] + (size_t)l * 64; L.lq1 = p.in[9] + (size_t)l * 64; L.lk1 = p.in[10] + (size_t)l * 64;
  L.lq2 = p.in[11] + (size_t)l * 64; L.lk2 = p.in[12] + (size_t)l * 64; L.diff_norm_w = p.in[13] + (size_t)l * 128; L.w_out = p.in[14] + (size_t)l * DM * DM; L.norm_ffn_w = p.in[15] + (size_t)l * DM;
  L.w_gate = p.in[16] + (size_t)l * DM * DFF; L.w_up = p.in[17] + (size_t)l * DM * DFF; L.conv_w = p.in[18] + (size_t)l * 3 * DFF; L.conv_b = p.in[19] + (size_t)l * DFF; L.w_down = p.in[20] + (size_t)l * DFF * DM;
  L.lambda_init = 0.8f - 0.6f * expf(-0.3f * (float)(l + 1));
  const unsigned char* wb = p.ws + OFF_W + (size_t)l * W_STRIDE;
  L.WinT = (const bf16_t*)(wb + WO_IN); L.WoutT = (const bf16_t*)(wb + WO_OUT); L.WguT = (const bf16_t*)(wb + WO_GU); L.WdT = (const bf16_t*)(wb + WO_DN); L.Wsp = (const bf16_t*)(wb + WO_SP);
  return L;
}
DI float lam_of(const LP& lp) {
  const int lane = threadIdx.x & 63;
  float a = lp.lq1[lane] * lp.lk1[lane], b = lp.lq2[lane] * lp.lk2[lane];
  a = wave_sum(a); b = wave_sum(b);
  return expf(a) - expf(b) + lp.lambda_init;
}

DI void conv_item(bf16_t* dst, int K, int row, int kg, const float* src, int ld, int col, const float* ks) {
  float v[32];
#pragma unroll
  for (int i = 0; i < 32; ++i) v[i] = src[(size_t)(kg * 32 + i) * ld + col];
  if (ks) {
#pragma unroll
    for (int i = 0; i < 32; i += 4) { const f32x4 s = *(const f32x4*)(ks + kg * 32 + i); v[i] *= s[0]; v[i + 1] *= s[1]; v[i + 2] *= s[2]; v[i + 3] *= s[3]; }
  }
  u32x4_t* d = (u32x4_t*)(dst + (size_t)row * K + kg * 32);
#pragma unroll
  for (int i = 0; i < 4; ++i) { u32x4_t w; w.x = pk2(v[8 * i], v[8 * i + 1]); w.y = pk2(v[8 * i + 2], v[8 * i + 3]); w.z = pk2(v[8 * i + 4], v[8 * i + 5]); w.w = pk2(v[8 * i + 6], v[8 * i + 7]); d[i] = w; }
}
DI int perm_logical(int p) {
  const int bj = p >> 7, wc = (p >> 5) & 3, n = (p >> 4) & 1, fq = (p >> 2) & 3, e = p & 3;
  return 64 * wc + 32 * bj + 8 * fq + 4 * n + e;
}
DI int perm_res(int p) { return (p & ~31) + 8 * ((p >> 2) & 3) + 4 * ((p >> 4) & 1) + (p & 3); }
DI void prologue(const MParams& p, LAS unsigned char* lds) {
  const int tidp = tid_opaque(); const int gtid = blockIdx.x * 512 + tidp, gsz = gridDim.x * 512;
  unsigned char* ws = p.ws;
  { const int gw = gtid >> 6, nw = gsz >> 6, lane = threadIdx.x & 63; bf16_t* XB = (bf16_t*)(ws + OFF_XB); u64* SS1 = (u64*)(ws + OFF_SS1);
    for (int row = gw; row < T_TOK; row += nw) { const float* xp = p.in[0] + (size_t)row * DM; float s = 0.f;
#pragma unroll
      for (int i = 0; i < 4; ++i) { const f32x4 v = *(const f32x4*)(xp + i * 256 + lane * 4); s += v[0] * v[0] + v[1] * v[1] + v[2] * v[2] + v[3] * v[3];
        u32x2_t w; w.x = pk2(v[0], v[1]); w.y = pk2(v[2], v[3]); *(u32x2_t*)(XB + (size_t)row * DM + i * 256 + lane * 4) = w; }
      s = wave_sum(s); if (lane == 0) SS1[row] = f2fx(s); } }
  { u64* SSV = (u64*)(ws + OFF_SSV); for (int i = gtid; i < T_TOK * 4; i += gsz) SSV[i] = 0ull; }
  { const int lane = tidp & 63, wv = tidp >> 6, n4 = lane & 15, kq = lane >> 4; LAS unsigned char* wl = lds + wv * 9216;
    for (int t = blockIdx.x * 8 + wv; t < NLAYER * 3008; t += gridDim.x * 8) {
      const int l = t / 3008; int r = t - l * 3008; const LP lp = make_lp(p, l);
      const float* src; const float* ks; bf16_t* dst; int ld, K, rt, kt, col;
      if (r < 640) { rt = r % 40; kt = r / 40; dst = (bf16_t*)lp.WinT; K = 1024; ld = INW; ks = lp.norm_attn_w; src = lp.w_in; const int row = 64 * rt + 4 * n4;
        if (row < 1536) { const int L = (row & ~255) + perm_logical(row & 255); col = L < 512 ? L : L + 512; } else { const int q = row - 1536; col = q < 512 ? 512 + q : 1536 + q; } }
      else if (r < 896) { r -= 640; rt = r & 15; kt = r >> 4; dst = (bf16_t*)lp.WoutT; K = 1024; ld = DM; ks = nullptr; src = lp.w_out; col = perm_res(64 * rt + 4 * n4); }
      else if (r < 2304) { r -= 896; rt = r % 88; kt = r / 88; dst = (bf16_t*)lp.WguT; K = 1024; ld = DFF; ks = lp.norm_ffn_w; const int row = 64 * rt + 4 * n4, pn = row >> 8, pp = row & 255;
        src = (pp >> 7) ? lp.w_up : lp.w_gate; const int q = pp & 127; col = 128 * pn + 32 * ((q >> 5) & 3) + 8 * ((q >> 2) & 3) + 4 * ((q >> 4) & 1) + (q & 3); }
      else { r -= 2304; rt = r & 15; kt = r >> 4; dst = (bf16_t*)lp.WdT; K = DFF; ld = DM; ks = nullptr; src = lp.w_down; col = perm_res(64 * rt + 4 * n4); }
      const float* sp = src + (size_t)(64 * kt + 16 * kq) * ld + col;
      f32x4 v[16];
#pragma unroll
      for (int j = 0; j < 16; ++j) v[j] = *(const f32x4*)(sp + (size_t)j * ld);
      if (ks) {
#pragma unroll
        for (int i = 0; i < 4; ++i) { const f32x4 sc = *(const f32x4*)(ks + 64 * kt + 16 * kq + 4 * i); v[4 * i] *= sc[0]; v[4 * i + 1] *= sc[1]; v[4 * i + 2] *= sc[2]; v[4 * i + 3] *= sc[3]; } }
#pragma unroll
      for (int n = 0; n < 4; ++n)
#pragma unroll
        for (int hh = 0; hh < 2; ++hh) { u32x4_t w; w.x = pk2(v[8 * hh][n], v[8 * hh + 1][n]); w.y = pk2(v[8 * hh + 2][n], v[8 * hh + 3][n]); w.z = pk2(v[8 * hh + 4][n], v[8 * hh + 5][n]); w.w = pk2(v[8 * hh + 6][n], v[8 * hh + 7][n]);
          *(LAS u32x4_t*)(wl + (4 * n4 + n) * 144 + (16 * kq + 8 * hh) * 2) = w; }
#pragma unroll
      for (int i = 0; i < 8; ++i) { const int row = 8 * i + (lane >> 3), pc = lane & 7; const u32x4_t w = *(const LAS u32x4_t*)(wl + row * 144 + pc * 16);
        *(u32x4_t*)(dst + (size_t)(64 * rt + row) * K + 64 * kt + pc * 8) = w; }
    }
  }
  for (int l = 0; l < NLAYER; ++l) { const LP lp = make_lp(p, l);
    for (int i = gtid; i < 65536; i += gsz) { const int jj = i & 127, ii = (i >> 7) & 127; ((bf16_t*)lp.Wsp)[i] = ((jj >> 6) <= (ii >> 6)) ? f2bf(lp.sp_w[i]) : (bf16_t)0; } }
}

struct DupOrder : pg8::StaticOrder {
  __device__ bool next(int i, Unit& u) const { return pg8::StaticOrder::next(i >> 1, u); }
};
struct EpiResid {
  static constexpr bool PERM = false, AFTER_DRAIN = false, TWICE = (PROBE_EPI_ACE != 0);
  const float* base32; float* out32; bf16_t* XB; u64* SS;
  DI void operator()(const f32x4 (&acc)[2][2][4][2], const Unit& u, int wr, int wc, int fr, int fq) const {
    const int row0 = u.pm * 256 + wr * 64 + fr, col0 = u.pn * 256 + wc * 32 + 8 * fq;
    if (base32) {
      f32x4 nb[2][2];
#pragma unroll
      for (int bj = 0; bj < 2; ++bj)
#pragma unroll
        for (int n = 0; n < 2; ++n) nb[bj][n] = *(const f32x4*)(base32 + (size_t)row0 * DM + col0 + bj * 128 + n * 4);
#pragma unroll
      for (int g = 0; g < 8; ++g) { const int ai = g >> 2, m = g & 3; const int row = row0 + ai * 128 + m * 16; const size_t ro = (size_t)row * DM + col0; float ss = 0.f;
        f32x4 cbv[2][2];
#pragma unroll
        for (int bj = 0; bj < 2; ++bj)
#pragma unroll
          for (int n = 0; n < 2; ++n) cbv[bj][n] = nb[bj][n];
        if (g < 7) { const int r2 = row0 + ((g + 1) >> 2) * 128 + ((g + 1) & 3) * 16;
#pragma unroll
          for (int bj = 0; bj < 2; ++bj)
#pragma unroll
            for (int n = 0; n < 2; ++n) nb[bj][n] = *(const f32x4*)(base32 + (size_t)r2 * DM + col0 + bj * 128 + n * 4); }
#pragma unroll
        for (int bj = 0; bj < 2; ++bj) { const f32x4 v0 = acc[ai][bj][m][0] + cbv[bj][0], v1 = acc[ai][bj][m][1] + cbv[bj][1];
          u32x4_t w; w.x = pk2(v0[0], v0[1]); w.y = pk2(v0[2], v0[3]); w.z = pk2(v1[0], v1[1]); w.w = pk2(v1[2], v1[3]); *(u32x4_t*)(XB + ro + bj * 128) = w;
          ss += ((v0[0] * v0[0] + v0[1] * v0[1]) + (v0[2] * v0[2] + v0[3] * v0[3])) + ((v1[0] * v1[0] + v1[1] * v1[1]) + (v1[2] * v1[2] + v1[3] * v1[3])); }
        ss += __shfl_xor(ss, 16); ss += __shfl_xor(ss, 32); if (fq == 0) fx_add(SS + row, ss);
        asm volatile("" ::: "memory"); }
    } else {
      u32x4_t nb[2];
#pragma unroll
      for (int bj = 0; bj < 2; ++bj) nb[bj] = *(const u32x4_t*)(XB + (size_t)row0 * DM + col0 + bj * 128);
#pragma unroll
      for (int g = 0; g < 8; ++g) { const int ai = g >> 2, m = g & 3; const int row = row0 + ai * 128 + m * 16; const size_t ro = (size_t)row * DM + col0; float ss = 0.f;
        u32x4_t cbv[2];
#pragma unroll
        for (int bj = 0; bj < 2; ++bj) cbv[bj] = nb[bj];
        if (g < 7) { const int r2 = row0 + ((g + 1) >> 2) * 128 + ((g + 1) & 3) * 16;
#pragma unroll
          for (int bj = 0; bj < 2; ++bj) nb[bj] = *(const u32x4_t*)(XB + (size_t)r2 * DM + col0 + bj * 128); }
#pragma unroll
        for (int bj = 0; bj < 2; ++bj) { const u32x4_t c = cbv[bj];
          const f32x4 v0 = acc[ai][bj][m][0] + (f32x4){bflo(c.x), bfhi(c.x), bflo(c.y), bfhi(c.y)}, v1 = acc[ai][bj][m][1] + (f32x4){bflo(c.z), bfhi(c.z), bflo(c.w), bfhi(c.w)};
          if (out32) { *(f32x4*)(out32 + ro + bj * 128) = v0; *(f32x4*)(out32 + ro + bj * 128 + 4) = v1; }
          else { u32x4_t w; w.x = pk2(v0[0], v0[1]); w.y = pk2(v0[2], v0[3]); w.z = pk2(v1[0], v1[1]); w.w = pk2(v1[2], v1[3]); *(u32x4_t*)(XB + ro + bj * 128) = w;
            ss += ((v0[0] * v0[0] + v0[1] * v0[1]) + (v0[2] * v0[2] + v0[3] * v0[3])) + ((v1[0] * v1[0] + v1[1] * v1[1]) + (v1[2] * v1[2] + v1[3] * v1[3])); } }
        if (!out32) { ss += __shfl_xor(ss, 16); ss += __shfl_xor(ss, 32); if (fq == 0) fx_add(SS + row, ss); }
        asm volatile("" ::: "memory"); }
    }
  }
};
struct EpiA1 {
  static constexpr bool PERM = false, AFTER_DRAIN = false, TWICE = (PROBE_EPI_ACE != 0);
  const u64* SS1; bf16_t *U, *Q, *KB; const float *qw, *kw;
  DI void operator()(const f32x4 (&acc)[2][2][4][2], const Unit& u, int wr, int wc, int fr, int fq) const {
    const int row0 = u.pm * 256 + wr * 64 + fr, lc0 = wc * 64 + 8 * fq, region = u.pn >> 1;
    u64 rsv[8];
#pragma unroll
    for (int g = 0; g < 8; ++g) rsv[g] = SS1[row0 + (g >> 2) * 128 + (g & 3) * 16];
    if (region == 0) {
#pragma unroll
      for (int g = 0; g < 8; ++g) { const int ai = g >> 2, m = g & 3; const int row = row0 + ai * 128 + m * 16; const float rs = rs1024(rsv[g]);
#pragma unroll
        for (int bj = 0; bj < 2; ++bj) { const f32x4 a = acc[ai][bj][m][0] * rs, b = acc[ai][bj][m][1] * rs; u32x4_t w;
          w.x = pk2(gelu1(a[0]), gelu1(a[1])); w.y = pk2(gelu1(a[2]), gelu1(a[3])); w.z = pk2(gelu1(b[0]), gelu1(b[1])); w.w = pk2(gelu1(b[2]), gelu1(b[3]));
          *(u32x4_t*)(U + (size_t)row * 512 + u.pn * 256 + lc0 + 32 * bj) = w; } }
    } else {
      const bool isq = region == 1; const float* wp = (isq ? qw : kw) + 8 * fq; bf16_t* dst = (isq ? Q : KB) + (u.pn & 1) * 256 + lc0; const float sc = isq ? QSCALE : 1.0f;
      f32x4 wv[2][2];
#pragma unroll
      for (int bj = 0; bj < 2; ++bj)
#pragma unroll
        for (int n = 0; n < 2; ++n) wv[bj][n] = *(const f32x4*)(wp + 32 * bj + 4 * n);
#pragma unroll
      for (int g = 0; g < 8; ++g) { const int ai = g >> 2, m = g & 3; const int row = row0 + ai * 128 + m * 16; const float rs = rs1024(rsv[g]); float ss = 0.f; f32x4 v[2][2];
#pragma unroll
        for (int bj = 0; bj < 2; ++bj)
#pragma unroll
          for (int n = 0; n < 2; ++n) { v[bj][n] = acc[ai][bj][m][n] * rs; const f32x4 t = v[bj][n]; ss += (t[0] * t[0] + t[1] * t[1]) + (t[2] * t[2] + t[3] * t[3]); }
        ss += __shfl_xor(ss, 16); ss += __shfl_xor(ss, 32);
        const float r2 = rsqrtf(ss * (1.0f / 64.0f) + EPS) * sc;
#pragma unroll
        for (int bj = 0; bj < 2; ++bj) { const f32x4 a = v[bj][0] * r2 * wv[bj][0], b = v[bj][1] * r2 * wv[bj][1]; u32x4_t w;
          w.x = pk2(a[0], a[1]); w.y = pk2(a[2], a[3]); w.z = pk2(b[0], b[1]); w.w = pk2(b[2], b[3]);
          *(u32x4_t*)(dst + (size_t)row * 512 + 32 * bj) = w; } }
    }
  }
};
struct EpiA2 {
  static constexpr bool PERM = false, AFTER_DRAIN = false, TWICE = (PROBE_EPI_ACE != 0);
  const u64* SS1; bf16_t *GVT, *VT; u64* SSV;
  DI void operator()(const f32x4 (&acc)[2][2][4][2], const Unit& u, int wr, int wc, int fr, int fq) const {
    const int colbase = u.pn * 256 + wc * 32;
    f32x4 rs[2][2];
#pragma unroll
    for (int bj = 0; bj < 2; ++bj)
#pragma unroll
      for (int n = 0; n < 2; ++n) { const u64* sp = SS1 + colbase + bj * 128 + n * 16 + 4 * fq; rs[bj][n] = (f32x4){rs1024(sp[0]), rs1024(sp[1]), rs1024(sp[2]), rs1024(sp[3])}; }
    if (u.pm < 2) {
#pragma unroll
      for (int ai = 0; ai < 2; ++ai) { const int head = 2 * u.pm + ai;
#pragma unroll
        for (int bj = 0; bj < 2; ++bj)
#pragma unroll
          for (int n = 0; n < 2; ++n) { f32x4 sq = (f32x4){0.f, 0.f, 0.f, 0.f}; const int tok = colbase + bj * 128 + n * 16 + 4 * fq;
#pragma unroll
            for (int m = 0; m < 4; ++m) { const int row = u.pm * 256 + ai * 128 + wr * 64 + m * 16 + fr;
              const f32x4 a = acc[ai][bj][m][n] * rs[bj][n]; f32x4 g; g[0] = gelu1(a[0]); g[1] = gelu1(a[1]); g[2] = gelu1(a[2]); g[3] = gelu1(a[3]);
              u32x2_t w; w.x = pk2(g[0], g[1]); w.y = pk2(g[2], g[3]); *(u32x2_t*)(GVT + (size_t)row * T_TOK + tok) = w; sq += g * g; }
#pragma unroll
            for (int e = 0; e < 4; ++e) sq[e] = row_sum16(sq[e]);
            if (fr == 0) {
#pragma unroll
              for (int e = 0; e < 4; ++e) fx_add(SSV + (size_t)(tok + e) * 4 + head, sq[e]); }
            asm volatile("" ::: "memory"); } }
    } else {
#pragma unroll
      for (int ai = 0; ai < 2; ++ai)
#pragma unroll
        for (int m = 0; m < 4; ++m) { const int row = (u.pm - 2) * 256 + ai * 128 + wr * 64 + m * 16 + fr;
#pragma unroll
          for (int bj = 0; bj < 2; ++bj)
#pragma unroll
            for (int n = 0; n < 2; ++n) { const f32x4 a = acc[ai][bj][m][n] * rs[bj][n]; u32x2_t w; w.x = pk2(a[0], a[1]); w.y = pk2(a[2], a[3]);
              *(u32x2_t*)(VT + (size_t)row * T_TOK + colbase + bj * 128 + n * 16 + 8 * (fq & 1) + 4 * (fq >> 1)) = w; } }
    }
  }
};
struct EpiD {
  static constexpr bool PERM = false, AFTER_DRAIN = false, TWICE = (PROBE_EPI_D != 0);
  const u64* SS2; const float *cw, *cb; bf16_t* F; float *GB, *PB, *UB;
  DI void operator()(const f32x4 (&acc)[2][2][4][2], const Unit& u, int wr, int wc, int fr, int fq) const {
    const int cbase = u.pn * 128 + wc * 32 + 8 * fq;
    const int rb0 = u.pm * 256 + wr * 64;
    u64 rsv[8]; f32x4 w0[2], w1[2], w2[2], bb[2];
#pragma unroll
    for (int g = 0; g < 8; ++g) rsv[g] = SS2[rb0 + (g >> 2) * 128 + (g & 3) * 16 + fr];
#pragma unroll
    for (int n = 0; n < 2; ++n) { w0[n] = *(const f32x4*)(cw + cbase + 4 * n); w1[n] = *(const f32x4*)(cw + DFF + cbase + 4 * n); w2[n] = *(const f32x4*)(cw + 2 * DFF + cbase + 4 * n); bb[n] = *(const f32x4*)(cb + cbase + 4 * n); }
#pragma unroll
    for (int ai = 0; ai < 2; ++ai) {
      const int rb = rb0 + ai * 128, bd = rb >> 6;
      float rs[4];
#pragma unroll
      for (int m = 0; m < 4; ++m) rs[m] = rs1024(rsv[ai * 4 + m]);
      unsigned fo[4][4];
#pragma unroll
      for (int n = 0; n < 2; ++n) {
        const int cn = cbase + 4 * n;
        f32x4 pg, ug, gg; float fv[4][4];
#pragma unroll
        for (int e = 0; e < 4; ++e) {
          float G[4], r1[4], r2[4];
#pragma unroll
          for (int m = 0; m < 4; ++m) { G[m] = acc[ai][0][m][n][e] * rs[m]; r1[m] = dpp_ror1(G[m]); r2[m] = dpp_ror2(G[m]); }
#pragma unroll
          for (int m = 0; m < 4; ++m) {
            const float p1 = (fr >= 1) ? r1[m] : (m > 0 ? r1[m > 0 ? m - 1 : 0] : 0.f);
            const float p2 = (fr >= 2) ? r2[m] : (m > 0 ? r2[m > 0 ? m - 1 : 0] : 0.f);
            const float g = w2[n][e] * G[m] + w1[n][e] * p1 + w0[n][e] * p2 + bb[n][e];
            const float uv = acc[ai][1][m][n][e] * rs[m];
            if (m == 0) { pg[e] = g; ug[e] = uv; }
            if (m == 3) gg[e] = G[3];
            fv[m][e] = g * __builtin_amdgcn_rcpf(1.0f + __expf(-g)) * uv;
          }
        }
#pragma unroll
        for (int m = 0; m < 4; ++m) { fo[m][2 * n] = pk2(fv[m][0], fv[m][1]); fo[m][2 * n + 1] = pk2(fv[m][2], fv[m][3]); }
        if (fr < 2) { *(f32x4*)(PB + (size_t)(bd * 2 + fr) * DFF + cn) = pg; *(f32x4*)(UB + (size_t)(bd * 2 + fr) * DFF + cn) = ug; }
        if (fr >= 14) { *(f32x4*)(GB + (size_t)(bd * 2 + fr - 14) * DFF + cn) = gg; }
      }
#pragma unroll
      for (int m = 0; m < 4; ++m) {
        if (!(m == 0 && fr < 2)) { u32x4_t w; w.x = fo[m][0]; w.y = fo[m][1]; w.z = fo[m][2]; w.w = fo[m][3]; *(u32x4_t*)(F + (size_t)(rb + 16 * m + fr) * DFF + cbase) = w; }
      }
    }
  }
};
DI void fixup_phase(const LP& lp, unsigned char* ws) {
  const float *GB = (const float*)(ws + OFF_GB), *PB = (const float*)(ws + OFF_PB), *UB = (const float*)(ws + OFF_UB); bf16_t* F = (bf16_t*)(ws + OFF_F);
  const int gtid = blockIdx.x * 512 + tid_opaque(), gsz = gridDim.x * 512;
  for (int w = gtid; w < 512 * 2 * 704; w += gsz) {
    const int c = (w % 704) * 4, j = (w / 704) & 1, bd = w / 1408;
    f32x4 g = *(const f32x4*)(PB + (size_t)(bd * 2 + j) * DFF + c);
    if (bd & 31) { const f32x4 gm1 = *(const f32x4*)(GB + (size_t)((bd - 1) * 2 + 1) * DFF + c); const f32x4 w0 = *(const f32x4*)(lp.conv_w + c);
      if (j == 0) { const f32x4 gm2 = *(const f32x4*)(GB + (size_t)((bd - 1) * 2) * DFF + c); const f32x4 w1 = *(const f32x4*)(lp.conv_w + DFF + c); g += w1 * gm1 + w0 * gm2; }
      else g += w0 * gm1; }
    const f32x4 uv = *(const f32x4*)(UB + (size_t)(bd * 2 + j) * DFF + c); float f[4];
#pragma unroll
    for (int e = 0; e < 4; ++e) f[e] = g[e] * __builtin_amdgcn_rcpf(1.0f + __expf(-g[e])) * uv[e];
    u32x2_t o; o.x = pk2(f[0], f[1]); o.y = pk2(f[2], f[3]);
    *(u32x2_t*)(F + (size_t)(bd * 64 + j) * DFF + c) = o;
  }
}

DI void spatial_phase(const LP& lp, unsigned char* ws, LAS unsigned char* lds) {
  const bf16_t *U = (const bf16_t*)(ws + OFF_U), *GVT = (const bf16_t*)(ws + OFF_GVT); const u64* SSV = (const u64*)(ws + OFF_SSV); bf16_t* MIX = (bf16_t*)(ws + OFF_MIX);
  constexpr int TB = 32768;
  LAS float* sr = (LAS float*)(lds + 2 * TB);
  const int tid = tid_opaque(), lane = tid & 63, w = __builtin_amdgcn_readfirstlane(tid >> 6), l15 = lane & 15, kq = lane >> 4;
#define SP_STAGE(item, buf) do { const int h_ = (item) & 3, t_ = ((item) >> 2) * 128; _Pragma("unroll") for (int i = 0; i < 4; ++i) { const int P = (w * 4 + i) * 64 + lane, row = P >> 4, pc = (P & 15) ^ (row & 15); \
    __builtin_amdgcn_global_load_lds((const unsigned*)(GVT + (size_t)(h_ * 128 + row) * T_TOK + t_ + pc * 8), (LAS unsigned*)(lds + (buf) * TB + (w * 4 + i) * 1024), 16, 0, 0); } } while (0)
  LAS float* vn_l = sr + 128; LAS float* on_l = vn_l + 512; LAS float* sb_l = on_l + 512;
  int it = blockIdx.x, buf = 0;
  if (it < 1024) SP_STAGE(it, 0);
  { const float a = lp.v_norm_w[tid], b = lp.out_norm_w[tid], c = lp.sp_b[tid]; vn_l[tid] = a; on_l[tid] = b; sb_l[tid] = c; }
  asm volatile("s_waitcnt vmcnt(0)" ::: "memory");
  __syncthreads();
  const int x_lane = l15 * 256 + ((kq ^ l15) << 4);
  const int i0 = 16 * w, nks = (w < 4) ? 2 : 4;
  u32x4_t rawN[4]; u32x2_t urN[8]; u64 ssvN = 0ull;
#define SP_LOADREGS(item) do { const int h_ = (item) & 3, t_ = ((item) >> 2) * 128; \
    _Pragma("unroll") for (int ks = 0; ks < 4; ++ks) rawN[ks] = (ks < nks) ? *(const u32x4_t*)(lp.Wsp + (size_t)(h_ * 128 + i0 + l15) * 128 + ks * 32 + kq * 8) : (u32x4_t){0u, 0u, 0u, 0u}; \
    _Pragma("unroll") for (int dt = 0; dt < 8; ++dt) urN[dt] = *(const u32x2_t*)(U + (size_t)(t_ + i0 + l15) * 512 + h_ * 128 + 16 * dt + 4 * kq); \
    ssvN = (tid < 128) ? SSV[(size_t)(t_ + tid) * 4 + h_] : 0ull; } while (0)
  if (it < 1024) SP_LOADREGS(it);
  for (; it < 1024; it += gridDim.x, buf ^= 1) {
    const int h = it & 3, tok0 = (it >> 2) * 128, irow = tok0 + i0 + l15;
    u32x4_t raw[4]; u32x2_t ur[8];
#pragma unroll
    for (int ks = 0; ks < 4; ++ks) raw[ks] = rawN[ks];
#pragma unroll
    for (int dt = 0; dt < 8; ++dt) ur[dt] = urN[dt];
    const u64 ssv = ssvN;
    const float bias = sb_l[h * 128 + i0 + l15];
    const int nit = it + gridDim.x;
    if (nit < 1024) { SP_STAGE(nit, buf ^ 1); SP_LOADREGS(nit); }
    if (tid < 128) sr[tid] = rsqrtf(fx2f(ssv) * (1.0f / 128.0f) + EPS);
    __syncthreads();
    bf16x8 yf[4];
#pragma unroll
    for (int ks = 0; ks < 4; ++ks) { const LAS float* sp = sr + ks * 32 + kq * 8; const u32x4_t r = raw[ks]; u32x4_t o;
      o.x = pk2(bflo(r.x) * sp[0], bfhi(r.x) * sp[1]); o.y = pk2(bflo(r.y) * sp[2], bfhi(r.y) * sp[3]); o.z = pk2(bflo(r.z) * sp[4], bfhi(r.z) * sp[5]); o.w = pk2(bflo(r.w) * sp[6], bfhi(r.w) * sp[7]);
      yf[ks] = __builtin_bit_cast(bf16x8, o); }
    const LAS unsigned char* tb = lds + buf * TB;
    float o[8][4]; float ss = 0.f;
#pragma unroll
    for (int dt = 0; dt < 8; ++dt) {
      f32x4 acc = (f32x4){0.f, 0.f, 0.f, 0.f};
#pragma unroll
      for (int ks = 0; ks < 4; ++ks) if (ks < nks) {
        const bf16x8 xf = *(const LAS bf16x8*)(tb + dt * 4096 + (x_lane ^ (ks << 6)));
        acc = __builtin_amdgcn_mfma_f32_16x16x32_bf16(xf, yf[ks], acc, 0, 0, 0); }
      const int d0 = 16 * dt + 4 * kq; const f32x4 wv = *(const LAS f32x4*)(vn_l + h * 128 + d0);
      o[dt][0] = bflo(ur[dt].x) * (acc[0] * wv[0] + bias); o[dt][1] = bfhi(ur[dt].x) * (acc[1] * wv[1] + bias); o[dt][2] = bflo(ur[dt].y) * (acc[2] * wv[2] + bias); o[dt][3] = bfhi(ur[dt].y) * (acc[3] * wv[3] + bias);
      ss += (o[dt][0] * o[dt][0] + o[dt][1] * o[dt][1]) + (o[dt][2] * o[dt][2] + o[dt][3] * o[dt][3]);
    }
    ss += __shfl_xor(ss, 16); ss += __shfl_xor(ss, 32);
    const float rs = rsqrtf(ss * (1.0f / 128.0f) + EPS);
#pragma unroll
    for (int dt = 0; dt < 8; ++dt) { const int d0 = 16 * dt + 4 * kq; const f32x4 wo = *(const LAS f32x4*)(on_l + h * 128 + d0);
      u32x2_t q; q.x = pk2(o[dt][0] * rs * wo[0], o[dt][1] * rs * wo[1]); q.y = pk2(o[dt][2] * rs * wo[2], o[dt][3] * rs * wo[3]);
      *(u32x2_t*)(MIX + (size_t)irow * 1024 + h * 128 + d0) = q; }
    asm volatile("s_waitcnt vmcnt(8)" ::: "memory");
    __syncthreads();
  }
#undef SP_STAGE
#undef SP_LOADREGS
}

DI void attn_phase(const MParams& p, int l, LAS unsigned char* lds) {
  unsigned char* ws = p.ws;
  const bf16_t *Q = (const bf16_t*)(ws + OFF_Q), *KB = (const bf16_t*)(ws + OFF_KB), *VT = (const bf16_t*)(ws + OFF_VT); bf16_t* MIX = (bf16_t*)(ws + OFF_MIX);
  constexpr int KBUF = 16384, VBUF = 16384, STG = KBUF + VBUF, QOFF = 3 * STG;
  static_assert(QOFF + 65536 <= LDS_BYTES, "attention LDS");
  const unsigned sv0 = __builtin_amdgcn_readfirstlane(((volatile LAS unsigned*)(lds + 131072))[0]), sv1 = __builtin_amdgcn_readfirstlane(((volatile LAS unsigned*)(lds + 131072))[1]), sv2 = __builtin_amdgcn_readfirstlane(((volatile LAS unsigned*)(lds + 131072))[2]);
  __syncthreads();
  const float lambda_init = 0.8f - 0.6f * expf(-0.3f * (float)(l + 1));
  const float* dnw = p.in[13] + l * 128;
#pragma unroll 1
  for (int pi = blockIdx.x; pi < 256; pi += gridDim.x) {
    const int b = pi >> 4, h = (pi >> 2) & 3, j = pi & 3;
#pragma unroll 1
    for (int it = 0; it < 2; ++it) {
      const int tid = tid_opaque(), lane = tid & 63, w = __builtin_amdgcn_readfirstlane(tid >> 6), l31 = lane & 31, hh = lane >> 5;
      const int qb = it ? j : 7 - j, t0 = b * 2048 + 256 * qb, ntl = 4 * qb + 4, ntw = 4 * qb + (w >> 1) + 1;
#pragma unroll
      for (int i = 0; i < 8; ++i) { const int P = (w * 8 + i) * 64 + lane, row = P >> 4, pos = P & 15, pc = pos ^ (row & 15);
        __builtin_amdgcn_global_load_lds((const unsigned*)(Q + (size_t)(t0 + row) * 512 + h * 128 + pc * 8), (LAS unsigned*)(lds + QOFF + (w * 8 + i) * 1024), 16, 0, 0); }
      const bf16_t* kbase = KB + (size_t)(b * 2048) * 512 + h * 128; const bf16_t* vbase = VT + (size_t)(h * 128) * T_TOK + b * 2048;
      int koff[2], voff[2];
#pragma unroll
      for (int i = 0; i < 2; ++i) { const int P = (w * 2 + i) * 64 + lane; { const int row = P >> 4, pos = P & 15, pc = pos ^ (row & 15); koff[i] = row * 512 + pc * 8; }
        { const int row = P >> 3, pos = P & 7, pc = pos ^ ((row >> 1) & 7); voff[i] = row * T_TOK + pc * 8; } }
#define ATT_STAGE(kt, buf) do { _Pragma("unroll") for (int i = 0; i < 2; ++i) { \
        __builtin_amdgcn_global_load_lds((const unsigned*)(kbase + (size_t)(kt) * (64 * 512) + koff[i]), (LAS unsigned*)(lds + (buf) * STG + (w * 2 + i) * 1024), 16, 0, 0); \
        __builtin_amdgcn_global_load_lds((const unsigned*)(vbase + (kt) * 64 + voff[i]), (LAS unsigned*)(lds + (buf) * STG + KBUF + (w * 2 + i) * 1024), 16, 0, 0); } } while (0)
#define ATT_STAGE_AT(kt, soff) do { _Pragma("unroll") for (int i = 0; i < 2; ++i) { \
        __builtin_amdgcn_global_load_lds((const unsigned*)(kbase + (size_t)(kt) * (64 * 512) + koff[i]), (LAS unsigned*)(lds + (soff) + (w * 2 + i) * 1024), 16, 0, 0); \
        __builtin_amdgcn_global_load_lds((const unsigned*)(vbase + (kt) * 64 + voff[i]), (LAS unsigned*)(lds + (soff) + KBUF + (w * 2 + i) * 1024), 16, 0, 0); } } while (0)
      ATT_STAGE(0, 0);
      if (ntl > 1) { ATT_STAGE(1, 1); asm volatile("s_waitcnt vmcnt(4)" ::: "memory"); } else asm volatile("s_waitcnt vmcnt(0)" ::: "memory");
      __syncthreads();
      int st_cur = 0, st_pre = 2 * STG;
      f32x16 O[2][4];
#pragma unroll
      for (int c = 0; c < 2; ++c)
#pragma unroll
        for (int bk = 0; bk < 4; ++bk)
#pragma unroll
          for (int i = 0; i < 16; ++i) O[c][bk][i] = 0.f;
      float lsum[2] = {0.f, 0.f};
      const int qr = 32 * w + l31;
      int k_lane = l31 * 256 + ((hh ^ (l31 & 15)) << 4), q_lane = QOFF + qr * 256 + ((hh ^ (qr & 15)) << 4), v_lane = KBUF + l31 * 128 + ((hh ^ ((l31 >> 1) & 7)) << 4);
#pragma unroll 1
      for (int kt = 0; kt < ntl; ++kt) {
        if (kt + 2 < ntl) ATT_STAGE_AT(kt + 2, st_pre);
        if (kt < ntw) {
          asm volatile("" : "+v"(k_lane), "+v"(q_lane), "+v"(v_lane));
          const LAS unsigned char* tb = lds + st_cur;
#pragma unroll
          for (int kb = 0; kb < 2; ++kb) {
            bf16x8 pf[2][2];
#pragma unroll
            for (int c = 0; c < 2; ++c) {
              f32x16 S;
#pragma unroll
              for (int i = 0; i < 16; ++i) S[i] = 0.f;
#pragma unroll
              for (int ks = 0; ks < 4; ++ks) {
                const int xo = (c * 8 + ks * 2) << 4;
                const bf16x8 qf = *(const LAS bf16x8*)(lds + (q_lane ^ xo));
                const bf16x8 kf = *(const LAS bf16x8*)(tb + (k_lane ^ xo) + kb * 8192);
                S = __builtin_amdgcn_mfma_f32_32x32x16_bf16(kf, qf, S, 0, 0, 0);
              }
              float ls = 0.f;
#pragma unroll
              for (int hs = 0; hs < 2; ++hs) { u32x4_t pw;
#pragma unroll
                for (int t = 0; t < 4; ++t) { const float a = __builtin_amdgcn_exp2f(S[8 * hs + 2 * t]), bq = __builtin_amdgcn_exp2f(S[8 * hs + 2 * t + 1]); ls += a + bq; pw[t] = pk2(a, bq); }
                pf[c][hs] = __builtin_bit_cast(bf16x8, pw); }
              lsum[c] += ls;
              __builtin_amdgcn_sched_barrier(0);
            }
#pragma unroll
            for (int bk = 0; bk < 4; ++bk) {
              const bf16x8 v0 = *(const LAS bf16x8*)(tb + (v_lane ^ ((2 * kb) << 5)) + bk * 4096);
              const bf16x8 v1 = *(const LAS bf16x8*)(tb + (v_lane ^ ((2 * kb + 1) << 5)) + bk * 4096);
              O[0][bk] = __builtin_amdgcn_mfma_f32_32x32x16_bf16(v0, pf[0][0], O[0][bk], 0, 0, 0);
              O[1][bk] = __builtin_amdgcn_mfma_f32_32x32x16_bf16(v0, pf[1][0], O[1][bk], 0, 0, 0);
              O[0][bk] = __builtin_amdgcn_mfma_f32_32x32x16_bf16(v1, pf[0][1], O[0][bk], 0, 0, 0);
              O[1][bk] = __builtin_amdgcn_mfma_f32_32x32x16_bf16(v1, pf[1][1], O[1][bk], 0, 0, 0);
              __builtin_amdgcn_sched_barrier(0);
            }
          }
        }
        if (kt + 2 < ntl) asm volatile("s_waitcnt vmcnt(4)" ::: "memory"); else asm volatile("s_waitcnt vmcnt(0)" ::: "memory");
        __syncthreads();
        st_pre = st_cur; st_cur = (st_cur == 2 * STG) ? 0 : st_cur + STG;
      }
#undef ATT_STAGE
#undef ATT_STAGE_AT
      const int tid2 = tid_opaque(), lane2 = tid2 & 63, w2 = __builtin_amdgcn_readfirstlane(tid2 >> 6), hh2 = lane2 >> 5, qr2 = 32 * w2 + (lane2 & 31);
      float lam;
      { const float* q1 = p.in[9] + l * 64; const float* k1 = p.in[10] + l * 64; const float* q2 = p.in[11] + l * 64; const float* k2 = p.in[12] + l * 64;
        float a = q1[lane2] * k1[lane2], bq = q2[lane2] * k2[lane2]; a = wave_sum(a); bq = wave_sum(bq); lam = expf(a) - expf(bq) + lambda_init; }
      float l1 = lsum[0], l2 = lsum[1]; l1 += __shfl_xor(l1, 32); l2 += __shfl_xor(l2, 32);
      const float inv1 = 1.0f / l1, inv2 = lam / l2; float ss = 0.f;
#pragma unroll
      for (int bk = 0; bk < 4; ++bk)
#pragma unroll
        for (int i = 0; i < 16; ++i) { const float o = O[0][bk][i] * inv1 - O[1][bk][i] * inv2; O[0][bk][i] = o; ss += o * o; }
      ss += __shfl_xor(ss, 32);
      const float rs = rsqrtf(ss * (1.0f / 128.0f) + EPS) * (1.0f - lambda_init);
      bf16_t* orow = MIX + (size_t)(t0 + qr2) * 1024 + 512 + h * 128;
#pragma unroll
      for (int bk = 0; bk < 4; ++bk)
#pragma unroll
        for (int g = 0; g < 4; ++g) { const int dv0 = 32 * bk + 8 * g + 4 * hh2; const f32x4 wv = *(const f32x4*)(dnw + dv0);
          u32x2_t q; q.x = pk2(O[0][bk][4 * g] * rs * wv[0], O[0][bk][4 * g + 1] * rs * wv[1]); q.y = pk2(O[0][bk][4 * g + 2] * rs * wv[2], O[0][bk][4 * g + 3] * rs * wv[3]);
          *(u32x2_t*)(orow + dv0) = q; }
    }
  }
  __syncthreads();
  if (threadIdx.x == 0) { volatile LAS unsigned* stw = (volatile LAS unsigned*)(lds + 131072); stw[0] = sv0; stw[1] = sv1; stw[2] = sv2; }
  __syncthreads();
}


#define XB_TMO      128
#define XB_XCNT(j)  (256  + 64 * (j))
#define XB_XSUB(j)  (1280 + 64 * (j))
#define XB_XGEN(j)  (2304 + 64 * (j))
#define XB_TOP      3328
#define XB_TOPGEN   3392
#define XCD_BAR_WORDS 3456
#define XB_SPIN_CAP (1u << 18)

__device__ __forceinline__ unsigned xb_ld(unsigned* p)              { return __hip_atomic_load(p, __ATOMIC_RELAXED, __HIP_MEMORY_SCOPE_AGENT); }
__device__ __forceinline__ unsigned xb_add(unsigned* p, unsigned v) { return __hip_atomic_fetch_add(p, v, __ATOMIC_RELAXED, __HIP_MEMORY_SCOPE_AGENT); }
__device__ __forceinline__ unsigned xb_xcc_id() { return (unsigned)__builtin_amdgcn_s_getreg((3 << 11) | 20) & 0xFu; }
#define XB_SPIN(cond, bar) do { unsigned _sp = 0; while (cond) { __builtin_amdgcn_s_sleep(1); \
    if ((++_sp & 255u) == 0u) { if (xb_ld(&(bar)[XB_TMO])) break; if (_sp > XB_SPIN_CAP) { atomicAdd(&(bar)[XB_TMO], 1u); break; } } } } while (0)

struct XcdBarrier {
    unsigned* bar; unsigned x;
    volatile LAS unsigned* st;
};

__device__ __forceinline__ XcdBarrier xcd_barrier_post(unsigned* bar, volatile LAS unsigned* st) {
    XcdBarrier b; b.bar = bar; b.x = xb_xcc_id(); b.st = st;
    if (threadIdx.x == 0) (void)xb_add(&bar[XB_XCNT(b.x)], 1u);
    return b;
}
__device__ __forceinline__ void xcd_barrier_complete(unsigned* bar, unsigned x, unsigned& nloc, unsigned& nx) {
    const unsigned G = gridDim.x * gridDim.y * gridDim.z;
    unsigned sum, cnt, mine, sp = 0u;
    for (;;) {
        sum = 0u; cnt = 0u; mine = 0u;
#pragma unroll
        for (unsigned j = 0; j < 16; ++j) { const unsigned c = xb_ld(&bar[XB_XCNT(j)]); sum += c; cnt += (c > 0u) ? 1u : 0u; mine = (j == x) ? c : mine; }
        if (sum == G) break;
        __builtin_amdgcn_s_sleep(1);
        if ((++sp & 255u) == 0u) { if (xb_ld(&bar[XB_TMO])) break; if (sp > XB_SPIN_CAP) { atomicAdd(&bar[XB_TMO], 1u); break; } }
    }
    nloc = mine > 0u ? mine : 1u; nx = cnt > 0u ? cnt : 1u;
}

__device__ __forceinline__ void xcd_barrier(const XcdBarrier& b) {
    asm volatile("s_waitcnt vmcnt(0)" ::: "memory");
    __syncthreads();
    if (threadIdx.x == 0) {
        unsigned* bar = b.bar;
        __builtin_amdgcn_s_waitcnt(0);
        unsigned nloc = b.st[0], nx = b.st[1];
        if (nloc == 0u) { xcd_barrier_complete(bar, b.x, nloc, nx); b.st[0] = nloc; b.st[1] = nx; }
        const unsigned old = xb_add(&bar[XB_XSUB(b.x)], 1u);
        const unsigned gen = old / nloc;
        if (old + 1u == (gen + 1u) * nloc) {
            __builtin_amdgcn_fence(__ATOMIC_RELEASE, "agent");
            asm volatile("s_waitcnt vmcnt(0)" ::: "memory");
            const unsigned og = xb_add(&bar[XB_TOP], 1u);
            const unsigned tg = og / nx;
            if (og + 1u == (tg + 1u) * nx) xb_add(&bar[XB_TOPGEN], 1u);
            else XB_SPIN(xb_ld(&bar[XB_TOPGEN]) == tg, bar);
            __builtin_amdgcn_fence(__ATOMIC_ACQUIRE, "agent");
            xb_add(&bar[XB_XGEN(b.x)], 1u);
            asm volatile("s_waitcnt vmcnt(0)" ::: "memory");
        } else {
            XB_SPIN(xb_ld(&bar[XB_XGEN(b.x)]) == gen, bar);
            __builtin_amdgcn_fence(__ATOMIC_ACQUIRE, "agent");
            asm volatile("s_waitcnt vmcnt(0)" ::: "memory");
        }
    }
    __syncthreads();
}

DI void zero_u64(u64* p, int n) { for (int i = blockIdx.x * 512 + tid_opaque(); i < n; i += gridDim.x * 512) p[i] = 0ull; }

#if PROBE_EPI_ACE
typedef DupOrder OrderACE;
#else
typedef pg8::StaticOrder OrderACE;
#endif
DI void phaseA(const MParams& p, int l, LAS unsigned char* lds) {
  unsigned char* ws = p.ws; const bf16_t* XB = (const bf16_t*)(ws + OFF_XB); const bf16_t* WinT = (const bf16_t*)(ws + OFF_W + (size_t)l * W_STRIDE + WO_IN); const u64* SS1 = (const u64*)(ws + OFF_SS1);
  zero_u64((u64*)(ws + OFF_SS2), T_TOK);
  { pg8::Gemm g{XB, WinT, T_TOK, 1536, DM}; OrderACE S; S.init(T_TOK, 1536, gridDim.x, blockIdx.x);
    EpiA1 E{SS1, (bf16_t*)(ws + OFF_U), (bf16_t*)(ws + OFF_Q), (bf16_t*)(ws + OFF_KB), p.in[7] + l * 64, p.in[8] + l * 64}; pg8::gemm_phase<EpiA1, OrderACE>(lds, g, S, E); }
  { pg8::Gemm g{WinT + (size_t)1536 * DM, XB, 1024, T_TOK, DM}; OrderACE S; S.init(1024, T_TOK, gridDim.x, blockIdx.x);
    EpiA2 E{SS1, (bf16_t*)(ws + OFF_GVT), (bf16_t*)(ws + OFF_VT), (u64*)(ws + OFF_SSV)}; pg8::gemm_phase<EpiA2, OrderACE>(lds, g, S, E); }
}
DI void phaseCE(const MParams& p, int l, bool isC, LAS unsigned char* lds) {
  unsigned char* ws = p.ws; const unsigned char* wb = ws + OFF_W + (size_t)l * W_STRIDE;
  if (isC) zero_u64((u64*)(ws + OFF_SS1), T_TOK);
  pg8::Gemm g{(const bf16_t*)(ws + (isC ? OFF_MIX : OFF_F)), (const bf16_t*)(wb + (isC ? WO_OUT : WO_DN)), T_TOK, DM, isC ? DM : DFF}; OrderACE S; S.init(T_TOK, DM, gridDim.x, blockIdx.x);
  EpiResid E{(isC && l == 0) ? p.in[0] : nullptr, (!isC && l == NLAYER - 1) ? p.out : nullptr, (bf16_t*)(ws + OFF_XB), (u64*)(ws + (isC ? OFF_SS2 : OFF_SS1))}; pg8::gemm_phase<EpiResid, OrderACE>(lds, g, S, E);
}
DI void phaseD(const MParams& p, int l, LAS unsigned char* lds) {
  unsigned char* ws = p.ws;
  zero_u64((u64*)(ws + OFF_SSV), T_TOK * 4);
  pg8::Gemm g{(const bf16_t*)(ws + OFF_XB), (const bf16_t*)(ws + OFF_W + (size_t)l * W_STRIDE + WO_GU), T_TOK, 2 * DFF, DM};
#if PROBE_EPI_D
  DupOrder S;
#else
  pg8::StaticOrder S;
#endif
  S.init(T_TOK, 2 * DFF, gridDim.x, blockIdx.x);
  EpiD E{(const u64*)(ws + OFF_SS2), p.in[18] + (size_t)l * 3 * DFF, p.in[19] + (size_t)l * DFF, (bf16_t*)(ws + OFF_F), (float*)(ws + OFF_GB), (float*)(ws + OFF_PB), (float*)(ws + OFF_UB)};
#if PROBE_EPI_D
  pg8::gemm_phase<EpiD, DupOrder>(lds, g, S, E);
#else
  pg8::gemm_phase<EpiD, pg8::StaticOrder>(lds, g, S, E);
#endif
}

__global__ void __launch_bounds__(512) k_run(MParams p) {
  extern __shared__ __attribute__((aligned(16))) unsigned char lds_raw[];
  LAS unsigned char* lds = (LAS unsigned char*)lds_raw;
  cg::grid_group grid = cg::this_grid();
  if (threadIdx.x < 4) ((LAS unsigned*)(lds + 131072))[threadIdx.x] = 0u;
  __syncthreads();
  XcdBarrier xbar = xcd_barrier_post((unsigned*)(p.ws + OFF_BAR), (volatile LAS unsigned*)(lds + 131072));
  if (p.ph_lo < 0) grid.sync();
  for (int ph = p.ph_lo; ph < p.ph_hi; ++ph) {
    for (int rep = 0; rep < 1 + ((PROBE_MASK >> (ph == 0 ? 6 : (ph - 1) % 6)) & 1); ++rep) {
    if (ph == 0) { if (EN_MASK & 1) prologue(p, lds); }
    else {
      const int l = (ph - 1) / 6, s = (ph - 1) % 6;
      if (s == 0) { if (EN_MASK & 2) phaseA(p, l, lds); }
      else if (s == 1) { if (EN_MASK & 4) attn_phase(p, l, lds); if (EN_MASK & 8) { const LP lp = make_lp(p, l); spatial_phase(lp, p.ws, lds); } }
      else if (s == 2 || s == 5) { if (EN_MASK & 16) phaseCE(p, l, s == 2, lds); }
      else if (s == 3) { if (EN_MASK & 32) phaseD(p, l, lds); }
      else { if (EN_MASK & 64) { const LP lp = make_lp(p, l); fixup_phase(lp, p.ws); } }
    }
    }
    if (ph + 1 < p.ph_hi) xcd_barrier(xbar);
  }
}

extern "C" void kernel_launch(void* const* d_in, const int* in_sizes, int n_in, void* d_out, int out_size, void* d_ws, size_t ws_size, hipStream_t stream) {
  static int grid_blocks = 0;
  if (!grid_blocks) {
    (void)hipFuncSetAttribute((const void*)k_run, hipFuncAttributeMaxDynamicSharedMemorySize, LDS_BYTES);
    int dev = 0, cus = 0, per_cu = 0; (void)hipGetDevice(&dev); (void)hipDeviceGetAttribute(&cus, hipDeviceAttributeMultiprocessorCount, dev);
    (void)hipOccupancyMaxActiveBlocksPerMultiprocessor(&per_cu, (const void*)k_run, 512, LDS_BYTES); if (per_cu < 1) per_cu = 1;
    grid_blocks = cus * per_cu; if (grid_blocks > 256) grid_blocks = 256;
  }
  MParams mp; memset(&mp, 0, sizeof(mp));
  for (int i = 0; i < 21; ++i) mp.in[i] = (const float*)d_in[i];
  mp.out = (float*)d_out; mp.ws = (unsigned char*)d_ws; mp.ph_lo = 0; mp.ph_hi = 1 + 6 * NLAYER;
  (void)hipMemsetAsync((unsigned char*)d_ws + OFF_BAR, 0, 3456 * sizeof(unsigned), stream);
  void* args[] = {&mp};
  hipError_t e = hipLaunchCooperativeKernel((const void*)k_run, dim3(grid_blocks), dim3(512), args, LDS_BYTES, stream);
  if (e != hipSuccess) fprintf(stderr, "cooperative launch failed: %s (grid %d)\n", hipGetErrorString(e), grid_blocks);
}
```

```cpp
#include <hip/hip_runtime.h>
#include <hip/hip_cooperative_groups.h>
#include <cstdio>
#include <cmath>
#include <cstring>

typedef unsigned short bf16_t;
#define DI __device__ __forceinline__

constexpr int T_TOK = 32768, DM = 1024, SEQ = 2048, DFF = 2816, INW = 2560, NLAYER = 4;
constexpr float EPS = 1e-6f;
constexpr float QSCALE = 0.125f * 1.4426950408889634f;

constexpr size_t MiB = 1024ull * 1024ull;
constexpr size_t OFF_XB = 0;
constexpr size_t OFF_R = 64 * MiB;
constexpr size_t OFF_U = OFF_R, OFF_Q = OFF_R + 32 * MiB, OFF_KB = OFF_R + 64 * MiB, OFF_GVT = OFF_R + 96 * MiB, OFF_VT = OFF_R + 128 * MiB, OFF_MIX = OFF_R + 160 * MiB;
constexpr size_t OFF_F = OFF_R, OFF_GB = OFF_R + 176 * MiB, OFF_PB = OFF_R + 188 * MiB, OFF_UB = OFF_R + 200 * MiB;
constexpr size_t OFF_W = 288 * MiB, W_STRIDE = 24 * MiB;
constexpr size_t WO_IN = 0, WO_OUT = 5 * MiB, WO_GU = 7 * MiB, WO_DN = 18 * MiB, WO_SP = 23 * MiB + 512 * 1024;
constexpr size_t OFF_SS1 = 384 * MiB, OFF_SS2 = OFF_SS1 + 256 * 1024, OFF_SSV = OFF_SS2 + 256 * 1024;
constexpr size_t OFF_BAR = 385 * MiB + 512 * 1024;
constexpr size_t OFF_TMP1 = 386 * MiB, OFF_TMP2 = 418 * MiB;

DI int tid_opaque() { int t = threadIdx.x; asm volatile("" : "+v"(t)); return t; }
DI float bf2f(bf16_t b) { return __uint_as_float(((unsigned)b) << 16); }
DI bf16_t f2bf(float f) { unsigned u = __float_as_uint(f); u += 0x7FFFu + ((u >> 16) & 1u); return (bf16_t)(u >> 16); }
DI float gelu_exact(float x) { return 0.5f * x * (1.0f + erff(x * 0.70710678118654752f)); }
DI int permpos16(int k) { return (k & 3) + 4 * (k >> 3) + 8 * ((k >> 2) & 1); }
DI float wave_sum(float v) { for (int o = 32; o >= 1; o >>= 1) v += __shfl_xor(v, o); return v; }

namespace pg8 {
#define PG8_LAS __attribute__((address_space(3)))
typedef unsigned short bf16_t;
typedef short bf16x8 __attribute__((ext_vector_type(8)));
typedef float f32x4 __attribute__((ext_vector_type(4)));
typedef unsigned u32x4 __attribute__((ext_vector_type(4)));
constexpr int BM = 256, BK = 64, HALF = 128, HTB = HALF * BK * 2  , STAGE_BYTES = 8 * HTB, NXCD = 8, WGM = 8;

__host__ __device__ __forceinline__ int lds_byte(int r, int c) { const int st = (r >> 4) * 2 + (c >> 5), rr = r & 15, cc = c & 31, ob = rr * 64 + cc * 2; return st * 1024 + (ob ^ (((ob >> 9) & 1) << 5)); }
__host__ __device__ __forceinline__ void stage_rc(int b, int& R, int& C) { const int st = b / 1024, sb = b % 1024, swz = sb ^ (((sb >> 9) & 1) << 5); R = (st >> 1) * 16 + swz / 64; C = (st & 1) * 32 + (swz % 64) / 2; }
__host__ __device__ __forceinline__ int perm32(int rho) { const int n = rho >> 4, i = rho & 15; return 8 * (i >> 2) + 4 * n + (i & 3); }

struct Unit { int pm, pn; };
struct Gemm { const bf16_t* A; const bf16_t* Bt; int M, N, K; };

struct StaticOrder {
    int nM, nN, nwg, G, c;
    __host__ __device__ void init(int M, int N, int G_, int c_) { nM = M / BM; nN = N / BM; nwg = nM * nN; G = G_; c = c_; }
    __host__ __device__ bool next(int i, Unit& u) const {
        const long L = (long)i * G + c; if (L >= nwg) return false;
        int wgid = (int)L; { const int q = nwg / NXCD, r = nwg % NXCD, xcd = wgid % NXCD, off = wgid / NXCD; wgid = (xcd < r ? xcd * (q + 1) : r * (q + 1) + (xcd - r) * q) + off; }
        const int nig = WGM * nN, gid = wgid / nig, fm = gid * WGM, gsz = (nM - fm) < WGM ? (nM - fm) : WGM;
        u.pm = fm + ((wgid % nig) % gsz); u.pn = (wgid % nig) / gsz; return true;
    }
    __device__ __forceinline__ void a_ready(const Unit&) const {}
    __device__ __forceinline__ void done(const Unit&) const {}
};
template <class Epi, class Sched>
__device__ __forceinline__ void gemm_phase(PG8_LAS unsigned char* lds, const Gemm g, const Sched& S, const Epi& E) {
    const int tid = tid_opaque(), wid = __builtin_amdgcn_readfirstlane(tid >> 6), lane = tid & 63, wr = wid >> 2, wc = wid & 3, fr = lane & 15, fq = lane >> 4;
    const int K = g.K, nt = K / BK;
    unsigned voffA[2], voffB[2];
#pragma unroll
    for (int i = 0; i < 2; ++i) { int R, C; stage_rc(tid * 16 + i * 8192, R, C); const int Rb = Epi::PERM ? ((R & ~31) + perm32(R & 31)) : R;
        voffA[i] = (unsigned)(R * K + C) * 2u; voffB[i] = (unsigned)(Rb * K + C) * 2u; }
    const size_t kstep = (size_t)(BK * 2);
    const size_t hstep = (size_t)HALF * K * 2;
    const size_t tstep = 2 * hstep;
    const unsigned ldsw = (unsigned)wid * 1024u;
    const int aoff = lds_byte(wr * 64 + fr, fq * 8), boff = lds_byte(wc * 32 + fr, fq * 8);
#define PG8_SA(b, h) (((b) * 2 + (h)) * HTB)
#define PG8_SB(b, h) ((4 + (b) * 2 + (h)) * HTB)
#define PG8_STAGE(bufoff, gbase, voff) do { _Pragma("unroll") for (int _i = 0; _i < 2; ++_i) \
        __builtin_amdgcn_global_load_lds((const unsigned*)((const char*)(gbase) + (voff)[_i]), (PG8_LAS unsigned*)(lds + (bufoff) + ldsw + _i * 8192), 16, 0, 0); } while (0)
#define PG8_LDA(dst, b, h) do { _Pragma("unroll") for (int m = 0; m < 4; ++m) _Pragma("unroll") for (int k = 0; k < 2; ++k) dst[m][k] = *(const PG8_LAS bf16x8*)(lds + PG8_SA(b, h) + aoff + m * 2048 + k * 1024); } while (0)
#define PG8_LDB(dst, b, h) do { _Pragma("unroll") for (int n = 0; n < 2; ++n) _Pragma("unroll") for (int k = 0; k < 2; ++k) dst[n][k] = *(const PG8_LAS bf16x8*)(lds + PG8_SB(b, h) + boff + n * 2048 + k * 1024); } while (0)
#define PG8_MMA(ai, bj, At, Bt) do { __builtin_amdgcn_s_setprio(1); _Pragma("unroll") for (int m = 0; m < 4; ++m) _Pragma("unroll") for (int n = 0; n < 2; ++n) _Pragma("unroll") for (int k = 0; k < 2; ++k) \
        acc[ai][bj][m][n] = __builtin_amdgcn_mfma_f32_16x16x32_bf16(Bt[n][k], At[m][k], acc[ai][bj][m][n], 0, 0, 0); __builtin_amdgcn_s_setprio(0); } while (0)
#define PG8_WAIT_V(n) asm volatile("s_waitcnt vmcnt(" #n ")" ::: "memory")
#define PG8_WAIT_L(n) asm volatile("s_waitcnt lgkmcnt(" #n ")" ::: "memory")
#define PG8_BAR __builtin_amdgcn_s_barrier()
#define PG8_SCHED __builtin_amdgcn_sched_barrier(0)
    Unit cur, nxt; int ui = 0;
    if (!S.next(0, cur)) return;
    f32x4 acc[2][2][4][2];
#pragma unroll
    for (int a = 0; a < 2; ++a)
#pragma unroll
        for (int b = 0; b < 2; ++b)
#pragma unroll
            for (int m = 0; m < 4; ++m)
#pragma unroll
                for (int n = 0; n < 2; ++n) acc[a][b][m][n] = (f32x4){0.f, 0.f, 0.f, 0.f};
    bf16x8 At[4][2], B0[2][2], B1[2][2];
    const char* cA = (const char*)g.A + (size_t)cur.pm * tstep; const char* cB = (const char*)g.Bt + (size_t)cur.pn * tstep;
    S.a_ready(cur);
    PG8_STAGE(PG8_SB(0, 0), cB, voffB); PG8_STAGE(PG8_SA(0, 0), cA, voffA); PG8_STAGE(PG8_SB(0, 1), cB + hstep, voffB); PG8_STAGE(PG8_SA(0, 1), cA + hstep, voffA);
    if (wr == 1) PG8_BAR;
    PG8_WAIT_V(4); PG8_BAR;
    PG8_STAGE(PG8_SB(1, 0), cB + kstep, voffB); PG8_STAGE(PG8_SA(1, 0), cA + kstep, voffA); PG8_STAGE(PG8_SB(1, 1), cB + hstep + kstep, voffB);
    PG8_WAIT_V(6); PG8_BAR;
    for (;;) {
        const bool has_next = S.next(ui + 1, nxt);
        const char* nA = has_next ? (const char*)g.A + (size_t)nxt.pm * tstep : cA; const char* nB = has_next ? (const char*)g.Bt + (size_t)nxt.pn * tstep : cB;
        for (int t = 0; t < nt; t += 2) {
            const bool last = (t == nt - 2);
            const char* a1 = cA + (size_t)(t + 1) * kstep;
            const char* a2 = last ? nA : cA + (size_t)(t + 2) * kstep; const char* b2 = last ? nB : cB + (size_t)(t + 2) * kstep;
            const char* a3 = a2 + kstep; const char* b3 = b2 + kstep;
            if (last && has_next) S.a_ready(nxt);
            PG8_LDB(B0, 0, 0); PG8_SCHED; PG8_LDA(At, 0, 0); PG8_STAGE(PG8_SA(1, 1), a1 + hstep, voffA);
            PG8_WAIT_L(8); PG8_BAR; PG8_WAIT_L(0); PG8_MMA(0, 0, At, B0); PG8_BAR; PG8_SCHED;
            PG8_LDB(B1, 0, 1); PG8_STAGE(PG8_SB(0, 0), b2, voffB);
            PG8_BAR; PG8_WAIT_L(0); PG8_MMA(0, 1, At, B1); PG8_BAR;
            PG8_LDA(At, 0, 1); PG8_STAGE(PG8_SA(0, 0), a2, voffA);
            PG8_BAR; PG8_WAIT_L(0); PG8_MMA(1, 0, At, B0); PG8_BAR; PG8_SCHED;
            PG8_STAGE(PG8_SB(0, 1), b2 + hstep, voffB);
            PG8_WAIT_V(6); PG8_BAR; PG8_MMA(1, 1, At, B1); PG8_BAR;
            PG8_LDB(B0, 1, 0); PG8_SCHED; PG8_LDA(At, 1, 0); PG8_STAGE(PG8_SA(0, 1), a2 + hstep, voffA);
            PG8_WAIT_L(8); PG8_BAR; PG8_WAIT_L(0); PG8_MMA(0, 0, At, B0); PG8_BAR; PG8_SCHED;
            PG8_LDB(B1, 1, 1); PG8_STAGE(PG8_SB(1, 0), b3, voffB);
            PG8_BAR; PG8_WAIT_L(0); PG8_MMA(0, 1, At, B1); PG8_BAR;
            PG8_LDA(At, 1, 1); PG8_STAGE(PG8_SA(1, 0), a3, voffA);
            PG8_BAR; PG8_WAIT_L(0); PG8_MMA(1, 0, At, B0); PG8_BAR; PG8_SCHED;
            PG8_STAGE(PG8_SB(1, 1), b3 + hstep, voffB);
            PG8_WAIT_V(6); PG8_BAR; PG8_MMA(1, 1, At, B1); PG8_BAR;
        }
        if constexpr (!Epi::AFTER_DRAIN) { if (!Epi::TWICE || (ui & 1)) E(acc, cur, wr, wc, fr, fq); S.done(cur); }
        if (!has_next) break;
#pragma unroll
        for (int a = 0; a < 2; ++a)
#pragma unroll
            for (int b = 0; b < 2; ++b)
#pragma unroll
                for (int m = 0; m < 4; ++m)
#pragma unroll
                    for (int n = 0; n < 2; ++n) acc[a][b][m][n] = (f32x4){0.f, 0.f, 0.f, 0.f};
        cur = nxt; cA = nA; cB = nB; ++ui;
    }
    PG8_WAIT_V(0);
    if (wr == 0) PG8_BAR;
    PG8_BAR;
    if constexpr (Epi::AFTER_DRAIN) { E.fused(acc, cur, wr, wc, fr, fq, lds, wid, lane); S.done(cur); }
#undef PG8_SA
#undef PG8_SB
#undef PG8_STAGE
#undef PG8_LDA
#undef PG8_LDB
#undef PG8_MMA
#undef PG8_WAIT_V
#undef PG8_WAIT_L
#undef PG8_BAR
#undef PG8_SCHED
}
}

namespace cg = cooperative_groups;
using pg8::f32x4; using pg8::bf16x8; using pg8::Unit;
typedef unsigned u32x2_t __attribute__((ext_vector_type(2)));
typedef unsigned u32x4_t __attribute__((ext_vector_type(4)));
typedef float f32x16 __attribute__((ext_vector_type(16)));
typedef float f32x2_t __attribute__((ext_vector_type(2)));
#define LAS PG8_LAS
constexpr int LDS_BYTES = 163840;
#ifndef EN_MASK
#define EN_MASK 0x7f
#endif
#ifndef PROBE_EPI_ACE
#define PROBE_EPI_ACE 0
#endif
#ifndef PROBE_EPI_D
#define PROBE_EPI_D 0
#endif
#ifndef PROBE_SYNC
#define PROBE_SYNC 0
#endif
#ifndef PROBE_MASK
#define PROBE_MASK 0x00
#endif

DI unsigned pk2(float lo, float hi) { unsigned r; asm volatile("s_nop 0\n\tv_cvt_pk_bf16_f32 %0, %1, %2\n\ts_nop 1" : "=v"(r) : "v"(lo), "v"(hi)); return r; }
DI float bflo(unsigned w) { return __uint_as_float(w << 16); }
DI float bfhi(unsigned w) { return __uint_as_float(w & 0xffff0000u); }
DI float gelu1(float v) {
  const float av = fabsf(v), t = __builtin_amdgcn_rcpf(av * 0.2316418882f + 1.0f);
  float q = t * 0.5307027145f + (-0.7265760135f); q = q * t + 0.7107068705f; q = q * t + (-0.142248368f); q = q * t + 0.127414796f; q = q * t;
  const float e = __builtin_amdgcn_exp2f((v * v) * (-0.72134752044f));
  const float m = v * (q * e);
  return v < 0.f ? m : v - m;
}
DI float dpp_ror1(float v) { return __builtin_bit_cast(float, __builtin_amdgcn_update_dpp(0, __builtin_bit_cast(int, v), 0x121, 0xf, 0xf, false)); }
DI float dpp_ror2(float v) { return __builtin_bit_cast(float, __builtin_amdgcn_update_dpp(0, __builtin_bit_cast(int, v), 0x122, 0xf, 0xf, false)); }
DI float row_sum16(float v) {
  v += __builtin_bit_cast(float, __builtin_amdgcn_update_dpp(0, __builtin_bit_cast(int, v), 0x128, 0xf, 0xf, false));
  v += __builtin_bit_cast(float, __builtin_amdgcn_update_dpp(0, __builtin_bit_cast(int, v), 0x124, 0xf, 0xf, false));
  v += __builtin_bit_cast(float, __builtin_amdgcn_update_dpp(0, __builtin_bit_cast(int, v), 0x122, 0xf, 0xf, false));
  v += __builtin_bit_cast(float, __builtin_amdgcn_update_dpp(0, __builtin_bit_cast(int, v), 0x121, 0xf, 0xf, false));
  return v; }
typedef unsigned long long u64;
DI float fx2f(u64 v) { return (float)v * (1.0f / 1048576.0f); }
DI u64 f2fx(float v) { return (u64)(v * 1048576.0f + 0.5f); }
DI void fx_add(u64* p, float v) { __hip_atomic_fetch_add(p, f2fx(v), __ATOMIC_RELAXED, __HIP_MEMORY_SCOPE_AGENT); }
DI float rs1024(u64 ss) { return rsqrtf(fx2f(ss) * (1.0f / 1024.0f) + EPS); }

struct MParams { const float* in[21]; float* out; unsigned char* ws; int ph_lo, ph_hi; };
struct LP {
  const float *norm_attn_w, *w_in, *v_norm_w, *sp_w, *sp_b, *out_norm_w, *q_norm_w, *k_norm_w, *lq1, *lk1, *lq2, *lk2, *diff_norm_w, *w_out, *norm_ffn_w, *w_gate, *w_up, *conv_w, *conv_b, *w_down;
  float lambda_init;
  const bf16_t *WinT, *WoutT, *WguT, *WdT, *Wsp;
};
DI LP make_lp(const MParams& p, int l) {
  LP L;
  L.norm_attn_w = p.in[1] + (size_t)l * DM; L.w_in = p.in[2] + (size_t)l * DM * INW; L.v_norm_w = p.in[3] + (size_t)l * 512; L.sp_w = p.in[4] + (size_t)l * 65536; L.sp_b = p.in[5] + (size_t)l * 512;
  L.out_norm_w = p.in[6] + (size_t)l * 512; L.q_norm_w = p.in[7] + (size_t)l * 64; L.k_norm_w = p.in[8] + (size_t)l * 64; L.lq1 = p.in[9] + (size_t)l * 64; L.lk1 = p.in[10] + (size_t)l * 64;
  L.lq2 = p.in[11] + (size_t)l * 64; L.lk2 = p.in[12] + (size_t)l * 64; L.diff_norm_w = p.in[13] + (size_t)l * 128; L.w_out = p.in[14] + (size_t)l * DM * DM; L.norm_ffn_w = p.in[15] + (size_t)l * DM;
  L.w_gate = p.in[16] + (size_t)l * DM * DFF; L.w_up = p.in[17] + (size_t)l * DM * DFF; L.conv_w = p.in[18] + (size_t)l * 3 * DFF; L.conv_b = p.in[19] + (size_t)l * DFF; L.w_down = p.in[20] + (size_t)l * DFF * DM;
  L.lambda_init = 0.8f - 0.6f * expf(-0.3f * (float)(l + 1));
  const unsigned char* wb = p.ws + OFF_W + (size_t)l * W_STRIDE;
  L.WinT = (const bf16_t*)(wb + WO_IN); L.WoutT = (const bf16_t*)(wb + WO_OUT); L.WguT = (const bf16_t*)(wb + WO_GU); L.WdT = (const bf16_t*)(wb + WO_DN); L.Wsp = (const bf16_t*)(wb + WO_SP);
  return L;
}
DI float lam_of(const LP& lp) {
  const int lane = threadIdx.x & 63;
  float a = lp.lq1[lane] * lp.lk1[lane], b = lp.lq2[lane] * lp.lk2[lane];
  a = wave_sum(a); b = wave_sum(b);
  return expf(a) - expf(b) + lp.lambda_init;
}

DI void conv_item(bf16_t* dst, int K, int row, int kg, const float* src, int ld, int col, const float* ks) {
  float v[32];
#pragma unroll
  for (int i = 0; i < 32; ++i) v[i] = src[(size_t)(kg * 32 + i) * ld + col];
  if (ks) {
#pragma unroll
    for (int i = 0; i < 32; i += 4) { const f32x4 s = *(const f32x4*)(ks + kg * 32 + i); v[i] *= s[0]; v[i + 1] *= s[1]; v[i + 2] *= s[2]; v[i + 3] *= s[3]; }
  }
  u32x4_t* d = (u32x4_t*)(dst + (size_t)row * K + kg * 32);
#pragma unroll
  for (int i = 0; i < 4; ++i) { u32x4_t w; w.x = pk2(v[8 * i], v[8 * i + 1]); w.y = pk2(v[8 * i + 2], v[8 * i + 3]); w.z = pk2(v[8 * i + 4], v[8 * i + 5]); w.w = pk2(v[8 * i + 6], v[8 * i + 7]); d[i] = w; }
}
DI int perm_logical(int p) {
  const int bj = p >> 7, wc = (p >> 5) & 3, n = (p >> 4) & 1, fq = (p >> 2) & 3, e = p & 3;
  return 64 * wc + 32 * bj + 8 * fq + 4 * n + e;
}
DI int perm_res(int p) { return (p & ~31) + 8 * ((p >> 2) & 3) + 4 * ((p >> 4) & 1) + (p & 3); }
DI void prologue(const MParams& p, LAS unsigned char* lds) {
  const int tidp = tid_opaque(); const int gtid = blockIdx.x * 512 + tidp, gsz = gridDim.x * 512;
  unsigned char* ws = p.ws;
  { const int gw = gtid >> 6, nw = gsz >> 6, lane = threadIdx.x & 63; bf16_t* XB = (bf16_t*)(ws + OFF_XB); u64* SS1 = (u64*)(ws + OFF_SS1);
    for (int row = gw; row < T_TOK; row += nw) { const float* xp = p.in[0] + (size_t)row * DM; float s = 0.f;
#pragma unroll
      for (int i = 0; i < 4; ++i) { const f32x4 v = *(const f32x4*)(xp + i * 256 + lane * 4); s += v[0] * v[0] + v[1] * v[1] + v[2] * v[2] + v[3] * v[3];
        u32x2_t w; w.x = pk2(v[0], v[1]); w.y = pk2(v[2], v[3]); *(u32x2_t*)(XB + (size_t)row * DM + i * 256 + lane * 4) = w; }
      s = wave_sum(s); if (lane == 0) SS1[row] = f2fx(s); } }
  { u64* SSV = (u64*)(ws + OFF_SSV); for (int i = gtid; i < T_TOK * 4; i += gsz) SSV[i] = 0ull; }
  { const int lane = tidp & 63, wv = tidp >> 6, n4 = lane & 15, kq = lane >> 4; LAS unsigned char* wl = lds + wv * 9216;
    for (int t = blockIdx.x * 8 + wv; t < NLAYER * 3008; t += gridDim.x * 8) {
      const int l = t / 3008; int r = t - l * 3008; const LP lp = make_lp(p, l);
      const float* src; const float* ks; bf16_t* dst; int ld, K, rt, kt, col;
      if (r < 640) { rt = r % 40; kt = r / 40; dst = (bf16_t*)lp.WinT; K = 1024; ld = INW; ks = lp.norm_attn_w; src = lp.w_in; const int row = 64 * rt + 4 * n4;
        if (row < 1536) { const int L = (row & ~255) + perm_logical(row & 255); col = L < 512 ? L : L + 512; } else { const int q = row - 1536; col = q < 512 ? 512 + q : 1536 + q; } }
      else if (r < 896) { r -= 640; rt = r & 15; kt = r >> 4; dst = (bf16_t*)lp.WoutT; K = 1024; ld = DM; ks = nullptr; src = lp.w_out; col = perm_res(64 * rt + 4 * n4); }
      else if (r < 2304) { r -= 896; rt = r % 88; kt = r / 88; dst = (bf16_t*)lp.WguT; K = 1024; ld = DFF; ks = lp.norm_ffn_w; const int row = 64 * rt + 4 * n4, pn = row >> 8, pp = row & 255;
        src = (pp >> 7) ? lp.w_up : lp.w_gate; const int q = pp & 127; col = 128 * pn + 32 * ((q >> 5) & 3) + 8 * ((q >> 2) & 3) + 4 * ((q >> 4) & 1) + (q & 3); }
      else { r -= 2304; rt = r & 15; kt = r >> 4; dst = (bf16_t*)lp.WdT; K = DFF; ld = DM; ks = nullptr; src = lp.w_down; col = perm_res(64 * rt + 4 * n4); }
      const float* sp = src + (size_t)(64 * kt + 16 * kq) * ld + col;
      f32x4 v[16];
#pragma unroll
      for (int j = 0; j < 16; ++j) v[j] = *(const f32x4*)(sp + (size_t)j * ld);
      if (ks) {
#pragma unroll
        for (int i = 0; i < 4; ++i) { const f32x4 sc = *(const f32x4*)(ks + 64 * kt + 16 * kq + 4 * i); v[4 * i] *= sc[0]; v[4 * i + 1] *= sc[1]; v[4 * i + 2] *= sc[2]; v[4 * i + 3] *= sc[3]; } }
#pragma unroll
      for (int n = 0; n < 4; ++n)
#pragma unroll
        for (int hh = 0; hh < 2; ++hh) { u32x4_t w; w.x = pk2(v[8 * hh][n], v[8 * hh + 1][n]); w.y = pk2(v[8 * hh + 2][n], v[8 * hh + 3][n]); w.z = pk2(v[8 * hh + 4][n], v[8 * hh + 5][n]); w.w = pk2(v[8 * hh + 6][n], v[8 * hh + 7][n]);
          *(LAS u32x4_t*)(wl + (4 * n4 + n) * 144 + (16 * kq + 8 * hh) * 2) = w; }
#pragma unroll
      for (int i = 0; i < 8; ++i) { const int row = 8 * i + (lane >> 3), pc = lane & 7; const u32x4_t w = *(const LAS u32x4_t*)(wl + row * 144 + pc * 16);
        *(u32x4_t*)(dst + (size_t)(64 * rt + row) * K + 64 * kt + pc * 8) = w; }
    }
  }
  for (int l = 0; l < NLAYER; ++l) { const LP lp = make_lp(p, l);
    for (int i = gtid; i < 65536; i += gsz) { const int jj = i & 127, ii = (i >> 7) & 127; ((bf16_t*)lp.Wsp)[i] = ((jj >> 6) <= (ii >> 6)) ? f2bf(lp.sp_w[i]) : (bf16_t)0; } }
}

struct DupOrder : pg8::StaticOrder {
  __device__ bool next(int i, Unit& u) const { return pg8::StaticOrder::next(i >> 1, u); }
};
struct EpiResid {
  static constexpr bool PERM = false, AFTER_DRAIN = false, TWICE = (PROBE_EPI_ACE != 0);
  const float* base32; float* out32; bf16_t* XB; u64* SS;
  DI void operator()(const f32x4 (&acc)[2][2][4][2], const Unit& u, int wr, int wc, int fr, int fq) const {
    const int row0 = u.pm * 256 + wr * 64 + fr, col0 = u.pn * 256 + wc * 32 + 8 * fq;
    if (base32) {
      f32x4 nb[2][2];
#pragma unroll
      for (int bj = 0; bj < 2; ++bj)
#pragma unroll
        for (int n = 0; n < 2; ++n) nb[bj][n] = *(const f32x4*)(base32 + (size_t)row0 * DM + col0 + bj * 128 + n * 4);
#pragma unroll
      for (int g = 0; g < 8; ++g) { const int ai = g >> 2, m = g & 3; const int row = row0 + ai * 128 + m * 16; const size_t ro = (size_t)row * DM + col0; float ss = 0.f;
        f32x4 cbv[2][2];
#pragma unroll
        for (int bj = 0; bj < 2; ++bj)
#pragma unroll
          for (int n = 0; n < 2; ++n) cbv[bj][n] = nb[bj][n];
        if (g < 7) { const int r2 = row0 + ((g + 1) >> 2) * 128 + ((g + 1) & 3) * 16;
#pragma unroll
          for (int bj = 0; bj < 2; ++bj)
#pragma unroll
            for (int n = 0; n < 2; ++n) nb[bj][n] = *(const f32x4*)(base32 + (size_t)r2 * DM + col0 + bj * 128 + n * 4); }
#pragma unroll
        for (int bj = 0; bj < 2; ++bj) { const f32x4 v0 = acc[ai][bj][m][0] + cbv[bj][0], v1 = acc[ai][bj][m][1] + cbv[bj][1];
          u32x4_t w; w.x = pk2(v0[0], v0[1]); w.y = pk2(v0[2], v0[3]); w.z = pk2(v1[0], v1[1]); w.w = pk2(v1[2], v1[3]); *(u32x4_t*)(XB + ro + bj * 128) = w;
          ss += ((v0[0] * v0[0] + v0[1] * v0[1]) + (v0[2] * v0[2] + v0[3] * v0[3])) + ((v1[0] * v1[0] + v1[1] * v1[1]) + (v1[2] * v1[2] + v1[3] * v1[3])); }
        ss += __shfl_xor(ss, 16); ss += __shfl_xor(ss, 32); if (fq == 0) fx_add(SS + row, ss);
        asm volatile("" ::: "memory"); }
    } else {
      u32x4_t nb[2];
#pragma unroll
      for (int bj = 0; bj < 2; ++bj) nb[bj] = *(const u32x4_t*)(XB + (size_t)row0 * DM + col0 + bj * 128);
#pragma unroll
      for (int g = 0; g < 8; ++g) { const int ai = g >> 2, m = g & 3; const int row = row0 + ai * 128 + m * 16; const size_t ro = (size_t)row * DM + col0; float ss = 0.f;
        u32x4_t cbv[2];
#pragma unroll
        for (int bj = 0; bj < 2; ++bj) cbv[bj] = nb[bj];
        if (g < 7) { const int r2 = row0 + ((g + 1) >> 2) * 128 + ((g + 1) & 3) * 16;
#pragma unroll
          for (int bj = 0; bj < 2; ++bj) nb[bj] = *(const u32x4_t*)(XB + (size_t)r2 * DM + col0 + bj * 128); }
#pragma unroll
        for (int bj = 0; bj < 2; ++bj) { const u32x4_t c = cbv[bj];
          const f32x4 v0 = acc[ai][bj][m][0] + (f32x4){bflo(c.x), bfhi(c.x), bflo(c.y), bfhi(c.y)}, v1 = acc[ai][bj][m][1] + (f32x4){bflo(c.z), bfhi(c.z), bflo(c.w), bfhi(c.w)};
          if (out32) { *(f32x4*)(out32 + ro + bj * 128) = v0; *(f32x4*)(out32 + ro + bj * 128 + 4) = v1; }
          else { u32x4_t w; w.x = pk2(v0[0], v0[1]); w.y = pk2(v0[2], v0[3]); w.z = pk2(v1[0], v1[1]); w.w = pk2(v1[2], v1[3]); *(u32x4_t*)(XB + ro + bj * 128) = w;
            ss += ((v0[0] * v0[0] + v0[1] * v0[1]) + (v0[2] * v0[2] + v0[3] * v0[3])) + ((v1[0] * v1[0] + v1[1] * v1[1]) + (v1[2] * v1[2] + v1[3] * v1[3])); } }
        if (!out32) { ss += __shfl_xor(ss, 16); ss += __shfl_xor(ss, 32); if (fq == 0) fx_add(SS + row, ss); }
        asm volatile("" ::: "memory"); }
    }
  }
};
struct EpiA1 {
  static constexpr bool PERM = false, AFTER_DRAIN = false, TWICE = (PROBE_EPI_ACE != 0);
  const u64* SS1; bf16_t *U, *Q, *KB; const float *qw, *kw;
  DI void operator()(const f32x4 (&acc)[2][2][4][2], const Unit& u, int wr, int wc, int fr, int fq) const {
    const int row0 = u.pm * 256 + wr * 64 + fr, lc0 = wc * 64 + 8 * fq, region = u.pn >> 1;
    u64 rsv[8];
#pragma unroll
    for (int g = 0; g < 8; ++g) rsv[g] = SS1[row0 + (g >> 2) * 128 + (g & 3) * 16];
    if (region == 0) {
#pragma unroll
      for (int g = 0; g < 8; ++g) { const int ai = g >> 2, m = g & 3; const int row = row0 + ai * 128 + m * 16; const float rs = rs1024(rsv[g]);
#pragma unroll
        for (int bj = 0; bj < 2; ++bj) { const f32x4 a = acc[ai][bj][m][0] * rs, b = acc[ai][bj][m][1] * rs; u32x4_t w;
          w.x = pk2(gelu1(a[0]), gelu1(a[1])); w.y = pk2(gelu1(a[2]), gelu1(a[3])); w.z = pk2(gelu1(b[0]), gelu1(b[1])); w.w = pk2(gelu1(b[2]), gelu1(b[3]));
          *(u32x4_t*)(U + (size_t)row * 512 + u.pn * 256 + lc0 + 32 * bj) = w; } }
    } else {
      const bool isq = region == 1; const float* wp = (isq ? qw : kw) + 8 * fq; bf16_t* dst = (isq ? Q : KB) + (u.pn & 1) * 256 + lc0; const float sc = isq ? QSCALE : 1.0f;
      f32x4 wv[2][2];
#pragma unroll
      for (int bj = 0; bj < 2; ++bj)
#pragma unroll
        for (int n = 0; n < 2; ++n) wv[bj][n] = *(const f32x4*)(wp + 32 * bj + 4 * n);
#pragma unroll
      for (int g = 0; g < 8; ++g) { const int ai = g >> 2, m = g & 3; const int row = row0 + ai * 128 + m * 16; const float rs = rs1024(rsv[g]); float ss = 0.f; f32x4 v[2][2];
#pragma unroll
        for (int bj = 0; bj < 2; ++bj)
#pragma unroll
          for (int n = 0; n < 2; ++n) { v[bj][n] = acc[ai][bj][m][n] * rs; const f32x4 t = v[bj][n]; ss += (t[0] * t[0] + t[1] * t[1]) + (t[2] * t[2] + t[3] * t[3]); }
        ss += __shfl_xor(ss, 16); ss += __shfl_xor(ss, 32);
        const float r2 = rsqrtf(ss * (1.0f / 64.0f) + EPS) * sc;
#pragma unroll
        for (int bj = 0; bj < 2; ++bj) { const f32x4 a = v[bj][0] * r2 * wv[bj][0], b = v[bj][1] * r2 * wv[bj][1]; u32x4_t w;
          w.x = pk2(a[0], a[1]); w.y = pk2(a[2], a[3]); w.z = pk2(b[0], b[1]); w.w = pk2(b[2], b[3]);
          *(u32x4_t*)(dst + (size_t)row * 512 + 32 * bj) = w; } }
    }
  }
};
struct EpiA2 {
  static constexpr bool PERM = false, AFTER_DRAIN = false, TWICE = (PROBE_EPI_ACE != 0);
  const u64* SS1; bf16_t *GVT, *VT; u64* SSV;
  DI void operator()(const f32x4 (&acc)[2][2][4][2], const Unit& u, int wr, int wc, int fr, int fq) const {
    const int colbase = u.pn * 256 + wc * 32;
    f32x4 rs[2][2];
#pragma unroll
    for (int bj = 0; bj < 2; ++bj)
#pragma unroll
      for (int n = 0; n < 2; ++n) { const u64* sp = SS1 + colbase + bj * 128 + n * 16 + 4 * fq; rs[bj][n] = (f32x4){rs1024(sp[0]), rs1024(sp[1]), rs1024(sp[2]), rs1024(sp[3])}; }
    if (u.pm < 2) {
#pragma unroll
      for (int ai = 0; ai < 2; ++ai) { const int head = 2 * u.pm + ai;
#pragma unroll
        for (int bj = 0; bj < 2; ++bj)
#pragma unroll
          for (int n = 0; n < 2; ++n) { f32x4 sq = (f32x4){0.f, 0.f, 0.f, 0.f}; const int tok = colbase + bj * 128 + n * 16 + 4 * fq;
#pragma unroll
            for (int m = 0; m < 4; ++m) { const int row = u.pm * 256 + ai * 128 + wr * 64 + m * 16 + fr;
              const f32x4 a = acc[ai][bj][m][n] * rs[bj][n]; f32x4 g; g[0] = gelu1(a[0]); g[1] = gelu1(a[1]); g[2] = gelu1(a[2]); g[3] = gelu1(a[3]);
              u32x2_t w; w.x = pk2(g[0], g[1]); w.y = pk2(g[2], g[3]); *(u32x2_t*)(GVT + (size_t)row * T_TOK + tok) = w; sq += g * g; }
#pragma unroll
            for (int e = 0; e < 4; ++e) sq[e] = row_sum16(sq[e]);
            if (fr == 0) {
#pragma unroll
              for (int e = 0; e < 4; ++e) fx_add(SSV + (size_t)(tok + e) * 4 + head, sq[e]); }
            asm volatile("" ::: "memory"); } }
    } else {
#pragma unroll
      for (int ai = 0; ai < 2; ++ai)
#pragma unroll
        for (int m = 0; m < 4; ++m) { const int row = (u.pm - 2) * 256 + ai * 128 + wr * 64 + m * 16 + fr;
#pragma unroll
          for (int bj = 0; bj < 2; ++bj)
#pragma unroll
            for (int n = 0; n < 2; ++n) { const f32x4 a = acc[ai][bj][m][n] * rs[bj][n]; u32x2_t w; w.x = pk2(a[0], a[1]); w.y = pk2(a[2], a[3]);
              *(u32x2_t*)(VT + (size_t)row * T_TOK + colbase + bj * 128 + n * 16 + 8 * (fq & 1) + 4 * (fq >> 1)) = w; } }
    }
  }
};
struct EpiD {
  static constexpr bool PERM = false, AFTER_DRAIN = false, TWICE = (PROBE_EPI_D != 0);
  const u64* SS2; const float *cw, *cb; bf16_t* F; float *GB, *PB, *UB;
  DI void operator()(const f32x4 (&acc)[2][2][4][2], const Unit& u, int wr, int wc, int fr, int fq) const {
    const int cbase = u.pn * 128 + wc * 32 + 8 * fq;
    const int rb0 = u.pm * 256 + wr * 64;
    u64 rsv[8]; f32x4 w0[2], w1[2], w2[2], bb[2];
#pragma unroll
    for (int g = 0; g < 8; ++g) rsv[g] = SS2[rb0 + (g >> 2) * 128 + (g & 3) * 16 + fr];
#pragma unroll
    for (int n = 0; n < 2; ++n) { w0[n] = *(const f32x4*)(cw + cbase + 4 * n); w1[n] = *(const f32x4*)(cw + DFF + cbase + 4 * n); w2[n] = *(const f32x4*)(cw + 2 * DFF + cbase + 4 * n); bb[n] = *(const f32x4*)(cb + cbase + 4 * n); }
#pragma unroll
    for (int ai = 0; ai < 2; ++ai) {
      const int rb = rb0 + ai * 128, bd = rb >> 6;
      float rs[4];
#pragma unroll
      for (int m = 0; m < 4; ++m) rs[m] = rs1024(rsv[ai * 4 + m]);
      unsigned fo[4][4];
#pragma unroll
      for (int n = 0; n < 2; ++n) {
        const int cn = cbase + 4 * n;
        f32x4 pg, ug, gg; float fv[4][4];
#pragma unroll
        for (int e = 0; e < 4; ++e) {
          float G[4], r1[4], r2[4];
#pragma unroll
          for (int m = 0; m < 4; ++m) { G[m] = acc[ai][0][m][n][e] * rs[m]; r1[m] = dpp_ror1(G[m]); r2[m] = dpp_ror2(G[m]); }
#pragma unroll
          for (int m = 0; m < 4; ++m) {
            const float p1 = (fr >= 1) ? r1[m] : (m > 0 ? r1[m > 0 ? m - 1 : 0] : 0.f);
            const float p2 = (fr >= 2) ? r2[m] : (m > 0 ? r2[m > 0 ? m - 1 : 0] : 0.f);
            const float g = w2[n][e] * G[m] + w1[n][e] * p1 + w0[n][e] * p2 + bb[n][e];
            const float uv = acc[ai][1][m][n][e] * rs[m];
            if (m == 0) { pg[e] = g; ug[e] = uv; }
            if (m == 3) gg[e] = G[3];
            fv[m][e] = g * __builtin_amdgcn_rcpf(1.0f + __expf(-g)) * uv;
          }
        }
#pragma unroll
        for (int m = 0; m < 4; ++m) { fo[m][2 * n] = pk2(fv[m][0], fv[m][1]); fo[m][2 * n + 1] = pk2(fv[m][2], fv[m][3]); }
        if (fr < 2) { *(f32x4*)(PB + (size_t)(bd * 2 + fr) * DFF + cn) = pg; *(f32x4*)(UB + (size_t)(bd * 2 + fr) * DFF + cn) = ug; }
        if (fr >= 14) { *(f32x4*)(GB + (size_t)(bd * 2 + fr - 14) * DFF + cn) = gg; }
      }
#pragma unroll
      for (int m = 0; m < 4; ++m) {
        if (!(m == 0 && fr < 2)) { u32x4_t w; w.x = fo[m][0]; w.y = fo[m][1]; w.z = fo[m][2]; w.w = fo[m][3]; *(u32x4_t*)(F + (size_t)(rb + 16 * m + fr) * DFF + cbase) = w; }
      }
    }
  }
};
DI void fixup_phase(const LP& lp, unsigned char* ws, int vcu, int loc) {
  const float *GB = (const float*)(ws + OFF_GB), *PB = (const float*)(ws + OFF_PB), *UB = (const float*)(ws + OFF_UB); bf16_t* F = (bf16_t*)(ws + OFF_F);
  const int t_ = tid_opaque(); const int w0 = loc ? (vcu >> 5) * 90112 + (vcu & 31) * 512 + t_ : blockIdx.x * 512 + t_, wend = loc ? ((vcu >> 5) + 1) * 90112 : 512 * 2 * 704, gsz = loc ? 32 * 512 : gridDim.x * 512;
  for (int w = w0; w < wend; w += gsz) {
    const int c = (w % 704) * 4, j = (w / 704) & 1, bd = w / 1408;
    f32x4 g = *(const f32x4*)(PB + (size_t)(bd * 2 + j) * DFF + c);
    if (bd & 31) { const f32x4 gm1 = *(const f32x4*)(GB + (size_t)((bd - 1) * 2 + 1) * DFF + c); const f32x4 w0 = *(const f32x4*)(lp.conv_w + c);
      if (j == 0) { const f32x4 gm2 = *(const f32x4*)(GB + (size_t)((bd - 1) * 2) * DFF + c); const f32x4 w1 = *(const f32x4*)(lp.conv_w + DFF + c); g += w1 * gm1 + w0 * gm2; }
      else g += w0 * gm1; }
    const f32x4 uv = *(const f32x4*)(UB + (size_t)(bd * 2 + j) * DFF + c); float f[4];
#pragma unroll
    for (int e = 0; e < 4; ++e) f[e] = g[e] * __builtin_amdgcn_rcpf(1.0f + __expf(-g[e])) * uv[e];
    u32x2_t o; o.x = pk2(f[0], f[1]); o.y = pk2(f[2], f[3]);
    *(u32x2_t*)(F + (size_t)(bd * 64 + j) * DFF + c) = o;
  }
}

DI void spatial_phase(const LP& lp, unsigned char* ws, LAS unsigned char* lds, int vcu, int loc) {
  const bf16_t *U = (const bf16_t*)(ws + OFF_U), *GVT = (const bf16_t*)(ws + OFF_GVT); const u64* SSV = (const u64*)(ws + OFF_SSV); bf16_t* MIX = (bf16_t*)(ws + OFF_MIX);
  constexpr int TB = 32768;
  LAS float* sr = (LAS float*)(lds + 2 * TB);
  const int tid = tid_opaque(), lane = tid & 63, w = __builtin_amdgcn_readfirstlane(tid >> 6), l15 = lane & 15, kq = lane >> 4;
#define SP_STAGE(item, buf) do { const int h_ = (item) & 3, t_ = ((item) >> 2) * 128; _Pragma("unroll") for (int i = 0; i < 4; ++i) { const int P = (w * 4 + i) * 64 + lane, row = P >> 4, pc = (P & 15) ^ (row & 15); \
    __builtin_amdgcn_global_load_lds((const unsigned*)(GVT + (size_t)(h_ * 128 + row) * T_TOK + t_ + pc * 8), (LAS unsigned*)(lds + (buf) * TB + (w * 4 + i) * 1024), 16, 0, 0); } } while (0)
  LAS float* vn_l = sr + 128; LAS float* on_l = vn_l + 512; LAS float* sb_l = on_l + 512;
  const int it_step = loc ? 1 : (int)gridDim.x, it_end = loc ? vcu * 4 + 4 : 1024;
  int it = loc ? vcu * 4 : (int)blockIdx.x, buf = 0;
  if (it < it_end) SP_STAGE(it, 0);
  { const float a = lp.v_norm_w[tid], b = lp.out_norm_w[tid], c = lp.sp_b[tid]; vn_l[tid] = a; on_l[tid] = b; sb_l[tid] = c; }
  asm volatile("s_waitcnt vmcnt(0)" ::: "memory");
  __syncthreads();
  const int x_lane = l15 * 256 + ((kq ^ l15) << 4);
  const int i0 = 16 * w, nks = (w < 4) ? 2 : 4;
  u32x4_t rawN[4]; u32x2_t urN[8]; u64 ssvN = 0ull;
#define SP_LOADREGS(item) do { const int h_ = (item) & 3, t_ = ((item) >> 2) * 128; \
    _Pragma("unroll") for (int ks = 0; ks < 4; ++ks) rawN[ks] = (ks < nks) ? *(const u32x4_t*)(lp.Wsp + (size_t)(h_ * 128 + i0 + l15) * 128 + ks * 32 + kq * 8) : (u32x4_t){0u, 0u, 0u, 0u}; \
    _Pragma("unroll") for (int dt = 0; dt < 8; ++dt) urN[dt] = *(const u32x2_t*)(U + (size_t)(t_ + i0 + l15) * 512 + h_ * 128 + 16 * dt + 4 * kq); \
    ssvN = (tid < 128) ? SSV[(size_t)(t_ + tid) * 4 + h_] : 0ull; } while (0)
  if (it < it_end) SP_LOADREGS(it);
  for (; it < it_end; it += it_step, buf ^= 1) {
    const int h = it & 3, tok0 = (it >> 2) * 128, irow = tok0 + i0 + l15;
    u32x4_t raw[4]; u32x2_t ur[8];
#pragma unroll
    for (int ks = 0; ks < 4; ++ks) raw[ks] = rawN[ks];
#pragma unroll
    for (int dt = 0; dt < 8; ++dt) ur[dt] = urN[dt];
    const u64 ssv = ssvN;
    const float bias = sb_l[h * 128 + i0 + l15];
    const int nit = it + it_step;
    if (nit < it_end) { SP_STAGE(nit, buf ^ 1); SP_LOADREGS(nit); }
    if (tid < 128) sr[tid] = rsqrtf(fx2f(ssv) * (1.0f / 128.0f) + EPS);
    __syncthreads();
    bf16x8 yf[4];
#pragma unroll
    for (int ks = 0; ks < 4; ++ks) { const LAS float* sp = sr + ks * 32 + kq * 8; const u32x4_t r = raw[ks]; u32x4_t o;
      o.x = pk2(bflo(r.x) * sp[0], bfhi(r.x) * sp[1]); o.y = pk2(bflo(r.y) * sp[2], bfhi(r.y) * sp[3]); o.z = pk2(bflo(r.z) * sp[4], bfhi(r.z) * sp[5]); o.w = pk2(bflo(r.w) * sp[6], bfhi(r.w) * sp[7]);
      yf[ks] = __builtin_bit_cast(bf16x8, o); }
    const LAS unsigned char* tb = lds + buf * TB;
    float o[8][4]; float ss = 0.f;
#pragma unroll
    for (int dt = 0; dt < 8; ++dt) {
      f32x4 acc = (f32x4){0.f, 0.f, 0.f, 0.f};
#pragma unroll
      for (int ks = 0; ks < 4; ++ks) if (ks < nks) {
        const bf16x8 xf = *(const LAS bf16x8*)(tb + dt * 4096 + (x_lane ^ (ks << 6)));
        acc = __builtin_amdgcn_mfma_f32_16x16x32_bf16(xf, yf[ks], acc, 0, 0, 0); }
      const int d0 = 16 * dt + 4 * kq; const f32x4 wv = *(const LAS f32x4*)(vn_l + h * 128 + d0);
      o[dt][0] = bflo(ur[dt].x) * (acc[0] * wv[0] + bias); o[dt][1] = bfhi(ur[dt].x) * (acc[1] * wv[1] + bias); o[dt][2] = bflo(ur[dt].y) * (acc[2] * wv[2] + bias); o[dt][3] = bfhi(ur[dt].y) * (acc[3] * wv[3] + bias);
      ss += (o[dt][0] * o[dt][0] + o[dt][1] * o[dt][1]) + (o[dt][2] * o[dt][2] + o[dt][3] * o[dt][3]);
    }
    ss += __shfl_xor(ss, 16); ss += __shfl_xor(ss, 32);
    const float rs = rsqrtf(ss * (1.0f / 128.0f) + EPS);
#pragma unroll
    for (int dt = 0; dt < 8; ++dt) { const int d0 = 16 * dt + 4 * kq; const f32x4 wo = *(const LAS f32x4*)(on_l + h * 128 + d0);
      u32x2_t q; q.x = pk2(o[dt][0] * rs * wo[0], o[dt][1] * rs * wo[1]); q.y = pk2(o[dt][2] * rs * wo[2], o[dt][3] * rs * wo[3]);
      *(u32x2_t*)(MIX + (size_t)irow * 1024 + h * 128 + d0) = q; }
    asm volatile("s_waitcnt vmcnt(8)" ::: "memory");
    __syncthreads();
  }
#undef SP_STAGE
#undef SP_LOADREGS
}

DI void attn_phase(const MParams& p, int l, LAS unsigned char* lds, int vcu) {
  unsigned char* ws = p.ws;
  const bf16_t *Q = (const bf16_t*)(ws + OFF_Q), *KB = (const bf16_t*)(ws + OFF_KB), *VT = (const bf16_t*)(ws + OFF_VT); bf16_t* MIX = (bf16_t*)(ws + OFF_MIX);
  constexpr int KBUF = 16384, VBUF = 16384, STG = KBUF + VBUF, QOFF = 3 * STG;
  static_assert(QOFF + 65536 <= LDS_BYTES, "attention LDS");
  const unsigned sv0 = __builtin_amdgcn_readfirstlane(((volatile LAS unsigned*)(lds + 131072))[0]), sv1 = __builtin_amdgcn_readfirstlane(((volatile LAS unsigned*)(lds + 131072))[1]), sv2 = __builtin_amdgcn_readfirstlane(((volatile LAS unsigned*)(lds + 131072))[2]), sv3 = __builtin_amdgcn_readfirstlane(((volatile LAS unsigned*)(lds + 131072))[3]);
  __syncthreads();
  const float lambda_init = 0.8f - 0.6f * expf(-0.3f * (float)(l + 1));
  const float* dnw = p.in[13] + l * 128;
#pragma unroll 1
  for (int pi = vcu; pi < 256; pi += gridDim.x) {
    const int b = pi >> 4, h = (pi >> 2) & 3, j = pi & 3;
#pragma unroll 1
    for (int it = 0; it < 2; ++it) {
      const int tid = tid_opaque(), lane = tid & 63, w = __builtin_amdgcn_readfirstlane(tid >> 6), l31 = lane & 31, hh = lane >> 5;
      const int qb = it ? j : 7 - j, t0 = b * 2048 + 256 * qb, ntl = 4 * qb + 4, ntw = 4 * qb + (w >> 1) + 1;
#pragma unroll
      for (int i = 0; i < 8; ++i) { const int P = (w * 8 + i) * 64 + lane, row = P >> 4, pos = P & 15, pc = pos ^ (row & 15);
        __builtin_amdgcn_global_load_lds((const unsigned*)(Q + (size_t)(t0 + row) * 512 + h * 128 + pc * 8), (LAS unsigned*)(lds + QOFF + (w * 8 + i) * 1024), 16, 0, 0); }
      const bf16_t* kbase = KB + (size_t)(b * 2048) * 512 + h * 128; const bf16_t* vbase = VT + (size_t)(h * 128) * T_TOK + b * 2048;
      int koff[2], voff[2];
#pragma unroll
      for (int i = 0; i < 2; ++i) { const int P = (w * 2 + i) * 64 + lane; { const int row = P >> 4, pos = P & 15, pc = pos ^ (row & 15); koff[i] = row * 512 + pc * 8; }
        { const int row = P >> 3, pos = P & 7, pc = pos ^ ((row >> 1) & 7); voff[i] = row * T_TOK + pc * 8; } }
#define ATT_STAGE(kt, buf) do { _Pragma("unroll") for (int i = 0; i < 2; ++i) { \
        __builtin_amdgcn_global_load_lds((const unsigned*)(kbase + (size_t)(kt) * (64 * 512) + koff[i]), (LAS unsigned*)(lds + (buf) * STG + (w * 2 + i) * 1024), 16, 0, 0); \
        __builtin_amdgcn_global_load_lds((const unsigned*)(vbase + (kt) * 64 + voff[i]), (LAS unsigned*)(lds + (buf) * STG + KBUF + (w * 2 + i) * 1024), 16, 0, 0); } } while (0)
#define ATT_STAGE_AT(kt, soff) do { _Pragma("unroll") for (int i = 0; i < 2; ++i) { \
        __builtin_amdgcn_global_load_lds((const unsigned*)(kbase + (size_t)(kt) * (64 * 512) + koff[i]), (LAS unsigned*)(lds + (soff) + (w * 2 + i) * 1024), 16, 0, 0); \
        __builtin_amdgcn_global_load_lds((const unsigned*)(vbase + (kt) * 64 + voff[i]), (LAS unsigned*)(lds + (soff) + KBUF + (w * 2 + i) * 1024), 16, 0, 0); } } while (0)
      ATT_STAGE(0, 0);
      if (ntl > 1) { ATT_STAGE(1, 1); asm volatile("s_waitcnt vmcnt(4)" ::: "memory"); } else asm volatile("s_waitcnt vmcnt(0)" ::: "memory");
      __syncthreads();
      int st_cur = 0, st_pre = 2 * STG;
      f32x16 O[2][4];
#pragma unroll
      for (int c = 0; c < 2; ++c)
#pragma unroll
        for (int bk = 0; bk < 4; ++bk)
#pragma unroll
          for (int i = 0; i < 16; ++i) O[c][bk][i] = 0.f;
      float lsum[2] = {0.f, 0.f};
      const int qr = 32 * w + l31;
      int k_lane = l31 * 256 + ((hh ^ (l31 & 15)) << 4), q_lane = QOFF + qr * 256 + ((hh ^ (qr & 15)) << 4), v_lane = KBUF + l31 * 128 + ((hh ^ ((l31 >> 1) & 7)) << 4);
#pragma unroll 1
      for (int kt = 0; kt < ntl; ++kt) {
        if (kt + 2 < ntl) ATT_STAGE_AT(kt + 2, st_pre);
        if (kt < ntw) {
          asm volatile("" : "+v"(k_lane), "+v"(q_lane), "+v"(v_lane));
          const LAS unsigned char* tb = lds + st_cur;
#pragma unroll
          for (int kb = 0; kb < 2; ++kb) {
            bf16x8 pf[2][2];
#pragma unroll
            for (int c = 0; c < 2; ++c) {
              f32x16 S;
#pragma unroll
              for (int i = 0; i < 16; ++i) S[i] = 0.f;
#pragma unroll
              for (int ks = 0; ks < 4; ++ks) {
                const int xo = (c * 8 + ks * 2) << 4;
                const bf16x8 qf = *(const LAS bf16x8*)(lds + (q_lane ^ xo));
                const bf16x8 kf = *(const LAS bf16x8*)(tb + (k_lane ^ xo) + kb * 8192);
                S = __builtin_amdgcn_mfma_f32_32x32x16_bf16(kf, qf, S, 0, 0, 0);
              }
              float ls = 0.f;
#pragma unroll
              for (int hs = 0; hs < 2; ++hs) { u32x4_t pw;
#pragma unroll
                for (int t = 0; t < 4; ++t) { const float a = __builtin_amdgcn_exp2f(S[8 * hs + 2 * t]), bq = __builtin_amdgcn_exp2f(S[8 * hs + 2 * t + 1]); ls += a + bq; pw[t] = pk2(a, bq); }
                pf[c][hs] = __builtin_bit_cast(bf16x8, pw); }
              lsum[c] += ls;
              __builtin_amdgcn_sched_barrier(0);
            }
#pragma unroll
            for (int bk = 0; bk < 4; ++bk) {
              const bf16x8 v0 = *(const LAS bf16x8*)(tb + (v_lane ^ ((2 * kb) << 5)) + bk * 4096);
              const bf16x8 v1 = *(const LAS bf16x8*)(tb + (v_lane ^ ((2 * kb + 1) << 5)) + bk * 4096);
              O[0][bk] = __builtin_amdgcn_mfma_f32_32x32x16_bf16(v0, pf[0][0], O[0][bk], 0, 0, 0);
              O[1][bk] = __builtin_amdgcn_mfma_f32_32x32x16_bf16(v0, pf[1][0], O[1][bk], 0, 0, 0);
              O[0][bk] = __builtin_amdgcn_mfma_f32_32x32x16_bf16(v1, pf[0][1], O[0][bk], 0, 0, 0);
              O[1][bk] = __builtin_amdgcn_mfma_f32_32x32x16_bf16(v1, pf[1][1], O[1][bk], 0, 0, 0);
              __builtin_amdgcn_sched_barrier(0);
            }
          }
        }
        if (kt + 2 < ntl) asm volatile("s_waitcnt vmcnt(4)" ::: "memory"); else asm volatile("s_waitcnt vmcnt(0)" ::: "memory");
        __syncthreads();
        st_pre = st_cur; st_cur = (st_cur == 2 * STG) ? 0 : st_cur + STG;
      }
#undef ATT_STAGE
#undef ATT_STAGE_AT
      const int tid2 = tid_opaque(), lane2 = tid2 & 63, w2 = __builtin_amdgcn_readfirstlane(tid2 >> 6), hh2 = lane2 >> 5, qr2 = 32 * w2 + (lane2 & 31);
      float lam;
      { const float* q1 = p.in[9] + l * 64; const float* k1 = p.in[10] + l * 64; const float* q2 = p.in[11] + l * 64; const float* k2 = p.in[12] + l * 64;
        float a = q1[lane2] * k1[lane2], bq = q2[lane2] * k2[lane2]; a = wave_sum(a); bq = wave_sum(bq); lam = expf(a) - expf(bq) + lambda_init; }
      float l1 = lsum[0], l2 = lsum[1]; l1 += __shfl_xor(l1, 32); l2 += __shfl_xor(l2, 32);
      const float inv1 = 1.0f / l1, inv2 = lam / l2; float ss = 0.f;
#pragma unroll
      for (int bk = 0; bk < 4; ++bk)
#pragma unroll
        for (int i = 0; i < 16; ++i) { const float o = O[0][bk][i] * inv1 - O[1][bk][i] * inv2; O[0][bk][i] = o; ss += o * o; }
      ss += __shfl_xor(ss, 32);
      const float rs = rsqrtf(ss * (1.0f / 128.0f) + EPS) * (1.0f - lambda_init);
      bf16_t* orow = MIX + (size_t)(t0 + qr2) * 1024 + 512 + h * 128;
#pragma unroll
      for (int bk = 0; bk < 4; ++bk)
#pragma unroll
        for (int g = 0; g < 4; ++g) { const int dv0 = 32 * bk + 8 * g + 4 * hh2; const f32x4 wv = *(const f32x4*)(dnw + dv0);
          u32x2_t q; q.x = pk2(O[0][bk][4 * g] * rs * wv[0], O[0][bk][4 * g + 1] * rs * wv[1]); q.y = pk2(O[0][bk][4 * g + 2] * rs * wv[2], O[0][bk][4 * g + 3] * rs * wv[3]);
          *(u32x2_t*)(orow + dv0) = q; }
    }
  }
  __syncthreads();
  if (threadIdx.x == 0) { volatile LAS unsigned* stw = (volatile LAS unsigned*)(lds + 131072); stw[0] = sv0; stw[1] = sv1; stw[2] = sv2; stw[3] = sv3; }
  __syncthreads();
}


#define XB_TMO      128
#define XB_XCNT(j)  (256  + 64 * (j))
#define XB_XSUB(j)  (1280 + 64 * (j))
#define XB_XGEN(j)  (2304 + 64 * (j))
#define XB_TOP      3328
#define XB_TOPGEN   3392
#define XCD_BAR_WORDS 3456
#define XB_SPIN_CAP (1u << 18)

__device__ __forceinline__ unsigned xb_ld(unsigned* p)              { return __hip_atomic_load(p, __ATOMIC_RELAXED, __HIP_MEMORY_SCOPE_AGENT); }
__device__ __forceinline__ unsigned xb_add(unsigned* p, unsigned v) { return __hip_atomic_fetch_add(p, v, __ATOMIC_RELAXED, __HIP_MEMORY_SCOPE_AGENT); }
__device__ __forceinline__ unsigned xb_xcc_id() { return (unsigned)__builtin_amdgcn_s_getreg((3 << 11) | 20) & 0xFu; }
#define XB_SPIN(cond, bar) do { unsigned _sp = 0; while (cond) { __builtin_amdgcn_s_sleep(1); \
    if ((++_sp & 255u) == 0u) { if (xb_ld(&(bar)[XB_TMO])) break; if (_sp > XB_SPIN_CAP) { atomicAdd(&(bar)[XB_TMO], 1u); break; } } } } while (0)

struct XcdBarrier {
    unsigned* bar; unsigned x;
    volatile LAS unsigned* st;
};

__device__ __forceinline__ XcdBarrier xcd_barrier_post(unsigned* bar, volatile LAS unsigned* st) {
    XcdBarrier b; b.bar = bar; b.x = xb_xcc_id(); b.st = st;
    if (threadIdx.x == 0) st[2] = xb_add(&bar[XB_XCNT(b.x)], 1u);
    return b;
}
__device__ __forceinline__ void xcd_barrier_complete(unsigned* bar, unsigned x, unsigned& nloc, unsigned& nx) {
    const unsigned G = gridDim.x * gridDim.y * gridDim.z;
    unsigned sum, cnt, mine, sp = 0u;
    for (;;) {
        sum = 0u; cnt = 0u; mine = 0u;
#pragma unroll
        for (unsigned j = 0; j < 16; ++j) { const unsigned c = xb_ld(&bar[XB_XCNT(j)]); sum += c; cnt += (c > 0u) ? 1u : 0u; mine = (j == x) ? c : mine; }
        if (sum == G) break;
        __builtin_amdgcn_s_sleep(1);
        if ((++sp & 255u) == 0u) { if (xb_ld(&bar[XB_TMO])) break; if (sp > XB_SPIN_CAP) { atomicAdd(&bar[XB_TMO], 1u); break; } }
    }
    nloc = mine > 0u ? mine : 1u; nx = cnt > 0u ? cnt : 1u;
}

__device__ __forceinline__ void xcd_barrier(const XcdBarrier& b) {
    asm volatile("s_waitcnt vmcnt(0)" ::: "memory");
    __syncthreads();
    if (threadIdx.x == 0) {
        unsigned* bar = b.bar;
        __builtin_amdgcn_s_waitcnt(0);
        unsigned nloc = b.st[0], nx = b.st[1];
        if (nloc == 0u) { xcd_barrier_complete(bar, b.x, nloc, nx); b.st[0] = nloc; b.st[1] = nx; }
        const unsigned old = xb_add(&bar[XB_XSUB(b.x)], 1u);
        const unsigned gen = old / nloc;
        if (old + 1u == (gen + 1u) * nloc) {
            __builtin_amdgcn_fence(__ATOMIC_RELEASE, "agent");
            asm volatile("s_waitcnt vmcnt(0)" ::: "memory");
            const unsigned og = xb_add(&bar[XB_TOP], 1u);
            const unsigned tg = og / nx;
            if (og + 1u == (tg + 1u) * nx) xb_add(&bar[XB_TOPGEN], 1u);
            else XB_SPIN(xb_ld(&bar[XB_TOPGEN]) == tg, bar);
            __builtin_amdgcn_fence(__ATOMIC_ACQUIRE, "agent");
            xb_add(&bar[XB_XGEN(b.x)], 1u);
            asm volatile("s_waitcnt vmcnt(0)" ::: "memory");
        } else {
            XB_SPIN(xb_ld(&bar[XB_XGEN(b.x)]) == gen, bar);
            __builtin_amdgcn_fence(__ATOMIC_ACQUIRE, "agent");
            asm volatile("s_waitcnt vmcnt(0)" ::: "memory");
        }
    }
    __syncthreads();
}

#define XB_LSUB(j)  (3456 + 64 * (j))
#define XB_LGEN(j)  (4480 + 64 * (j))
#define XB_ALL_WORDS 5504
__device__ __forceinline__ void xcd_local_barrier(const XcdBarrier& b) {
    asm volatile("s_waitcnt vmcnt(0)" ::: "memory");
    __syncthreads();
    if (threadIdx.x == 0) {
        unsigned* bar = b.bar;
        __builtin_amdgcn_s_waitcnt(0);
        const unsigned nloc = b.st[0];
        const unsigned old = xb_add(&bar[XB_LSUB(b.x)], 1u);
        const unsigned gen = old / nloc;
        if (old + 1u == (gen + 1u) * nloc) xb_add(&bar[XB_LGEN(b.x)], 1u);
        else XB_SPIN(xb_ld(&bar[XB_LGEN(b.x)]) == gen, bar);
        __builtin_amdgcn_fence(__ATOMIC_ACQUIRE, "agent");
        asm volatile("s_waitcnt vmcnt(0)" ::: "memory");
    }
    __syncthreads();
}

DI void zero_u64(u64* p, int n, int vcu, int loc) {
  const int t = tid_opaque();
  if (loc) { const int per = n >> 3; u64* q = p + (size_t)(vcu >> 5) * per; for (int i = (vcu & 31) * 512 + t; i < per; i += 32 * 512) __hip_atomic_store(q + i, 0ull, __ATOMIC_RELAXED, __HIP_MEMORY_SCOPE_AGENT); }
  else for (int i = blockIdx.x * 512 + t; i < n; i += gridDim.x * 512) __hip_atomic_store(p + i, 0ull, __ATOMIC_RELAXED, __HIP_MEMORY_SCOPE_AGENT);
}
typedef pg8::StaticOrder OrderACE;
DI void phaseA(const MParams& p, int l, LAS unsigned char* lds, int cx, int vcu, int loc) {
  unsigned char* ws = p.ws; const bf16_t* XB = (const bf16_t*)(ws + OFF_XB); const bf16_t* WinT = (const bf16_t*)(ws + OFF_W + (size_t)l * W_STRIDE + WO_IN); const u64* SS1 = (const u64*)(ws + OFF_SS1);
  zero_u64((u64*)(ws + OFF_SS2), T_TOK, vcu, loc);
  { pg8::Gemm g{XB, WinT, T_TOK, 1536, DM}; OrderACE S; S.init(T_TOK, 1536, gridDim.x, cx);
    EpiA1 E{SS1, (bf16_t*)(ws + OFF_U), (bf16_t*)(ws + OFF_Q), (bf16_t*)(ws + OFF_KB), p.in[7] + l * 64, p.in[8] + l * 64}; pg8::gemm_phase<EpiA1, OrderACE>(lds, g, S, E); }
  { pg8::Gemm g{WinT + (size_t)1536 * DM, XB, 1024, T_TOK, DM}; OrderACE S; S.init(1024, T_TOK, gridDim.x, cx);
    EpiA2 E{SS1, (bf16_t*)(ws + OFF_GVT), (bf16_t*)(ws + OFF_VT), (u64*)(ws + OFF_SSV)}; pg8::gemm_phase<EpiA2, OrderACE>(lds, g, S, E); }
}
DI void phaseCE(const MParams& p, int l, bool isC, LAS unsigned char* lds, int cx, int vcu, int loc) {
  unsigned char* ws = p.ws; const unsigned char* wb = ws + OFF_W + (size_t)l * W_STRIDE;
  if (isC) zero_u64((u64*)(ws + OFF_SS1), T_TOK, vcu, loc);
  pg8::Gemm g{(const bf16_t*)(ws + (isC ? OFF_MIX : OFF_F)), (const bf16_t*)(wb + (isC ? WO_OUT : WO_DN)), T_TOK, DM, isC ? DM : DFF}; OrderACE S; S.init(T_TOK, DM, gridDim.x, cx);
  EpiResid E{(isC && l == 0) ? p.in[0] : nullptr, (!isC && l == NLAYER - 1) ? p.out : nullptr, (bf16_t*)(ws + OFF_XB), (u64*)(ws + (isC ? OFF_SS2 : OFF_SS1))}; pg8::gemm_phase<EpiResid, OrderACE>(lds, g, S, E);
}
DI void phaseD(const MParams& p, int l, LAS unsigned char* lds, int cx, int vcu, int loc) {
  unsigned char* ws = p.ws;
  zero_u64((u64*)(ws + OFF_SSV), T_TOK * 4, vcu, loc);
  pg8::Gemm g{(const bf16_t*)(ws + OFF_XB), (const bf16_t*)(ws + OFF_W + (size_t)l * W_STRIDE + WO_GU), T_TOK, 2 * DFF, DM};
#if PROBE_EPI_D
  DupOrder S;
#else
  pg8::StaticOrder S;
#endif
  S.init(T_TOK, 2 * DFF, gridDim.x, cx);
  EpiD E{(const u64*)(ws + OFF_SS2), p.in[18] + (size_t)l * 3 * DFF, p.in[19] + (size_t)l * DFF, (bf16_t*)(ws + OFF_F), (float*)(ws + OFF_GB), (float*)(ws + OFF_PB), (float*)(ws + OFF_UB)};
#if PROBE_EPI_D
  pg8::gemm_phase<EpiD, DupOrder>(lds, g, S, E);
#else
  pg8::gemm_phase<EpiD, pg8::StaticOrder>(lds, g, S, E);
#endif
}

__global__ void __launch_bounds__(512) k_run(MParams p) {
  extern __shared__ __attribute__((aligned(16))) unsigned char lds_raw[];
  LAS unsigned char* lds = (LAS unsigned char*)lds_raw;
  cg::grid_group grid = cg::this_grid();
  if (threadIdx.x < 4) ((LAS unsigned*)(lds + 131072))[threadIdx.x] = 0u;
  __syncthreads();
  XcdBarrier xbar = xcd_barrier_post((unsigned*)(p.ws + OFF_BAR), (volatile LAS unsigned*)(lds + 131072));
  if (p.ph_lo < 0) grid.sync();
  for (int ph = p.ph_lo; ph < p.ph_hi; ++ph) {
    const volatile LAS unsigned* stw = (const volatile LAS unsigned*)(lds + 131072);
    const int loc = (ph > 0) ? (int)__builtin_amdgcn_readfirstlane(stw[3]) : 0, rk = (int)__builtin_amdgcn_readfirstlane(stw[2]);
#define RUN_PHASES(LOC, CX, VCU) do { const int l = (ph - 1) / 6, s = (ph - 1) % 6; \
      if (s == 0) phaseA(p, l, lds, (CX), (VCU), (LOC)); \
      else if (s == 1) { attn_phase(p, l, lds, (VCU)); const LP lp = make_lp(p, l); spatial_phase(lp, p.ws, lds, (VCU), (LOC)); } \
      else if (s == 2 || s == 5) phaseCE(p, l, s == 2, lds, (CX), (VCU), (LOC)); \
      else if (s == 3) phaseD(p, l, lds, (CX), (VCU), (LOC)); \
      else { const LP lp = make_lp(p, l); fixup_phase(lp, p.ws, (VCU), (LOC)); } } while (0)
    if (ph == 0) prologue(p, lds);
    else if (loc) RUN_PHASES(1, rk * 8 + (int)xbar.x, (int)xbar.x * 32 + rk);
    else RUN_PHASES(0, (int)blockIdx.x, (int)blockIdx.x);
#undef RUN_PHASES
    if (ph + 1 < p.ph_hi) {
      const int sx = (ph - 1) % 6;
      if (ph == 0 || !loc || sx == 2 || sx == 5) {
        xcd_barrier(xbar);
        if (ph == 0) {
          if (threadIdx.x == 0) { unsigned ok = (gridDim.x == 256u) ? 1u : 0u;
            for (unsigned j = 0; j < 16; ++j) { const unsigned c = xb_ld(&xbar.bar[XB_XCNT(j)]); if (c != (j < 8 ? 32u : 0u)) ok = 0u; }
            ((volatile LAS unsigned*)(lds + 131072))[3] = ok; }
          __syncthreads();
        }
      } else xcd_local_barrier(xbar);
    }
  }
}

extern "C" void kernel_launch(void* const* d_in, const int* in_sizes, int n_in, void* d_out, int out_size, void* d_ws, size_t ws_size, hipStream_t stream) {
  static int grid_blocks = 0;
  if (!grid_blocks) {
    (void)hipFuncSetAttribute((const void*)k_run, hipFuncAttributeMaxDynamicSharedMemorySize, LDS_BYTES);
    int dev = 0, cus = 0, per_cu = 0; (void)hipGetDevice(&dev); (void)hipDeviceGetAttribute(&cus, hipDeviceAttributeMultiprocessorCount, dev);
    (void)hipOccupancyMaxActiveBlocksPerMultiprocessor(&per_cu, (const void*)k_run, 512, LDS_BYTES); if (per_cu < 1) per_cu = 1;
    grid_blocks = cus * per_cu; if (grid_blocks > 256) grid_blocks = 256;
  }
  MParams mp; memset(&mp, 0, sizeof(mp));
  for (int i = 0; i < 21; ++i) mp.in[i] = (const float*)d_in[i];
  mp.out = (float*)d_out; mp.ws = (unsigned char*)d_ws; mp.ph_lo = 0; mp.ph_hi = 1 + 6 * NLAYER;
  (void)hipMemsetAsync((unsigned char*)d_ws + OFF_BAR, 0, 5504 * sizeof(unsigned), stream);
  void* args[] = {&mp};
  hipError_t e = hipLaunchCooperativeKernel((const void*)k_run, dim3(grid_blocks), dim3(512), args, LDS_BYTES, stream);
  if (e != hipSuccess) fprintf(stderr, "cooperative launch failed: %s (grid %d)\n", hipGetErrorString(e), grid_blocks);
}
```

```cpp
#include <hip/hip_runtime.h>
#include <hip/hip_cooperative_groups.h>
#include <cstdio>
#include <cmath>
#include <cstring>

typedef unsigned short bf16_t;
#define DI __device__ __forceinline__

constexpr int T_TOK = 32768, DM = 1024, SEQ = 2048, DFF = 2816, INW = 2560, NLAYER = 4;
constexpr float EPS = 1e-6f;
constexpr float QSCALE = 0.125f * 1.4426950408889634f;

constexpr size_t MiB = 1024ull * 1024ull;
constexpr size_t OFF_XB = 0;
constexpr size_t OFF_R = 64 * MiB;
constexpr size_t OFF_U = OFF_R, OFF_Q = OFF_R + 32 * MiB, OFF_KB = OFF_R + 64 * MiB, OFF_GVT = OFF_R + 96 * MiB, OFF_VT = OFF_R + 128 * MiB, OFF_MIX = OFF_R + 160 * MiB;
constexpr size_t OFF_F = OFF_R, OFF_GB = OFF_R + 176 * MiB, OFF_PB = OFF_R + 188 * MiB, OFF_UB = OFF_R + 200 * MiB;
constexpr size_t OFF_W = 288 * MiB, W_STRIDE = 24 * MiB;
constexpr size_t WO_IN = 0, WO_OUT = 5 * MiB, WO_GU = 7 * MiB, WO_DN = 18 * MiB, WO_SP = 23 * MiB + 512 * 1024;
constexpr size_t OFF_SS1 = 384 * MiB, OFF_SS2 = OFF_SS1 + 256 * 1024, OFF_SSV = OFF_SS2 + 256 * 1024;
constexpr size_t OFF_BAR = 385 * MiB + 512 * 1024;
constexpr size_t OFF_TMP1 = 386 * MiB, OFF_TMP2 = 418 * MiB;

DI int tid_opaque() { int t = threadIdx.x; asm volatile("" : "+v"(t)); return t; }
DI float bf2f(bf16_t b) { return __uint_as_float(((unsigned)b) << 16); }
DI bf16_t f2bf(float f) { unsigned u = __float_as_uint(f); u += 0x7FFFu + ((u >> 16) & 1u); return (bf16_t)(u >> 16); }
DI float gelu_exact(float x) { return 0.5f * x * (1.0f + erff(x * 0.70710678118654752f)); }
DI int permpos16(int k) { return (k & 3) + 4 * (k >> 3) + 8 * ((k >> 2) & 1); }
DI float wave_sum(float v) { for (int o = 32; o >= 1; o >>= 1) v += __shfl_xor(v, o); return v; }

namespace pg8 {
#define PG8_LAS __attribute__((address_space(3)))
typedef unsigned short bf16_t;
typedef short bf16x8 __attribute__((ext_vector_type(8)));
typedef float f32x4 __attribute__((ext_vector_type(4)));
typedef unsigned u32x4 __attribute__((ext_vector_type(4)));
constexpr int BM = 256, BK = 64, HALF = 128, HTB = HALF * BK * 2  , STAGE_BYTES = 8 * HTB, NXCD = 8, WGM = 8;

__host__ __device__ __forceinline__ int lds_byte(int r, int c) { const int st = (r >> 4) * 2 + (c >> 5), rr = r & 15, cc = c & 31, ob = rr * 64 + cc * 2; return st * 1024 + (ob ^ (((ob >> 9) & 1) << 5)); }
__host__ __device__ __forceinline__ void stage_rc(int b, int& R, int& C) { const int st = b / 1024, sb = b % 1024, swz = sb ^ (((sb >> 9) & 1) << 5); R = (st >> 1) * 16 + swz / 64; C = (st & 1) * 32 + (swz % 64) / 2; }
__host__ __device__ __forceinline__ int perm32(int rho) { const int n = rho >> 4, i = rho & 15; return 8 * (i >> 2) + 4 * n + (i & 3); }

struct Unit { int pm, pn; };
struct Gemm { const bf16_t* A; const bf16_t* Bt; int M, N, K; };

struct StaticOrder {
    int nM, nN, nwg, G, c;
    __host__ __device__ void init(int M, int N, int G_, int c_) { nM = M / BM; nN = N / BM; nwg = nM * nN; G = G_; c = c_; }
    __host__ __device__ bool next(int i, Unit& u) const {
        const long L = (long)i * G + c; if (L >= nwg) return false;
        int wgid = (int)L; { const int q = nwg / NXCD, r = nwg % NXCD, xcd = wgid % NXCD, off = wgid / NXCD; wgid = (xcd < r ? xcd * (q + 1) : r * (q + 1) + (xcd - r) * q) + off; }
        const int nig = WGM * nN, gid = wgid / nig, fm = gid * WGM, gsz = (nM - fm) < WGM ? (nM - fm) : WGM;
        u.pm = fm + ((wgid % nig) % gsz); u.pn = (wgid % nig) / gsz; return true;
    }
    __device__ __forceinline__ void a_ready(const Unit&) const {}
    __device__ __forceinline__ void done(const Unit&) const {}
};
template <class Epi, class Sched>
__device__ __forceinline__ void gemm_phase(PG8_LAS unsigned char* lds, const Gemm g, const Sched& S, const Epi& E) {
    const int tid = tid_opaque(), wid = __builtin_amdgcn_readfirstlane(tid >> 6), lane = tid & 63, wr = wid >> 2, wc = wid & 3, fr = lane & 15, fq = lane >> 4;
    const int K = g.K, nt = K / BK;
    unsigned voffA[2], voffB[2];
#pragma unroll
    for (int i = 0; i < 2; ++i) { int R, C; stage_rc(tid * 16 + i * 8192, R, C); const int Rb = Epi::PERM ? ((R & ~31) + perm32(R & 31)) : R;
        voffA[i] = (unsigned)(R * K + C) * 2u; voffB[i] = (unsigned)(Rb * K + C) * 2u; }
    const size_t kstep = (size_t)(BK * 2);
    const size_t hstep = (size_t)HALF * K * 2;
    const size_t tstep = 2 * hstep;
    const unsigned ldsw = (unsigned)wid * 1024u;
    const int aoff = lds_byte(wr * 64 + fr, fq * 8), boff = lds_byte(wc * 32 + fr, fq * 8);
#define PG8_SA(b, h) (((b) * 2 + (h)) * HTB)
#define PG8_SB(b, h) ((4 + (b) * 2 + (h)) * HTB)
#define PG8_STAGE(bufoff, gbase, voff) do { _Pragma("unroll") for (int _i = 0; _i < 2; ++_i) \
        __builtin_amdgcn_global_load_lds((const unsigned*)((const char*)(gbase) + (voff)[_i]), (PG8_LAS unsigned*)(lds + (bufoff) + ldsw + _i * 8192), 16, 0, 0); } while (0)
#define PG8_LDA(dst, b, h) do { _Pragma("unroll") for (int m = 0; m < 4; ++m) _Pragma("unroll") for (int k = 0; k < 2; ++k) dst[m][k] = *(const PG8_LAS bf16x8*)(lds + PG8_SA(b, h) + aoff + m * 2048 + k * 1024); } while (0)
#define PG8_LDB(dst, b, h) do { _Pragma("unroll") for (int n = 0; n < 2; ++n) _Pragma("unroll") for (int k = 0; k < 2; ++k) dst[n][k] = *(const PG8_LAS bf16x8*)(lds + PG8_SB(b, h) + boff + n * 2048 + k * 1024); } while (0)
#define PG8_MMA(ai, bj, At, Bt) do { __builtin_amdgcn_s_setprio(1); _Pragma("unroll") for (int m = 0; m < 4; ++m) _Pragma("unroll") for (int n = 0; n < 2; ++n) _Pragma("unroll") for (int k = 0; k < 2; ++k) \
        acc[ai][bj][m][n] = __builtin_amdgcn_mfma_f32_16x16x32_bf16(Bt[n][k], At[m][k], acc[ai][bj][m][n], 0, 0, 0); __builtin_amdgcn_s_setprio(0); } while (0)
#define PG8_WAIT_V(n) asm volatile("s_waitcnt vmcnt(" #n ")" ::: "memory")
#define PG8_WAIT_L(n) asm volatile("s_waitcnt lgkmcnt(" #n ")" ::: "memory")
#define PG8_BAR __builtin_amdgcn_s_barrier()
#define PG8_SCHED __builtin_amdgcn_sched_barrier(0)
    Unit cur, nxt; int ui = 0;
    if (!S.next(0, cur)) return;
    f32x4 acc[2][2][4][2];
#pragma unroll
    for (int a = 0; a < 2; ++a)
#pragma unroll
        for (int b = 0; b < 2; ++b)
#pragma unroll
            for (int m = 0; m < 4; ++m)
#pragma unroll
                for (int n = 0; n < 2; ++n) acc[a][b][m][n] = (f32x4){0.f, 0.f, 0.f, 0.f};
    bf16x8 At[4][2], B0[2][2], B1[2][2];
    const char* cA = (const char*)g.A + (size_t)cur.pm * tstep; const char* cB = (const char*)g.Bt + (size_t)cur.pn * tstep;
    S.a_ready(cur);
    PG8_STAGE(PG8_SB(0, 0), cB, voffB); PG8_STAGE(PG8_SA(0, 0), cA, voffA); PG8_STAGE(PG8_SB(0, 1), cB + hstep, voffB); PG8_STAGE(PG8_SA(0, 1), cA + hstep, voffA);
    if (wr == 1) PG8_BAR;
    PG8_WAIT_V(4); PG8_BAR;
    PG8_STAGE(PG8_SB(1, 0), cB + kstep, voffB); PG8_STAGE(PG8_SA(1, 0), cA + kstep, voffA); PG8_STAGE(PG8_SB(1, 1), cB + hstep + kstep, voffB);
    PG8_WAIT_V(6); PG8_BAR;
    for (;;) {
        const bool has_next = S.next(ui + 1, nxt);
        const char* nA = has_next ? (const char*)g.A + (size_t)nxt.pm * tstep : cA; const char* nB = has_next ? (const char*)g.Bt + (size_t)nxt.pn * tstep : cB;
        for (int t = 0; t < nt; t += 2) {
            const bool last = (t == nt - 2);
            const char* a1 = cA + (size_t)(t + 1) * kstep;
            const char* a2 = last ? nA : cA + (size_t)(t + 2) * kstep; const char* b2 = last ? nB : cB + (size_t)(t + 2) * kstep;
            const char* a3 = a2 + kstep; const char* b3 = b2 + kstep;
            if (last && has_next) S.a_ready(nxt);
            PG8_LDB(B0, 0, 0); PG8_SCHED; PG8_LDA(At, 0, 0); PG8_STAGE(PG8_SA(1, 1), a1 + hstep, voffA);
            PG8_WAIT_L(8); PG8_BAR; PG8_WAIT_L(0); PG8_MMA(0, 0, At, B0); PG8_BAR; PG8_SCHED;
            PG8_LDB(B1, 0, 1); PG8_STAGE(PG8_SB(0, 0), b2, voffB);
            PG8_BAR; PG8_WAIT_L(0); PG8_MMA(0, 1, At, B1); PG8_BAR;
            PG8_LDA(At, 0, 1); PG8_STAGE(PG8_SA(0, 0), a2, voffA);
            PG8_BAR; PG8_WAIT_L(0); PG8_MMA(1, 0, At, B0); PG8_BAR; PG8_SCHED;
            PG8_STAGE(PG8_SB(0, 1), b2 + hstep, voffB);
            PG8_WAIT_V(6); PG8_BAR; PG8_MMA(1, 1, At, B1); PG8_BAR;
            PG8_LDB(B0, 1, 0); PG8_SCHED; PG8_LDA(At, 1, 0); PG8_STAGE(PG8_SA(0, 1), a2 + hstep, voffA);
            PG8_WAIT_L(8); PG8_BAR; PG8_WAIT_L(0); PG8_MMA(0, 0, At, B0); PG8_BAR; PG8_SCHED;
            PG8_LDB(B1, 1, 1); PG8_STAGE(PG8_SB(1, 0), b3, voffB);
            PG8_BAR; PG8_WAIT_L(0); PG8_MMA(0, 1, At, B1); PG8_BAR;
            PG8_LDA(At, 1, 1); PG8_STAGE(PG8_SA(1, 0), a3, voffA);
            PG8_BAR; PG8_WAIT_L(0); PG8_MMA(1, 0, At, B0); PG8_BAR; PG8_SCHED;
            PG8_STAGE(PG8_SB(1, 1), b3 + hstep, voffB);
            PG8_WAIT_V(6); PG8_BAR; PG8_MMA(1, 1, At, B1); PG8_BAR;
        }
        if constexpr (!Epi::AFTER_DRAIN) { if (!Epi::TWICE || (ui & 1)) E(acc, cur, wr, wc, fr, fq); S.done(cur); }
        if (!has_next) break;
#pragma unroll
        for (int a = 0; a < 2; ++a)
#pragma unroll
            for (int b = 0; b < 2; ++b)
#pragma unroll
                for (int m = 0; m < 4; ++m)
#pragma unroll
                    for (int n = 0; n < 2; ++n) acc[a][b][m][n] = (f32x4){0.f, 0.f, 0.f, 0.f};
        cur = nxt; cA = nA; cB = nB; ++ui;
    }
    PG8_WAIT_V(0);
    if (wr == 0) PG8_BAR;
    PG8_BAR;
    if constexpr (Epi::AFTER_DRAIN) { E.fused(acc, cur, wr, wc, fr, fq, lds, wid, lane); S.done(cur); }
#undef PG8_SA
#undef PG8_SB
#undef PG8_STAGE
#undef PG8_LDA
#undef PG8_LDB
#undef PG8_MMA
#undef PG8_WAIT_V
#undef PG8_WAIT_L
#undef PG8_BAR
#undef PG8_SCHED
}
}

namespace cg = cooperative_groups;
using pg8::f32x4; using pg8::bf16x8; using pg8::Unit;
typedef unsigned u32x2_t __attribute__((ext_vector_type(2)));
typedef unsigned u32x4_t __attribute__((ext_vector_type(4)));
typedef float f32x16 __attribute__((ext_vector_type(16)));
typedef float f32x2_t __attribute__((ext_vector_type(2)));
#define LAS PG8_LAS
constexpr int LDS_BYTES = 163840;
#ifndef EN_MASK
#define EN_MASK 0x7f
#endif
#ifndef PROBE_EPI_ACE
#define PROBE_EPI_ACE 0
#endif
#ifndef PROBE_EPI_D
#define PROBE_EPI_D 0
#endif
#ifndef PROBE_SYNC
#define PROBE_SYNC 0
#endif
#ifndef PROBE_MASK
#define PROBE_MASK 0x00
#endif

DI unsigned pk2(float lo, float hi) { unsigned r; asm volatile("s_nop 0\n\tv_cvt_pk_bf16_f32 %0, %1, %2\n\ts_nop 1" : "=v"(r) : "v"(lo), "v"(hi)); return r; }
DI float bflo(unsigned w) { return __uint_as_float(w << 16); }
DI float bfhi(unsigned w) { return __uint_as_float(w & 0xffff0000u); }
DI float gelu1(float v) {
  const float av = fabsf(v), t = __builtin_amdgcn_rcpf(av * 0.2316418882f + 1.0f);
  float q = t * 0.5307027145f + (-0.7265760135f); q = q * t + 0.7107068705f; q = q * t + (-0.142248368f); q = q * t + 0.127414796f; q = q * t;
  const float e = __builtin_amdgcn_exp2f((v * v) * (-0.72134752044f));
  const float m = v * (q * e);
  return v < 0.f ? m : v - m;
}
DI float dpp_ror1(float v) { return __builtin_bit_cast(float, __builtin_amdgcn_update_dpp(0, __builtin_bit_cast(int, v), 0x121, 0xf, 0xf, false)); }
DI float dpp_ror2(float v) { return __builtin_bit_cast(float, __builtin_amdgcn_update_dpp(0, __builtin_bit_cast(int, v), 0x122, 0xf, 0xf, false)); }
DI float row_sum16(float v) {
  v += __builtin_bit_cast(float, __builtin_amdgcn_update_dpp(0, __builtin_bit_cast(int, v), 0x128, 0xf, 0xf, false));
  v += __builtin_bit_cast(float, __builtin_amdgcn_update_dpp(0, __builtin_bit_cast(int, v), 0x124, 0xf, 0xf, false));
  v += __builtin_bit_cast(float, __builtin_amdgcn_update_dpp(0, __builtin_bit_cast(int, v), 0x122, 0xf, 0xf, false));
  v += __builtin_bit_cast(float, __builtin_amdgcn_update_dpp(0, __builtin_bit_cast(int, v), 0x121, 0xf, 0xf, false));
  return v; }
typedef unsigned long long u64;
DI float fx2f(u64 v) { return (float)v * (1.0f / 1048576.0f); }
DI u64 f2fx(float v) { return (u64)(v * 1048576.0f + 0.5f); }
DI void fx_add(u64* p, float v) { __hip_atomic_fetch_add(p, f2fx(v), __ATOMIC_RELAXED, __HIP_MEMORY_SCOPE_AGENT); }
DI float rs1024(u64 ss) { return rsqrtf(fx2f(ss) * (1.0f / 1024.0f) + EPS); }

struct MParams { const float* in[21]; float* out; unsigned char* ws; int ph_lo, ph_hi; };
struct LP {
  const float *norm_attn_w, *w_in, *v_norm_w, *sp_w, *sp_b, *out_norm_w, *q_norm_w, *k_norm_w, *lq1, *lk1, *lq2, *lk2, *diff_norm_w, *w_out, *norm_ffn_w, *w_gate, *w_up, *conv_w, *conv_b, *w_down;
  float lambda_init;
  const bf16_t *WinT, *WoutT, *WguT, *WdT, *Wsp;
};
DI LP make_lp(const MParams& p, int l) {
  LP L;
  L.norm_attn_w = p.in[1] + (size_t)l * DM; L.w_in = p.in[2] + (size_t)l * DM * INW; L.v_norm_w = p.in[3] + (size_t)l * 512; L.sp_w = p.in[4] + (size_t)l * 65536; L.sp_b = p.in[5] + (size_t)l * 512;
  L.out_norm_w = p.in[6] + (size_t)l * 512; L.q_norm_w = p.in[7] + (size_t)l * 64; L.k_norm_w = p.in[8] + (size_t)l * 64; L.lq1 = p.in[9] + (size_t)l * 64; L.lk1 = p.in[10] + (size_t)l * 64;
  L.lq2 = p.in[11] + (size_t)l * 64; L.lk2 = p.in[12] + (size_t)l * 64; L.diff_norm_w = p.in[13] + (size_t)l * 128; L.w_out = p.in[14] + (size_t)l * DM * DM; L.norm_ffn_w = p.in[15] + (size_t)l * DM;
  L.w_gate = p.in[16] + (size_t)l * DM * DFF; L.w_up = p.in[17] + (size_t)l * DM * DFF; L.conv_w = p.in[18] + (size_t)l * 3 * DFF; L.conv_b = p.in[19] + (size_t)l * DFF; L.w_down = p.in[20] + (size_t)l * DFF * DM;
  L.lambda_init = 0.8f - 0.6f * expf(-0.3f * (float)(l + 1));
  const unsigned char* wb = p.ws + OFF_W + (size_t)l * W_STRIDE;
  L.WinT = (const bf16_t*)(wb + WO_IN); L.WoutT = (const bf16_t*)(wb + WO_OUT); L.WguT = (const bf16_t*)(wb + WO_GU); L.WdT = (const bf16_t*)(wb + WO_DN); L.Wsp = (const bf16_t*)(wb + WO_SP);
  return L;
}
DI float lam_of(const LP& lp) {
  const int lane = threadIdx.x & 63;
  float a = lp.lq1[lane] * lp.lk1[lane], b = lp.lq2[lane] * lp.lk2[lane];
  a = wave_sum(a); b = wave_sum(b);
  return expf(a) - expf(b) + lp.lambda_init;
}

DI void conv_item(bf16_t* dst, int K, int row, int kg, const float* src, int ld, int col, const float* ks) {
  float v[32];
#pragma unroll
  for (int i = 0; i < 32; ++i) v[i] = src[(size_t)(kg * 32 + i) * ld + col];
  if (ks) {
#pragma unroll
    for (int i = 0; i < 32; i += 4) { const f32x4 s = *(const f32x4*)(ks + kg * 32 + i); v[i] *= s[0]; v[i + 1] *= s[1]; v[i + 2] *= s[2]; v[i + 3] *= s[3]; }
  }
  u32x4_t* d = (u32x4_t*)(dst + (size_t)row * K + kg * 32);
#pragma unroll
  for (int i = 0; i < 4; ++i) { u32x4_t w; w.x = pk2(v[8 * i], v[8 * i + 1]); w.y = pk2(v[8 * i + 2], v[8 * i + 3]); w.z = pk2(v[8 * i + 4], v[8 * i + 5]); w.w = pk2(v[8 * i + 6], v[8 * i + 7]); d[i] = w; }
}
DI int perm_logical(int p) {
  const int bj = p >> 7, wc = (p >> 5) & 3, n = (p >> 4) & 1, fq = (p >> 2) & 3, e = p & 3;
  return 64 * wc + 32 * bj + 8 * fq + 4 * n + e;
}
DI int perm_res(int p) { return (p & ~31) + 8 * ((p >> 2) & 3) + 4 * ((p >> 4) & 1) + (p & 3); }
DI void prologue(const MParams& p, LAS unsigned char* lds) {
  const int tidp = tid_opaque(); const int gtid = blockIdx.x * 512 + tidp, gsz = gridDim.x * 512;
  unsigned char* ws = p.ws;
  { const int gw = gtid >> 6, nw = gsz >> 6, lane = threadIdx.x & 63; bf16_t* XB = (bf16_t*)(ws + OFF_XB); u64* SS1 = (u64*)(ws + OFF_SS1);
    for (int row = gw; row < T_TOK; row += nw) { const float* xp = p.in[0] + (size_t)row * DM; float s = 0.f;
#pragma unroll
      for (int i = 0; i < 4; ++i) { const f32x4 v = *(const f32x4*)(xp + i * 256 + lane * 4); s += v[0] * v[0] + v[1] * v[1] + v[2] * v[2] + v[3] * v[3];
        u32x2_t w; w.x = pk2(v[0], v[1]); w.y = pk2(v[2], v[3]); *(u32x2_t*)(XB + (size_t)row * DM + i * 256 + lane * 4) = w; }
      s = wave_sum(s); if (lane == 0) SS1[row] = f2fx(s); } }
  { u64* SSV = (u64*)(ws + OFF_SSV); for (int i = gtid; i < T_TOK * 4; i += gsz) SSV[i] = 0ull; }
  { const int lane = tidp & 63, wv = tidp >> 6, n4 = lane & 15, kq = lane >> 4; LAS unsigned char* wl = lds + wv * 9216;
    for (int t = blockIdx.x * 8 + wv; t < NLAYER * 3008; t += gridDim.x * 8) {
      const int l = t / 3008; int r = t - l * 3008; const LP lp = make_lp(p, l);
      const float* src; const float* ks; bf16_t* dst; int ld, K, rt, kt, col;
      if (r < 640) { rt = r % 40; kt = r / 40; dst = (bf16_t*)lp.WinT; K = 1024; ld = INW; ks = lp.norm_attn_w; src = lp.w_in; const int row = 64 * rt + 4 * n4;
        if (row < 1536) { const int L = (row & ~255) + perm_logical(row & 255); col = L < 512 ? L : L + 512; } else { const int q = row - 1536; col = q < 512 ? 512 + q : 1536 + q; } }
      else if (r < 896) { r -= 640; rt = r & 15; kt = r >> 4; dst = (bf16_t*)lp.WoutT; K = 1024; ld = DM; ks = nullptr; src = lp.w_out; col = perm_res(64 * rt + 4 * n4); }
      else if (r < 2304) { r -= 896; rt = r % 88; kt = r / 88; dst = (bf16_t*)lp.WguT; K = 1024; ld = DFF; ks = lp.norm_ffn_w; const int row = 64 * rt + 4 * n4, pn = row >> 8, pp = row & 255;
        src = (pp >> 7) ? lp.w_up : lp.w_gate; const int q = pp & 127; col = 128 * pn + 32 * ((q >> 5) & 3) + 8 * ((q >> 2) & 3) + 4 * ((q >> 4) & 1) + (q & 3); }
      else { r -= 2304; rt = r & 15; kt = r >> 4; dst = (bf16_t*)lp.WdT; K = DFF; ld = DM; ks = nullptr; src = lp.w_down; col = perm_res(64 * rt + 4 * n4); }
      const float* sp = src + (size_t)(64 * kt + 16 * kq) * ld + col;
      f32x4 v[16];
#pragma unroll
      for (int j = 0; j < 16; ++j) v[j] = *(const f32x4*)(sp + (size_t)j * ld);
      if (ks) {
#pragma unroll
        for (int i = 0; i < 4; ++i) { const f32x4 sc = *(const f32x4*)(ks + 64 * kt + 16 * kq + 4 * i); v[4 * i] *= sc[0]; v[4 * i + 1] *= sc[1]; v[4 * i + 2] *= sc[2]; v[4 * i + 3] *= sc[3]; } }
#pragma unroll
      for (int n = 0; n < 4; ++n)
#pragma unroll
        for (int hh = 0; hh < 2; ++hh) { u32x4_t w; w.x = pk2(v[8 * hh][n], v[8 * hh + 1][n]); w.y = pk2(v[8 * hh + 2][n], v[8 * hh + 3][n]); w.z = pk2(v[8 * hh + 4][n], v[8 * hh + 5][n]); w.w = pk2(v[8 * hh + 6][n], v[8 * hh + 7][n]);
          *(LAS u32x4_t*)(wl + (4 * n4 + n) * 144 + (16 * kq + 8 * hh) * 2) = w; }
#pragma unroll
      for (int i = 0; i < 8; ++i) { const int row = 8 * i + (lane >> 3), pc = lane & 7; const u32x4_t w = *(const LAS u32x4_t*)(wl + row * 144 + pc * 16);
        *(u32x4_t*)(dst + (size_t)(64 * rt + row) * K + 64 * kt + pc * 8) = w; }
    }
  }
  for (int l = 0; l < NLAYER; ++l) { const LP lp = make_lp(p, l);
    for (int i = gtid; i < 65536; i += gsz) { const int jj = i & 127, ii = (i >> 7) & 127; ((bf16_t*)lp.Wsp)[i] = ((jj >> 6) <= (ii >> 6)) ? f2bf(lp.sp_w[i]) : (bf16_t)0; } }
}

enum { RB_U = 0, RB_Q, RB_KB, RB_GVT, RB_VT, RB_MIX, RB_F, RB_GB, RB_PB, RB_UB };
template <int W> DI unsigned char* rbuf(unsigned char* ws, int vcu, int loc) {
  constexpr size_t goff = W == RB_U ? OFF_U : W == RB_Q ? OFF_Q : W == RB_KB ? OFF_KB : W == RB_GVT ? OFF_GVT : W == RB_VT ? OFF_VT : W == RB_MIX ? OFF_MIX : W == RB_F ? OFF_F : W == RB_GB ? OFF_GB : W == RB_PB ? OFF_PB : OFF_UB;
  if (!loc) return ws + goff;
  constexpr size_t KiB = 1024;
  constexpr size_t loff = W == RB_U ? 0 : W == RB_Q ? 4 * MiB : W == RB_KB ? 8 * MiB : W == RB_GVT ? 12 * MiB : W == RB_VT ? 16 * MiB : W == RB_MIX ? 20 * MiB : W == RB_F ? 0 : W == RB_GB ? 22 * MiB : W == RB_PB ? 22 * MiB + 1536 * KiB : 25 * MiB;
  constexpr size_t bias = (W == RB_U || W == RB_Q || W == RB_KB) ? (size_t)4096 * 512 * 2 : (W == RB_GVT || W == RB_VT) ? (size_t)4096 * 2 : W == RB_MIX ? (size_t)4096 * 1024 * 2 : W == RB_F ? (size_t)4096 * DFF * 2 : (size_t)64 * 2 * DFF * 4;
  const size_t x = (size_t)(vcu >> 5);
  return ws + OFF_R + x * (28 * MiB) + loff - x * bias;
}
struct DupOrder : pg8::StaticOrder {
  __device__ bool next(int i, Unit& u) const { return pg8::StaticOrder::next(i >> 1, u); }
};
struct EpiResid {
  static constexpr bool PERM = false, AFTER_DRAIN = false, TWICE = (PROBE_EPI_ACE != 0);
  const float* base32; float* out32; bf16_t* XB; u64* SS;
  DI void operator()(const f32x4 (&acc)[2][2][4][2], const Unit& u, int wr, int wc, int fr, int fq) const {
    const int row0 = u.pm * 256 + wr * 64 + fr, col0 = u.pn * 256 + wc * 32 + 8 * fq;
    if (base32) {
      f32x4 nb[2][2];
#pragma unroll
      for (int bj = 0; bj < 2; ++bj)
#pragma unroll
        for (int n = 0; n < 2; ++n) nb[bj][n] = *(const f32x4*)(base32 + (size_t)row0 * DM + col0 + bj * 128 + n * 4);
#pragma unroll
      for (int g = 0; g < 8; ++g) { const int ai = g >> 2, m = g & 3; const int row = row0 + ai * 128 + m * 16; const size_t ro = (size_t)row * DM + col0; float ss = 0.f;
        f32x4 cbv[2][2];
#pragma unroll
        for (int bj = 0; bj < 2; ++bj)
#pragma unroll
          for (int n = 0; n < 2; ++n) cbv[bj][n] = nb[bj][n];
        if (g < 7) { const int r2 = row0 + ((g + 1) >> 2) * 128 + ((g + 1) & 3) * 16;
#pragma unroll
          for (int bj = 0; bj < 2; ++bj)
#pragma unroll
            for (int n = 0; n < 2; ++n) nb[bj][n] = *(const f32x4*)(base32 + (size_t)r2 * DM + col0 + bj * 128 + n * 4); }
#pragma unroll
        for (int bj = 0; bj < 2; ++bj) { const f32x4 v0 = acc[ai][bj][m][0] + cbv[bj][0], v1 = acc[ai][bj][m][1] + cbv[bj][1];
          u32x4_t w; w.x = pk2(v0[0], v0[1]); w.y = pk2(v0[2], v0[3]); w.z = pk2(v1[0], v1[1]); w.w = pk2(v1[2], v1[3]); *(u32x4_t*)(XB + ro + bj * 128) = w;
          ss += ((v0[0] * v0[0] + v0[1] * v0[1]) + (v0[2] * v0[2] + v0[3] * v0[3])) + ((v1[0] * v1[0] + v1[1] * v1[1]) + (v1[2] * v1[2] + v1[3] * v1[3])); }
        ss += __shfl_xor(ss, 16); ss += __shfl_xor(ss, 32); if (fq == 0) fx_add(SS + row, ss);
        asm volatile("" ::: "memory"); }
    } else {
      u32x4_t nb[2];
#pragma unroll
      for (int bj = 0; bj < 2; ++bj) nb[bj] = *(const u32x4_t*)(XB + (size_t)row0 * DM + col0 + bj * 128);
#pragma unroll
      for (int g = 0; g < 8; ++g) { const int ai = g >> 2, m = g & 3; const int row = row0 + ai * 128 + m * 16; const size_t ro = (size_t)row * DM + col0; float ss = 0.f;
        u32x4_t cbv[2];
#pragma unroll
        for (int bj = 0; bj < 2; ++bj) cbv[bj] = nb[bj];
        if (g < 7) { const int r2 = row0 + ((g + 1) >> 2) * 128 + ((g + 1) & 3) * 16;
#pragma unroll
          for (int bj = 0; bj < 2; ++bj) nb[bj] = *(const u32x4_t*)(XB + (size_t)r2 * DM + col0 + bj * 128); }
#pragma unroll
        for (int bj = 0; bj < 2; ++bj) { const u32x4_t c = cbv[bj];
          const f32x4 v0 = acc[ai][bj][m][0] + (f32x4){bflo(c.x), bfhi(c.x), bflo(c.y), bfhi(c.y)}, v1 = acc[ai][bj][m][1] + (f32x4){bflo(c.z), bfhi(c.z), bflo(c.w), bfhi(c.w)};
          if (out32) { *(f32x4*)(out32 + ro + bj * 128) = v0; *(f32x4*)(out32 + ro + bj * 128 + 4) = v1; }
          else { u32x4_t w; w.x = pk2(v0[0], v0[1]); w.y = pk2(v0[2], v0[3]); w.z = pk2(v1[0], v1[1]); w.w = pk2(v1[2], v1[3]); *(u32x4_t*)(XB + ro + bj * 128) = w;
            ss += ((v0[0] * v0[0] + v0[1] * v0[1]) + (v0[2] * v0[2] + v0[3] * v0[3])) + ((v1[0] * v1[0] + v1[1] * v1[1]) + (v1[2] * v1[2] + v1[3] * v1[3])); } }
        if (!out32) { ss += __shfl_xor(ss, 16); ss += __shfl_xor(ss, 32); if (fq == 0) fx_add(SS + row, ss); }
        asm volatile("" ::: "memory"); }
    }
  }
};
struct EpiA1 {
  static constexpr bool PERM = false, AFTER_DRAIN = false, TWICE = (PROBE_EPI_ACE != 0);
  const u64* SS1; bf16_t *U, *Q, *KB; const float *qw, *kw;
  DI void operator()(const f32x4 (&acc)[2][2][4][2], const Unit& u, int wr, int wc, int fr, int fq) const {
    const int row0 = u.pm * 256 + wr * 64 + fr, lc0 = wc * 64 + 8 * fq, region = u.pn >> 1;
    u64 rsv[8];
#pragma unroll
    for (int g = 0; g < 8; ++g) rsv[g] = SS1[row0 + (g >> 2) * 128 + (g & 3) * 16];
    if (region == 0) {
#pragma unroll
      for (int g = 0; g < 8; ++g) { const int ai = g >> 2, m = g & 3; const int row = row0 + ai * 128 + m * 16; const float rs = rs1024(rsv[g]);
#pragma unroll
        for (int bj = 0; bj < 2; ++bj) { const f32x4 a = acc[ai][bj][m][0] * rs, b = acc[ai][bj][m][1] * rs; u32x4_t w;
          w.x = pk2(gelu1(a[0]), gelu1(a[1])); w.y = pk2(gelu1(a[2]), gelu1(a[3])); w.z = pk2(gelu1(b[0]), gelu1(b[1])); w.w = pk2(gelu1(b[2]), gelu1(b[3]));
          *(u32x4_t*)(U + (size_t)row * 512 + u.pn * 256 + lc0 + 32 * bj) = w; } }
    } else {
      const bool isq = region == 1; const float* wp = (isq ? qw : kw) + 8 * fq; bf16_t* dst = (isq ? Q : KB) + (u.pn & 1) * 256 + lc0; const float sc = isq ? QSCALE : 1.0f;
      f32x4 wv[2][2];
#pragma unroll
      for (int bj = 0; bj < 2; ++bj)
#pragma unroll
        for (int n = 0; n < 2; ++n) wv[bj][n] = *(const f32x4*)(wp + 32 * bj + 4 * n);
#pragma unroll
      for (int g = 0; g < 8; ++g) { const int ai = g >> 2, m = g & 3; const int row = row0 + ai * 128 + m * 16; const float rs = rs1024(rsv[g]); float ss = 0.f; f32x4 v[2][2];
#pragma unroll
        for (int bj = 0; bj < 2; ++bj)
#pragma unroll
          for (int n = 0; n < 2; ++n) { v[bj][n] = acc[ai][bj][m][n] * rs; const f32x4 t = v[bj][n]; ss += (t[0] * t[0] + t[1] * t[1]) + (t[2] * t[2] + t[3] * t[3]); }
        ss += __shfl_xor(ss, 16); ss += __shfl_xor(ss, 32);
        const float r2 = rsqrtf(ss * (1.0f / 64.0f) + EPS) * sc;
#pragma unroll
        for (int bj = 0; bj < 2; ++bj) { const f32x4 a = v[bj][0] * r2 * wv[bj][0], b = v[bj][1] * r2 * wv[bj][1]; u32x4_t w;
          w.x = pk2(a[0], a[1]); w.y = pk2(a[2], a[3]); w.z = pk2(b[0], b[1]); w.w = pk2(b[2], b[3]);
          *(u32x4_t*)(dst + (size_t)row * 512 + 32 * bj) = w; } }
    }
  }
};
struct EpiA2 {
  static constexpr bool PERM = false, AFTER_DRAIN = false, TWICE = (PROBE_EPI_ACE != 0);
  const u64* SS1; bf16_t *GVT, *VT; u64* SSV; int vtp;
  DI void operator()(const f32x4 (&acc)[2][2][4][2], const Unit& u, int wr, int wc, int fr, int fq) const {
    const int colbase = u.pn * 256 + wc * 32;
    f32x4 rs[2][2];
#pragma unroll
    for (int bj = 0; bj < 2; ++bj)
#pragma unroll
      for (int n = 0; n < 2; ++n) { const u64* sp = SS1 + colbase + bj * 128 + n * 16 + 4 * fq; rs[bj][n] = (f32x4){rs1024(sp[0]), rs1024(sp[1]), rs1024(sp[2]), rs1024(sp[3])}; }
    if (u.pm < 2) {
#pragma unroll
      for (int ai = 0; ai < 2; ++ai) { const int head = 2 * u.pm + ai;
#pragma unroll
        for (int bj = 0; bj < 2; ++bj)
#pragma unroll
          for (int n = 0; n < 2; ++n) { f32x4 sq = (f32x4){0.f, 0.f, 0.f, 0.f}; const int tok = colbase + bj * 128 + n * 16 + 4 * fq;
#pragma unroll
            for (int m = 0; m < 4; ++m) { const int row = u.pm * 256 + ai * 128 + wr * 64 + m * 16 + fr;
              const f32x4 a = acc[ai][bj][m][n] * rs[bj][n]; f32x4 g; g[0] = gelu1(a[0]); g[1] = gelu1(a[1]); g[2] = gelu1(a[2]); g[3] = gelu1(a[3]);
              u32x2_t w; w.x = pk2(g[0], g[1]); w.y = pk2(g[2], g[3]); *(u32x2_t*)(GVT + (size_t)row * vtp + tok) = w; sq += g * g; }
#pragma unroll
            for (int e = 0; e < 4; ++e) sq[e] = row_sum16(sq[e]);
            if (fr == 0) {
#pragma unroll
              for (int e = 0; e < 4; ++e) fx_add(SSV + (size_t)(tok + e) * 4 + head, sq[e]); }
            asm volatile("" ::: "memory"); } }
    } else {
#pragma unroll
      for (int ai = 0; ai < 2; ++ai)
#pragma unroll
        for (int m = 0; m < 4; ++m) { const int row = (u.pm - 2) * 256 + ai * 128 + wr * 64 + m * 16 + fr;
#pragma unroll
          for (int bj = 0; bj < 2; ++bj)
#pragma unroll
            for (int n = 0; n < 2; ++n) { const f32x4 a = acc[ai][bj][m][n] * rs[bj][n]; u32x2_t w; w.x = pk2(a[0], a[1]); w.y = pk2(a[2], a[3]);
              *(u32x2_t*)(VT + (size_t)row * vtp + colbase + bj * 128 + n * 16 + 8 * (fq & 1) + 4 * (fq >> 1)) = w; } }
    }
  }
};
struct EpiD {
  static constexpr bool PERM = false, AFTER_DRAIN = false, TWICE = (PROBE_EPI_D != 0);
  const u64* SS2; const float *cw, *cb; bf16_t* F; float *GB, *PB, *UB;
  DI void operator()(const f32x4 (&acc)[2][2][4][2], const Unit& u, int wr, int wc, int fr, int fq) const {
    const int cbase = u.pn * 128 + wc * 32 + 8 * fq;
    const int rb0 = u.pm * 256 + wr * 64;
    u64 rsv[8]; f32x4 w0[2], w1[2], w2[2], bb[2];
#pragma unroll
    for (int g = 0; g < 8; ++g) rsv[g] = SS2[rb0 + (g >> 2) * 128 + (g & 3) * 16 + fr];
#pragma unroll
    for (int n = 0; n < 2; ++n) { w0[n] = *(const f32x4*)(cw + cbase + 4 * n); w1[n] = *(const f32x4*)(cw + DFF + cbase + 4 * n); w2[n] = *(const f32x4*)(cw + 2 * DFF + cbase + 4 * n); bb[n] = *(const f32x4*)(cb + cbase + 4 * n); }
#pragma unroll
    for (int ai = 0; ai < 2; ++ai) {
      const int rb = rb0 + ai * 128, bd = rb >> 6;
      float rs[4];
#pragma unroll
      for (int m = 0; m < 4; ++m) rs[m] = rs1024(rsv[ai * 4 + m]);
      unsigned fo[4][4];
#pragma unroll
      for (int n = 0; n < 2; ++n) {
        const int cn = cbase + 4 * n;
        f32x4 pg, ug, gg; float fv[4][4];
#pragma unroll
        for (int e = 0; e < 4; ++e) {
          float G[4], r1[4], r2[4];
#pragma unroll
          for (int m = 0; m < 4; ++m) { G[m] = acc[ai][0][m][n][e] * rs[m]; r1[m] = dpp_ror1(G[m]); r2[m] = dpp_ror2(G[m]); }
#pragma unroll
          for (int m = 0; m < 4; ++m) {
            const float p1 = (fr >= 1) ? r1[m] : (m > 0 ? r1[m > 0 ? m - 1 : 0] : 0.f);
            const float p2 = (fr >= 2) ? r2[m] : (m > 0 ? r2[m > 0 ? m - 1 : 0] : 0.f);
            const float g = w2[n][e] * G[m] + w1[n][e] * p1 + w0[n][e] * p2 + bb[n][e];
            const float uv = acc[ai][1][m][n][e] * rs[m];
            if (m == 0) { pg[e] = g; ug[e] = uv; }
            if (m == 3) gg[e] = G[3];
            fv[m][e] = g * __builtin_amdgcn_rcpf(1.0f + __expf(-g)) * uv;
          }
        }
#pragma unroll
        for (int m = 0; m < 4; ++m) { fo[m][2 * n] = pk2(fv[m][0], fv[m][1]); fo[m][2 * n + 1] = pk2(fv[m][2], fv[m][3]); }
        if (fr < 2) { *(f32x4*)(PB + (size_t)(bd * 2 + fr) * DFF + cn) = pg; *(f32x4*)(UB + (size_t)(bd * 2 + fr) * DFF + cn) = ug; }
        if (fr >= 14) { *(f32x4*)(GB + (size_t)(bd * 2 + fr - 14) * DFF + cn) = gg; }
      }
#pragma unroll
      for (int m = 0; m < 4; ++m) {
        if (!(m == 0 && fr < 2)) { u32x4_t w; w.x = fo[m][0]; w.y = fo[m][1]; w.z = fo[m][2]; w.w = fo[m][3]; *(u32x4_t*)(F + (size_t)(rb + 16 * m + fr) * DFF + cbase) = w; }
      }
    }
  }
};
DI void fixup_phase(const LP& lp, unsigned char* ws, int vcu, int loc) {
  const float *GB = (const float*)rbuf<RB_GB>(ws, vcu, loc), *PB = (const float*)rbuf<RB_PB>(ws, vcu, loc), *UB = (const float*)rbuf<RB_UB>(ws, vcu, loc); bf16_t* F = (bf16_t*)rbuf<RB_F>(ws, vcu, loc);
  const int t_ = tid_opaque(); const int w0 = loc ? (vcu >> 5) * 90112 + (vcu & 31) * 512 + t_ : blockIdx.x * 512 + t_, wend = loc ? ((vcu >> 5) + 1) * 90112 : 512 * 2 * 704, gsz = loc ? 32 * 512 : gridDim.x * 512;
  for (int w = w0; w < wend; w += gsz) {
    const int c = (w % 704) * 4, j = (w / 704) & 1, bd = w / 1408;
    f32x4 g = *(const f32x4*)(PB + (size_t)(bd * 2 + j) * DFF + c);
    if (bd & 31) { const f32x4 gm1 = *(const f32x4*)(GB + (size_t)((bd - 1) * 2 + 1) * DFF + c); const f32x4 w0 = *(const f32x4*)(lp.conv_w + c);
      if (j == 0) { const f32x4 gm2 = *(const f32x4*)(GB + (size_t)((bd - 1) * 2) * DFF + c); const f32x4 w1 = *(const f32x4*)(lp.conv_w + DFF + c); g += w1 * gm1 + w0 * gm2; }
      else g += w0 * gm1; }
    const f32x4 uv = *(const f32x4*)(UB + (size_t)(bd * 2 + j) * DFF + c); float f[4];
#pragma unroll
    for (int e = 0; e < 4; ++e) f[e] = g[e] * __builtin_amdgcn_rcpf(1.0f + __expf(-g[e])) * uv[e];
    u32x2_t o; o.x = pk2(f[0], f[1]); o.y = pk2(f[2], f[3]);
    *(u32x2_t*)(F + (size_t)(bd * 64 + j) * DFF + c) = o;
  }
}

DI void spatial_phase(const LP& lp, unsigned char* ws, LAS unsigned char* lds, int vcu, int loc) {
  const bf16_t *U = (const bf16_t*)rbuf<RB_U>(ws, vcu, loc), *GVT = (const bf16_t*)rbuf<RB_GVT>(ws, vcu, loc); const u64* SSV = (const u64*)(ws + OFF_SSV); bf16_t* MIX = (bf16_t*)rbuf<RB_MIX>(ws, vcu, loc);
  const int vtp = loc ? 4096 : T_TOK;
  constexpr int TB = 32768;
  LAS float* sr = (LAS float*)(lds + 2 * TB);
  const int tid = tid_opaque(), lane = tid & 63, w = __builtin_amdgcn_readfirstlane(tid >> 6), l15 = lane & 15, kq = lane >> 4;
#define SP_STAGE(item, buf) do { const int h_ = (item) & 3, t_ = ((item) >> 2) * 128; _Pragma("unroll") for (int i = 0; i < 4; ++i) { const int P = (w * 4 + i) * 64 + lane, row = P >> 4, pc = (P & 15) ^ (row & 15); \
    __builtin_amdgcn_global_load_lds((const unsigned*)(GVT + (size_t)(h_ * 128 + row) * vtp + t_ + pc * 8), (LAS unsigned*)(lds + (buf) * TB + (w * 4 + i) * 1024), 16, 0, 0); } } while (0)
  LAS float* vn_l = sr + 128; LAS float* on_l = vn_l + 512; LAS float* sb_l = on_l + 512;
  const int it_step = loc ? 1 : (int)gridDim.x, it_end = loc ? vcu * 4 + 4 : 1024;
  int it = loc ? vcu * 4 : (int)blockIdx.x, buf = 0;
  if (it < it_end) SP_STAGE(it, 0);
  { const float a = lp.v_norm_w[tid], b = lp.out_norm_w[tid], c = lp.sp_b[tid]; vn_l[tid] = a; on_l[tid] = b; sb_l[tid] = c; }
  asm volatile("s_waitcnt vmcnt(0)" ::: "memory");
  __syncthreads();
  const int x_lane = l15 * 256 + ((kq ^ l15) << 4);
  const int i0 = 16 * w, nks = (w < 4) ? 2 : 4;
  u32x4_t rawN[4]; u32x2_t urN[8]; u64 ssvN = 0ull;
#define SP_LOADREGS(item) do { const int h_ = (item) & 3, t_ = ((item) >> 2) * 128; \
    _Pragma("unroll") for (int ks = 0; ks < 4; ++ks) rawN[ks] = (ks < nks) ? *(const u32x4_t*)(lp.Wsp + (size_t)(h_ * 128 + i0 + l15) * 128 + ks * 32 + kq * 8) : (u32x4_t){0u, 0u, 0u, 0u}; \
    _Pragma("unroll") for (int dt = 0; dt < 8; ++dt) urN[dt] = *(const u32x2_t*)(U + (size_t)(t_ + i0 + l15) * 512 + h_ * 128 + 16 * dt + 4 * kq); \
    ssvN = (tid < 128) ? SSV[(size_t)(t_ + tid) * 4 + h_] : 0ull; } while (0)
  if (it < it_end) SP_LOADREGS(it);
  for (; it < it_end; it += it_step, buf ^= 1) {
    const int h = it & 3, tok0 = (it >> 2) * 128, irow = tok0 + i0 + l15;
    u32x4_t raw[4]; u32x2_t ur[8];
#pragma unroll
    for (int ks = 0; ks < 4; ++ks) raw[ks] = rawN[ks];
#pragma unroll
    for (int dt = 0; dt < 8; ++dt) ur[dt] = urN[dt];
    const u64 ssv = ssvN;
    const float bias = sb_l[h * 128 + i0 + l15];
    const int nit = it + it_step;
    if (nit < it_end) { SP_STAGE(nit, buf ^ 1); SP_LOADREGS(nit); }
    if (tid < 128) sr[tid] = rsqrtf(fx2f(ssv) * (1.0f / 128.0f) + EPS);
    __syncthreads();
    bf16x8 yf[4];
#pragma unroll
    for (int ks = 0; ks < 4; ++ks) { const LAS float* sp = sr + ks * 32 + kq * 8; const u32x4_t r = raw[ks]; u32x4_t o;
      o.x = pk2(bflo(r.x) * sp[0], bfhi(r.x) * sp[1]); o.y = pk2(bflo(r.y) * sp[2], bfhi(r.y) * sp[3]); o.z = pk2(bflo(r.z) * sp[4], bfhi(r.z) * sp[5]); o.w = pk2(bflo(r.w) * sp[6], bfhi(r.w) * sp[7]);
      yf[ks] = __builtin_bit_cast(bf16x8, o); }
    const LAS unsigned char* tb = lds + buf * TB;
    float o[8][4]; float ss = 0.f;
#pragma unroll
    for (int dt = 0; dt < 8; ++dt) {
      f32x4 acc = (f32x4){0.f, 0.f, 0.f, 0.f};
#pragma unroll
      for (int ks = 0; ks < 4; ++ks) if (ks < nks) {
        const bf16x8 xf = *(const LAS bf16x8*)(tb + dt * 4096 + (x_lane ^ (ks << 6)));
        acc = __builtin_amdgcn_mfma_f32_16x16x32_bf16(xf, yf[ks], acc, 0, 0, 0); }
      const int d0 = 16 * dt + 4 * kq; const f32x4 wv = *(const LAS f32x4*)(vn_l + h * 128 + d0);
      o[dt][0] = bflo(ur[dt].x) * (acc[0] * wv[0] + bias); o[dt][1] = bfhi(ur[dt].x) * (acc[1] * wv[1] + bias); o[dt][2] = bflo(ur[dt].y) * (acc[2] * wv[2] + bias); o[dt][3] = bfhi(ur[dt].y) * (acc[3] * wv[3] + bias);
      ss += (o[dt][0] * o[dt][0] + o[dt][1] * o[dt][1]) + (o[dt][2] * o[dt][2] + o[dt][3] * o[dt][3]);
    }
    ss += __shfl_xor(ss, 16); ss += __shfl_xor(ss, 32);
    const float rs = rsqrtf(ss * (1.0f / 128.0f) + EPS);
#pragma unroll
    for (int dt = 0; dt < 8; ++dt) { const int d0 = 16 * dt + 4 * kq; const f32x4 wo = *(const LAS f32x4*)(on_l + h * 128 + d0);
      u32x2_t q; q.x = pk2(o[dt][0] * rs * wo[0], o[dt][1] * rs * wo[1]); q.y = pk2(o[dt][2] * rs * wo[2], o[dt][3] * rs * wo[3]);
      *(u32x2_t*)(MIX + (size_t)irow * 1024 + h * 128 + d0) = q; }
    asm volatile("s_waitcnt vmcnt(8)" ::: "memory");
    __syncthreads();
  }
#undef SP_STAGE
#undef SP_LOADREGS
}

DI void attn_phase(const MParams& p, int l, LAS unsigned char* lds, int vcu, int loc) {
  unsigned char* ws = p.ws;
  const bf16_t *Q = (const bf16_t*)rbuf<RB_Q>(ws, vcu, loc), *KB = (const bf16_t*)rbuf<RB_KB>(ws, vcu, loc), *VT = (const bf16_t*)rbuf<RB_VT>(ws, vcu, loc); bf16_t* MIX = (bf16_t*)rbuf<RB_MIX>(ws, vcu, loc);
  const int vtp = loc ? 4096 : T_TOK;
  constexpr int KBUF = 16384, VBUF = 16384, STG = KBUF + VBUF, QOFF = 3 * STG;
  static_assert(QOFF + 65536 <= LDS_BYTES, "attention LDS");
  const unsigned sv0 = __builtin_amdgcn_readfirstlane(((volatile LAS unsigned*)(lds + 131072))[0]), sv1 = __builtin_amdgcn_readfirstlane(((volatile LAS unsigned*)(lds + 131072))[1]), sv2 = __builtin_amdgcn_readfirstlane(((volatile LAS unsigned*)(lds + 131072))[2]), sv3 = __builtin_amdgcn_readfirstlane(((volatile LAS unsigned*)(lds + 131072))[3]);
  __syncthreads();
  const float lambda_init = 0.8f - 0.6f * expf(-0.3f * (float)(l + 1));
  const float* dnw = p.in[13] + l * 128;
#pragma unroll 1
  for (int pi = vcu; pi < 256; pi += gridDim.x) {
    const int b = pi >> 4, h = (pi >> 2) & 3, j = pi & 3;
#pragma unroll 1
    for (int it = 0; it < 2; ++it) {
      const int tid = tid_opaque(), lane = tid & 63, w = __builtin_amdgcn_readfirstlane(tid >> 6), l31 = lane & 31, hh = lane >> 5;
      const int qb = it ? j : 7 - j, t0 = b * 2048 + 256 * qb, ntl = 4 * qb + 4, ntw = 4 * qb + (w >> 1) + 1;
#pragma unroll
      for (int i = 0; i < 8; ++i) { const int P = (w * 8 + i) * 64 + lane, row = P >> 4, pos = P & 15, pc = pos ^ (row & 15);
        __builtin_amdgcn_global_load_lds((const unsigned*)(Q + (size_t)(t0 + row) * 512 + h * 128 + pc * 8), (LAS unsigned*)(lds + QOFF + (w * 8 + i) * 1024), 16, 0, 0); }
      const bf16_t* kbase = KB + (size_t)(b * 2048) * 512 + h * 128; const bf16_t* vbase = VT + (size_t)(h * 128) * vtp + b * 2048;
      int koff[2], voff[2];
#pragma unroll
      for (int i = 0; i < 2; ++i) { const int P = (w * 2 + i) * 64 + lane; { const int row = P >> 4, pos = P & 15, pc = pos ^ (row & 15); koff[i] = row * 512 + pc * 8; }
        { const int row = P >> 3, pos = P & 7, pc = pos ^ ((row >> 1) & 7); voff[i] = row * vtp + pc * 8; } }
#define ATT_STAGE(kt, buf) do { _Pragma("unroll") for (int i = 0; i < 2; ++i) { \
        __builtin_amdgcn_global_load_lds((const unsigned*)(kbase + (size_t)(kt) * (64 * 512) + koff[i]), (LAS unsigned*)(lds + (buf) * STG + (w * 2 + i) * 1024), 16, 0, 0); \
        __builtin_amdgcn_global_load_lds((const unsigned*)(vbase + (kt) * 64 + voff[i]), (LAS unsigned*)(lds + (buf) * STG + KBUF + (w * 2 + i) * 1024), 16, 0, 0); } } while (0)
#define ATT_STAGE_AT(kt, soff) do { _Pragma("unroll") for (int i = 0; i < 2; ++i) { \
        __builtin_amdgcn_global_load_lds((const unsigned*)(kbase + (size_t)(kt) * (64 * 512) + koff[i]), (LAS unsigned*)(lds + (soff) + (w * 2 + i) * 1024), 16, 0, 0); \
        __builtin_amdgcn_global_load_lds((const unsigned*)(vbase + (kt) * 64 + voff[i]), (LAS unsigned*)(lds + (soff) + KBUF + (w * 2 + i) * 1024), 16, 0, 0); } } while (0)
      ATT_STAGE(0, 0);
      if (ntl > 1) { ATT_STAGE(1, 1); asm volatile("s_waitcnt vmcnt(4)" ::: "memory"); } else asm volatile("s_waitcnt vmcnt(0)" ::: "memory");
      __syncthreads();
      int st_cur = 0, st_pre = 2 * STG;
      f32x16 O[2][4];
#pragma unroll
      for (int c = 0; c < 2; ++c)
#pragma unroll
        for (int bk = 0; bk < 4; ++bk)
#pragma unroll
          for (int i = 0; i < 16; ++i) O[c][bk][i] = 0.f;
      float lsum[2] = {0.f, 0.f};
      const int qr = 32 * w + l31;
      int k_lane = l31 * 256 + ((hh ^ (l31 & 15)) << 4), q_lane = QOFF + qr * 256 + ((hh ^ (qr & 15)) << 4), v_lane = KBUF + l31 * 128 + ((hh ^ ((l31 >> 1) & 7)) << 4);
#pragma unroll 1
      for (int kt = 0; kt < ntl; ++kt) {
        if (kt + 2 < ntl) ATT_STAGE_AT(kt + 2, st_pre);
        if (kt < ntw) {
          asm volatile("" : "+v"(k_lane), "+v"(q_lane), "+v"(v_lane));
          const LAS unsigned char* tb = lds + st_cur;
#pragma unroll
          for (int kb = 0; kb < 2; ++kb) {
            bf16x8 pf[2][2];
#pragma unroll
            for (int c = 0; c < 2; ++c) {
              f32x16 S;
#pragma unroll
              for (int i = 0; i < 16; ++i) S[i] = 0.f;
#pragma unroll
              for (int ks = 0; ks < 4; ++ks) {
                const int xo = (c * 8 + ks * 2) << 4;
                const bf16x8 qf = *(const LAS bf16x8*)(lds + (q_lane ^ xo));
                const bf16x8 kf = *(const LAS bf16x8*)(tb + (k_lane ^ xo) + kb * 8192);
                S = __builtin_amdgcn_mfma_f32_32x32x16_bf16(kf, qf, S, 0, 0, 0);
              }
              float ls = 0.f;
#pragma unroll
              for (int hs = 0; hs < 2; ++hs) { u32x4_t pw;
#pragma unroll
                for (int t = 0; t < 4; ++t) { const float a = __builtin_amdgcn_exp2f(S[8 * hs + 2 * t]), bq = __builtin_amdgcn_exp2f(S[8 * hs + 2 * t + 1]); ls += a + bq; pw[t] = pk2(a, bq); }
                pf[c][hs] = __builtin_bit_cast(bf16x8, pw); }
              lsum[c] += ls;
              __builtin_amdgcn_sched_barrier(0);
            }
#pragma unroll
            for (int bk = 0; bk < 4; ++bk) {
              const bf16x8 v0 = *(const LAS bf16x8*)(tb + (v_lane ^ ((2 * kb) << 5)) + bk * 4096);
              const bf16x8 v1 = *(const LAS bf16x8*)(tb + (v_lane ^ ((2 * kb + 1) << 5)) + bk * 4096);
              O[0][bk] = __builtin_amdgcn_mfma_f32_32x32x16_bf16(v0, pf[0][0], O[0][bk], 0, 0, 0);
              O[1][bk] = __builtin_amdgcn_mfma_f32_32x32x16_bf16(v0, pf[1][0], O[1][bk], 0, 0, 0);
              O[0][bk] = __builtin_amdgcn_mfma_f32_32x32x16_bf16(v1, pf[0][1], O[0][bk], 0, 0, 0);
              O[1][bk] = __builtin_amdgcn_mfma_f32_32x32x16_bf16(v1, pf[1][1], O[1][bk], 0, 0, 0);
              __builtin_amdgcn_sched_barrier(0);
            }
          }
        }
        if (kt + 2 < ntl) asm volatile("s_waitcnt vmcnt(4)" ::: "memory"); else asm volatile("s_waitcnt vmcnt(0)" ::: "memory");
        __syncthreads();
        st_pre = st_cur; st_cur = (st_cur == 2 * STG) ? 0 : st_cur + STG;
      }
#undef ATT_STAGE
#undef ATT_STAGE_AT
      const int tid2 = tid_opaque(), lane2 = tid2 & 63, w2 = __builtin_amdgcn_readfirstlane(tid2 >> 6), hh2 = lane2 >> 5, qr2 = 32 * w2 + (lane2 & 31);
      float lam;
      { const float* q1 = p.in[9] + l * 64; const float* k1 = p.in[10] + l * 64; const float* q2 = p.in[11] + l * 64; const float* k2 = p.in[12] + l * 64;
        float a = q1[lane2] * k1[lane2], bq = q2[lane2] * k2[lane2]; a = wave_sum(a); bq = wave_sum(bq); lam = expf(a) - expf(bq) + lambda_init; }
      float l1 = lsum[0], l2 = lsum[1]; l1 += __shfl_xor(l1, 32); l2 += __shfl_xor(l2, 32);
      const float inv1 = 1.0f / l1, inv2 = lam / l2; float ss = 0.f;
#pragma unroll
      for (int bk = 0; bk < 4; ++bk)
#pragma unroll
        for (int i = 0; i < 16; ++i) { const float o = O[0][bk][i] * inv1 - O[1][bk][i] * inv2; O[0][bk][i] = o; ss += o * o; }
      ss += __shfl_xor(ss, 32);
      const float rs = rsqrtf(ss * (1.0f / 128.0f) + EPS) * (1.0f - lambda_init);
      bf16_t* orow = MIX + (size_t)(t0 + qr2) * 1024 + 512 + h * 128;
#pragma unroll
      for (int bk = 0; bk < 4; ++bk)
#pragma unroll
        for (int g = 0; g < 4; ++g) { const int dv0 = 32 * bk + 8 * g + 4 * hh2; const f32x4 wv = *(const f32x4*)(dnw + dv0);
          u32x2_t q; q.x = pk2(O[0][bk][4 * g] * rs * wv[0], O[0][bk][4 * g + 1] * rs * wv[1]); q.y = pk2(O[0][bk][4 * g + 2] * rs * wv[2], O[0][bk][4 * g + 3] * rs * wv[3]);
          *(u32x2_t*)(orow + dv0) = q; }
    }
  }
  __syncthreads();
  if (threadIdx.x == 0) { volatile LAS unsigned* stw = (volatile LAS unsigned*)(lds + 131072); stw[0] = sv0; stw[1] = sv1; stw[2] = sv2; stw[3] = sv3; }
  __syncthreads();
}


#define XB_TMO      128
#define XB_XCNT(j)  (256  + 64 * (j))
#define XB_XSUB(j)  (1280 + 64 * (j))
#define XB_XGEN(j)  (2304 + 64 * (j))
#define XB_TOP      3328
#define XB_TOPGEN   3392
#define XCD_BAR_WORDS 3456
#define XB_SPIN_CAP (1u << 18)

__device__ __forceinline__ unsigned xb_ld(unsigned* p)              { return __hip_atomic_load(p, __ATOMIC_RELAXED, __HIP_MEMORY_SCOPE_AGENT); }
__device__ __forceinline__ unsigned xb_add(unsigned* p, unsigned v) { return __hip_atomic_fetch_add(p, v, __ATOMIC_RELAXED, __HIP_MEMORY_SCOPE_AGENT); }
__device__ __forceinline__ unsigned xb_xcc_id() { return (unsigned)__builtin_amdgcn_s_getreg((3 << 11) | 20) & 0xFu; }
#define XB_SPIN(cond, bar) do { unsigned _sp = 0; while (cond) { __builtin_amdgcn_s_sleep(1); \
    if ((++_sp & 255u) == 0u) { if (xb_ld(&(bar)[XB_TMO])) break; if (_sp > XB_SPIN_CAP) { atomicAdd(&(bar)[XB_TMO], 1u); break; } } } } while (0)

struct XcdBarrier {
    unsigned* bar; unsigned x;
    volatile LAS unsigned* st;
};

__device__ __forceinline__ XcdBarrier xcd_barrier_post(unsigned* bar, volatile LAS unsigned* st) {
    XcdBarrier b; b.bar = bar; b.x = xb_xcc_id(); b.st = st;
    if (threadIdx.x == 0) st[2] = xb_add(&bar[XB_XCNT(b.x)], 1u);
    return b;
}
__device__ __forceinline__ void xcd_barrier_complete(unsigned* bar, unsigned x, unsigned& nloc, unsigned& nx) {
    const unsigned G = gridDim.x * gridDim.y * gridDim.z;
    unsigned sum, cnt, mine, sp = 0u;
    for (;;) {
        sum = 0u; cnt = 0u; mine = 0u;
#pragma unroll
        for (unsigned j = 0; j < 16; ++j) { const unsigned c = xb_ld(&bar[XB_XCNT(j)]); sum += c; cnt += (c > 0u) ? 1u : 0u; mine = (j == x) ? c : mine; }
        if (sum == G) break;
        __builtin_amdgcn_s_sleep(1);
        if ((++sp & 255u) == 0u) { if (xb_ld(&bar[XB_TMO])) break; if (sp > XB_SPIN_CAP) { atomicAdd(&bar[XB_TMO], 1u); break; } }
    }
    nloc = mine > 0u ? mine : 1u; nx = cnt > 0u ? cnt : 1u;
}

__device__ __forceinline__ void xcd_barrier(const XcdBarrier& b) {
    asm volatile("s_waitcnt vmcnt(0)" ::: "memory");
    __syncthreads();
    if (threadIdx.x == 0) {
        unsigned* bar = b.bar;
        __builtin_amdgcn_s_waitcnt(0);
        unsigned nloc = b.st[0], nx = b.st[1];
        if (nloc == 0u) { xcd_barrier_complete(bar, b.x, nloc, nx); b.st[0] = nloc; b.st[1] = nx; }
        const unsigned old = xb_add(&bar[XB_XSUB(b.x)], 1u);
        const unsigned gen = old / nloc;
        if (old + 1u == (gen + 1u) * nloc) {
            __builtin_amdgcn_fence(__ATOMIC_RELEASE, "agent");
            asm volatile("s_waitcnt vmcnt(0)" ::: "memory");
            const unsigned og = xb_add(&bar[XB_TOP], 1u);
            const unsigned tg = og / nx;
            if (og + 1u == (tg + 1u) * nx) xb_add(&bar[XB_TOPGEN], 1u);
            else XB_SPIN(xb_ld(&bar[XB_TOPGEN]) == tg, bar);
            __builtin_amdgcn_fence(__ATOMIC_ACQUIRE, "agent");
            xb_add(&bar[XB_XGEN(b.x)], 1u);
            asm volatile("s_waitcnt vmcnt(0)" ::: "memory");
        } else {
            XB_SPIN(xb_ld(&bar[XB_XGEN(b.x)]) == gen, bar);
            __builtin_amdgcn_fence(__ATOMIC_ACQUIRE, "agent");
            asm volatile("s_waitcnt vmcnt(0)" ::: "memory");
        }
    }
    __syncthreads();
}

#define XB_LSUB(j)  (3456 + 64 * (j))
#define XB_LGEN(j)  (4480 + 64 * (j))
#define XB_ALL_WORDS 5504
__device__ __forceinline__ void xcd_local_barrier(const XcdBarrier& b) {
    asm volatile("s_waitcnt vmcnt(0)" ::: "memory");
    __syncthreads();
    if (threadIdx.x == 0) {
        unsigned* bar = b.bar;
        __builtin_amdgcn_s_waitcnt(0);
        const unsigned nloc = b.st[0];
        const unsigned old = xb_add(&bar[XB_LSUB(b.x)], 1u);
        const unsigned gen = old / nloc;
        if (old + 1u == (gen + 1u) * nloc) xb_add(&bar[XB_LGEN(b.x)], 1u);
        else XB_SPIN(xb_ld(&bar[XB_LGEN(b.x)]) == gen, bar);
        __builtin_amdgcn_fence(__ATOMIC_ACQUIRE, "agent");
        asm volatile("s_waitcnt vmcnt(0)" ::: "memory");
    }
    __syncthreads();
}

DI void zero_u64(u64* p, int n, int vcu, int loc) {
  const int t = tid_opaque();
  if (loc) { const int per = n >> 3; u64* q = p + (size_t)(vcu >> 5) * per; for (int i = (vcu & 31) * 512 + t; i < per; i += 32 * 512) __hip_atomic_store(q + i, 0ull, __ATOMIC_RELAXED, __HIP_MEMORY_SCOPE_AGENT); }
  else for (int i = blockIdx.x * 512 + t; i < n; i += gridDim.x * 512) __hip_atomic_store(p + i, 0ull, __ATOMIC_RELAXED, __HIP_MEMORY_SCOPE_AGENT);
}
typedef pg8::StaticOrder OrderACE;
DI void phaseA(const MParams& p, int l, LAS unsigned char* lds, int cx, int vcu, int loc) {
  unsigned char* ws = p.ws; const bf16_t* XB = (const bf16_t*)(ws + OFF_XB); const bf16_t* WinT = (const bf16_t*)(ws + OFF_W + (size_t)l * W_STRIDE + WO_IN); const u64* SS1 = (const u64*)(ws + OFF_SS1);
  zero_u64((u64*)(ws + OFF_SS2), T_TOK, vcu, loc);
  { pg8::Gemm g{XB, WinT, T_TOK, 1536, DM}; OrderACE S; S.init(T_TOK, 1536, gridDim.x, cx);
    EpiA1 E{SS1, (bf16_t*)rbuf<RB_U>(ws, vcu, loc), (bf16_t*)rbuf<RB_Q>(ws, vcu, loc), (bf16_t*)rbuf<RB_KB>(ws, vcu, loc), p.in[7] + l * 64, p.in[8] + l * 64}; pg8::gemm_phase<EpiA1, OrderACE>(lds, g, S, E); }
  { pg8::Gemm g{WinT + (size_t)1536 * DM, XB, 1024, T_TOK, DM}; OrderACE S; S.init(1024, T_TOK, gridDim.x, cx);
    EpiA2 E{SS1, (bf16_t*)rbuf<RB_GVT>(ws, vcu, loc), (bf16_t*)rbuf<RB_VT>(ws, vcu, loc), (u64*)(ws + OFF_SSV), loc ? 4096 : T_TOK}; pg8::gemm_phase<EpiA2, OrderACE>(lds, g, S, E); }
}
DI void phaseCE(const MParams& p, int l, bool isC, LAS unsigned char* lds, int cx, int vcu, int loc) {
  unsigned char* ws = p.ws; const unsigned char* wb = ws + OFF_W + (size_t)l * W_STRIDE;
  if (isC) zero_u64((u64*)(ws + OFF_SS1), T_TOK, vcu, loc);
  pg8::Gemm g{(const bf16_t*)(isC ? rbuf<RB_MIX>(ws, vcu, loc) : rbuf<RB_F>(ws, vcu, loc)), (const bf16_t*)(wb + (isC ? WO_OUT : WO_DN)), T_TOK, DM, isC ? DM : DFF}; OrderACE S; S.init(T_TOK, DM, gridDim.x, cx);
  EpiResid E{(isC && l == 0) ? p.in[0] : nullptr, (!isC && l == NLAYER - 1) ? p.out : nullptr, (bf16_t*)(ws + OFF_XB), (u64*)(ws + (isC ? OFF_SS2 : OFF_SS1))}; pg8::gemm_phase<EpiResid, OrderACE>(lds, g, S, E);
}
DI void phaseD(const MParams& p, int l, LAS unsigned char* lds, int cx, int vcu, int loc) {
  unsigned char* ws = p.ws;
  zero_u64((u64*)(ws + OFF_SSV), T_TOK * 4, vcu, loc);
  pg8::Gemm g{(const bf16_t*)(ws + OFF_XB), (const bf16_t*)(ws + OFF_W + (size_t)l * W_STRIDE + WO_GU), T_TOK, 2 * DFF, DM};
#if PROBE_EPI_D
  DupOrder S;
#else
  pg8::StaticOrder S;
#endif
  S.init(T_TOK, 2 * DFF, gridDim.x, cx);
  EpiD E{(const u64*)(ws + OFF_SS2), p.in[18] + (size_t)l * 3 * DFF, p.in[19] + (size_t)l * DFF, (bf16_t*)rbuf<RB_F>(ws, vcu, loc), (float*)rbuf<RB_GB>(ws, vcu, loc), (float*)rbuf<RB_PB>(ws, vcu, loc), (float*)rbuf<RB_UB>(ws, vcu, loc)};
#if PROBE_EPI_D
  pg8::gemm_phase<EpiD, DupOrder>(lds, g, S, E);
#else
  pg8::gemm_phase<EpiD, pg8::StaticOrder>(lds, g, S, E);
#endif
}

__global__ void __launch_bounds__(512) k_run(MParams p) {
  extern __shared__ __attribute__((aligned(16))) unsigned char lds_raw[];
  LAS unsigned char* lds = (LAS unsigned char*)lds_raw;
  cg::grid_group grid = cg::this_grid();
  if (threadIdx.x < 4) ((LAS unsigned*)(lds + 131072))[threadIdx.x] = 0u;
  __syncthreads();
  XcdBarrier xbar = xcd_barrier_post((unsigned*)(p.ws + OFF_BAR), (volatile LAS unsigned*)(lds + 131072));
  if (p.ph_lo < 0) grid.sync();
  for (int ph = p.ph_lo; ph < p.ph_hi; ++ph) {
    const volatile LAS unsigned* stw = (const volatile LAS unsigned*)(lds + 131072);
    const int loc = (ph > 0) ? (int)__builtin_amdgcn_readfirstlane(stw[3]) : 0;
    const int xv = loc ? (int)xbar.x : (int)(blockIdx.x & 7), rv = loc ? (int)__builtin_amdgcn_readfirstlane(stw[2]) : (int)(blockIdx.x >> 3);
#define RUN_PHASES(LOC, CX, VCU) do { const int l = (ph - 1) / 6, s = (ph - 1) % 6; \
      if (s == 0) phaseA(p, l, lds, (CX), (VCU), (LOC)); \
      else if (s == 1) { attn_phase(p, l, lds, (VCU), (LOC)); const LP lp = make_lp(p, l); spatial_phase(lp, p.ws, lds, (VCU), (LOC)); } \
      else if (s == 2 || s == 5) phaseCE(p, l, s == 2, lds, (CX), (VCU), (LOC)); \
      else if (s == 3) phaseD(p, l, lds, (CX), (VCU), (LOC)); \
      else { const LP lp = make_lp(p, l); fixup_phase(lp, p.ws, (VCU), (LOC)); } } while (0)
    if (ph == 0) prologue(p, lds);
    else RUN_PHASES(1, rv * 8 + xv, xv * 32 + rv);
#undef RUN_PHASES
    if (ph + 1 < p.ph_hi) {
      const int sx = (ph - 1) % 6;
      (void)sx;
      if (ph == 0 || !loc) {
        xcd_barrier(xbar);
        if (ph == 0) {
          if (threadIdx.x == 0) { unsigned ok = (gridDim.x == 256u) ? 1u : 0u;
            for (unsigned j = 0; j < 16; ++j) { const unsigned c = xb_ld(&xbar.bar[XB_XCNT(j)]); if (c != (j < 8 ? 32u : 0u)) ok = 0u; }
            ((volatile LAS unsigned*)(lds + 131072))[3] = ok; }
          __syncthreads();
        }
      } else xcd_local_barrier(xbar);
    }
  }
}

extern "C" void kernel_launch(void* const* d_in, const int* in_sizes, int n_in, void* d_out, int out_size, void* d_ws, size_t ws_size, hipStream_t stream) {
  static int grid_blocks = 0;
  if (!grid_blocks) {
    (void)hipFuncSetAttribute((const void*)k_run, hipFuncAttributeMaxDynamicSharedMemorySize, LDS_BYTES);
    int dev = 0, cus = 0, per_cu = 0; (void)hipGetDevice(&dev); (void)hipDeviceGetAttribute(&cus, hipDeviceAttributeMultiprocessorCount, dev);
    (void)hipOccupancyMaxActiveBlocksPerMultiprocessor(&per_cu, (const void*)k_run, 512, LDS_BYTES); if (per_cu < 1) per_cu = 1;
    grid_blocks = 256;
  }
  MParams mp; memset(&mp, 0, sizeof(mp));
  for (int i = 0; i < 21; ++i) mp.in[i] = (const float*)d_in[i];
  mp.out = (float*)d_out; mp.ws = (unsigned char*)d_ws; mp.ph_lo = 0; mp.ph_hi = 1 + 6 * NLAYER;
  (void)hipMemsetAsync((unsigned char*)d_ws + OFF_BAR, 0, 5504 * sizeof(unsigned), stream);
  void* args[] = {&mp};
  hipError_t e = hipLaunchCooperativeKernel((const void*)k_run, dim3(grid_blocks), dim3(512), args, LDS_BYTES, stream);
  if (e != hipSuccess) fprintf(stderr, "cooperative launch failed: %s (grid %d)\n", hipGetErrorString(e), grid_blocks);
}
```

```cpp
#include <hip/hip_runtime.h>
#include <hip/hip_cooperative_groups.h>
#include <cstdio>
#include <cmath>
#include <cstring>

typedef unsigned short bf16_t;
#define DI __device__ __forceinline__

constexpr int T_TOK = 32768, DM = 1024, SEQ = 2048, DFF = 2816, INW = 2560, NLAYER = 4;
constexpr float EPS = 1e-6f;
constexpr float QSCALE = 0.125f * 1.4426950408889634f;

constexpr size_t MiB = 1024ull * 1024ull;
constexpr size_t OFF_XB = 0;
constexpr size_t OFF_R = 64 * MiB;
constexpr size_t OFF_U = OFF_R, OFF_Q = OFF_R + 32 * MiB, OFF_KB = OFF_R + 64 * MiB, OFF_GVT = OFF_R + 96 * MiB, OFF_VT = OFF_R + 128 * MiB, OFF_MIX = OFF_R + 160 * MiB;
constexpr size_t OFF_F = OFF_R, OFF_GB = OFF_R + 176 * MiB, OFF_PB = OFF_R + 188 * MiB, OFF_UB = OFF_R + 200 * MiB;
constexpr size_t OFF_W = 288 * MiB, W_STRIDE = 24 * MiB;
constexpr size_t WO_IN = 0, WO_OUT = 5 * MiB, WO_GU = 7 * MiB, WO_DN = 18 * MiB, WO_SP = 23 * MiB + 512 * 1024;
constexpr size_t OFF_SS1 = 384 * MiB, OFF_SS2 = OFF_SS1 + 256 * 1024, OFF_SSV = OFF_SS2 + 256 * 1024;
constexpr size_t OFF_BAR = 385 * MiB + 512 * 1024;
constexpr size_t OFF_TMP1 = 386 * MiB, OFF_TMP2 = 418 * MiB;

DI int tid_opaque() { int t = threadIdx.x; asm volatile("" : "+v"(t)); return t; }
DI float bf2f(bf16_t b) { return __uint_as_float(((unsigned)b) << 16); }
DI bf16_t f2bf(float f) { unsigned u = __float_as_uint(f); u += 0x7FFFu + ((u >> 16) & 1u); return (bf16_t)(u >> 16); }
DI float gelu_exact(float x) { return 0.5f * x * (1.0f + erff(x * 0.70710678118654752f)); }
DI int permpos16(int k) { return (k & 3) + 4 * (k >> 3) + 8 * ((k >> 2) & 1); }
DI float wave_sum(float v) { for (int o = 32; o >= 1; o >>= 1) v += __shfl_xor(v, o); return v; }

namespace pg8 {
#define PG8_LAS __attribute__((address_space(3)))
typedef unsigned short bf16_t;
typedef short bf16x8 __attribute__((ext_vector_type(8)));
typedef float f32x4 __attribute__((ext_vector_type(4)));
typedef unsigned u32x4 __attribute__((ext_vector_type(4)));
constexpr int BM = 256, BK = 64, HALF = 128, HTB = HALF * BK * 2  , STAGE_BYTES = 8 * HTB, NXCD = 8, WGM = 8;

__host__ __device__ __forceinline__ int lds_byte(int r, int c) { const int st = (r >> 4) * 2 + (c >> 5), rr = r & 15, cc = c & 31, ob = rr * 64 + cc * 2; return st * 1024 + (ob ^ (((ob >> 9) & 1) << 5)); }
__host__ __device__ __forceinline__ void stage_rc(int b, int& R, int& C) { const int st = b / 1024, sb = b % 1024, swz = sb ^ (((sb >> 9) & 1) << 5); R = (st >> 1) * 16 + swz / 64; C = (st & 1) * 32 + (swz % 64) / 2; }
__host__ __device__ __forceinline__ int perm32(int rho) { const int n = rho >> 4, i = rho & 15; return 8 * (i >> 2) + 4 * n + (i & 3); }

struct Unit { int pm, pn; };
struct Gemm { const bf16_t* A; const bf16_t* Bt; int M, N, K; };

struct StaticOrder {
    int nM, nN, nwg, G, c;
    __host__ __device__ void init(int M, int N, int G_, int c_) { nM = M / BM; nN = N / BM; nwg = nM * nN; G = G_; c = c_; }
    __host__ __device__ bool next(int i, Unit& u) const {
        const long L = (long)i * G + c; if (L >= nwg) return false;
        int wgid = (int)L; { const int q = nwg / NXCD, r = nwg % NXCD, xcd = wgid % NXCD, off = wgid / NXCD; wgid = (xcd < r ? xcd * (q + 1) : r * (q + 1) + (xcd - r) * q) + off; }
        const int nig = WGM * nN, gid = wgid / nig, fm = gid * WGM, gsz = (nM - fm) < WGM ? (nM - fm) : WGM;
        u.pm = fm + ((wgid % nig) % gsz); u.pn = (wgid % nig) / gsz; return true;
    }
    __device__ __forceinline__ void a_ready(const Unit&) const {}
    __device__ __forceinline__ void done(const Unit&) const {}
};
template <class Epi, class Sched>
__device__ __forceinline__ void gemm_phase(PG8_LAS unsigned char* lds, const Gemm g, const Sched& S, const Epi& E) {
    const int tid = tid_opaque(), wid = __builtin_amdgcn_readfirstlane(tid >> 6), lane = tid & 63, wr = wid >> 2, wc = wid & 3, fr = lane & 15, fq = lane >> 4;
    const int K = g.K, nt = K / BK;
    unsigned voffA[2], voffB[2];
#pragma unroll
    for (int i = 0; i < 2; ++i) { int R, C; stage_rc(tid * 16 + i * 8192, R, C); const int Rb = Epi::PERM ? ((R & ~31) + perm32(R & 31)) : R;
        voffA[i] = (unsigned)(R * K + C) * 2u; voffB[i] = (unsigned)(Rb * K + C) * 2u; }
    const size_t kstep = (size_t)(BK * 2);
    const size_t hstep = (size_t)HALF * K * 2;
    const size_t tstep = 2 * hstep;
    const unsigned ldsw = (unsigned)wid * 1024u;
    const int aoff = lds_byte(wr * 64 + fr, fq * 8), boff = lds_byte(wc * 32 + fr, fq * 8);
#define PG8_SA(b, h) (((b) * 2 + (h)) * HTB)
#define PG8_SB(b, h) ((4 + (b) * 2 + (h)) * HTB)
#define PG8_STAGE(bufoff, gbase, voff) do { _Pragma("unroll") for (int _i = 0; _i < 2; ++_i) \
        __builtin_amdgcn_global_load_lds((const unsigned*)((const char*)(gbase) + (voff)[_i]), (PG8_LAS unsigned*)(lds + (bufoff) + ldsw + _i * 8192), 16, 0, 0); } while (0)
#define PG8_LDA(dst, b, h) do { _Pragma("unroll") for (int m = 0; m < 4; ++m) _Pragma("unroll") for (int k = 0; k < 2; ++k) dst[m][k] = *(const PG8_LAS bf16x8*)(lds + PG8_SA(b, h) + aoff + m * 2048 + k * 1024); } while (0)
#define PG8_LDB(dst, b, h) do { _Pragma("unroll") for (int n = 0; n < 2; ++n) _Pragma("unroll") for (int k = 0; k < 2; ++k) dst[n][k] = *(const PG8_LAS bf16x8*)(lds + PG8_SB(b, h) + boff + n * 2048 + k * 1024); } while (0)
#define PG8_MMA(ai, bj, At, Bt) do { __builtin_amdgcn_s_setprio(1); _Pragma("unroll") for (int m = 0; m < 4; ++m) _Pragma("unroll") for (int n = 0; n < 2; ++n) _Pragma("unroll") for (int k = 0; k < 2; ++k) \
        acc[ai][bj][m][n] = __builtin_amdgcn_mfma_f32_16x16x32_bf16(Bt[n][k], At[m][k], acc[ai][bj][m][n], 0, 0, 0); __builtin_amdgcn_s_setprio(0); } while (0)
#define PG8_WAIT_V(n) asm volatile("s_waitcnt vmcnt(" #n ")" ::: "memory")
#define PG8_WAIT_L(n) asm volatile("s_waitcnt lgkmcnt(" #n ")" ::: "memory")
#define PG8_BAR __builtin_amdgcn_s_barrier()
#define PG8_SCHED __builtin_amdgcn_sched_barrier(0)
    Unit cur, nxt; int ui = 0;
    if (!S.next(0, cur)) return;
    f32x4 acc[2][2][4][2];
#pragma unroll
    for (int a = 0; a < 2; ++a)
#pragma unroll
        for (int b = 0; b < 2; ++b)
#pragma unroll
            for (int m = 0; m < 4; ++m)
#pragma unroll
                for (int n = 0; n < 2; ++n) acc[a][b][m][n] = (f32x4){0.f, 0.f, 0.f, 0.f};
    bf16x8 At[4][2], B0[2][2], B1[2][2];
    const char* cA = (const char*)g.A + (size_t)cur.pm * tstep; const char* cB = (const char*)g.Bt + (size_t)cur.pn * tstep;
    S.a_ready(cur);
    PG8_STAGE(PG8_SB(0, 0), cB, voffB); PG8_STAGE(PG8_SA(0, 0), cA, voffA); PG8_STAGE(PG8_SB(0, 1), cB + hstep, voffB); PG8_STAGE(PG8_SA(0, 1), cA + hstep, voffA);
    if (wr == 1) PG8_BAR;
    PG8_WAIT_V(4); PG8_BAR;
    PG8_STAGE(PG8_SB(1, 0), cB + kstep, voffB); PG8_STAGE(PG8_SA(1, 0), cA + kstep, voffA); PG8_STAGE(PG8_SB(1, 1), cB + hstep + kstep, voffB);
    PG8_WAIT_V(6); PG8_BAR;
    for (;;) {
        const bool has_next = S.next(ui + 1, nxt);
        const char* nA = has_next ? (const char*)g.A + (size_t)nxt.pm * tstep : cA; const char* nB = has_next ? (const char*)g.Bt + (size_t)nxt.pn * tstep : cB;
        for (int t = 0; t < nt; t += 2) {
            const bool last = (t == nt - 2);
            const char* a1 = cA + (size_t)(t + 1) * kstep;
            const char* a2 = last ? nA : cA + (size_t)(t + 2) * kstep; const char* b2 = last ? nB : cB + (size_t)(t + 2) * kstep;
            const char* a3 = a2 + kstep; const char* b3 = b2 + kstep;
            if (last && has_next) S.a_ready(nxt);
            PG8_LDB(B0, 0, 0); PG8_SCHED; PG8_LDA(At, 0, 0); PG8_STAGE(PG8_SA(1, 1), a1 + hstep, voffA);
            PG8_WAIT_L(8); PG8_BAR; PG8_WAIT_L(0); PG8_MMA(0, 0, At, B0); PG8_BAR; PG8_SCHED;
            PG8_LDB(B1, 0, 1); PG8_STAGE(PG8_SB(0, 0), b2, voffB);
            PG8_BAR; PG8_WAIT_L(0); PG8_MMA(0, 1, At, B1); PG8_BAR;
            PG8_LDA(At, 0, 1); PG8_STAGE(PG8_SA(0, 0), a2, voffA);
            PG8_BAR; PG8_WAIT_L(0); PG8_MMA(1, 0, At, B0); PG8_BAR; PG8_SCHED;
            PG8_STAGE(PG8_SB(0, 1), b2 + hstep, voffB);
            PG8_WAIT_V(6); PG8_BAR; PG8_MMA(1, 1, At, B1); PG8_BAR;
            PG8_LDB(B0, 1, 0); PG8_SCHED; PG8_LDA(At, 1, 0); PG8_STAGE(PG8_SA(0, 1), a2 + hstep, voffA);
            PG8_WAIT_L(8); PG8_BAR; PG8_WAIT_L(0); PG8_MMA(0, 0, At, B0); PG8_BAR; PG8_SCHED;
            PG8_LDB(B1, 1, 1); PG8_STAGE(PG8_SB(1, 0), b3, voffB);
            PG8_BAR; PG8_WAIT_L(0); PG8_MMA(0, 1, At, B1); PG8_BAR;
            PG8_LDA(At, 1, 1); PG8_STAGE(PG8_SA(1, 0), a3, voffA);
            PG8_BAR; PG8_WAIT_L(0); PG8_MMA(1, 0, At, B0); PG8_BAR; PG8_SCHED;
            PG8_STAGE(PG8_SB(1, 1), b3 + hstep, voffB);
            PG8_WAIT_V(6); PG8_BAR; PG8_MMA(1, 1, At, B1); PG8_BAR;
        }
        if constexpr (!Epi::AFTER_DRAIN) { if (!Epi::TWICE || (ui & 1)) E(acc, cur, wr, wc, fr, fq); S.done(cur); }
        if (!has_next) break;
#pragma unroll
        for (int a = 0; a < 2; ++a)
#pragma unroll
            for (int b = 0; b < 2; ++b)
#pragma unroll
                for (int m = 0; m < 4; ++m)
#pragma unroll
                    for (int n = 0; n < 2; ++n) acc[a][b][m][n] = (f32x4){0.f, 0.f, 0.f, 0.f};
        cur = nxt; cA = nA; cB = nB; ++ui;
    }
    PG8_WAIT_V(0);
    if (wr == 0) PG8_BAR;
    PG8_BAR;
    if constexpr (Epi::AFTER_DRAIN) { E.fused(acc, cur, wr, wc, fr, fq, lds, wid, lane); S.done(cur); }
#undef PG8_SA
#undef PG8_SB
#undef PG8_STAGE
#undef PG8_LDA
#undef PG8_LDB
#undef PG8_MMA
#undef PG8_WAIT_V
#undef PG8_WAIT_L
#undef PG8_BAR
#undef PG8_SCHED
}
}

namespace cg = cooperative_groups;
using pg8::f32x4; using pg8::bf16x8; using pg8::Unit;
typedef unsigned u32x2_t __attribute__((ext_vector_type(2)));
typedef unsigned u32x4_t __attribute__((ext_vector_type(4)));
typedef float f32x16 __attribute__((ext_vector_type(16)));
typedef float f32x2_t __attribute__((ext_vector_type(2)));
#define LAS PG8_LAS
constexpr int LDS_BYTES = 163840;
#ifndef EN_MASK
#define EN_MASK 0x7f
#endif
#ifndef PROBE_EPI_ACE
#define PROBE_EPI_ACE 0
#endif
#ifndef PROBE_EPI_D
#define PROBE_EPI_D 0
#endif
#ifndef PROBE_SYNC
#define PROBE_SYNC 0
#endif
#ifndef PROBE_MASK
#define PROBE_MASK 0x00
#endif

DI unsigned pk2(float lo, float hi) { unsigned r; asm volatile("s_nop 0\n\tv_cvt_pk_bf16_f32 %0, %1, %2\n\ts_nop 1" : "=v"(r) : "v"(lo), "v"(hi)); return r; }
DI float bflo(unsigned w) { return __uint_as_float(w << 16); }
DI float bfhi(unsigned w) { return __uint_as_float(w & 0xffff0000u); }
DI float gelu1(float v) {
  const float av = fabsf(v), t = __builtin_amdgcn_rcpf(av * 0.2316418882f + 1.0f);
  float q = t * 0.5307027145f + (-0.7265760135f); q = q * t + 0.7107068705f; q = q * t + (-0.142248368f); q = q * t + 0.127414796f; q = q * t;
  const float e = __builtin_amdgcn_exp2f((v * v) * (-0.72134752044f));
  const float m = v * (q * e);
  return v < 0.f ? m : v - m;
}
DI float dpp_ror1(float v) { return __builtin_bit_cast(float, __builtin_amdgcn_update_dpp(0, __builtin_bit_cast(int, v), 0x121, 0xf, 0xf, false)); }
DI float dpp_ror2(float v) { return __builtin_bit_cast(float, __builtin_amdgcn_update_dpp(0, __builtin_bit_cast(int, v), 0x122, 0xf, 0xf, false)); }
DI float row_sum16(float v) {
  v += __builtin_bit_cast(float, __builtin_amdgcn_update_dpp(0, __builtin_bit_cast(int, v), 0x128, 0xf, 0xf, false));
  v += __builtin_bit_cast(float, __builtin_amdgcn_update_dpp(0, __builtin_bit_cast(int, v), 0x124, 0xf, 0xf, false));
  v += __builtin_bit_cast(float, __builtin_amdgcn_update_dpp(0, __builtin_bit_cast(int, v), 0x122, 0xf, 0xf, false));
  v += __builtin_bit_cast(float, __builtin_amdgcn_update_dpp(0, __builtin_bit_cast(int, v), 0x121, 0xf, 0xf, false));
  return v; }
typedef unsigned long long u64;
DI float fx2f(u64 v) { return (float)v * (1.0f / 1048576.0f); }
DI u64 f2fx(float v) { return (u64)(v * 1048576.0f + 0.5f); }
DI void fx_add(u64* p, float v) { __hip_atomic_fetch_add(p, f2fx(v), __ATOMIC_RELAXED, __HIP_MEMORY_SCOPE_AGENT); }
DI float rs1024(u64 ss) { return rsqrtf(fx2f(ss) * (1.0f / 1024.0f) + EPS); }

struct MParams { const float* in[21]; float* out; unsigned char* ws; int ph_lo, ph_hi; };
struct LP {
  const float *norm_attn_w, *w_in, *v_norm_w, *sp_w, *sp_b, *out_norm_w, *q_norm_w, *k_norm_w, *lq1, *lk1, *lq2, *lk2, *diff_norm_w, *w_out, *norm_ffn_w, *w_gate, *w_up, *conv_w, *conv_b, *w_down;
  float lambda_init;
  const bf16_t *WinT, *WoutT, *WguT, *WdT, *Wsp;
};
DI LP make_lp(const MParams& p, int l) {
  LP L;
  L.norm_attn_w = p.in[1] + (size_t)l * DM; L.w_in = p.in[2] + (size_t)l * DM * INW; L.v_norm_w = p.in[3] + (size_t)l * 512; L.sp_w = p.in[4] + (size_t)l * 65536; L.sp_b = p.in[5] + (size_t)l * 512;
  L.out_norm_w = p.in[6] + (size_t)l * 512; L.q_norm_w = p.in[7] + (size_t)l * 64; L.k_norm_w = p.in[8] + (size_t)l * 64; L.lq1 = p.in[9] + (size_t)l * 64; L.lk1 = p.in[10] + (size_t)l * 64;
  L.lq2 = p.in[11] + (size_t)l * 64; L.lk2 = p.in[12] + (size_t)l * 64; L.diff_norm_w = p.in[13] + (size_t)l * 128; L.w_out = p.in[14] + (size_t)l * DM * DM; L.norm_ffn_w = p.in[15] + (size_t)l * DM;
  L.w_gate = p.in[16] + (size_t)l * DM * DFF; L.w_up = p.in[17] + (size_t)l * DM * DFF; L.conv_w = p.in[18] + (size_t)l * 3 * DFF; L.conv_b = p.in[19] + (size_t)l * DFF; L.w_down = p.in[20] + (size_t)l * DFF * DM;
  L.lambda_init = 0.8f - 0.6f * expf(-0.3f * (float)(l + 1));
  const unsigned char* wb = p.ws + OFF_W + (size_t)l * W_STRIDE;
  L.WinT = (const bf16_t*)(wb + WO_IN); L.WoutT = (const bf16_t*)(wb + WO_OUT); L.WguT = (const bf16_t*)(wb + WO_GU); L.WdT = (const bf16_t*)(wb + WO_DN); L.Wsp = (const bf16_t*)(wb + WO_SP);
  return L;
}
DI float lam_of(const LP& lp) {
  const int lane = threadIdx.x & 63;
  float a = lp.lq1[lane] * lp.lk1[lane], b = lp.lq2[lane] * lp.lk2[lane];
  a = wave_sum(a); b = wave_sum(b);
  return expf(a) - expf(b) + lp.lambda_init;
}

DI void conv_item(bf16_t* dst, int K, int row, int kg, const float* src, int ld, int col, const float* ks) {
  float v[32];
#pragma unroll
  for (int i = 0; i < 32; ++i) v[i] = src[(size_t)(kg * 32 + i) * ld + col];
  if (ks) {
#pragma unroll
    for (int i = 0; i < 32; i += 4) { const f32x4 s = *(const f32x4*)(ks + kg * 32 + i); v[i] *= s[0]; v[i + 1] *= s[1]; v[i + 2] *= s[2]; v[i + 3] *= s[3]; }
  }
  u32x4_t* d = (u32x4_t*)(dst + (size_t)row * K + kg * 32);
#pragma unroll
  for (int i = 0; i < 4; ++i) { u32x4_t w; w.x = pk2(v[8 * i], v[8 * i + 1]); w.y = pk2(v[8 * i + 2], v[8 * i + 3]); w.z = pk2(v[8 * i + 4], v[8 * i + 5]); w.w = pk2(v[8 * i + 6], v[8 * i + 7]); d[i] = w; }
}
DI int perm_logical(int p) {
  const int bj = p >> 7, wc = (p >> 5) & 3, n = (p >> 4) & 1, fq = (p >> 2) & 3, e = p & 3;
  return 64 * wc + 32 * bj + 8 * fq + 4 * n + e;
}
DI int perm_res(int p) { return (p & ~31) + 8 * ((p >> 2) & 3) + 4 * ((p >> 4) & 1) + (p & 3); }
DI void prologue(const MParams& p, LAS unsigned char* lds) {
  const int tidp = tid_opaque(); const int gtid = blockIdx.x * 512 + tidp, gsz = gridDim.x * 512;
  unsigned char* ws = p.ws;
  { const int gw = gtid >> 6, nw = gsz >> 6, lane = threadIdx.x & 63; bf16_t* XB = (bf16_t*)(ws + OFF_XB); u64* SS1 = (u64*)(ws + OFF_SS1);
    for (int row = gw; row < T_TOK; row += nw) { const float* xp = p.in[0] + (size_t)row * DM; float s = 0.f;
#pragma unroll
      for (int i = 0; i < 4; ++i) { const f32x4 v = *(const f32x4*)(xp + i * 256 + lane * 4); s += v[0] * v[0] + v[1] * v[1] + v[2] * v[2] + v[3] * v[3];
        u32x2_t w; w.x = pk2(v[0], v[1]); w.y = pk2(v[2], v[3]); *(u32x2_t*)(XB + (size_t)row * DM + i * 256 + lane * 4) = w; }
      s = wave_sum(s); if (lane == 0) SS1[row] = f2fx(s); } }
  { u64* SSV = (u64*)(ws + OFF_SSV); for (int i = gtid; i < T_TOK * 4; i += gsz) SSV[i] = 0ull; }
  { const int lane = tidp & 63, wv = tidp >> 6, n4 = lane & 15, kq = lane >> 4; LAS unsigned char* wl = lds + wv * 9216;
    for (int t = blockIdx.x * 8 + wv; t < NLAYER * 3008; t += gridDim.x * 8) {
      const int l = t / 3008; int r = t - l * 3008; const LP lp = make_lp(p, l);
      const float* src; const float* ks; bf16_t* dst; int ld, K, rt, kt, col;
      if (r < 640) { rt = r % 40; kt = r / 40; dst = (bf16_t*)lp.WinT; K = 1024; ld = INW; ks = lp.norm_attn_w; src = lp.w_in; const int row = 64 * rt + 4 * n4;
        if (row < 1536) { const int L = (row & ~255) + perm_logical(row & 255); col = L < 512 ? L : L + 512; } else { const int q = row - 1536; col = q < 512 ? 512 + q : 1536 + q; } }
      else if (r < 896) { r -= 640; rt = r & 15; kt = r >> 4; dst = (bf16_t*)lp.WoutT; K = 1024; ld = DM; ks = nullptr; src = lp.w_out; col = perm_res(64 * rt + 4 * n4); }
      else if (r < 2304) { r -= 896; rt = r % 88; kt = r / 88; dst = (bf16_t*)lp.WguT; K = 1024; ld = DFF; ks = lp.norm_ffn_w; const int row = 64 * rt + 4 * n4, pn = row >> 8, pp = row & 255;
        src = (pp >> 7) ? lp.w_up : lp.w_gate; const int q = pp & 127; col = 128 * pn + 32 * ((q >> 5) & 3) + 8 * ((q >> 2) & 3) + 4 * ((q >> 4) & 1) + (q & 3); }
      else { r -= 2304; rt = r & 15; kt = r >> 4; dst = (bf16_t*)lp.WdT; K = DFF; ld = DM; ks = nullptr; src = lp.w_down; col = perm_res(64 * rt + 4 * n4); }
      const float* sp = src + (size_t)(64 * kt + 16 * kq) * ld + col;
      f32x4 v[16];
#pragma unroll
      for (int j = 0; j < 16; ++j) v[j] = *(const f32x4*)(sp + (size_t)j * ld);
      if (ks) {
#pragma unroll
        for (int i = 0; i < 4; ++i) { const f32x4 sc = *(const f32x4*)(ks + 64 * kt + 16 * kq + 4 * i); v[4 * i] *= sc[0]; v[4 * i + 1] *= sc[1]; v[4 * i + 2] *= sc[2]; v[4 * i + 3] *= sc[3]; } }
#pragma unroll
      for (int n = 0; n < 4; ++n)
#pragma unroll
        for (int hh = 0; hh < 2; ++hh) { u32x4_t w; w.x = pk2(v[8 * hh][n], v[8 * hh + 1][n]); w.y = pk2(v[8 * hh + 2][n], v[8 * hh + 3][n]); w.z = pk2(v[8 * hh + 4][n], v[8 * hh + 5][n]); w.w = pk2(v[8 * hh + 6][n], v[8 * hh + 7][n]);
          *(LAS u32x4_t*)(wl + (4 * n4 + n) * 144 + (16 * kq + 8 * hh) * 2) = w; }
#pragma unroll
      for (int i = 0; i < 8; ++i) { const int row = 8 * i + (lane >> 3), pc = lane & 7; const u32x4_t w = *(const LAS u32x4_t*)(wl + row * 144 + pc * 16);
        *(u32x4_t*)(dst + (size_t)(64 * rt + row) * K + 64 * kt + pc * 8) = w; }
    }
  }
  for (int l = 0; l < NLAYER; ++l) { const LP lp = make_lp(p, l);
    for (int i = gtid; i < 65536; i += gsz) { const int jj = i & 127, ii = (i >> 7) & 127; ((bf16_t*)lp.Wsp)[i] = ((jj >> 6) <= (ii >> 6)) ? f2bf(lp.sp_w[i]) : (bf16_t)0; } }
}

enum { RB_U = 0, RB_Q, RB_KB, RB_GVT, RB_VT, RB_MIX, RB_F, RB_GB, RB_PB, RB_UB };
template <int W> DI unsigned char* rbuf(unsigned char* ws, int vcu, int loc) {
  constexpr size_t goff = W == RB_U ? OFF_U : W == RB_Q ? OFF_Q : W == RB_KB ? OFF_KB : W == RB_GVT ? OFF_GVT : W == RB_VT ? OFF_VT : W == RB_MIX ? OFF_MIX : W == RB_F ? OFF_F : W == RB_GB ? OFF_GB : W == RB_PB ? OFF_PB : OFF_UB;
  if (!loc) return ws + goff;
  constexpr size_t KiB = 1024;
  constexpr size_t loff = W == RB_U ? 0 : W == RB_Q ? 4 * MiB : W == RB_KB ? 8 * MiB : W == RB_GVT ? 12 * MiB : W == RB_VT ? 16 * MiB : W == RB_MIX ? 20 * MiB : W == RB_F ? 0 : W == RB_GB ? 22 * MiB : W == RB_PB ? 22 * MiB + 1536 * KiB : 25 * MiB;
  constexpr size_t bias = (W == RB_U || W == RB_Q || W == RB_KB) ? (size_t)4096 * 512 * 2 : (W == RB_GVT || W == RB_VT) ? (size_t)4096 * 2 : W == RB_MIX ? (size_t)4096 * 1024 * 2 : W == RB_F ? (size_t)4096 * DFF * 2 : (size_t)64 * 2 * DFF * 4;
  const size_t x = (size_t)(vcu >> 5);
  return ws + OFF_R + x * (28 * MiB) + loff - x * bias;
}
struct DupOrder : pg8::StaticOrder {
  __device__ bool next(int i, Unit& u) const { return pg8::StaticOrder::next(i >> 1, u); }
};
struct BalA2Order : pg8::StaticOrder {
  __device__ bool next(int i, Unit& u) const { const bool ok = pg8::StaticOrder::next(i, u); u.pm = (u.pm + 2 * i) & 3; return ok; }
};
struct EpiResid {
  static constexpr bool PERM = false, AFTER_DRAIN = false, TWICE = (PROBE_EPI_ACE != 0);
  const float* base32; float* out32; bf16_t* XB; u64* SS;
  DI void operator()(const f32x4 (&acc)[2][2][4][2], const Unit& u, int wr, int wc, int fr, int fq) const {
    const int row0 = u.pm * 256 + wr * 64 + fr, col0 = u.pn * 256 + wc * 32 + 8 * fq;
    if (base32) {
      f32x4 nb[2][2];
#pragma unroll
      for (int bj = 0; bj < 2; ++bj)
#pragma unroll
        for (int n = 0; n < 2; ++n) nb[bj][n] = *(const f32x4*)(base32 + (size_t)row0 * DM + col0 + bj * 128 + n * 4);
#pragma unroll
      for (int g = 0; g < 8; ++g) { const int ai = g >> 2, m = g & 3; const int row = row0 + ai * 128 + m * 16; const size_t ro = (size_t)row * DM + col0; float ss = 0.f;
        f32x4 cbv[2][2];
#pragma unroll
        for (int bj = 0; bj < 2; ++bj)
#pragma unroll
          for (int n = 0; n < 2; ++n) cbv[bj][n] = nb[bj][n];
        if (g < 7) { const int r2 = row0 + ((g + 1) >> 2) * 128 + ((g + 1) & 3) * 16;
#pragma unroll
          for (int bj = 0; bj < 2; ++bj)
#pragma unroll
            for (int n = 0; n < 2; ++n) nb[bj][n] = *(const f32x4*)(base32 + (size_t)r2 * DM + col0 + bj * 128 + n * 4); }
#pragma unroll
        for (int bj = 0; bj < 2; ++bj) { const f32x4 v0 = acc[ai][bj][m][0] + cbv[bj][0], v1 = acc[ai][bj][m][1] + cbv[bj][1];
          u32x4_t w; w.x = pk2(v0[0], v0[1]); w.y = pk2(v0[2], v0[3]); w.z = pk2(v1[0], v1[1]); w.w = pk2(v1[2], v1[3]); *(u32x4_t*)(XB + ro + bj * 128) = w;
          ss += ((v0[0] * v0[0] + v0[1] * v0[1]) + (v0[2] * v0[2] + v0[3] * v0[3])) + ((v1[0] * v1[0] + v1[1] * v1[1]) + (v1[2] * v1[2] + v1[3] * v1[3])); }
        ss += __shfl_xor(ss, 16); ss += __shfl_xor(ss, 32); if (fq == 0) fx_add(SS + row, ss);
        asm volatile("" ::: "memory"); }
    } else {
      u32x4_t nb[2];
#pragma unroll
      for (int bj = 0; bj < 2; ++bj) nb[bj] = *(const u32x4_t*)(XB + (size_t)row0 * DM + col0 + bj * 128);
#pragma unroll
      for (int g = 0; g < 8; ++g) { const int ai = g >> 2, m = g & 3; const int row = row0 + ai * 128 + m * 16; const size_t ro = (size_t)row * DM + col0; float ss = 0.f;
        u32x4_t cbv[2];
#pragma unroll
        for (int bj = 0; bj < 2; ++bj) cbv[bj] = nb[bj];
        if (g < 7) { const int r2 = row0 + ((g + 1) >> 2) * 128 + ((g + 1) & 3) * 16;
#pragma unroll
          for (int bj = 0; bj < 2; ++bj) nb[bj] = *(const u32x4_t*)(XB + (size_t)r2 * DM + col0 + bj * 128); }
#pragma unroll
        for (int bj = 0; bj < 2; ++bj) { const u32x4_t c = cbv[bj];
          const f32x4 v0 = acc[ai][bj][m][0] + (f32x4){bflo(c.x), bfhi(c.x), bflo(c.y), bfhi(c.y)}, v1 = acc[ai][bj][m][1] + (f32x4){bflo(c.z), bfhi(c.z), bflo(c.w), bfhi(c.w)};
          if (out32) { *(f32x4*)(out32 + ro + bj * 128) = v0; *(f32x4*)(out32 + ro + bj * 128 + 4) = v1; }
          else { u32x4_t w; w.x = pk2(v0[0], v0[1]); w.y = pk2(v0[2], v0[3]); w.z = pk2(v1[0], v1[1]); w.w = pk2(v1[2], v1[3]); *(u32x4_t*)(XB + ro + bj * 128) = w;
            ss += ((v0[0] * v0[0] + v0[1] * v0[1]) + (v0[2] * v0[2] + v0[3] * v0[3])) + ((v1[0] * v1[0] + v1[1] * v1[1]) + (v1[2] * v1[2] + v1[3] * v1[3])); } }
        if (!out32) { ss += __shfl_xor(ss, 16); ss += __shfl_xor(ss, 32); if (fq == 0) fx_add(SS + row, ss); }
        asm volatile("" ::: "memory"); }
    }
  }
};
struct EpiA1 {
  static constexpr bool PERM = false, AFTER_DRAIN = false, TWICE = (PROBE_EPI_ACE != 0);
  const u64* SS1; bf16_t *U, *Q, *KB; const float *qw, *kw;
  DI void operator()(const f32x4 (&acc)[2][2][4][2], const Unit& u, int wr, int wc, int fr, int fq) const {
    const int row0 = u.pm * 256 + wr * 64 + fr, lc0 = wc * 64 + 8 * fq, region = u.pn >> 1;
    u64 rsv[8];
#pragma unroll
    for (int g = 0; g < 8; ++g) rsv[g] = SS1[row0 + (g >> 2) * 128 + (g & 3) * 16];
    if (region == 0) {
#pragma unroll
      for (int g = 0; g < 8; ++g) { const int ai = g >> 2, m = g & 3; const int row = row0 + ai * 128 + m * 16; const float rs = rs1024(rsv[g]);
#pragma unroll
        for (int bj = 0; bj < 2; ++bj) { const f32x4 a = acc[ai][bj][m][0] * rs, b = acc[ai][bj][m][1] * rs; u32x4_t w;
          w.x = pk2(gelu1(a[0]), gelu1(a[1])); w.y = pk2(gelu1(a[2]), gelu1(a[3])); w.z = pk2(gelu1(b[0]), gelu1(b[1])); w.w = pk2(gelu1(b[2]), gelu1(b[3]));
          *(u32x4_t*)(U + (size_t)row * 512 + u.pn * 256 + lc0 + 32 * bj) = w; } }
    } else {
      const bool isq = region == 1; const float* wp = (isq ? qw : kw) + 8 * fq; bf16_t* dst = (isq ? Q : KB) + (u.pn & 1) * 256 + lc0; const float sc = isq ? QSCALE : 1.0f;
      f32x4 wv[2][2];
#pragma unroll
      for (int bj = 0; bj < 2; ++bj)
#pragma unroll
        for (int n = 0; n < 2; ++n) wv[bj][n] = *(const f32x4*)(wp + 32 * bj + 4 * n);
#pragma unroll
      for (int g = 0; g < 8; ++g) { const int ai = g >> 2, m = g & 3; const int row = row0 + ai * 128 + m * 16; const float rs = rs1024(rsv[g]); float ss = 0.f; f32x4 v[2][2];
#pragma unroll
        for (int bj = 0; bj < 2; ++bj)
#pragma unroll
          for (int n = 0; n < 2; ++n) { v[bj][n] = acc[ai][bj][m][n] * rs; const f32x4 t = v[bj][n]; ss += (t[0] * t[0] + t[1] * t[1]) + (t[2] * t[2] + t[3] * t[3]); }
        ss += __shfl_xor(ss, 16); ss += __shfl_xor(ss, 32);
        const float r2 = rsqrtf(ss * (1.0f / 64.0f) + EPS) * sc;
#pragma unroll
        for (int bj = 0; bj < 2; ++bj) { const f32x4 a = v[bj][0] * r2 * wv[bj][0], b = v[bj][1] * r2 * wv[bj][1]; u32x4_t w;
          w.x = pk2(a[0], a[1]); w.y = pk2(a[2], a[3]); w.z = pk2(b[0], b[1]); w.w = pk2(b[2], b[3]);
          *(u32x4_t*)(dst + (size_t)row * 512 + 32 * bj) = w; } }
    }
  }
};
struct EpiA2 {
  static constexpr bool PERM = false, AFTER_DRAIN = false, TWICE = (PROBE_EPI_ACE != 0);
  const u64* SS1; bf16_t *GVT, *VT; u64* SSV; int vtp;
  DI void operator()(const f32x4 (&acc)[2][2][4][2], const Unit& u, int wr, int wc, int fr, int fq) const {
    const int colbase = u.pn * 256 + wc * 32;
    f32x4 rs[2][2];
#pragma unroll
    for (int bj = 0; bj < 2; ++bj)
#pragma unroll
      for (int n = 0; n < 2; ++n) { const u64* sp = SS1 + colbase + bj * 128 + n * 16 + 4 * fq; rs[bj][n] = (f32x4){rs1024(sp[0]), rs1024(sp[1]), rs1024(sp[2]), rs1024(sp[3])}; }
    if (u.pm < 2) {
#pragma unroll
      for (int ai = 0; ai < 2; ++ai) { const int head = 2 * u.pm + ai;
#pragma unroll
        for (int bj = 0; bj < 2; ++bj)
#pragma unroll
          for (int n = 0; n < 2; ++n) { f32x4 sq = (f32x4){0.f, 0.f, 0.f, 0.f}; const int tok = colbase + bj * 128 + n * 16 + 4 * fq;
#pragma unroll
            for (int m = 0; m < 4; ++m) { const int row = u.pm * 256 + ai * 128 + wr * 64 + m * 16 + fr;
              const f32x4 a = acc[ai][bj][m][n] * rs[bj][n]; f32x4 g; g[0] = gelu1(a[0]); g[1] = gelu1(a[1]); g[2] = gelu1(a[2]); g[3] = gelu1(a[3]);
              u32x2_t w; w.x = pk2(g[0], g[1]); w.y = pk2(g[2], g[3]); *(u32x2_t*)(GVT + (size_t)row * vtp + tok) = w; sq += g * g; }
#pragma unroll
            for (int e = 0; e < 4; ++e) sq[e] = row_sum16(sq[e]);
            if (fr == 0) {
#pragma unroll
              for (int e = 0; e < 4; ++e) fx_add(SSV + (size_t)(tok + e) * 4 + head, sq[e]); }
            asm volatile("" ::: "memory"); } }
    } else {
#pragma unroll
      for (int ai = 0; ai < 2; ++ai)
#pragma unroll
        for (int m = 0; m < 4; ++m) { const int row = (u.pm - 2) * 256 + ai * 128 + wr * 64 + m * 16 + fr;
#pragma unroll
          for (int bj = 0; bj < 2; ++bj)
#pragma unroll
            for (int n = 0; n < 2; ++n) { const f32x4 a = acc[ai][bj][m][n] * rs[bj][n]; u32x2_t w; w.x = pk2(a[0], a[1]); w.y = pk2(a[2], a[3]);
              *(u32x2_t*)(VT + (size_t)row * vtp + colbase + bj * 128 + n * 16 + 8 * (fq & 1) + 4 * (fq >> 1)) = w; } }
    }
  }
};
struct EpiD {
  static constexpr bool PERM = false, AFTER_DRAIN = false, TWICE = (PROBE_EPI_D != 0);
  const u64* SS2; const float *cw, *cb; bf16_t* F; float *GB, *PB, *UB;
  DI void operator()(const f32x4 (&acc)[2][2][4][2], const Unit& u, int wr, int wc, int fr, int fq) const {
    const int cbase = u.pn * 128 + wc * 32 + 8 * fq;
    const int rb0 = u.pm * 256 + wr * 64;
    u64 rsv[8]; f32x4 w0[2], w1[2], w2[2], bb[2];
#pragma unroll
    for (int g = 0; g < 8; ++g) rsv[g] = SS2[rb0 + (g >> 2) * 128 + (g & 3) * 16 + fr];
#pragma unroll
    for (int n = 0; n < 2; ++n) { w0[n] = *(const f32x4*)(cw + cbase + 4 * n); w1[n] = *(const f32x4*)(cw + DFF + cbase + 4 * n); w2[n] = *(const f32x4*)(cw + 2 * DFF + cbase + 4 * n); bb[n] = *(const f32x4*)(cb + cbase + 4 * n); }
#pragma unroll
    for (int ai = 0; ai < 2; ++ai) {
      const int rb = rb0 + ai * 128, bd = rb >> 6;
      float rs[4];
#pragma unroll
      for (int m = 0; m < 4; ++m) rs[m] = rs1024(rsv[ai * 4 + m]);
      unsigned fo[4][4];
#pragma unroll
      for (int n = 0; n < 2; ++n) {
        const int cn = cbase + 4 * n;
        f32x4 pg, ug, gg; float fv[4][4];
#pragma unroll
        for (int e = 0; e < 4; ++e) {
          float G[4], r1[4], r2[4];
#pragma unroll
          for (int m = 0; m < 4; ++m) { G[m] = acc[ai][0][m][n][e] * rs[m]; r1[m] = dpp_ror1(G[m]); r2[m] = dpp_ror2(G[m]); }
#pragma unroll
          for (int m = 0; m < 4; ++m) {
            const float p1 = (fr >= 1) ? r1[m] : (m > 0 ? r1[m > 0 ? m - 1 : 0] : 0.f);
            const float p2 = (fr >= 2) ? r2[m] : (m > 0 ? r2[m > 0 ? m - 1 : 0] : 0.f);
            const float g = w2[n][e] * G[m] + w1[n][e] * p1 + w0[n][e] * p2 + bb[n][e];
            const float uv = acc[ai][1][m][n][e] * rs[m];
            if (m == 0) { pg[e] = g; ug[e] = uv; }
            if (m == 3) gg[e] = G[3];
            fv[m][e] = g * __builtin_amdgcn_rcpf(1.0f + __expf(-g)) * uv;
          }
        }
#pragma unroll
        for (int m = 0; m < 4; ++m) { fo[m][2 * n] = pk2(fv[m][0], fv[m][1]); fo[m][2 * n + 1] = pk2(fv[m][2], fv[m][3]); }
        if (fr < 2) { *(f32x4*)(PB + (size_t)(bd * 2 + fr) * DFF + cn) = pg; *(f32x4*)(UB + (size_t)(bd * 2 + fr) * DFF + cn) = ug; }
        if (fr >= 14) { *(f32x4*)(GB + (size_t)(bd * 2 + fr - 14) * DFF + cn) = gg; }
      }
#pragma unroll
      for (int m = 0; m < 4; ++m) {
        if (!(m == 0 && fr < 2)) { u32x4_t w; w.x = fo[m][0]; w.y = fo[m][1]; w.z = fo[m][2]; w.w = fo[m][3]; *(u32x4_t*)(F + (size_t)(rb + 16 * m + fr) * DFF + cbase) = w; }
      }
    }
  }
};
DI void fixup_phase(const LP& lp, unsigned char* ws, int vcu, int loc) {
  const float *GB = (const float*)rbuf<RB_GB>(ws, vcu, loc), *PB = (const float*)rbuf<RB_PB>(ws, vcu, loc), *UB = (const float*)rbuf<RB_UB>(ws, vcu, loc); bf16_t* F = (bf16_t*)rbuf<RB_F>(ws, vcu, loc);
  const int t_ = tid_opaque(); const int w0 = loc ? (vcu >> 5) * 90112 + (vcu & 31) * 512 + t_ : blockIdx.x * 512 + t_, wend = loc ? ((vcu >> 5) + 1) * 90112 : 512 * 2 * 704, gsz = loc ? 32 * 512 : gridDim.x * 512;
  for (int w = w0; w < wend; w += gsz) {
    const int c = (w % 704) * 4, j = (w / 704) & 1, bd = w / 1408;
    f32x4 g = *(const f32x4*)(PB + (size_t)(bd * 2 + j) * DFF + c);
    if (bd & 31) { const f32x4 gm1 = *(const f32x4*)(GB + (size_t)((bd - 1) * 2 + 1) * DFF + c); const f32x4 w0 = *(const f32x4*)(lp.conv_w + c);
      if (j == 0) { const f32x4 gm2 = *(const f32x4*)(GB + (size_t)((bd - 1) * 2) * DFF + c); const f32x4 w1 = *(const f32x4*)(lp.conv_w + DFF + c); g += w1 * gm1 + w0 * gm2; }
      else g += w0 * gm1; }
    const f32x4 uv = *(const f32x4*)(UB + (size_t)(bd * 2 + j) * DFF + c); float f[4];
#pragma unroll
    for (int e = 0; e < 4; ++e) f[e] = g[e] * __builtin_amdgcn_rcpf(1.0f + __expf(-g[e])) * uv[e];
    u32x2_t o; o.x = pk2(f[0], f[1]); o.y = pk2(f[2], f[3]);
    *(u32x2_t*)(F + (size_t)(bd * 64 + j) * DFF + c) = o;
  }
}

DI void spatial_phase(const LP& lp, unsigned char* ws, LAS unsigned char* lds, int vcu, int loc) {
  const bf16_t *U = (const bf16_t*)rbuf<RB_U>(ws, vcu, loc), *GVT = (const bf16_t*)rbuf<RB_GVT>(ws, vcu, loc); const u64* SSV = (const u64*)(ws + OFF_SSV); bf16_t* MIX = (bf16_t*)rbuf<RB_MIX>(ws, vcu, loc);
  const int vtp = loc ? 4096 : T_TOK;
  constexpr int TB = 32768;
  LAS float* sr = (LAS float*)(lds + 2 * TB);
  const int tid = tid_opaque(), lane = tid & 63, w = __builtin_amdgcn_readfirstlane(tid >> 6), l15 = lane & 15, kq = lane >> 4;
#define SP_STAGE(item, buf) do { const int h_ = (item) & 3, t_ = ((item) >> 2) * 128; _Pragma("unroll") for (int i = 0; i < 4; ++i) { const int P = (w * 4 + i) * 64 + lane, row = P >> 4, pc = (P & 15) ^ (row & 15); \
    __builtin_amdgcn_global_load_lds((const unsigned*)(GVT + (size_t)(h_ * 128 + row) * vtp + t_ + pc * 8), (LAS unsigned*)(lds + (buf) * TB + (w * 4 + i) * 1024), 16, 0, 0); } } while (0)
  LAS float* vn_l = sr + 128; LAS float* on_l = vn_l + 512; LAS float* sb_l = on_l + 512;
  const int it_step = loc ? 1 : (int)gridDim.x, it_end = loc ? vcu * 4 + 4 : 1024;
  int it = loc ? vcu * 4 : (int)blockIdx.x, buf = 0;
  if (it < it_end) SP_STAGE(it, 0);
  { const float a = lp.v_norm_w[tid], b = lp.out_norm_w[tid], c = lp.sp_b[tid]; vn_l[tid] = a; on_l[tid] = b; sb_l[tid] = c; }
  asm volatile("s_waitcnt vmcnt(0)" ::: "memory");
  __syncthreads();
  const int x_lane = l15 * 256 + ((kq ^ l15) << 4);
  const int i0 = 16 * w, nks = (w < 4) ? 2 : 4;
  u32x4_t rawN[4]; u32x2_t urN[8]; u64 ssvN = 0ull;
#define SP_LOADREGS(item) do { const int h_ = (item) & 3, t_ = ((item) >> 2) * 128; \
    _Pragma("unroll") for (int ks = 0; ks < 4; ++ks) rawN[ks] = (ks < nks) ? *(const u32x4_t*)(lp.Wsp + (size_t)(h_ * 128 + i0 + l15) * 128 + ks * 32 + kq * 8) : (u32x4_t){0u, 0u, 0u, 0u}; \
    _Pragma("unroll") for (int dt = 0; dt < 8; ++dt) urN[dt] = *(const u32x2_t*)(U + (size_t)(t_ + i0 + l15) * 512 + h_ * 128 + 16 * dt + 4 * kq); \
    ssvN = (tid < 128) ? SSV[(size_t)(t_ + tid) * 4 + h_] : 0ull; } while (0)
  if (it < it_end) SP_LOADREGS(it);
  for (; it < it_end; it += it_step, buf ^= 1) {
    const int h = it & 3, tok0 = (it >> 2) * 128, irow = tok0 + i0 + l15;
    u32x4_t raw[4]; u32x2_t ur[8];
#pragma unroll
    for (int ks = 0; ks < 4; ++ks) raw[ks] = rawN[ks];
#pragma unroll
    for (int dt = 0; dt < 8; ++dt) ur[dt] = urN[dt];
    const u64 ssv = ssvN;
    const float bias = sb_l[h * 128 + i0 + l15];
    const int nit = it + it_step;
    if (nit < it_end) { SP_STAGE(nit, buf ^ 1); SP_LOADREGS(nit); }
    if (tid < 128) sr[tid] = rsqrtf(fx2f(ssv) * (1.0f / 128.0f) + EPS);
    __syncthreads();
    bf16x8 yf[4];
#pragma unroll
    for (int ks = 0; ks < 4; ++ks) { const LAS float* sp = sr + ks * 32 + kq * 8; const u32x4_t r = raw[ks]; u32x4_t o;
      o.x = pk2(bflo(r.x) * sp[0], bfhi(r.x) * sp[1]); o.y = pk2(bflo(r.y) * sp[2], bfhi(r.y) * sp[3]); o.z = pk2(bflo(r.z) * sp[4], bfhi(r.z) * sp[5]); o.w = pk2(bflo(r.w) * sp[6], bfhi(r.w) * sp[7]);
      yf[ks] = __builtin_bit_cast(bf16x8, o); }
    const LAS unsigned char* tb = lds + buf * TB;
    float o[8][4]; float ss = 0.f;
#pragma unroll
    for (int dt = 0; dt < 8; ++dt) {
      f32x4 acc = (f32x4){0.f, 0.f, 0.f, 0.f};
#pragma unroll
      for (int ks = 0; ks < 4; ++ks) if (ks < nks) {
        const bf16x8 xf = *(const LAS bf16x8*)(tb + dt * 4096 + (x_lane ^ (ks << 6)));
        acc = __builtin_amdgcn_mfma_f32_16x16x32_bf16(xf, yf[ks], acc, 0, 0, 0); }
      const int d0 = 16 * dt + 4 * kq; const f32x4 wv = *(const LAS f32x4*)(vn_l + h * 128 + d0);
      o[dt][0] = bflo(ur[dt].x) * (acc[0] * wv[0] + bias); o[dt][1] = bfhi(ur[dt].x) * (acc[1] * wv[1] + bias); o[dt][2] = bflo(ur[dt].y) * (acc[2] * wv[2] + bias); o[dt][3] = bfhi(ur[dt].y) * (acc[3] * wv[3] + bias);
      ss += (o[dt][0] * o[dt][0] + o[dt][1] * o[dt][1]) + (o[dt][2] * o[dt][2] + o[dt][3] * o[dt][3]);
    }
    ss += __shfl_xor(ss, 16); ss += __shfl_xor(ss, 32);
    const float rs = rsqrtf(ss * (1.0f / 128.0f) + EPS);
#pragma unroll
    for (int dt = 0; dt < 8; ++dt) { const int d0 = 16 * dt + 4 * kq; const f32x4 wo = *(const LAS f32x4*)(on_l + h * 128 + d0);
      u32x2_t q; q.x = pk2(o[dt][0] * rs * wo[0], o[dt][1] * rs * wo[1]); q.y = pk2(o[dt][2] * rs * wo[2], o[dt][3] * rs * wo[3]);
      *(u32x2_t*)(MIX + (size_t)irow * 1024 + h * 128 + d0) = q; }
    asm volatile("s_waitcnt vmcnt(8)" ::: "memory");
    __syncthreads();
  }
#undef SP_STAGE
#undef SP_LOADREGS
}

DI void attn_phase(const MParams& p, int l, LAS unsigned char* lds, int vcu, int loc) {
  unsigned char* ws = p.ws;
  const bf16_t *Q = (const bf16_t*)rbuf<RB_Q>(ws, vcu, loc), *KB = (const bf16_t*)rbuf<RB_KB>(ws, vcu, loc), *VT = (const bf16_t*)rbuf<RB_VT>(ws, vcu, loc); bf16_t* MIX = (bf16_t*)rbuf<RB_MIX>(ws, vcu, loc);
  const int vtp = loc ? 4096 : T_TOK;
  constexpr int KBUF = 16384, VBUF = 16384, STG = KBUF + VBUF, QOFF = 3 * STG;
  static_assert(QOFF + 65536 <= LDS_BYTES, "attention LDS");
  const unsigned sv0 = __builtin_amdgcn_readfirstlane(((volatile LAS unsigned*)(lds + 131072))[0]), sv1 = __builtin_amdgcn_readfirstlane(((volatile LAS unsigned*)(lds + 131072))[1]), sv2 = __builtin_amdgcn_readfirstlane(((volatile LAS unsigned*)(lds + 131072))[2]), sv3 = __builtin_amdgcn_readfirstlane(((volatile LAS unsigned*)(lds + 131072))[3]);
  __syncthreads();
  const float lambda_init = 0.8f - 0.6f * expf(-0.3f * (float)(l + 1));
  const float* dnw = p.in[13] + l * 128;
#pragma unroll 1
  for (int pi = vcu; pi < 256; pi += gridDim.x) {
    const int b = pi >> 4, h = (pi >> 2) & 3, j = pi & 3;
#pragma unroll 1
    for (int it = 0; it < 2; ++it) {
      const int tid = tid_opaque(), lane = tid & 63, w = __builtin_amdgcn_readfirstlane(tid >> 6), l31 = lane & 31, hh = lane >> 5;
      const int qb = it ? j : 7 - j, t0 = b * 2048 + 256 * qb, ntl = 4 * qb + 4, ntw = 4 * qb + (w >> 1) + 1;
#pragma unroll
      for (int i = 0; i < 8; ++i) { const int P = (w * 8 + i) * 64 + lane, row = P >> 4, pos = P & 15, pc = pos ^ (row & 15);
        __builtin_amdgcn_global_load_lds((const unsigned*)(Q + (size_t)(t0 + row) * 512 + h * 128 + pc * 8), (LAS unsigned*)(lds + QOFF + (w * 8 + i) * 1024), 16, 0, 0); }
      const bf16_t* kbase = KB + (size_t)(b * 2048) * 512 + h * 128; const bf16_t* vbase = VT + (size_t)(h * 128) * vtp + b * 2048;
      int koff[2], voff[2];
#pragma unroll
      for (int i = 0; i < 2; ++i) { const int P = (w * 2 + i) * 64 + lane; { const int row = P >> 4, pos = P & 15, pc = pos ^ (row & 15); koff[i] = row * 512 + pc * 8; }
        { const int row = P >> 3, pos = P & 7, pc = pos ^ ((row >> 1) & 7); voff[i] = row * vtp + pc * 8; } }
#define ATT_STAGE(kt, buf) do { _Pragma("unroll") for (int i = 0; i < 2; ++i) { \
        __builtin_amdgcn_global_load_lds((const unsigned*)(kbase + (size_t)(kt) * (64 * 512) + koff[i]), (LAS unsigned*)(lds + (buf) * STG + (w * 2 + i) * 1024), 16, 0, 0); \
        __builtin_amdgcn_global_load_lds((const unsigned*)(vbase + (kt) * 64 + voff[i]), (LAS unsigned*)(lds + (buf) * STG + KBUF + (w * 2 + i) * 1024), 16, 0, 0); } } while (0)
#define ATT_STAGE_AT(kt, soff) do { _Pragma("unroll") for (int i = 0; i < 2; ++i) { \
        __builtin_amdgcn_global_load_lds((const unsigned*)(kbase + (size_t)(kt) * (64 * 512) + koff[i]), (LAS unsigned*)(lds + (soff) + (w * 2 + i) * 1024), 16, 0, 0); \
        __builtin_amdgcn_global_load_lds((const unsigned*)(vbase + (kt) * 64 + voff[i]), (LAS unsigned*)(lds + (soff) + KBUF + (w * 2 + i) * 1024), 16, 0, 0); } } while (0)
      ATT_STAGE(0, 0);
      if (ntl > 1) { ATT_STAGE(1, 1); asm volatile("s_waitcnt vmcnt(4)" ::: "memory"); } else asm volatile("s_waitcnt vmcnt(0)" ::: "memory");
      __syncthreads();
      int st_cur = 0, st_pre = 2 * STG;
      f32x16 O[2][4];
#pragma unroll
      for (int c = 0; c < 2; ++c)
#pragma unroll
        for (int bk = 0; bk < 4; ++bk)
#pragma unroll
          for (int i = 0; i < 16; ++i) O[c][bk][i] = 0.f;
      float lsum[2] = {0.f, 0.f};
      const int qr = 32 * w + l31;
      int k_lane = l31 * 256 + ((hh ^ (l31 & 15)) << 4), q_lane = QOFF + qr * 256 + ((hh ^ (qr & 15)) << 4), v_lane = KBUF + l31 * 128 + ((hh ^ ((l31 >> 1) & 7)) << 4);
#pragma unroll 1
      for (int kt = 0; kt < ntl; ++kt) {
        if (kt + 2 < ntl) ATT_STAGE_AT(kt + 2, st_pre);
        if (kt < ntw) {
          asm volatile("" : "+v"(k_lane), "+v"(q_lane), "+v"(v_lane));
          const LAS unsigned char* tb = lds + st_cur;
#pragma unroll
          for (int kb = 0; kb < 2; ++kb) {
            bf16x8 pf[2][2];
#pragma unroll
            for (int c = 0; c < 2; ++c) {
              f32x16 S;
#pragma unroll
              for (int i = 0; i < 16; ++i) S[i] = 0.f;
#pragma unroll
              for (int ks = 0; ks < 4; ++ks) {
                const int xo = (c * 8 + ks * 2) << 4;
                const bf16x8 qf = *(const LAS bf16x8*)(lds + (q_lane ^ xo));
                const bf16x8 kf = *(const LAS bf16x8*)(tb + (k_lane ^ xo) + kb * 8192);
                S = __builtin_amdgcn_mfma_f32_32x32x16_bf16(kf, qf, S, 0, 0, 0);
              }
              float ls = 0.f;
#pragma unroll
              for (int hs = 0; hs < 2; ++hs) { u32x4_t pw;
#pragma unroll
                for (int t = 0; t < 4; ++t) { const float a = __builtin_amdgcn_exp2f(S[8 * hs + 2 * t]), bq = __builtin_amdgcn_exp2f(S[8 * hs + 2 * t + 1]); ls += a + bq; pw[t] = pk2(a, bq); }
                pf[c][hs] = __builtin_bit_cast(bf16x8, pw); }
              lsum[c] += ls;
              __builtin_amdgcn_sched_barrier(0);
            }
#pragma unroll
            for (int bk = 0; bk < 4; ++bk) {
              const bf16x8 v0 = *(const LAS bf16x8*)(tb + (v_lane ^ ((2 * kb) << 5)) + bk * 4096);
              const bf16x8 v1 = *(const LAS bf16x8*)(tb + (v_lane ^ ((2 * kb + 1) << 5)) + bk * 4096);
              O[0][bk] = __builtin_amdgcn_mfma_f32_32x32x16_bf16(v0, pf[0][0], O[0][bk], 0, 0, 0);
              O[1][bk] = __builtin_amdgcn_mfma_f32_32x32x16_bf16(v0, pf[1][0], O[1][bk], 0, 0, 0);
              O[0][bk] = __builtin_amdgcn_mfma_f32_32x32x16_bf16(v1, pf[0][1], O[0][bk], 0, 0, 0);
              O[1][bk] = __builtin_amdgcn_mfma_f32_32x32x16_bf16(v1, pf[1][1], O[1][bk], 0, 0, 0);
              __builtin_amdgcn_sched_barrier(0);
            }
          }
        }
        if (kt + 2 < ntl) asm volatile("s_waitcnt vmcnt(4)" ::: "memory"); else asm volatile("s_waitcnt vmcnt(0)" ::: "memory");
        __syncthreads();
        st_pre = st_cur; st_cur = (st_cur == 2 * STG) ? 0 : st_cur + STG;
      }
#undef ATT_STAGE
#undef ATT_STAGE_AT
      const int tid2 = tid_opaque(), lane2 = tid2 & 63, w2 = __builtin_amdgcn_readfirstlane(tid2 >> 6), hh2 = lane2 >> 5, qr2 = 32 * w2 + (lane2 & 31);
      float lam;
      { const float* q1 = p.in[9] + l * 64; const float* k1 = p.in[10] + l * 64; const float* q2 = p.in[11] + l * 64; const float* k2 = p.in[12] + l * 64;
        float a = q1[lane2] * k1[lane2], bq = q2[lane2] * k2[lane2]; a = wave_sum(a); bq = wave_sum(bq); lam = expf(a) - expf(bq) + lambda_init; }
      float l1 = lsum[0], l2 = lsum[1]; l1 += __shfl_xor(l1, 32); l2 += __shfl_xor(l2, 32);
      const float inv1 = 1.0f / l1, inv2 = lam / l2; float ss = 0.f;
#pragma unroll
      for (int bk = 0; bk < 4; ++bk)
#pragma unroll
        for (int i = 0; i < 16; ++i) { const float o = O[0][bk][i] * inv1 - O[1][bk][i] * inv2; O[0][bk][i] = o; ss += o * o; }
      ss += __shfl_xor(ss, 32);
      const float rs = rsqrtf(ss * (1.0f / 128.0f) + EPS) * (1.0f - lambda_init);
      bf16_t* orow = MIX + (size_t)(t0 + qr2) * 1024 + 512 + h * 128;
#pragma unroll
      for (int bk = 0; bk < 4; ++bk)
#pragma unroll
        for (int g = 0; g < 4; ++g) { const int dv0 = 32 * bk + 8 * g + 4 * hh2; const f32x4 wv = *(const f32x4*)(dnw + dv0);
          u32x2_t q; q.x = pk2(O[0][bk][4 * g] * rs * wv[0], O[0][bk][4 * g + 1] * rs * wv[1]); q.y = pk2(O[0][bk][4 * g + 2] * rs * wv[2], O[0][bk][4 * g + 3] * rs * wv[3]);
          *(u32x2_t*)(orow + dv0) = q; }
    }
  }
  __syncthreads();
  if (threadIdx.x == 0) { volatile LAS unsigned* stw = (volatile LAS unsigned*)(lds + 131072); stw[0] = sv0; stw[1] = sv1; stw[2] = sv2; stw[3] = sv3; }
  __syncthreads();
}


#define XB_TMO      128
#define XB_XCNT(j)  (256  + 64 * (j))
#define XB_XSUB(j)  (1280 + 64 * (j))
#define XB_XGEN(j)  (2304 + 64 * (j))
#define XB_TOP      3328
#define XB_TOPGEN   3392
#define XCD_BAR_WORDS 3456
#define XB_SPIN_CAP (1u << 18)

__device__ __forceinline__ unsigned xb_ld(unsigned* p)              { return __hip_atomic_load(p, __ATOMIC_RELAXED, __HIP_MEMORY_SCOPE_AGENT); }
__device__ __forceinline__ unsigned xb_add(unsigned* p, unsigned v) { return __hip_atomic_fetch_add(p, v, __ATOMIC_RELAXED, __HIP_MEMORY_SCOPE_AGENT); }
__device__ __forceinline__ unsigned xb_xcc_id() { return (unsigned)__builtin_amdgcn_s_getreg((3 << 11) | 20) & 0xFu; }
#define XB_SPIN(cond, bar) do { unsigned _sp = 0; while (cond) { __builtin_amdgcn_s_sleep(1); \
    if ((++_sp & 255u) == 0u) { if (xb_ld(&(bar)[XB_TMO])) break; if (_sp > XB_SPIN_CAP) { atomicAdd(&(bar)[XB_TMO], 1u); break; } } } } while (0)

struct XcdBarrier {
    unsigned* bar; unsigned x;
    volatile LAS unsigned* st;
};

__device__ __forceinline__ XcdBarrier xcd_barrier_post(unsigned* bar, volatile LAS unsigned* st) {
    XcdBarrier b; b.bar = bar; b.x = xb_xcc_id(); b.st = st;
    if (threadIdx.x == 0) st[2] = xb_add(&bar[XB_XCNT(b.x)], 1u);
    return b;
}
__device__ __forceinline__ void xcd_barrier_complete(unsigned* bar, unsigned x, unsigned& nloc, unsigned& nx) {
    const unsigned G = gridDim.x * gridDim.y * gridDim.z;
    unsigned sum, cnt, mine, sp = 0u;
    for (;;) {
        sum = 0u; cnt = 0u; mine = 0u;
#pragma unroll
        for (unsigned j = 0; j < 16; ++j) { const unsigned c = xb_ld(&bar[XB_XCNT(j)]); sum += c; cnt += (c > 0u) ? 1u : 0u; mine = (j == x) ? c : mine; }
        if (sum == G) break;
        __builtin_amdgcn_s_sleep(1);
        if ((++sp & 255u) == 0u) { if (xb_ld(&bar[XB_TMO])) break; if (sp > XB_SPIN_CAP) { atomicAdd(&bar[XB_TMO], 1u); break; } }
    }
    nloc = mine > 0u ? mine : 1u; nx = cnt > 0u ? cnt : 1u;
}

__device__ __forceinline__ void xcd_barrier(const XcdBarrier& b) {
    asm volatile("s_waitcnt vmcnt(0)" ::: "memory");
    __syncthreads();
    if (threadIdx.x == 0) {
        unsigned* bar = b.bar;
        __builtin_amdgcn_s_waitcnt(0);
        unsigned nloc = b.st[0], nx = b.st[1];
        if (nloc == 0u) { xcd_barrier_complete(bar, b.x, nloc, nx); b.st[0] = nloc; b.st[1] = nx; }
        const unsigned old = xb_add(&bar[XB_XSUB(b.x)], 1u);
        const unsigned gen = old / nloc;
        if (old + 1u == (gen + 1u) * nloc) {
            __builtin_amdgcn_fence(__ATOMIC_RELEASE, "agent");
            asm volatile("s_waitcnt vmcnt(0)" ::: "memory");
            const unsigned og = xb_add(&bar[XB_TOP], 1u);
            const unsigned tg = og / nx;
            if (og + 1u == (tg + 1u) * nx) xb_add(&bar[XB_TOPGEN], 1u);
            else XB_SPIN(xb_ld(&bar[XB_TOPGEN]) == tg, bar);
            __builtin_amdgcn_fence(__ATOMIC_ACQUIRE, "agent");
            xb_add(&bar[XB_XGEN(b.x)], 1u);
            asm volatile("s_waitcnt vmcnt(0)" ::: "memory");
        } else {
            XB_SPIN(xb_ld(&bar[XB_XGEN(b.x)]) == gen, bar);
            __builtin_amdgcn_fence(__ATOMIC_ACQUIRE, "agent");
            asm volatile("s_waitcnt vmcnt(0)" ::: "memory");
        }
    }
    __syncthreads();
}

#define XB_LSUB(j)  (3456 + 64 * (j))
#define XB_LGEN(j)  (4480 + 64 * (j))
#define XB_ALL_WORDS 5504
__device__ __forceinline__ void xcd_local_barrier(const XcdBarrier& b) {
    asm volatile("s_waitcnt vmcnt(0)" ::: "memory");
    __syncthreads();
    if (threadIdx.x == 0) {
        unsigned* bar = b.bar;
        __builtin_amdgcn_s_waitcnt(0);
        const unsigned nloc = b.st[0];
        const unsigned old = xb_add(&bar[XB_LSUB(b.x)], 1u);
        const unsigned gen = old / nloc;
        if (old + 1u == (gen + 1u) * nloc) xb_add(&bar[XB_LGEN(b.x)], 1u);
        else XB_SPIN(xb_ld(&bar[XB_LGEN(b.x)]) == gen, bar);
        __builtin_amdgcn_fence(__ATOMIC_ACQUIRE, "agent");
        asm volatile("s_waitcnt vmcnt(0)" ::: "memory");
    }
    __syncthreads();
}

DI void zero_u64(u64* p, int n, int vcu, int loc) {
  const int t = tid_opaque();
  if (loc) { const int per = n >> 3; u64* q = p + (size_t)(vcu >> 5) * per; for (int i = (vcu & 31) * 512 + t; i < per; i += 32 * 512) __hip_atomic_store(q + i, 0ull, __ATOMIC_RELAXED, __HIP_MEMORY_SCOPE_AGENT); }
  else for (int i = blockIdx.x * 512 + t; i < n; i += gridDim.x * 512) __hip_atomic_store(p + i, 0ull, __ATOMIC_RELAXED, __HIP_MEMORY_SCOPE_AGENT);
}
typedef pg8::StaticOrder OrderACE;
DI void phaseA(const MParams& p, int l, LAS unsigned char* lds, int cx, int vcu, int loc) {
  unsigned char* ws = p.ws; const bf16_t* XB = (const bf16_t*)(ws + OFF_XB); const bf16_t* WinT = (const bf16_t*)(ws + OFF_W + (size_t)l * W_STRIDE + WO_IN); const u64* SS1 = (const u64*)(ws + OFF_SS1);
  zero_u64((u64*)(ws + OFF_SS2), T_TOK, vcu, loc);
  { pg8::Gemm g{XB, WinT, T_TOK, 1536, DM}; OrderACE S; S.init(T_TOK, 1536, gridDim.x, cx);
    EpiA1 E{SS1, (bf16_t*)rbuf<RB_U>(ws, vcu, loc), (bf16_t*)rbuf<RB_Q>(ws, vcu, loc), (bf16_t*)rbuf<RB_KB>(ws, vcu, loc), p.in[7] + l * 64, p.in[8] + l * 64}; pg8::gemm_phase<EpiA1, OrderACE>(lds, g, S, E); }
  { pg8::Gemm g{WinT + (size_t)1536 * DM, XB, 1024, T_TOK, DM}; BalA2Order S; S.init(1024, T_TOK, gridDim.x, cx);
    EpiA2 E{SS1, (bf16_t*)rbuf<RB_GVT>(ws, vcu, loc), (bf16_t*)rbuf<RB_VT>(ws, vcu, loc), (u64*)(ws + OFF_SSV), loc ? 4096 : T_TOK}; pg8::gemm_phase<EpiA2, BalA2Order>(lds, g, S, E); }
}
DI void phaseCE(const MParams& p, int l, bool isC, LAS unsigned char* lds, int cx, int vcu, int loc) {
  unsigned char* ws = p.ws; const unsigned char* wb = ws + OFF_W + (size_t)l * W_STRIDE;
  if (isC) zero_u64((u64*)(ws + OFF_SS1), T_TOK, vcu, loc);
  pg8::Gemm g{(const bf16_t*)(isC ? rbuf<RB_MIX>(ws, vcu, loc) : rbuf<RB_F>(ws, vcu, loc)), (const bf16_t*)(wb + (isC ? WO_OUT : WO_DN)), T_TOK, DM, isC ? DM : DFF}; OrderACE S; S.init(T_TOK, DM, gridDim.x, cx);
  EpiResid E{(isC && l == 0) ? p.in[0] : nullptr, (!isC && l == NLAYER - 1) ? p.out : nullptr, (bf16_t*)(ws + OFF_XB), (u64*)(ws + (isC ? OFF_SS2 : OFF_SS1))}; pg8::gemm_phase<EpiResid, OrderACE>(lds, g, S, E);
}
DI void phaseD(const MParams& p, int l, LAS unsigned char* lds, int cx, int vcu, int loc) {
  unsigned char* ws = p.ws;
  zero_u64((u64*)(ws + OFF_SSV), T_TOK * 4, vcu, loc);
  pg8::Gemm g{(const bf16_t*)(ws + OFF_XB), (const bf16_t*)(ws + OFF_W + (size_t)l * W_STRIDE + WO_GU), T_TOK, 2 * DFF, DM};
#if PROBE_EPI_D
  DupOrder S;
#else
  pg8::StaticOrder S;
#endif
  S.init(T_TOK, 2 * DFF, gridDim.x, cx);
  EpiD E{(const u64*)(ws + OFF_SS2), p.in[18] + (size_t)l * 3 * DFF, p.in[19] + (size_t)l * DFF, (bf16_t*)rbuf<RB_F>(ws, vcu, loc), (float*)rbuf<RB_GB>(ws, vcu, loc), (float*)rbuf<RB_PB>(ws, vcu, loc), (float*)rbuf<RB_UB>(ws, vcu, loc)};
#if PROBE_EPI_D
  pg8::gemm_phase<EpiD, DupOrder>(lds, g, S, E);
#else
  pg8::gemm_phase<EpiD, pg8::StaticOrder>(lds, g, S, E);
#endif
}

__global__ void __launch_bounds__(512) k_run(MParams p) {
  extern __shared__ __attribute__((aligned(16))) unsigned char lds_raw[];
  LAS unsigned char* lds = (LAS unsigned char*)lds_raw;
  cg::grid_group grid = cg::this_grid();
  if (threadIdx.x < 4) ((LAS unsigned*)(lds + 131072))[threadIdx.x] = 0u;
  __syncthreads();
  XcdBarrier xbar = xcd_barrier_post((unsigned*)(p.ws + OFF_BAR), (volatile LAS unsigned*)(lds + 131072));
  if (p.ph_lo < 0) grid.sync();
  for (int ph = p.ph_lo; ph < p.ph_hi; ++ph) {
    const volatile LAS unsigned* stw = (const volatile LAS unsigned*)(lds + 131072);
    const int loc = (ph > 0) ? (int)__builtin_amdgcn_readfirstlane(stw[3]) : 0;
    const int xv = loc ? (int)xbar.x : (int)(blockIdx.x & 7), rv = loc ? (int)__builtin_amdgcn_readfirstlane(stw[2]) : (int)(blockIdx.x >> 3);
#define RUN_PHASES(LOC, CX, VCU) do { const int l = (ph - 1) / 6, s = (ph - 1) % 6; \
      if (s == 0) phaseA(p, l, lds, (CX), (VCU), (LOC)); \
      else if (s == 1) { attn_phase(p, l, lds, (VCU), (LOC)); const LP lp = make_lp(p, l); spatial_phase(lp, p.ws, lds, (VCU), (LOC)); } \
      else if (s == 2 || s == 5) phaseCE(p, l, s == 2, lds, (CX), (VCU), (LOC)); \
      else if (s == 3) phaseD(p, l, lds, (CX), (VCU), (LOC)); \
      else { const LP lp = make_lp(p, l); fixup_phase(lp, p.ws, (VCU), (LOC)); } } while (0)
    if (ph == 0) prologue(p, lds);
    else RUN_PHASES(1, rv * 8 + xv, xv * 32 + rv);
#undef RUN_PHASES
    if (ph + 1 < p.ph_hi) {
      const int sx = (ph - 1) % 6;
      (void)sx;
      if (ph == 0 || !loc) {
        xcd_barrier(xbar);
        if (ph == 0) {
          if (threadIdx.x == 0) { unsigned ok = (gridDim.x == 256u) ? 1u : 0u;
            for (unsigned j = 0; j < 16; ++j) { const unsigned c = xb_ld(&xbar.bar[XB_XCNT(j)]); if (c != (j < 8 ? 32u : 0u)) ok = 0u; }
            ((volatile LAS unsigned*)(lds + 131072))[3] = ok; }
          __syncthreads();
        }
      } else xcd_local_barrier(xbar);
    }
  }
}

extern "C" void kernel_launch(void* const* d_in, const int* in_sizes, int n_in, void* d_out, int out_size, void* d_ws, size_t ws_size, hipStream_t stream) {
  static int grid_blocks = 0;
  if (!grid_blocks) {
    (void)hipFuncSetAttribute((const void*)k_run, hipFuncAttributeMaxDynamicSharedMemorySize, LDS_BYTES);
    int dev = 0, cus = 0, per_cu = 0; (void)hipGetDevice(&dev); (void)hipDeviceGetAttribute(&cus, hipDeviceAttributeMultiprocessorCount, dev);
    (void)hipOccupancyMaxActiveBlocksPerMultiprocessor(&per_cu, (const void*)k_run, 512, LDS_BYTES); if (per_cu < 1) per_cu = 1;
    grid_blocks = 256;
  }
  MParams mp; memset(&mp, 0, sizeof(mp));
  for (int i = 0; i < 21; ++i) mp.in[i] = (const float*)d_in[i];
  mp.out = (float*)d_out; mp.ws = (unsigned char*)d_ws; mp.ph_lo = 0; mp.ph_hi = 1 + 6 * NLAYER;
  (void)hipMemsetAsync((unsigned char*)d_ws + OFF_BAR, 0, 5504 * sizeof(unsigned), stream);
  void* args[] = {&mp};
  hipError_t e = hipLaunchCooperativeKernel((const void*)k_run, dim3(grid_blocks), dim3(512), args, LDS_BYTES, stream);
  if (e != hipSuccess) fprintf(stderr, "cooperative launch failed: %s (grid %d)\n", hipGetErrorString(e), grid_blocks);
}
```

```cpp
#include <hip/hip_runtime.h>
#include <hip/hip_cooperative_groups.h>
#include <cstdio>
#include <cmath>
#include <cstring>

typedef unsigned short bf16_t;
#define DI __device__ __forceinline__

constexpr int T_TOK = 32768, DM = 1024, SEQ = 2048, DFF = 2816, INW = 2560, NLAYER = 4;
constexpr float EPS = 1e-6f;
constexpr float QSCALE = 0.125f * 1.4426950408889634f;

constexpr size_t MiB = 1024ull * 1024ull;
constexpr size_t OFF_XB = 0;
constexpr size_t OFF_R = 64 * MiB;
constexpr size_t OFF_U = OFF_R, OFF_Q = OFF_R + 32 * MiB, OFF_KB = OFF_R + 64 * MiB, OFF_GVT = OFF_R + 96 * MiB, OFF_VT = OFF_R + 128 * MiB, OFF_MIX = OFF_R + 160 * MiB;
constexpr size_t OFF_F = OFF_R, OFF_GB = OFF_R + 176 * MiB, OFF_PB = OFF_R + 188 * MiB, OFF_UB = OFF_R + 200 * MiB;
constexpr size_t OFF_W = 288 * MiB, W_STRIDE = 24 * MiB;
constexpr size_t WO_IN = 0, WO_OUT = 5 * MiB, WO_GU = 7 * MiB, WO_DN = 18 * MiB, WO_SP = 23 * MiB + 512 * 1024;
constexpr size_t OFF_SS1 = 384 * MiB, OFF_SS2 = OFF_SS1 + 256 * 1024, OFF_SSV = OFF_SS2 + 256 * 1024;
constexpr size_t OFF_BAR = 385 * MiB + 512 * 1024;
constexpr size_t OFF_TMP1 = 386 * MiB, OFF_TMP2 = 418 * MiB;

DI int tid_opaque() { int t = threadIdx.x; asm volatile("" : "+v"(t)); return t; }
DI float bf2f(bf16_t b) { return __uint_as_float(((unsigned)b) << 16); }
DI bf16_t f2bf(float f) { unsigned u = __float_as_uint(f); u += 0x7FFFu + ((u >> 16) & 1u); return (bf16_t)(u >> 16); }
DI float gelu_exact(float x) { return 0.5f * x * (1.0f + erff(x * 0.70710678118654752f)); }
DI int permpos16(int k) { return (k & 3) + 4 * (k >> 3) + 8 * ((k >> 2) & 1); }
DI float wave_sum(float v) { for (int o = 32; o >= 1; o >>= 1) v += __shfl_xor(v, o); return v; }

namespace pg8 {
#define PG8_LAS __attribute__((address_space(3)))
typedef unsigned short bf16_t;
typedef short bf16x8 __attribute__((ext_vector_type(8)));
typedef float f32x4 __attribute__((ext_vector_type(4)));
typedef unsigned u32x4 __attribute__((ext_vector_type(4)));
constexpr int BM = 256, BK = 64, HALF = 128, HTB = HALF * BK * 2  , STAGE_BYTES = 8 * HTB, NXCD = 8, WGM = 8;

__host__ __device__ __forceinline__ int lds_byte(int r, int c) { const int st = (r >> 4) * 2 + (c >> 5), rr = r & 15, cc = c & 31, ob = rr * 64 + cc * 2; return st * 1024 + (ob ^ (((ob >> 9) & 1) << 5)); }
__host__ __device__ __forceinline__ void stage_rc(int b, int& R, int& C) { const int st = b / 1024, sb = b % 1024, swz = sb ^ (((sb >> 9) & 1) << 5); R = (st >> 1) * 16 + swz / 64; C = (st & 1) * 32 + (swz % 64) / 2; }
__host__ __device__ __forceinline__ int perm32(int rho) { const int n = rho >> 4, i = rho & 15; return 8 * (i >> 2) + 4 * n + (i & 3); }

struct Unit { int pm, pn; };
struct Gemm { const bf16_t* A; const bf16_t* Bt; int M, N, K; };

struct StaticOrder {
    int nM, nN, nwg, G, c;
    __host__ __device__ void init(int M, int N, int G_, int c_) { nM = M / BM; nN = N / BM; nwg = nM * nN; G = G_; c = c_; }
    __host__ __device__ bool next(int i, Unit& u) const {
        const long L = (long)i * G + c; if (L >= nwg) return false;
        int wgid = (int)L; { const int q = nwg / NXCD, r = nwg % NXCD, xcd = wgid % NXCD, off = wgid / NXCD; wgid = (xcd < r ? xcd * (q + 1) : r * (q + 1) + (xcd - r) * q) + off; }
        const int nig = WGM * nN, gid = wgid / nig, fm = gid * WGM, gsz = (nM - fm) < WGM ? (nM - fm) : WGM;
        u.pm = fm + ((wgid % nig) % gsz); u.pn = (wgid % nig) / gsz; return true;
    }
    __device__ __forceinline__ void a_ready(const Unit&) const {}
    __device__ __forceinline__ void done(const Unit&) const {}
};
template <class Epi, class Sched>
__device__ __forceinline__ void gemm_phase(PG8_LAS unsigned char* lds, const Gemm g, const Sched& S, const Epi& E) {
    const int tid = tid_opaque(), wid = __builtin_amdgcn_readfirstlane(tid >> 6), lane = tid & 63, wr = wid >> 2, wc = wid & 3, fr = lane & 15, fq = lane >> 4;
    const int K = g.K, nt = K / BK;
    unsigned voffA[2], voffB[2];
#pragma unroll
    for (int i = 0; i < 2; ++i) { int R, C; stage_rc(tid * 16 + i * 8192, R, C); const int Rb = Epi::PERM ? ((R & ~31) + perm32(R & 31)) : R;
        voffA[i] = (unsigned)(R * K + C) * 2u; voffB[i] = (unsigned)(Rb * K + C) * 2u; }
    const size_t kstep = (size_t)(BK * 2);
    const size_t hstep = (size_t)HALF * K * 2;
    const size_t tstep = 2 * hstep;
    const unsigned ldsw = (unsigned)wid * 1024u;
    const int aoff = lds_byte(wr * 64 + fr, fq * 8), boff = lds_byte(wc * 32 + fr, fq * 8);
#define PG8_SA(b, h) (((b) * 2 + (h)) * HTB)
#define PG8_SB(b, h) ((4 + (b) * 2 + (h)) * HTB)
#define PG8_STAGE(bufoff, gbase, voff) do { _Pragma("unroll") for (int _i = 0; _i < 2; ++_i) \
        __builtin_amdgcn_global_load_lds((const unsigned*)((const char*)(gbase) + (voff)[_i]), (PG8_LAS unsigned*)(lds + (bufoff) + ldsw + _i * 8192), 16, 0, 0); } while (0)
#define PG8_LDA(dst, b, h) do { _Pragma("unroll") for (int m = 0; m < 4; ++m) _Pragma("unroll") for (int k = 0; k < 2; ++k) dst[m][k] = *(const PG8_LAS bf16x8*)(lds + PG8_SA(b, h) + aoff + m * 2048 + k * 1024); } while (0)
#define PG8_LDB(dst, b, h) do { _Pragma("unroll") for (int n = 0; n < 2; ++n) _Pragma("unroll") for (int k = 0; k < 2; ++k) dst[n][k] = *(const PG8_LAS bf16x8*)(lds + PG8_SB(b, h) + boff + n * 2048 + k * 1024); } while (0)
#define PG8_MMA(ai, bj, At, Bt) do { __builtin_amdgcn_s_setprio(1); _Pragma("unroll") for (int m = 0; m < 4; ++m) _Pragma("unroll") for (int n = 0; n < 2; ++n) _Pragma("unroll") for (int k = 0; k < 2; ++k) \
        acc[ai][bj][m][n] = __builtin_amdgcn_mfma_f32_16x16x32_bf16(Bt[n][k], At[m][k], acc[ai][bj][m][n], 0, 0, 0); __builtin_amdgcn_s_setprio(0); } while (0)
#define PG8_WAIT_V(n) asm volatile("s_waitcnt vmcnt(" #n ")" ::: "memory")
#define PG8_WAIT_L(n) asm volatile("s_waitcnt lgkmcnt(" #n ")" ::: "memory")
#define PG8_BAR __builtin_amdgcn_s_barrier()
#define PG8_SCHED __builtin_amdgcn_sched_barrier(0)
    Unit cur, nxt; int ui = 0;
    if (!S.next(0, cur)) return;
    f32x4 acc[2][2][4][2];
#pragma unroll
    for (int a = 0; a < 2; ++a)
#pragma unroll
        for (int b = 0; b < 2; ++b)
#pragma unroll
            for (int m = 0; m < 4; ++m)
#pragma unroll
                for (int n = 0; n < 2; ++n) acc[a][b][m][n] = (f32x4){0.f, 0.f, 0.f, 0.f};
    bf16x8 At[4][2], B0[2][2], B1[2][2];
    const char* cA = (const char*)g.A + (size_t)cur.pm * tstep; const char* cB = (const char*)g.Bt + (size_t)cur.pn * tstep;
    S.a_ready(cur);
    PG8_STAGE(PG8_SB(0, 0), cB, voffB); PG8_STAGE(PG8_SA(0, 0), cA, voffA); PG8_STAGE(PG8_SB(0, 1), cB + hstep, voffB); PG8_STAGE(PG8_SA(0, 1), cA + hstep, voffA);
    if (wr == 1) PG8_BAR;
    PG8_WAIT_V(4); PG8_BAR;
    PG8_STAGE(PG8_SB(1, 0), cB + kstep, voffB); PG8_STAGE(PG8_SA(1, 0), cA + kstep, voffA); PG8_STAGE(PG8_SB(1, 1), cB + hstep + kstep, voffB);
    PG8_WAIT_V(6); PG8_BAR;
    for (;;) {
        const bool has_next = S.next(ui + 1, nxt);
        const char* nA = has_next ? (const char*)g.A + (size_t)nxt.pm * tstep : cA; const char* nB = has_next ? (const char*)g.Bt + (size_t)nxt.pn * tstep : cB;
        for (int t = 0; t < nt; t += 2) {
            const bool last = (t == nt - 2);
            const char* a1 = cA + (size_t)(t + 1) * kstep;
            const char* a2 = last ? nA : cA + (size_t)(t + 2) * kstep; const char* b2 = last ? nB : cB + (size_t)(t + 2) * kstep;
            const char* a3 = a2 + kstep; const char* b3 = b2 + kstep;
            if (last && has_next) S.a_ready(nxt);
            PG8_LDB(B0, 0, 0); PG8_SCHED; PG8_LDA(At, 0, 0); PG8_STAGE(PG8_SA(1, 1), a1 + hstep, voffA);
            PG8_WAIT_L(8); PG8_BAR; PG8_WAIT_L(0); PG8_MMA(0, 0, At, B0); PG8_BAR; PG8_SCHED;
            PG8_LDB(B1, 0, 1); PG8_STAGE(PG8_SB(0, 0), b2, voffB);
            PG8_BAR; PG8_WAIT_L(0); PG8_MMA(0, 1, At, B1); PG8_BAR;
            PG8_LDA(At, 0, 1); PG8_STAGE(PG8_SA(0, 0), a2, voffA);
            PG8_BAR; PG8_WAIT_L(0); PG8_MMA(1, 0, At, B0); PG8_BAR; PG8_SCHED;
            PG8_STAGE(PG8_SB(0, 1), b2 + hstep, voffB);
            PG8_WAIT_V(6); PG8_BAR; PG8_MMA(1, 1, At, B1); PG8_BAR;
            PG8_LDB(B0, 1, 0); PG8_SCHED; PG8_LDA(At, 1, 0); PG8_STAGE(PG8_SA(0, 1), a2 + hstep, voffA);
            PG8_WAIT_L(8); PG8_BAR; PG8_WAIT_L(0); PG8_MMA(0, 0, At, B0); PG8_BAR; PG8_SCHED;
            PG8_LDB(B1, 1, 1); PG8_STAGE(PG8_SB(1, 0), b3, voffB);
            PG8_BAR; PG8_WAIT_L(0); PG8_MMA(0, 1, At, B1); PG8_BAR;
            PG8_LDA(At, 1, 1); PG8_STAGE(PG8_SA(1, 0), a3, voffA);
            PG8_BAR; PG8_WAIT_L(0); PG8_MMA(1, 0, At, B0); PG8_BAR; PG8_SCHED;
            PG8_STAGE(PG8_SB(1, 1), b3 + hstep, voffB);
            PG8_WAIT_V(6); PG8_BAR; PG8_MMA(1, 1, At, B1); PG8_BAR;
        }
        if constexpr (!Epi::AFTER_DRAIN) { if (!Epi::TWICE || (ui & 1)) E(acc, cur, wr, wc, fr, fq); S.done(cur); }
        if (!has_next) break;
#pragma unroll
        for (int a = 0; a < 2; ++a)
#pragma unroll
            for (int b = 0; b < 2; ++b)
#pragma unroll
                for (int m = 0; m < 4; ++m)
#pragma unroll
                    for (int n = 0; n < 2; ++n) acc[a][b][m][n] = (f32x4){0.f, 0.f, 0.f, 0.f};
        cur = nxt; cA = nA; cB = nB; ++ui;
    }
    PG8_WAIT_V(0);
    if (wr == 0) PG8_BAR;
    PG8_BAR;
    if constexpr (Epi::AFTER_DRAIN) { E.fused(acc, cur, wr, wc, fr, fq, lds, wid, lane); S.done(cur); }
#undef PG8_SA
#undef PG8_SB
#undef PG8_STAGE
#undef PG8_LDA
#undef PG8_LDB
#undef PG8_MMA
#undef PG8_WAIT_V
#undef PG8_WAIT_L
#undef PG8_BAR
#undef PG8_SCHED
}
}

namespace cg = cooperative_groups;
using pg8::f32x4; using pg8::bf16x8; using pg8::Unit;
typedef unsigned u32x2_t __attribute__((ext_vector_type(2)));
typedef unsigned u32x4_t __attribute__((ext_vector_type(4)));
typedef float f32x16 __attribute__((ext_vector_type(16)));
typedef float f32x2_t __attribute__((ext_vector_type(2)));
#define LAS PG8_LAS
constexpr int LDS_BYTES = 163840;
#ifndef EN_MASK
#define EN_MASK 0x7f
#endif
#ifndef PROBE_EPI_ACE
#define PROBE_EPI_ACE 0
#endif
#ifndef PROBE_EPI_D
#define PROBE_EPI_D 0
#endif
#ifndef PROBE_SYNC
#define PROBE_SYNC 0
#endif
#ifndef PROBE_MASK
#define PROBE_MASK 0x00
#endif

DI unsigned pk2(float lo, float hi) { unsigned r; asm volatile("s_nop 0\n\tv_cvt_pk_bf16_f32 %0, %1, %2\n\ts_nop 1" : "=v"(r) : "v"(lo), "v"(hi)); return r; }
DI float bflo(unsigned w) { return __uint_as_float(w << 16); }
DI float bfhi(unsigned w) { return __uint_as_float(w & 0xffff0000u); }
DI float gelu1(float v) {
  const float av = fabsf(v), t = __builtin_amdgcn_rcpf(av * 0.2316418882f + 1.0f);
  float q = t * 0.5307027145f + (-0.7265760135f); q = q * t + 0.7107068705f; q = q * t + (-0.142248368f); q = q * t + 0.127414796f; q = q * t;
  const float e = __builtin_amdgcn_exp2f((v * v) * (-0.72134752044f));
  const float m = v * (q * e);
  return v < 0.f ? m : v - m;
}
DI float dpp_ror1(float v) { return __builtin_bit_cast(float, __builtin_amdgcn_update_dpp(0, __builtin_bit_cast(int, v), 0x121, 0xf, 0xf, false)); }
DI float dpp_ror2(float v) { return __builtin_bit_cast(float, __builtin_amdgcn_update_dpp(0, __builtin_bit_cast(int, v), 0x122, 0xf, 0xf, false)); }
DI float row_sum16(float v) {
  v += __builtin_bit_cast(float, __builtin_amdgcn_update_dpp(0, __builtin_bit_cast(int, v), 0x128, 0xf, 0xf, false));
  v += __builtin_bit_cast(float, __builtin_amdgcn_update_dpp(0, __builtin_bit_cast(int, v), 0x124, 0xf, 0xf, false));
  v += __builtin_bit_cast(float, __builtin_amdgcn_update_dpp(0, __builtin_bit_cast(int, v), 0x122, 0xf, 0xf, false));
  v += __builtin_bit_cast(float, __builtin_amdgcn_update_dpp(0, __builtin_bit_cast(int, v), 0x121, 0xf, 0xf, false));
  return v; }
typedef unsigned long long u64;
DI float fx2f(u64 v) { return (float)v * (1.0f / 1048576.0f); }
DI u64 f2fx(float v) { return (u64)(v * 1048576.0f + 0.5f); }
DI void fx_add(u64* p, float v) { __hip_atomic_fetch_add(p, f2fx(v), __ATOMIC_RELAXED, __HIP_MEMORY_SCOPE_AGENT); }
DI float rs1024(u64 ss) { return rsqrtf(fx2f(ss) * (1.0f / 1024.0f) + EPS); }

struct MParams { const float* in[21]; float* out; unsigned char* ws; int ph_lo, ph_hi; };
struct LP {
  const float *norm_attn_w, *w_in, *v_norm_w, *sp_w, *sp_b, *out_norm_w, *q_norm_w, *k_norm_w, *lq1, *lk1, *lq2, *lk2, *diff_norm_w, *w_out, *norm_ffn_w, *w_gate, *w_up, *conv_w, *conv_b, *w_down;
  float lambda_init;
  const bf16_t *WinT, *WoutT, *WguT, *WdT, *Wsp;
};
DI LP make_lp(const MParams& p, int l) {
  LP L;
  L.norm_attn_w = p.in[1] + (size_t)l * DM; L.w_in = p.in[2] + (size_t)l * DM * INW; L.v_norm_w = p.in[3] + (size_t)l * 512; L.sp_w = p.in[4] + (size_t)l * 65536; L.sp_b = p.in[5] + (size_t)l * 512;
  L.out_norm_w = p.in[6] + (size_t)l * 512; L.q_norm_w = p.in[7] + (size_t)l * 64; L.k_norm_w = p.in[8] + (size_t)l * 64; L.lq1 = p.in[9] + (size_t)l * 64; L.lk1 = p.in[10] + (size_t)l * 64;
  L.lq2 = p.in[11] + (size_t)l * 64; L.lk2 = p.in[12] + (size_t)l * 64; L.diff_norm_w = p.in[13] + (size_t)l * 128; L.w_out = p.in[14] + (size_t)l * DM * DM; L.norm_ffn_w = p.in[15] + (size_t)l * DM;
  L.w_gate = p.in[16] + (size_t)l * DM * DFF; L.w_up = p.in[17] + (size_t)l * DM * DFF; L.conv_w = p.in[18] + (size_t)l * 3 * DFF; L.conv_b = p.in[19] + (size_t)l * DFF; L.w_down = p.in[20] + (size_t)l * DFF * DM;
  L.lambda_init = 0.8f - 0.6f * expf(-0.3f * (float)(l + 1));
  const unsigned char* wb = p.ws + OFF_W + (size_t)l * W_STRIDE;
  L.WinT = (const bf16_t*)(wb + WO_IN); L.WoutT = (const bf16_t*)(wb + WO_OUT); L.WguT = (const bf16_t*)(wb + WO_GU); L.WdT = (const bf16_t*)(wb + WO_DN); L.Wsp = (const bf16_t*)(wb + WO_SP);
  return L;
}
DI float lam_of(const LP& lp) {
  const int lane = threadIdx.x & 63;
  float a = lp.lq1[lane] * lp.lk1[lane], b = lp.lq2[lane] * lp.lk2[lane];
  a = wave_sum(a); b = wave_sum(b);
  return expf(a) - expf(b) + lp.lambda_init;
}

DI void conv_item(bf16_t* dst, int K, int row, int kg, const float* src, int ld, int col, const float* ks) {
  float v[32];
#pragma unroll
  for (int i = 0; i < 32; ++i) v[i] = src[(size_t)(kg * 32 + i) * ld + col];
  if (ks) {
#pragma unroll
    for (int i = 0; i < 32; i += 4) { const f32x4 s = *(const f32x4*)(ks + kg * 32 + i); v[i] *= s[0]; v[i + 1] *= s[1]; v[i + 2] *= s[2]; v[i + 3] *= s[3]; }
  }
  u32x4_t* d = (u32x4_t*)(dst + (size_t)row * K + kg * 32);
#pragma unroll
  for (int i = 0; i < 4; ++i) { u32x4_t w; w.x = pk2(v[8 * i], v[8 * i + 1]); w.y = pk2(v[8 * i + 2], v[8 * i + 3]); w.z = pk2(v[8 * i + 4], v[8 * i + 5]); w.w = pk2(v[8 * i + 6], v[8 * i + 7]); d[i] = w; }
}
DI int perm_logical(int p) {
  const int bj = p >> 7, wc = (p >> 5) & 3, n = (p >> 4) & 1, fq = (p >> 2) & 3, e = p & 3;
  return 64 * wc + 32 * bj + 8 * fq + 4 * n + e;
}
DI int perm_res(int p) { return (p & ~31) + 8 * ((p >> 2) & 3) + 4 * ((p >> 4) & 1) + (p & 3); }
DI void prologue(const MParams& p, LAS unsigned char* lds) {
  const int tidp = tid_opaque(); const int gtid = blockIdx.x * 512 + tidp, gsz = gridDim.x * 512;
  unsigned char* ws = p.ws;
  { const int gw = gtid >> 6, nw = gsz >> 6, lane = threadIdx.x & 63; bf16_t* XB = (bf16_t*)(ws + OFF_XB); u64* SS1 = (u64*)(ws + OFF_SS1);
    for (int row = gw; row < T_TOK; row += nw) { const float* xp = p.in[0] + (size_t)row * DM; float s = 0.f;
#pragma unroll
      for (int i = 0; i < 4; ++i) { const f32x4 v = *(const f32x4*)(xp + i * 256 + lane * 4); s += v[0] * v[0] + v[1] * v[1] + v[2] * v[2] + v[3] * v[3];
        u32x2_t w; w.x = pk2(v[0], v[1]); w.y = pk2(v[2], v[3]); *(u32x2_t*)(XB + (size_t)row * DM + i * 256 + lane * 4) = w; }
      s = wave_sum(s); if (lane == 0) SS1[row] = f2fx(s); } }
  { u64* SSV = (u64*)(ws + OFF_SSV); for (int i = gtid; i < T_TOK * 4; i += gsz) SSV[i] = 0ull; }
  { const int lane = tidp & 63, wv = tidp >> 6, n4 = lane & 15, kq = lane >> 4; LAS unsigned char* wl = lds + wv * 9216;
    for (int t = blockIdx.x * 8 + wv; t < NLAYER * 3008; t += gridDim.x * 8) {
      const int l = t / 3008; int r = t - l * 3008; const LP lp = make_lp(p, l);
      const float* src; const float* ks; bf16_t* dst; int ld, K, rt, kt, col;
      if (r < 640) { rt = r % 40; kt = r / 40; dst = (bf16_t*)lp.WinT; K = 1024; ld = INW; ks = lp.norm_attn_w; src = lp.w_in; const int row = 64 * rt + 4 * n4;
        if (row < 1536) { const int L = (row & ~255) + perm_logical(row & 255); col = L < 512 ? L : L + 512; } else { const int q = row - 1536; col = q < 512 ? 512 + q : 1536 + q; } }
      else if (r < 896) { r -= 640; rt = r & 15; kt = r >> 4; dst = (bf16_t*)lp.WoutT; K = 1024; ld = DM; ks = nullptr; src = lp.w_out; col = perm_res(64 * rt + 4 * n4); }
      else if (r < 2304) { r -= 896; rt = r % 88; kt = r / 88; dst = (bf16_t*)lp.WguT; K = 1024; ld = DFF; ks = lp.norm_ffn_w; const int row = 64 * rt + 4 * n4, pn = row >> 8, pp = row & 255;
        src = (pp >> 7) ? lp.w_up : lp.w_gate; const int q = pp & 127; col = 128 * pn + 32 * ((q >> 5) & 3) + 8 * ((q >> 2) & 3) + 4 * ((q >> 4) & 1) + (q & 3); }
      else { r -= 2304; rt = r & 15; kt = r >> 4; dst = (bf16_t*)lp.WdT; K = DFF; ld = DM; ks = nullptr; src = lp.w_down; col = perm_res(64 * rt + 4 * n4); }
      const float* sp = src + (size_t)(64 * kt + 16 * kq) * ld + col;
      f32x4 v[16];
#pragma unroll
      for (int j = 0; j < 16; ++j) v[j] = *(const f32x4*)(sp + (size_t)j * ld);
      if (ks) {
#pragma unroll
        for (int i = 0; i < 4; ++i) { const f32x4 sc = *(const f32x4*)(ks + 64 * kt + 16 * kq + 4 * i); v[4 * i] *= sc[0]; v[4 * i + 1] *= sc[1]; v[4 * i + 2] *= sc[2]; v[4 * i + 3] *= sc[3]; } }
#pragma unroll
      for (int n = 0; n < 4; ++n)
#pragma unroll
        for (int hh = 0; hh < 2; ++hh) { u32x4_t w; w.x = pk2(v[8 * hh][n], v[8 * hh + 1][n]); w.y = pk2(v[8 * hh + 2][n], v[8 * hh + 3][n]); w.z = pk2(v[8 * hh + 4][n], v[8 * hh + 5][n]); w.w = pk2(v[8 * hh + 6][n], v[8 * hh + 7][n]);
          *(LAS u32x4_t*)(wl + (4 * n4 + n) * 144 + (16 * kq + 8 * hh) * 2) = w; }
#pragma unroll
      for (int i = 0; i < 8; ++i) { const int row = 8 * i + (lane >> 3), pc = lane & 7; const u32x4_t w = *(const LAS u32x4_t*)(wl + row * 144 + pc * 16);
        *(u32x4_t*)(dst + (size_t)(64 * rt + row) * K + 64 * kt + pc * 8) = w; }
    }
  }
  for (int l = 0; l < NLAYER; ++l) { const LP lp = make_lp(p, l);
    for (int i = gtid; i < 65536; i += gsz) { const int jj = i & 127, ii = (i >> 7) & 127; ((bf16_t*)lp.Wsp)[i] = ((jj >> 6) <= (ii >> 6)) ? f2bf(lp.sp_w[i]) : (bf16_t)0; } }
}

enum { RB_U = 0, RB_Q, RB_KB, RB_GVT, RB_VT, RB_MIX, RB_F, RB_GB, RB_PB, RB_UB };
template <int W> DI unsigned char* rbuf(unsigned char* ws, int vcu, int loc) {
  constexpr size_t goff = W == RB_U ? OFF_U : W == RB_Q ? OFF_Q : W == RB_KB ? OFF_KB : W == RB_GVT ? OFF_GVT : W == RB_VT ? OFF_VT : W == RB_MIX ? OFF_MIX : W == RB_F ? OFF_F : W == RB_GB ? OFF_GB : W == RB_PB ? OFF_PB : OFF_UB;
  if (!loc) return ws + goff;
  constexpr size_t KiB = 1024;
  constexpr size_t loff = W == RB_U ? 0 : W == RB_Q ? 4 * MiB : W == RB_KB ? 8 * MiB : W == RB_GVT ? 12 * MiB : W == RB_VT ? 16 * MiB : W == RB_MIX ? 20 * MiB : W == RB_F ? 0 : W == RB_GB ? 22 * MiB : W == RB_PB ? 22 * MiB + 1536 * KiB : 25 * MiB;
  constexpr size_t bias = (W == RB_U || W == RB_Q || W == RB_KB) ? (size_t)4096 * 512 * 2 : (W == RB_GVT || W == RB_VT) ? (size_t)4096 * 2 : W == RB_MIX ? (size_t)4096 * 1024 * 2 : W == RB_F ? (size_t)4096 * DFF * 2 : (size_t)64 * 2 * DFF * 4;
  const size_t x = (size_t)(vcu >> 5);
  return ws + OFF_R + x * (28 * MiB) + loff - x * bias;
}
struct DupOrder : pg8::StaticOrder {
  __device__ bool next(int i, Unit& u) const { return pg8::StaticOrder::next(i >> 1, u); }
};
struct BalA2Order : pg8::StaticOrder {
  __device__ bool next(int i, Unit& u) const { const bool ok = pg8::StaticOrder::next(i, u); u.pm = (u.pm + 2 * i) & 3; return ok; }
};
struct EpiResid {
  static constexpr bool PERM = false, AFTER_DRAIN = false, TWICE = (PROBE_EPI_ACE != 0);
  const float* base32; float* out32; bf16_t* XB; u64* SS;
  DI void operator()(const f32x4 (&acc)[2][2][4][2], const Unit& u, int wr, int wc, int fr, int fq) const {
    const int row0 = u.pm * 256 + wr * 64 + fr, col0 = u.pn * 256 + wc * 32 + 8 * fq;
    if (base32) {
      f32x4 nb[2][2];
#pragma unroll
      for (int bj = 0; bj < 2; ++bj)
#pragma unroll
        for (int n = 0; n < 2; ++n) nb[bj][n] = *(const f32x4*)(base32 + (size_t)row0 * DM + col0 + bj * 128 + n * 4);
#pragma unroll
      for (int g = 0; g < 8; ++g) { const int ai = g >> 2, m = g & 3; const int row = row0 + ai * 128 + m * 16; const size_t ro = (size_t)row * DM + col0; float ss = 0.f;
        f32x4 cbv[2][2];
#pragma unroll
        for (int bj = 0; bj < 2; ++bj)
#pragma unroll
          for (int n = 0; n < 2; ++n) cbv[bj][n] = nb[bj][n];
        if (g < 7) { const int r2 = row0 + ((g + 1) >> 2) * 128 + ((g + 1) & 3) * 16;
#pragma unroll
          for (int bj = 0; bj < 2; ++bj)
#pragma unroll
            for (int n = 0; n < 2; ++n) nb[bj][n] = *(const f32x4*)(base32 + (size_t)r2 * DM + col0 + bj * 128 + n * 4); }
#pragma unroll
        for (int bj = 0; bj < 2; ++bj) { const f32x4 v0 = acc[ai][bj][m][0] + cbv[bj][0], v1 = acc[ai][bj][m][1] + cbv[bj][1];
          u32x4_t w; w.x = pk2(v0[0], v0[1]); w.y = pk2(v0[2], v0[3]); w.z = pk2(v1[0], v1[1]); w.w = pk2(v1[2], v1[3]); *(u32x4_t*)(XB + ro + bj * 128) = w;
          ss += ((v0[0] * v0[0] + v0[1] * v0[1]) + (v0[2] * v0[2] + v0[3] * v0[3])) + ((v1[0] * v1[0] + v1[1] * v1[1]) + (v1[2] * v1[2] + v1[3] * v1[3])); }
        ss += __shfl_xor(ss, 16); ss += __shfl_xor(ss, 32); if (fq == 0) fx_add(SS + row, ss);
        asm volatile("" ::: "memory"); }
    } else {
      u32x4_t nb[2];
#pragma unroll
      for (int bj = 0; bj < 2; ++bj) nb[bj] = *(const u32x4_t*)(XB + (size_t)row0 * DM + col0 + bj * 128);
#pragma unroll
      for (int g = 0; g < 8; ++g) { const int ai = g >> 2, m = g & 3; const int row = row0 + ai * 128 + m * 16; const size_t ro = (size_t)row * DM + col0; float ss = 0.f;
        u32x4_t cbv[2];
#pragma unroll
        for (int bj = 0; bj < 2; ++bj) cbv[bj] = nb[bj];
        if (g < 7) { const int r2 = row0 + ((g + 1) >> 2) * 128 + ((g + 1) & 3) * 16;
#pragma unroll
          for (int bj = 0; bj < 2; ++bj) nb[bj] = *(const u32x4_t*)(XB + (size_t)r2 * DM + col0 + bj * 128); }
#pragma unroll
        for (int bj = 0; bj < 2; ++bj) { const u32x4_t c = cbv[bj];
          const f32x4 v0 = acc[ai][bj][m][0] + (f32x4){bflo(c.x), bfhi(c.x), bflo(c.y), bfhi(c.y)}, v1 = acc[ai][bj][m][1] + (f32x4){bflo(c.z), bfhi(c.z), bflo(c.w), bfhi(c.w)};
          if (out32) { *(f32x4*)(out32 + ro + bj * 128) = v0; *(f32x4*)(out32 + ro + bj * 128 + 4) = v1; }
          else { u32x4_t w; w.x = pk2(v0[0], v0[1]); w.y = pk2(v0[2], v0[3]); w.z = pk2(v1[0], v1[1]); w.w = pk2(v1[2], v1[3]); *(u32x4_t*)(XB + ro + bj * 128) = w;
            ss += ((v0[0] * v0[0] + v0[1] * v0[1]) + (v0[2] * v0[2] + v0[3] * v0[3])) + ((v1[0] * v1[0] + v1[1] * v1[1]) + (v1[2] * v1[2] + v1[3] * v1[3])); } }
        if (!out32) { ss += __shfl_xor(ss, 16); ss += __shfl_xor(ss, 32); if (fq == 0) fx_add(SS + row, ss); }
        asm volatile("" ::: "memory"); }
    }
  }
};
struct EpiA1 {
  static constexpr bool PERM = false, AFTER_DRAIN = false, TWICE = (PROBE_EPI_ACE != 0);
  const u64* SS1; bf16_t *U, *Q, *KB; const float *qw, *kw;
  DI void operator()(const f32x4 (&acc)[2][2][4][2], const Unit& u, int wr, int wc, int fr, int fq) const {
    const int row0 = u.pm * 256 + wr * 64 + fr, lc0 = wc * 64 + 8 * fq, region = u.pn >> 1;
    u64 rsv[8];
#pragma unroll
    for (int g = 0; g < 8; ++g) rsv[g] = SS1[row0 + (g >> 2) * 128 + (g & 3) * 16];
    if (region == 0) {
#pragma unroll
      for (int g = 0; g < 8; ++g) { const int ai = g >> 2, m = g & 3; const int row = row0 + ai * 128 + m * 16; const float rs = rs1024(rsv[g]);
#pragma unroll
        for (int bj = 0; bj < 2; ++bj) { const f32x4 a = acc[ai][bj][m][0] * rs, b = acc[ai][bj][m][1] * rs; u32x4_t w;
          w.x = pk2(gelu1(a[0]), gelu1(a[1])); w.y = pk2(gelu1(a[2]), gelu1(a[3])); w.z = pk2(gelu1(b[0]), gelu1(b[1])); w.w = pk2(gelu1(b[2]), gelu1(b[3]));
          *(u32x4_t*)(U + (size_t)row * 512 + u.pn * 256 + lc0 + 32 * bj) = w; } }
    } else {
      const bool isq = region == 1; const float* wp = (isq ? qw : kw) + 8 * fq; bf16_t* dst = (isq ? Q : KB) + (u.pn & 1) * 256 + lc0; const float sc = isq ? QSCALE : 1.0f;
      f32x4 wv[2][2];
#pragma unroll
      for (int bj = 0; bj < 2; ++bj)
#pragma unroll
        for (int n = 0; n < 2; ++n) wv[bj][n] = *(const f32x4*)(wp + 32 * bj + 4 * n);
#pragma unroll
      for (int g = 0; g < 8; ++g) { const int ai = g >> 2, m = g & 3; const int row = row0 + ai * 128 + m * 16; const float rs = rs1024(rsv[g]); float ss = 0.f; f32x4 v[2][2];
#pragma unroll
        for (int bj = 0; bj < 2; ++bj)
#pragma unroll
          for (int n = 0; n < 2; ++n) { v[bj][n] = acc[ai][bj][m][n] * rs; const f32x4 t = v[bj][n]; ss += (t[0] * t[0] + t[1] * t[1]) + (t[2] * t[2] + t[3] * t[3]); }
        ss += __shfl_xor(ss, 16); ss += __shfl_xor(ss, 32);
        const float r2 = rsqrtf(ss * (1.0f / 64.0f) + EPS) * sc;
#pragma unroll
        for (int bj = 0; bj < 2; ++bj) { const f32x4 a = v[bj][0] * r2 * wv[bj][0], b = v[bj][1] * r2 * wv[bj][1]; u32x4_t w;
          w.x = pk2(a[0], a[1]); w.y = pk2(a[2], a[3]); w.z = pk2(b[0], b[1]); w.w = pk2(b[2], b[3]);
          *(u32x4_t*)(dst + (size_t)row * 512 + 32 * bj) = w; } }
    }
  }
};
struct EpiA2 {
  static constexpr bool PERM = false, AFTER_DRAIN = false, TWICE = (PROBE_EPI_ACE != 0);
  const u64* SS1; bf16_t *GVT, *VT; u64* SSV; int vtp;
  DI void operator()(const f32x4 (&acc)[2][2][4][2], const Unit& u, int wr, int wc, int fr, int fq) const {
    const int colbase = u.pn * 256 + wc * 32;
    f32x4 rs[2][2];
#pragma unroll
    for (int bj = 0; bj < 2; ++bj)
#pragma unroll
      for (int n = 0; n < 2; ++n) { const u64* sp = SS1 + colbase + bj * 128 + n * 16 + 4 * fq; rs[bj][n] = (f32x4){rs1024(sp[0]), rs1024(sp[1]), rs1024(sp[2]), rs1024(sp[3])}; }
    if (u.pm < 2) {
#pragma unroll
      for (int ai = 0; ai < 2; ++ai) { const int head = 2 * u.pm + ai;
#pragma unroll
        for (int bj = 0; bj < 2; ++bj)
#pragma unroll
          for (int n = 0; n < 2; ++n) { f32x4 sq = (f32x4){0.f, 0.f, 0.f, 0.f}; const int tok = colbase + bj * 128 + n * 16 + 4 * fq;
#pragma unroll
            for (int m = 0; m < 4; ++m) { const int row = u.pm * 256 + ai * 128 + wr * 64 + m * 16 + fr;
              const f32x4 a = acc[ai][bj][m][n] * rs[bj][n]; f32x4 g; g[0] = gelu1(a[0]); g[1] = gelu1(a[1]); g[2] = gelu1(a[2]); g[3] = gelu1(a[3]);
              u32x2_t w; w.x = pk2(g[0], g[1]); w.y = pk2(g[2], g[3]); *(u32x2_t*)(GVT + (size_t)row * vtp + tok) = w; sq += g * g; }
#pragma unroll
            for (int e = 0; e < 4; ++e) sq[e] = row_sum16(sq[e]);
            if (fr == 0) {
#pragma unroll
              for (int e = 0; e < 4; ++e) fx_add(SSV + (size_t)(tok + e) * 4 + head, sq[e]); }
            asm volatile("" ::: "memory"); } }
    } else {
#pragma unroll
      for (int ai = 0; ai < 2; ++ai)
#pragma unroll
        for (int m = 0; m < 4; ++m) { const int row = (u.pm - 2) * 256 + ai * 128 + wr * 64 + m * 16 + fr;
#pragma unroll
          for (int bj = 0; bj < 2; ++bj)
#pragma unroll
            for (int n = 0; n < 2; ++n) { const f32x4 a = acc[ai][bj][m][n] * rs[bj][n]; u32x2_t w; w.x = pk2(a[0], a[1]); w.y = pk2(a[2], a[3]);
              *(u32x2_t*)(VT + (size_t)row * vtp + colbase + bj * 128 + n * 16 + 8 * (fq & 1) + 4 * (fq >> 1)) = w; } }
    }
  }
};
struct EpiD {
  static constexpr bool PERM = false, AFTER_DRAIN = false, TWICE = (PROBE_EPI_D != 0);
  const u64* SS2; const float *cw, *cb; bf16_t* F; float *GB, *PB, *UB;
  DI void operator()(const f32x4 (&acc)[2][2][4][2], const Unit& u, int wr, int wc, int fr, int fq) const {
    const int cbase = u.pn * 128 + wc * 32 + 8 * fq;
    const int rb0 = u.pm * 256 + wr * 64;
    u64 rsv[8]; f32x4 w0[2], w1[2], w2[2], bb[2];
#pragma unroll
    for (int g = 0; g < 8; ++g) rsv[g] = SS2[rb0 + (g >> 2) * 128 + (g & 3) * 16 + fr];
#pragma unroll
    for (int n = 0; n < 2; ++n) { w0[n] = *(const f32x4*)(cw + cbase + 4 * n); w1[n] = *(const f32x4*)(cw + DFF + cbase + 4 * n); w2[n] = *(const f32x4*)(cw + 2 * DFF + cbase + 4 * n); bb[n] = *(const f32x4*)(cb + cbase + 4 * n); }
#pragma unroll
    for (int ai = 0; ai < 2; ++ai) {
      const int rb = rb0 + ai * 128, bd = rb >> 6;
      float rs[4];
#pragma unroll
      for (int m = 0; m < 4; ++m) rs[m] = rs1024(rsv[ai * 4 + m]);
      unsigned fo[4][4];
#pragma unroll
      for (int n = 0; n < 2; ++n) {
        const int cn = cbase + 4 * n;
        f32x4 pg, ug, gg; float fv[4][4];
#pragma unroll
        for (int e = 0; e < 4; ++e) {
          float G[4], r1[4], r2[4];
#pragma unroll
          for (int m = 0; m < 4; ++m) { G[m] = acc[ai][0][m][n][e] * rs[m]; r1[m] = dpp_ror1(G[m]); r2[m] = dpp_ror2(G[m]); }
#pragma unroll
          for (int m = 0; m < 4; ++m) {
            const float p1 = (fr >= 1) ? r1[m] : (m > 0 ? r1[m > 0 ? m - 1 : 0] : 0.f);
            const float p2 = (fr >= 2) ? r2[m] : (m > 0 ? r2[m > 0 ? m - 1 : 0] : 0.f);
            const float g = w2[n][e] * G[m] + w1[n][e] * p1 + w0[n][e] * p2 + bb[n][e];
            const float uv = acc[ai][1][m][n][e] * rs[m];
            if (m == 0) { pg[e] = g; ug[e] = uv; }
            if (m == 3) gg[e] = G[3];
            fv[m][e] = g * __builtin_amdgcn_rcpf(1.0f + __expf(-g)) * uv;
          }
        }
#pragma unroll
        for (int m = 0; m < 4; ++m) { fo[m][2 * n] = pk2(fv[m][0], fv[m][1]); fo[m][2 * n + 1] = pk2(fv[m][2], fv[m][3]); }
        if (fr < 2) { *(f32x4*)(PB + (size_t)(bd * 2 + fr) * DFF + cn) = pg; *(f32x4*)(UB + (size_t)(bd * 2 + fr) * DFF + cn) = ug; }
        if (fr >= 14) { *(f32x4*)(GB + (size_t)(bd * 2 + fr - 14) * DFF + cn) = gg; }
      }
#pragma unroll
      for (int m = 0; m < 4; ++m) {
        if (!(m == 0 && fr < 2)) { u32x4_t w; w.x = fo[m][0]; w.y = fo[m][1]; w.z = fo[m][2]; w.w = fo[m][3]; *(u32x4_t*)(F + (size_t)(rb + 16 * m + fr) * DFF + cbase) = w; }
      }
    }
  }
};
DI void fixup_phase(const LP& lp, unsigned char* ws, int vcu, int loc) {
  const float *GB = (const float*)rbuf<RB_GB>(ws, vcu, loc), *PB = (const float*)rbuf<RB_PB>(ws, vcu, loc), *UB = (const float*)rbuf<RB_UB>(ws, vcu, loc); bf16_t* F = (bf16_t*)rbuf<RB_F>(ws, vcu, loc);
  const int t_ = tid_opaque(); const int w0 = loc ? (vcu >> 5) * 90112 + (vcu & 31) * 512 + t_ : blockIdx.x * 512 + t_, wend = loc ? ((vcu >> 5) + 1) * 90112 : 512 * 2 * 704, gsz = loc ? 32 * 512 : gridDim.x * 512;
  for (int w = w0; w < wend; w += gsz) {
    const int c = (w % 704) * 4, j = (w / 704) & 1, bd = w / 1408;
    f32x4 g = *(const f32x4*)(PB + (size_t)(bd * 2 + j) * DFF + c);
    if (bd & 31) { const f32x4 gm1 = *(const f32x4*)(GB + (size_t)((bd - 1) * 2 + 1) * DFF + c); const f32x4 w0 = *(const f32x4*)(lp.conv_w + c);
      if (j == 0) { const f32x4 gm2 = *(const f32x4*)(GB + (size_t)((bd - 1) * 2) * DFF + c); const f32x4 w1 = *(const f32x4*)(lp.conv_w + DFF + c); g += w1 * gm1 + w0 * gm2; }
      else g += w0 * gm1; }
    const f32x4 uv = *(const f32x4*)(UB + (size_t)(bd * 2 + j) * DFF + c); float f[4];
#pragma unroll
    for (int e = 0; e < 4; ++e) f[e] = g[e] * __builtin_amdgcn_rcpf(1.0f + __expf(-g[e])) * uv[e];
    u32x2_t o; o.x = pk2(f[0], f[1]); o.y = pk2(f[2], f[3]);
    *(u32x2_t*)(F + (size_t)(bd * 64 + j) * DFF + c) = o;
  }
}

DI void spatial_phase(const LP& lp, unsigned char* ws, LAS unsigned char* lds, int vcu, int loc) {
  const bf16_t *U = (const bf16_t*)rbuf<RB_U>(ws, vcu, loc), *GVT = (const bf16_t*)rbuf<RB_GVT>(ws, vcu, loc); const u64* SSV = (const u64*)(ws + OFF_SSV); bf16_t* MIX = (bf16_t*)rbuf<RB_MIX>(ws, vcu, loc);
  const int vtp = loc ? 4096 : T_TOK;
  constexpr int TB = 32768;
  LAS float* sr = (LAS float*)(lds + 2 * TB);
  const int tid = tid_opaque(), lane = tid & 63, w = __builtin_amdgcn_readfirstlane(tid >> 6), l15 = lane & 15, kq = lane >> 4;
#define SP_STAGE(item, buf) do { const int h_ = (item) & 3, t_ = ((item) >> 2) * 128; _Pragma("unroll") for (int i = 0; i < 4; ++i) { const int P = (w * 4 + i) * 64 + lane, row = P >> 4, pc = (P & 15) ^ (row & 15); \
    __builtin_amdgcn_global_load_lds((const unsigned*)(GVT + (size_t)(h_ * 128 + row) * vtp + t_ + pc * 8), (LAS unsigned*)(lds + (buf) * TB + (w * 4 + i) * 1024), 16, 0, 0); } } while (0)
  LAS float* vn_l = sr + 128; LAS float* on_l = vn_l + 512; LAS float* sb_l = on_l + 512;
  const int it_step = loc ? 1 : (int)gridDim.x, it_end = loc ? vcu * 4 + 4 : 1024;
  int it = loc ? vcu * 4 : (int)blockIdx.x, buf = 0;
  if (it < it_end) SP_STAGE(it, 0);
  { const float a = lp.v_norm_w[tid], b = lp.out_norm_w[tid], c = lp.sp_b[tid]; vn_l[tid] = a; on_l[tid] = b; sb_l[tid] = c; }
  asm volatile("s_waitcnt vmcnt(0)" ::: "memory");
  __syncthreads();
  const int x_lane = l15 * 256 + ((kq ^ l15) << 4);
  const int i0 = 16 * w, nks = (w < 4) ? 2 : 4;
  u32x4_t rawN[4]; u32x2_t urN[8]; u64 ssvN = 0ull;
#define SP_LOADREGS(item) do { const int h_ = (item) & 3, t_ = ((item) >> 2) * 128; \
    _Pragma("unroll") for (int ks = 0; ks < 4; ++ks) rawN[ks] = (ks < nks) ? *(const u32x4_t*)(lp.Wsp + (size_t)(h_ * 128 + i0 + l15) * 128 + ks * 32 + kq * 8) : (u32x4_t){0u, 0u, 0u, 0u}; \
    _Pragma("unroll") for (int dt = 0; dt < 8; ++dt) urN[dt] = *(const u32x2_t*)(U + (size_t)(t_ + i0 + l15) * 512 + h_ * 128 + 16 * dt + 4 * kq); \
    ssvN = (tid < 128) ? SSV[(size_t)(t_ + tid) * 4 + h_] : 0ull; } while (0)
  if (it < it_end) SP_LOADREGS(it);
  for (; it < it_end; it += it_step, buf ^= 1) {
    const int h = it & 3, tok0 = (it >> 2) * 128, irow = tok0 + i0 + l15;
    u32x4_t raw[4]; u32x2_t ur[8];
#pragma unroll
    for (int ks = 0; ks < 4; ++ks) raw[ks] = rawN[ks];
#pragma unroll
    for (int dt = 0; dt < 8; ++dt) ur[dt] = urN[dt];
    const u64 ssv = ssvN;
    const float bias = sb_l[h * 128 + i0 + l15];
    const int nit = it + it_step;
    if (nit < it_end) { SP_STAGE(nit, buf ^ 1); SP_LOADREGS(nit); }
    if (tid < 128) sr[tid] = rsqrtf(fx2f(ssv) * (1.0f / 128.0f) + EPS);
    __syncthreads();
    bf16x8 yf[4];
#pragma unroll
    for (int ks = 0; ks < 4; ++ks) { const LAS float* sp = sr + ks * 32 + kq * 8; const u32x4_t r = raw[ks]; u32x4_t o;
      o.x = pk2(bflo(r.x) * sp[0], bfhi(r.x) * sp[1]); o.y = pk2(bflo(r.y) * sp[2], bfhi(r.y) * sp[3]); o.z = pk2(bflo(r.z) * sp[4], bfhi(r.z) * sp[5]); o.w = pk2(bflo(r.w) * sp[6], bfhi(r.w) * sp[7]);
      yf[ks] = __builtin_bit_cast(bf16x8, o); }
    const LAS unsigned char* tb = lds + buf * TB;
    float o[8][4]; float ss = 0.f;
#pragma unroll
    for (int dt = 0; dt < 8; ++dt) {
      f32x4 acc = (f32x4){0.f, 0.f, 0.f, 0.f};
#pragma unroll
      for (int ks = 0; ks < 4; ++ks) if (ks < nks) {
        const bf16x8 xf = *(const LAS bf16x8*)(tb + dt * 4096 + (x_lane ^ (ks << 6)));
        acc = __builtin_amdgcn_mfma_f32_16x16x32_bf16(xf, yf[ks], acc, 0, 0, 0); }
      const int d0 = 16 * dt + 4 * kq; const f32x4 wv = *(const LAS f32x4*)(vn_l + h * 128 + d0);
      o[dt][0] = bflo(ur[dt].x) * (acc[0] * wv[0] + bias); o[dt][1] = bfhi(ur[dt].x) * (acc[1] * wv[1] + bias); o[dt][2] = bflo(ur[dt].y) * (acc[2] * wv[2] + bias); o[dt][3] = bfhi(ur[dt].y) * (acc[3] * wv[3] + bias);
      ss += (o[dt][0] * o[dt][0] + o[dt][1] * o[dt][1]) + (o[dt][2] * o[dt][2] + o[dt][3] * o[dt][3]);
    }
    ss += __shfl_xor(ss, 16); ss += __shfl_xor(ss, 32);
    const float rs = rsqrtf(ss * (1.0f / 128.0f) + EPS);
#pragma unroll
    for (int dt = 0; dt < 8; ++dt) { const int d0 = 16 * dt + 4 * kq; const f32x4 wo = *(const LAS f32x4*)(on_l + h * 128 + d0);
      u32x2_t q; q.x = pk2(o[dt][0] * rs * wo[0], o[dt][1] * rs * wo[1]); q.y = pk2(o[dt][2] * rs * wo[2], o[dt][3] * rs * wo[3]);
      *(u32x2_t*)(MIX + (size_t)irow * 1024 + h * 128 + d0) = q; }
    asm volatile("s_waitcnt vmcnt(8)" ::: "memory");
    __syncthreads();
  }
#undef SP_STAGE
#undef SP_LOADREGS
}

DI void attn_phase(const MParams& p, int l, LAS unsigned char* lds, int vcu, int loc) {
  unsigned char* ws = p.ws;
  const bf16_t *Q = (const bf16_t*)rbuf<RB_Q>(ws, vcu, loc), *KB = (const bf16_t*)rbuf<RB_KB>(ws, vcu, loc), *VT = (const bf16_t*)rbuf<RB_VT>(ws, vcu, loc); bf16_t* MIX = (bf16_t*)rbuf<RB_MIX>(ws, vcu, loc);
  const int vtp = loc ? 4096 : T_TOK;
  constexpr int KBUF = 16384, VBUF = 16384, STG = KBUF + VBUF, QOFF = 3 * STG;
  static_assert(QOFF + 65536 <= LDS_BYTES, "attention LDS");
  const unsigned sv0 = __builtin_amdgcn_readfirstlane(((volatile LAS unsigned*)(lds + 131072))[0]), sv1 = __builtin_amdgcn_readfirstlane(((volatile LAS unsigned*)(lds + 131072))[1]), sv2 = __builtin_amdgcn_readfirstlane(((volatile LAS unsigned*)(lds + 131072))[2]), sv3 = __builtin_amdgcn_readfirstlane(((volatile LAS unsigned*)(lds + 131072))[3]);
  __syncthreads();
  const float lambda_init = 0.8f - 0.6f * expf(-0.3f * (float)(l + 1));
  const float* dnw = p.in[13] + l * 128;
#pragma unroll 1
  for (int pi = vcu; pi < 256; pi += gridDim.x) {
    const int b = pi >> 4, h = (pi >> 2) & 3, j = pi & 3;
#pragma unroll 1
    for (int it = 0; it < 2; ++it) {
      const int tid = tid_opaque(), lane = tid & 63, w = __builtin_amdgcn_readfirstlane(tid >> 6), l31 = lane & 31, hh = lane >> 5;
      const int qb = it ? j : 7 - j, t0 = b * 2048 + 256 * qb, ntl = 4 * qb + 4, ntw = 4 * qb + (w >> 1) + 1;
#pragma unroll
      for (int i = 0; i < 8; ++i) { const int P = (w * 8 + i) * 64 + lane, row = P >> 4, pos = P & 15, pc = pos ^ (row & 15);
        __builtin_amdgcn_global_load_lds((const unsigned*)(Q + (size_t)(t0 + row) * 512 + h * 128 + pc * 8), (LAS unsigned*)(lds + QOFF + (w * 8 + i) * 1024), 16, 0, 0); }
      const bf16_t* kbase = KB + (size_t)(b * 2048) * 512 + h * 128; const bf16_t* vbase = VT + (size_t)(h * 128) * vtp + b * 2048;
      int koff[2], voff[2];
#pragma unroll
      for (int i = 0; i < 2; ++i) { const int P = (w * 2 + i) * 64 + lane; { const int row = P >> 4, pos = P & 15, pc = pos ^ (row & 15); koff[i] = row * 512 + pc * 8; }
        { const int row = P >> 3, pos = P & 7, pc = pos ^ ((row >> 1) & 7); voff[i] = row * vtp + pc * 8; } }
#define ATT_STAGE(kt, buf) do { _Pragma("unroll") for (int i = 0; i < 2; ++i) { \
        __builtin_amdgcn_global_load_lds((const unsigned*)(kbase + (size_t)(kt) * (64 * 512) + koff[i]), (LAS unsigned*)(lds + (buf) * STG + (w * 2 + i) * 1024), 16, 0, 0); \
        __builtin_amdgcn_global_load_lds((const unsigned*)(vbase + (kt) * 64 + voff[i]), (LAS unsigned*)(lds + (buf) * STG + KBUF + (w * 2 + i) * 1024), 16, 0, 0); } } while (0)
#define ATT_STAGE_AT(kt, soff) do { _Pragma("unroll") for (int i = 0; i < 2; ++i) { \
        __builtin_amdgcn_global_load_lds((const unsigned*)(kbase + (size_t)(kt) * (64 * 512) + koff[i]), (LAS unsigned*)(lds + (soff) + (w * 2 + i) * 1024), 16, 0, 0); \
        __builtin_amdgcn_global_load_lds((const unsigned*)(vbase + (kt) * 64 + voff[i]), (LAS unsigned*)(lds + (soff) + KBUF + (w * 2 + i) * 1024), 16, 0, 0); } } while (0)
      ATT_STAGE(0, 0);
      if (ntl > 1) { ATT_STAGE(1, 1); asm volatile("s_waitcnt vmcnt(4)" ::: "memory"); } else asm volatile("s_waitcnt vmcnt(0)" ::: "memory");
      __syncthreads();
      int st_cur = 0, st_pre = 2 * STG;
      f32x16 O[2][4];
#pragma unroll
      for (int c = 0; c < 2; ++c)
#pragma unroll
        for (int bk = 0; bk < 4; ++bk)
#pragma unroll
          for (int i = 0; i < 16; ++i) O[c][bk][i] = 0.f;
      float lsum[2] = {0.f, 0.f};
      const int qr = 32 * w + l31;
      int k_lane = l31 * 256 + ((hh ^ (l31 & 15)) << 4), q_lane = QOFF + qr * 256 + ((hh ^ (qr & 15)) << 4), v_lane = KBUF + l31 * 128 + ((hh ^ ((l31 >> 1) & 7)) << 4);
#pragma unroll 1
      for (int kt = 0; kt < ntl; ++kt) {
        if (kt + 2 < ntl) ATT_STAGE_AT(kt + 2, st_pre);
        if (kt < ntw) {
          asm volatile("" : "+v"(k_lane), "+v"(q_lane), "+v"(v_lane));
          const LAS unsigned char* tb = lds + st_cur;
#pragma unroll
          for (int kb = 0; kb < 2; ++kb) {
            bf16x8 pf[2][2];
#pragma unroll
            for (int c = 0; c < 2; ++c) {
              f32x16 S;
#pragma unroll
              for (int i = 0; i < 16; ++i) S[i] = 0.f;
#pragma unroll
              for (int ks = 0; ks < 4; ++ks) {
                const int xo = (c * 8 + ks * 2) << 4;
                const bf16x8 qf = *(const LAS bf16x8*)(lds + (q_lane ^ xo));
                const bf16x8 kf = *(const LAS bf16x8*)(tb + (k_lane ^ xo) + kb * 8192);
                S = __builtin_amdgcn_mfma_f32_32x32x16_bf16(kf, qf, S, 0, 0, 0);
              }
              float ls = 0.f;
#pragma unroll
              for (int hs = 0; hs < 2; ++hs) { u32x4_t pw;
#pragma unroll
                for (int t = 0; t < 4; ++t) { const float a = __builtin_amdgcn_exp2f(S[8 * hs + 2 * t]), bq = __builtin_amdgcn_exp2f(S[8 * hs + 2 * t + 1]); ls += a + bq; pw[t] = pk2(a, bq); }
                pf[c][hs] = __builtin_bit_cast(bf16x8, pw); }
              lsum[c] += ls;
              __builtin_amdgcn_sched_barrier(0);
            }
#pragma unroll
            for (int bk = 0; bk < 4; ++bk) {
              const bf16x8 v0 = *(const LAS bf16x8*)(tb + (v_lane ^ ((2 * kb) << 5)) + bk * 4096);
              const bf16x8 v1 = *(const LAS bf16x8*)(tb + (v_lane ^ ((2 * kb + 1) << 5)) + bk * 4096);
              O[0][bk] = __builtin_amdgcn_mfma_f32_32x32x16_bf16(v0, pf[0][0], O[0][bk], 0, 0, 0);
              O[1][bk] = __builtin_amdgcn_mfma_f32_32x32x16_bf16(v0, pf[1][0], O[1][bk], 0, 0, 0);
              O[0][bk] = __builtin_amdgcn_mfma_f32_32x32x16_bf16(v1, pf[0][1], O[0][bk], 0, 0, 0);
              O[1][bk] = __builtin_amdgcn_mfma_f32_32x32x16_bf16(v1, pf[1][1], O[1][bk], 0, 0, 0);
              __builtin_amdgcn_sched_barrier(0);
            }
          }
        }
        if (kt + 2 < ntl) asm volatile("s_waitcnt vmcnt(4)" ::: "memory"); else asm volatile("s_waitcnt vmcnt(0)" ::: "memory");
        __syncthreads();
        st_pre = st_cur; st_cur = (st_cur == 2 * STG) ? 0 : st_cur + STG;
      }
#undef ATT_STAGE
#undef ATT_STAGE_AT
      const int tid2 = tid_opaque(), lane2 = tid2 & 63, w2 = __builtin_amdgcn_readfirstlane(tid2 >> 6), hh2 = lane2 >> 5, qr2 = 32 * w2 + (lane2 & 31);
      float lam;
      { const float* q1 = p.in[9] + l * 64; const float* k1 = p.in[10] + l * 64; const float* q2 = p.in[11] + l * 64; const float* k2 = p.in[12] + l * 64;
        float a = q1[lane2] * k1[lane2], bq = q2[lane2] * k2[lane2]; a = wave_sum(a); bq = wave_sum(bq); lam = expf(a) - expf(bq) + lambda_init; }
      float l1 = lsum[0], l2 = lsum[1]; l1 += __shfl_xor(l1, 32); l2 += __shfl_xor(l2, 32);
      const float inv1 = 1.0f / l1, inv2 = lam / l2; float ss = 0.f;
#pragma unroll
      for (int bk = 0; bk < 4; ++bk)
#pragma unroll
        for (int i = 0; i < 16; ++i) { const float o = O[0][bk][i] * inv1 - O[1][bk][i] * inv2; O[0][bk][i] = o; ss += o * o; }
      ss += __shfl_xor(ss, 32);
      const float rs = rsqrtf(ss * (1.0f / 128.0f) + EPS) * (1.0f - lambda_init);
      bf16_t* orow = MIX + (size_t)(t0 + qr2) * 1024 + 512 + h * 128;
#pragma unroll
      for (int bk = 0; bk < 4; ++bk)
#pragma unroll
        for (int g = 0; g < 4; ++g) { const int dv0 = 32 * bk + 8 * g + 4 * hh2; const f32x4 wv = *(const f32x4*)(dnw + dv0);
          u32x2_t q; q.x = pk2(O[0][bk][4 * g] * rs * wv[0], O[0][bk][4 * g + 1] * rs * wv[1]); q.y = pk2(O[0][bk][4 * g + 2] * rs * wv[2], O[0][bk][4 * g + 3] * rs * wv[3]);
          *(u32x2_t*)(orow + dv0) = q; }
    }
  }
  __syncthreads();
  if (threadIdx.x == 0) { volatile LAS unsigned* stw = (volatile LAS unsigned*)(lds + 131072); stw[0] = sv0; stw[1] = sv1; stw[2] = sv2; stw[3] = sv3; }
  __syncthreads();
}


#define XB_TMO      128
#define XB_XCNT(j)  (256  + 64 * (j))
#define XB_XSUB(j)  (1280 + 64 * (j))
#define XB_XGEN(j)  (2304 + 64 * (j))
#define XB_TOP      3328
#define XB_TOPGEN   3392
#define XCD_BAR_WORDS 3456
#define XB_SPIN_CAP (1u << 18)

__device__ __forceinline__ unsigned xb_ld(unsigned* p)              { return __hip_atomic_load(p, __ATOMIC_RELAXED, __HIP_MEMORY_SCOPE_AGENT); }
__device__ __forceinline__ unsigned xb_add(unsigned* p, unsigned v) { return __hip_atomic_fetch_add(p, v, __ATOMIC_RELAXED, __HIP_MEMORY_SCOPE_AGENT); }
__device__ __forceinline__ unsigned xb_xcc_id() { return (unsigned)__builtin_amdgcn_s_getreg((3 << 11) | 20) & 0xFu; }
#define XB_SPIN(cond, bar) do { unsigned _sp = 0; while (cond) { __builtin_amdgcn_s_sleep(1); \
    if ((++_sp & 255u) == 0u) { if (xb_ld(&(bar)[XB_TMO])) break; if (_sp > XB_SPIN_CAP) { atomicAdd(&(bar)[XB_TMO], 1u); break; } } } } while (0)

struct XcdBarrier {
    unsigned* bar; unsigned x;
    volatile LAS unsigned* st;
};

__device__ __forceinline__ XcdBarrier xcd_barrier_post(unsigned* bar, volatile LAS unsigned* st) {
    XcdBarrier b; b.bar = bar; b.x = xb_xcc_id(); b.st = st;
    if (threadIdx.x == 0) st[2] = xb_add(&bar[XB_XCNT(b.x)], 1u);
    return b;
}
__device__ __forceinline__ void xcd_barrier_complete(unsigned* bar, unsigned x, unsigned& nloc, unsigned& nx) {
    const unsigned G = gridDim.x * gridDim.y * gridDim.z;
    unsigned sum, cnt, mine, sp = 0u;
    for (;;) {
        sum = 0u; cnt = 0u; mine = 0u;
#pragma unroll
        for (unsigned j = 0; j < 16; ++j) { const unsigned c = xb_ld(&bar[XB_XCNT(j)]); sum += c; cnt += (c > 0u) ? 1u : 0u; mine = (j == x) ? c : mine; }
        if (sum == G) break;
        __builtin_amdgcn_s_sleep(1);
        if ((++sp & 255u) == 0u) { if (xb_ld(&bar[XB_TMO])) break; if (sp > XB_SPIN_CAP) { atomicAdd(&bar[XB_TMO], 1u); break; } }
    }
    nloc = mine > 0u ? mine : 1u; nx = cnt > 0u ? cnt : 1u;
}

__device__ __forceinline__ void xcd_barrier(const XcdBarrier& b) {
    asm volatile("s_waitcnt vmcnt(0)" ::: "memory");
    __syncthreads();
    if (threadIdx.x == 0) {
        unsigned* bar = b.bar;
        __builtin_amdgcn_s_waitcnt(0);
        unsigned nloc = b.st[0], nx = b.st[1];
        if (nloc == 0u) { xcd_barrier_complete(bar, b.x, nloc, nx); b.st[0] = nloc; b.st[1] = nx; }
        const unsigned old = xb_add(&bar[XB_XSUB(b.x)], 1u);
        const unsigned gen = old / nloc;
        if (old + 1u == (gen + 1u) * nloc) {
            __builtin_amdgcn_fence(__ATOMIC_RELEASE, "agent");
            asm volatile("s_waitcnt vmcnt(0)" ::: "memory");
            const unsigned og = xb_add(&bar[XB_TOP], 1u);
            const unsigned tg = og / nx;
            if (og + 1u == (tg + 1u) * nx) xb_add(&bar[XB_TOPGEN], 1u);
            else XB_SPIN(xb_ld(&bar[XB_TOPGEN]) == tg, bar);
            __builtin_amdgcn_fence(__ATOMIC_ACQUIRE, "agent");
            xb_add(&bar[XB_XGEN(b.x)], 1u);
            asm volatile("s_waitcnt vmcnt(0)" ::: "memory");
        } else {
            XB_SPIN(xb_ld(&bar[XB_XGEN(b.x)]) == gen, bar);
            __builtin_amdgcn_fence(__ATOMIC_ACQUIRE, "agent");
            asm volatile("s_waitcnt vmcnt(0)" ::: "memory");
        }
    }
    __syncthreads();
}

#define XB_LSUB(j)  (3456 + 64 * (j))
#define XB_LGEN(j)  (4480 + 64 * (j))
#define XB_ALL_WORDS 5504
__device__ __forceinline__ void xcd_local_barrier(const XcdBarrier& b, unsigned target) {
    asm volatile("s_waitcnt vmcnt(0)" ::: "memory");
    __syncthreads();
    if (threadIdx.x == 0) {
        unsigned* ctr = &b.bar[XB_LSUB(b.x)];
        __builtin_amdgcn_s_waitcnt(0);
        __hip_atomic_fetch_add(ctr, 1u, __ATOMIC_RELAXED, __HIP_MEMORY_SCOPE_AGENT);
        XB_SPIN(xb_ld(ctr) < target, b.bar);
        __builtin_amdgcn_fence(__ATOMIC_ACQUIRE, "agent");
        asm volatile("s_waitcnt vmcnt(0)" ::: "memory");
    }
    __syncthreads();
}

DI void zero_u64(u64* p, int n, int vcu, int loc) {
  const int t = tid_opaque();
  if (loc) { const int per = n >> 3; u64* q = p + (size_t)(vcu >> 5) * per; for (int i = (vcu & 31) * 512 + t; i < per; i += 32 * 512) __hip_atomic_store(q + i, 0ull, __ATOMIC_RELAXED, __HIP_MEMORY_SCOPE_AGENT); }
  else for (int i = blockIdx.x * 512 + t; i < n; i += gridDim.x * 512) __hip_atomic_store(p + i, 0ull, __ATOMIC_RELAXED, __HIP_MEMORY_SCOPE_AGENT);
}
typedef pg8::StaticOrder OrderACE;
DI void phaseA(const MParams& p, int l, LAS unsigned char* lds, int cx, int vcu, int loc) {
  unsigned char* ws = p.ws; const bf16_t* XB = (const bf16_t*)(ws + OFF_XB); const bf16_t* WinT = (const bf16_t*)(ws + OFF_W + (size_t)l * W_STRIDE + WO_IN); const u64* SS1 = (const u64*)(ws + OFF_SS1);
  zero_u64((u64*)(ws + OFF_SS2), T_TOK, vcu, loc);
  { pg8::Gemm g{XB, WinT, T_TOK, 1536, DM}; OrderACE S; S.init(T_TOK, 1536, gridDim.x, cx);
    EpiA1 E{SS1, (bf16_t*)rbuf<RB_U>(ws, vcu, loc), (bf16_t*)rbuf<RB_Q>(ws, vcu, loc), (bf16_t*)rbuf<RB_KB>(ws, vcu, loc), p.in[7] + l * 64, p.in[8] + l * 64}; pg8::gemm_phase<EpiA1, OrderACE>(lds, g, S, E); }
  { pg8::Gemm g{WinT + (size_t)1536 * DM, XB, 1024, T_TOK, DM}; BalA2Order S; S.init(1024, T_TOK, gridDim.x, cx);
    EpiA2 E{SS1, (bf16_t*)rbuf<RB_GVT>(ws, vcu, loc), (bf16_t*)rbuf<RB_VT>(ws, vcu, loc), (u64*)(ws + OFF_SSV), loc ? 4096 : T_TOK}; pg8::gemm_phase<EpiA2, BalA2Order>(lds, g, S, E); }
}
DI void phaseCE(const MParams& p, int l, bool isC, LAS unsigned char* lds, int cx, int vcu, int loc) {
  unsigned char* ws = p.ws; const unsigned char* wb = ws + OFF_W + (size_t)l * W_STRIDE;
  if (isC) zero_u64((u64*)(ws + OFF_SS1), T_TOK, vcu, loc);
  pg8::Gemm g{(const bf16_t*)(isC ? rbuf<RB_MIX>(ws, vcu, loc) : rbuf<RB_F>(ws, vcu, loc)), (const bf16_t*)(wb + (isC ? WO_OUT : WO_DN)), T_TOK, DM, isC ? DM : DFF}; OrderACE S; S.init(T_TOK, DM, gridDim.x, cx);
  EpiResid E{(isC && l == 0) ? p.in[0] : nullptr, (!isC && l == NLAYER - 1) ? p.out : nullptr, (bf16_t*)(ws + OFF_XB), (u64*)(ws + (isC ? OFF_SS2 : OFF_SS1))}; pg8::gemm_phase<EpiResid, OrderACE>(lds, g, S, E);
}
DI void phaseD(const MParams& p, int l, LAS unsigned char* lds, int cx, int vcu, int loc) {
  unsigned char* ws = p.ws;
  zero_u64((u64*)(ws + OFF_SSV), T_TOK * 4, vcu, loc);
  pg8::Gemm g{(const bf16_t*)(ws + OFF_XB), (const bf16_t*)(ws + OFF_W + (size_t)l * W_STRIDE + WO_GU), T_TOK, 2 * DFF, DM};
#if PROBE_EPI_D
  DupOrder S;
#else
  pg8::StaticOrder S;
#endif
  S.init(T_TOK, 2 * DFF, gridDim.x, cx);
  EpiD E{(const u64*)(ws + OFF_SS2), p.in[18] + (size_t)l * 3 * DFF, p.in[19] + (size_t)l * DFF, (bf16_t*)rbuf<RB_F>(ws, vcu, loc), (float*)rbuf<RB_GB>(ws, vcu, loc), (float*)rbuf<RB_PB>(ws, vcu, loc), (float*)rbuf<RB_UB>(ws, vcu, loc)};
#if PROBE_EPI_D
  pg8::gemm_phase<EpiD, DupOrder>(lds, g, S, E);
#else
  pg8::gemm_phase<EpiD, pg8::StaticOrder>(lds, g, S, E);
#endif
}

__global__ void __launch_bounds__(512) k_run(MParams p) {
  extern __shared__ __attribute__((aligned(16))) unsigned char lds_raw[];
  LAS unsigned char* lds = (LAS unsigned char*)lds_raw;
  cg::grid_group grid = cg::this_grid();
  if (threadIdx.x < 4) ((LAS unsigned*)(lds + 131072))[threadIdx.x] = 0u;
  __syncthreads();
  XcdBarrier xbar = xcd_barrier_post((unsigned*)(p.ws + OFF_BAR), (volatile LAS unsigned*)(lds + 131072));
  if (p.ph_lo < 0) grid.sync();
  for (int ph = p.ph_lo; ph < p.ph_hi; ++ph) {
    const volatile LAS unsigned* stw = (const volatile LAS unsigned*)(lds + 131072);
    const int loc = (ph > 0) ? (int)__builtin_amdgcn_readfirstlane(stw[3]) : 0;
    const int xv = loc ? (int)xbar.x : (int)(blockIdx.x & 7), rv = loc ? (int)__builtin_amdgcn_readfirstlane(stw[2]) : (int)(blockIdx.x >> 3);
#define RUN_PHASES(LOC, CX, VCU) do { const int l = (ph - 1) / 6, s = (ph - 1) % 6; \
      if (s == 0) phaseA(p, l, lds, (CX), (VCU), (LOC)); \
      else if (s == 1) { attn_phase(p, l, lds, (VCU), (LOC)); const LP lp = make_lp(p, l); spatial_phase(lp, p.ws, lds, (VCU), (LOC)); } \
      else if (s == 2 || s == 5) phaseCE(p, l, s == 2, lds, (CX), (VCU), (LOC)); \
      else if (s == 3) phaseD(p, l, lds, (CX), (VCU), (LOC)); \
      else { const LP lp = make_lp(p, l); fixup_phase(lp, p.ws, (VCU), (LOC)); } } while (0)
    if (ph == 0) prologue(p, lds);
    else RUN_PHASES(1, rv * 8 + xv, xv * 32 + rv);
#undef RUN_PHASES
    if (ph + 1 < p.ph_hi) {
      const int sx = (ph - 1) % 6;
      (void)sx;
      if (ph == 0 || !loc) {
        xcd_barrier(xbar);
        if (ph == 0) {
          if (threadIdx.x == 0) { unsigned ok = (gridDim.x == 256u) ? 1u : 0u;
            for (unsigned j = 0; j < 16; ++j) { const unsigned c = xb_ld(&xbar.bar[XB_XCNT(j)]); if (c != (j < 8 ? 32u : 0u)) ok = 0u; }
            ((volatile LAS unsigned*)(lds + 131072))[3] = ok; }
          __syncthreads();
        }
      } else xcd_local_barrier(xbar, (unsigned)ph * 32u);
    }
  }
}

extern "C" void kernel_launch(void* const* d_in, const int* in_sizes, int n_in, void* d_out, int out_size, void* d_ws, size_t ws_size, hipStream_t stream) {
  static int grid_blocks = 0;
  if (!grid_blocks) {
    (void)hipFuncSetAttribute((const void*)k_run, hipFuncAttributeMaxDynamicSharedMemorySize, LDS_BYTES);
    int dev = 0, cus = 0, per_cu = 0; (void)hipGetDevice(&dev); (void)hipDeviceGetAttribute(&cus, hipDeviceAttributeMultiprocessorCount, dev);
    (void)hipOccupancyMaxActiveBlocksPerMultiprocessor(&per_cu, (const void*)k_run, 512, LDS_BYTES); if (per_cu < 1) per_cu = 1;
    grid_blocks = 256;
  }
  MParams mp; memset(&mp, 0, sizeof(mp));
  for (int i = 0; i < 21; ++i) mp.in[i] = (const float*)d_in[i];
  mp.out = (float*)d_out; mp.ws = (unsigned char*)d_ws; mp.ph_lo = 0; mp.ph_hi = 1 + 6 * NLAYER;
  (void)hipMemsetAsync((unsigned char*)d_ws + OFF_BAR, 0, 5504 * sizeof(unsigned), stream);
  void* args[] = {&mp};
  hipError_t e = hipLaunchCooperativeKernel((const void*)k_run, dim3(grid_blocks), dim3(512), args, LDS_BYTES, stream);
  if (e != hipSuccess) fprintf(stderr, "cooperative launch failed: %s (grid %d)\n", hipGetErrorString(e), grid_blocks);
}
```
